# Optimizing an MI355X kernel written in HIP

```python
import jax, jax.numpy as jnp
from jax import lax
import numpy as np

D_MODEL = 1024
BATCH = 16
SEQ = 2048
DEPTH = 1

D_MIX = D_MODEL
GLA_HEADS = 4
GLA_DK = 64
GLA_DV = 128
GLA_QK = GLA_HEADS * GLA_DK
GLA_WIDTH = GLA_HEADS * GLA_DV
GLA_GATE_RANK = 16
GLA_GATE_NORMALIZER = 16.0
GLA_CHUNK = 64
SG_GROUPS = 4
SG_CH = 128
SG_WIDTH = SG_GROUPS * SG_CH
SG_CHUNK = 128
IN_SPLITS = (GLA_QK, GLA_QK, GLA_WIDTH, GLA_WIDTH, GLA_GATE_RANK, SG_WIDTH, SG_WIDTH)
IN_COLS = sum(IN_SPLITS)
N_EXPERTS = 32
TOP_K = 4
D_EXPERT = D_MODEL
SWIGLU_LIMIT = 7.0
SWIGLU_ALPHA = 1.702
MOE_BLOCK = 128
EPS = 1e-6

kernel_name = 'hymba_gla_sgu_moe_layer'


def rmsnorm(x, w):
    xf = x.astype(jnp.float32)
    y = xf * lax.rsqrt(jnp.mean(xf * xf, axis=-1, keepdims=True) + EPS) * w.astype(jnp.float32)
    return y.astype(x.dtype)


def gla_chunked(q, k, v, log_a):
    B, S, H, K = q.shape
    C = GLA_CHUNK
    N = S // C

    def to_chunks(t):
        return t.reshape(B, N, C, H, t.shape[-1]).transpose(0, 3, 1, 2, 4)

    q, k, v, log_a = to_chunks(q) * (K ** -0.5), to_chunks(k), to_chunks(v), to_chunks(log_a)
    b = jnp.cumsum(log_a, axis=3)
    b_last = b[:, :, :, -1:, :]
    q_dec = q * jnp.exp(b)
    k_inv = k * jnp.exp(-b)
    k_to_end = k * jnp.exp(b_last - b)
    causal = jnp.tril(jnp.ones((C, C), dtype=bool))
    scores = jnp.where(causal, jnp.einsum('bhnck,bhnsk->bhncs', q_dec, k_inv), 0.0)
    o_intra = jnp.einsum('bhncs,bhnsv->bhncv', scores, v)
    chunk_update = jnp.einsum('bhnsk,bhnsv->bhnkv', k_to_end, v)
    chunk_decay = jnp.exp(b_last[:, :, :, 0, :])

    def step(state, inp):
        decay, update = inp
        return decay[..., None] * state + update, state

    state0 = jnp.zeros((B, H, K, v.shape[-1]), jnp.float32)
    _, state_prev = lax.scan(step, state0, (jnp.moveaxis(chunk_decay, 2, 0), jnp.moveaxis(chunk_update, 2, 0)))
    o_inter = jnp.einsum('bhnck,nbhkv->bhncv', q_dec, state_prev)
    o = o_intra + o_inter
    return o.transpose(0, 2, 3, 1, 4).reshape(B, S, H, -1)


def spatial_gating(u, v, ln_w, ln_b, w_s, b_s):
    B, S, _ = u.shape
    N = S // SG_CHUNK
    u = jax.nn.gelu(u)
    vf = jax.nn.gelu(v).astype(jnp.float32)
    mu = jnp.mean(vf, axis=-1, keepdims=True)
    var = jnp.mean(jnp.square(vf - mu), axis=-1, keepdims=True)
    vn = (vf - mu) * lax.rsqrt(var + EPS) * ln_w.astype(jnp.float32) + ln_b.astype(jnp.float32)
    vn = vn.reshape(B, N, SG_CHUNK, SG_GROUPS, SG_CH)
    causal = jnp.tril(jnp.ones((SG_CHUNK, SG_CHUNK), dtype=bool))
    w_causal = jnp.where(causal, w_s.astype(jnp.float32), 0.0)
    mixed = jnp.einsum('gts,bnsgc->bntgc', w_causal, vn) + b_s.astype(jnp.float32).T[:, :, None]
    return u * mixed.reshape(B, S, SG_WIDTH).astype(u.dtype)


def clamped_swiglu(gate, up):
    gate = jnp.minimum(gate, SWIGLU_LIMIT)
    up = jnp.clip(up, -SWIGLU_LIMIT, SWIGLU_LIMIT)
    return (up + 1.0) * (gate * jax.nn.sigmoid(SWIGLU_ALPHA * gate))


def moe(h, w_router, b_router, w_gate_up, b_gate_up, w_down, b_down):
    B, S, D = h.shape
    T = B * S
    xt = h.reshape(T, D)
    logits = (xt @ w_router + b_router).astype(jnp.float32)
    top_val, top_idx = lax.top_k(logits, TOP_K)
    top_w = jax.nn.softmax(top_val, axis=-1)
    flat_e = top_idx.reshape(-1)
    flat_tok = jnp.repeat(jnp.arange(T, dtype=jnp.int32), TOP_K)
    flat_w = top_w.reshape(-1)
    order = jnp.argsort(flat_e)
    sorted_e, sorted_tok, sorted_w = flat_e[order], flat_tok[order], flat_w[order]
    counts = jnp.bincount(flat_e, length=N_EXPERTS)
    starts = jnp.cumsum(counts) - counts
    padded = (counts + MOE_BLOCK - 1) // MOE_BLOCK * MOE_BLOCK
    padded_ends = jnp.cumsum(padded)
    padded_starts = padded_ends - padded
    rank = jnp.arange(T * TOP_K, dtype=jnp.int32) - starts[sorted_e]
    dest = padded_starts[sorted_e] + rank
    n_blocks = -(-(T * TOP_K) // MOE_BLOCK) + N_EXPERTS
    x_buf = jnp.zeros((n_blocks * MOE_BLOCK, D), h.dtype).at[dest].set(xt[sorted_tok])
    block_starts = jnp.arange(n_blocks, dtype=jnp.int32) * MOE_BLOCK
    block_e = jnp.minimum(jnp.searchsorted(padded_ends, block_starts, side='right'), N_EXPERTS - 1)

    def expert_block(args):
        xb, e = args
        gu = xb @ w_gate_up[e] + b_gate_up[e]
        y = clamped_swiglu(gu[:, :D_EXPERT], gu[:, D_EXPERT:])
        return y @ w_down[e] + b_down[e]

    y_buf = lax.map(expert_block, (x_buf.reshape(n_blocks, MOE_BLOCK, D), block_e))
    y_sorted = y_buf.reshape(-1, D)[dest]
    out = jnp.zeros((T, D), h.dtype).at[sorted_tok].add(y_sorted * sorted_w[:, None].astype(h.dtype))
    return out.reshape(B, S, D)


def setup_inputs(seed: int = 0) -> dict:
    key = jax.random.key(seed)
    ks = jax.random.split(key, 20)
    L = DEPTH
    nrm = jax.random.normal
    f32 = jnp.float32
    return {
        'x': nrm(ks[0], (BATCH, SEQ, D_MODEL), f32),
        'norm_mix_w': 1.0 + 0.02 * nrm(ks[1], (L, D_MODEL), f32),
        'w_in': nrm(ks[2], (L, D_MODEL, IN_COLS), f32) * D_MODEL ** -0.5,
        'w_gk_up': nrm(ks[3], (L, GLA_GATE_RANK, GLA_QK), f32) * GLA_GATE_RANK ** -0.5,
        'b_gk': 0.1 * nrm(ks[4], (L, GLA_QK), f32),
        'gla_norm_w': 1.0 + 0.02 * nrm(ks[5], (L, GLA_DV), f32),
        'sg_ln_w': 1.0 + 0.02 * nrm(ks[6], (L, SG_WIDTH), f32),
        'sg_ln_b': 0.02 * nrm(ks[7], (L, SG_WIDTH), f32),
        'w_spatial': nrm(ks[8], (L, SG_GROUPS, SG_CHUNK, SG_CHUNK), f32) * SG_CHUNK ** -0.5,
        'b_spatial': 1.0 + 0.02 * nrm(ks[9], (L, SG_GROUPS, SG_CHUNK), f32),
        'w_out': nrm(ks[10], (L, D_MIX, D_MODEL), f32) * D_MIX ** -0.5,
        'norm_ffn_w': 1.0 + 0.02 * nrm(ks[11], (L, D_MODEL), f32),
        'w_router': nrm(ks[12], (L, D_MODEL, N_EXPERTS), f32) * D_MODEL ** -0.5,
        'b_router': 0.01 * nrm(ks[13], (L, N_EXPERTS), f32),
        'w_gate_up': nrm(ks[14], (L, N_EXPERTS, D_MODEL, 2 * D_EXPERT), f32) * D_MODEL ** -0.5,
        'b_gate_up': 0.01 * nrm(ks[15], (L, N_EXPERTS, 2 * D_EXPERT), f32),
        'w_down': nrm(ks[16], (L, N_EXPERTS, D_EXPERT, D_MODEL), f32) * D_EXPERT ** -0.5,
        'b_down': 0.01 * nrm(ks[17], (L, N_EXPERTS, D_MODEL), f32),
        'norm_final_w': 1.0 + 0.02 * nrm(ks[18], (D_MODEL,), f32),
    }


def reference(x, norm_mix_w, w_in, w_gk_up, b_gk, gla_norm_w, sg_ln_w, sg_ln_b, w_spatial, b_spatial,
              w_out, norm_ffn_w, w_router, b_router, w_gate_up, b_gate_up, w_down, b_down, norm_final_w):
    B, S, _ = x.shape
    split_points = list(np.cumsum(IN_SPLITS)[:-1])
    for l in range(DEPTH):
        h = rmsnorm(x, norm_mix_w[l])
        proj = h @ w_in[l]
        q, k, v, g, gk_low, u_sg, v_sg = jnp.split(proj, split_points, axis=-1)
        log_a = jax.nn.log_sigmoid((gk_low @ w_gk_up[l] + b_gk[l]).astype(jnp.float32)) / GLA_GATE_NORMALIZER
        o = gla_chunked(q.astype(jnp.float32).reshape(B, S, GLA_HEADS, GLA_DK),
                        k.astype(jnp.float32).reshape(B, S, GLA_HEADS, GLA_DK),
                        v.astype(jnp.float32).reshape(B, S, GLA_HEADS, GLA_DV),
                        log_a.reshape(B, S, GLA_HEADS, GLA_DK))
        o = o * lax.rsqrt(jnp.mean(o * o, axis=-1, keepdims=True) + EPS) * gla_norm_w[l].astype(jnp.float32)
        o = o * jax.nn.silu(g.astype(jnp.float32)).reshape(B, S, GLA_HEADS, GLA_DV)
        gla_out = o.reshape(B, S, GLA_WIDTH).astype(x.dtype)
        sg_out = spatial_gating(u_sg, v_sg, sg_ln_w[l], sg_ln_b[l], w_spatial[l], b_spatial[l])
        mixed = jnp.concatenate([gla_out, sg_out], axis=-1)
        x = x + mixed @ w_out[l]
        h = rmsnorm(x, norm_ffn_w[l])
        x = x + moe(h, w_router[l], b_router[l], w_gate_up[l], b_gate_up[l], w_down[l], b_down[l])
    return rmsnorm(x, norm_final_w)
```

```cpp
#include <hip/hip_runtime.h>
#include <cstdio>
#include <cstdint>

constexpr int T = 32768, D = 1024, SEQ = 2048, NB = 16;
constexpr int NIN_SRC = 2576, NPROJ = 2816;
constexpr int PC_Q = 0, PC_K = 256, PC_V = 512, PC_G = 1024, PC_GK = 1536, PC_U = 1792, PC_VS = 2304;
constexpr int NE = 32, TOPK = 4, DE = 1024;
constexpr int MT = 256;
constexpr int MAXSLOTS = T * TOPK + NE * MT;
constexpr float EPS = 1e-6f;

typedef unsigned short bf16;
typedef unsigned v4u __attribute__((ext_vector_type(4)));
typedef float f32x4 __attribute__((ext_vector_type(4)));

constexpr size_t MiB = 1u << 20;
constexpr size_t WS_CTL   = 0;
constexpr size_t WS_WIN   = 1 * MiB;
constexpr size_t WS_WOUT  = 7 * MiB;
constexpr size_t WS_WSP   = 9 * MiB;
constexpr size_t WS_ROUTE = 10 * MiB;
constexpr size_t WS_WGU   = 20 * MiB;
constexpr size_t WS_WD    = 148 * MiB;
constexpr size_t WS_X1    = 212 * MiB;
constexpr size_t WS_ACT   = 340 * MiB;
constexpr size_t WS_PROJ  = 612 * MiB;
constexpr size_t WS_MIX   = 788 * MiB;
constexpr size_t WS_H     = 852 * MiB;
constexpr size_t WS_YBUF  = WS_PROJ;
constexpr size_t WS_VN    = WS_ACT;
constexpr size_t WS_END   = 916 * MiB;
static_assert(WS_YBUF + (size_t)MAXSLOTS * 1024 * 2 <= WS_END, "ybuf fits");
static_assert(WS_ACT + (size_t)MAXSLOTS * 1024 * 2 <= WS_PROJ, "act fits");
constexpr size_t RT_ROWTOK = 0;
constexpr size_t RT_ROWW   = 4 * MiB;
constexpr size_t RT_TOKSLOT= 8 * MiB;
constexpr int CW_COUNTS = 64;
constexpr int CW_PSTART = 128;

__device__ __forceinline__ unsigned f2bf(float f) { unsigned u = __builtin_bit_cast(unsigned, f); return (u + 0x7fffu + ((u >> 16) & 1u)) >> 16; }
__device__ __forceinline__ float bf2f(unsigned h) { return __builtin_bit_cast(float, h << 16); }
__device__ __forceinline__ unsigned pk2(float lo, float hi) { return f2bf(lo) | (f2bf(hi) << 16); }
__device__ __forceinline__ float gelu_tanh(float x) { const float u = 0.7978845608028654f * (x + 0.044715f * x * x * x); return x / (1.0f + __expf(-2.0f * u)); }
__device__ __forceinline__ float silu(float x) { return x / (1.0f + __expf(-x)); }
__device__ __forceinline__ float log_sigmoid(float x) { return fminf(x, 0.0f) - log1pf(__expf(-fabsf(x))); }
__device__ __forceinline__ float wave_sum(float v) {
#pragma unroll
    for (int o = 1; o < 64; o <<= 1) v += __shfl_xor(v, o);
    return v;
}

struct Ptrs {
    const float *x, *norm_mix_w, *w_in, *w_gk_up, *b_gk, *gla_norm_w, *sg_ln_w, *sg_ln_b, *w_spatial, *b_spatial, *w_out, *norm_ffn_w,
                *w_router, *b_router, *w_gate_up, *b_gate_up, *w_down, *b_down, *norm_final_w;
    float* out; unsigned char* ws;
};

__device__ __forceinline__ void p0_tr_write(bf16* WT, int K, int d0, int k0, const float* scr, int lane) {
    const int c = lane & 7;
#pragma unroll
    for (int j = 0; j < 4; ++j) { const int n = (lane >> 3) + 8 * j; const float* s = scr + (8 * c) * 33 + n;
        v4u o; o.x = pk2(s[0 * 33], s[1 * 33]); o.y = pk2(s[2 * 33], s[3 * 33]); o.z = pk2(s[4 * 33], s[5 * 33]); o.w = pk2(s[6 * 33], s[7 * 33]);
        *(v4u*)(WT + (size_t)(d0 + n) * K + k0 + 8 * c) = o; }
}
__device__ __forceinline__ void p0_transpose_item(const float* W, int ldn, int n0, int k0, bf16* WT, int K, int d0, float* scr, int lane) {
#pragma unroll 8
    for (int i = 0; i < 32; ++i) { const int kk = 2 * i + (lane >> 5); scr[kk * 33 + (lane & 31)] = W[(size_t)(k0 + kk) * ldn + n0 + (lane & 31)]; }
    __builtin_amdgcn_wave_barrier(); asm volatile("s_waitcnt lgkmcnt(0)" ::: "memory");
    p0_tr_write(WT, K, d0, k0, scr, lane);
    asm volatile("s_waitcnt lgkmcnt(0)" ::: "memory"); __builtin_amdgcn_wave_barrier();
}
__device__ __forceinline__ void p0_gk_item(const float* w_in, const float* w_gk_up, int j0, int k0, bf16* WT, float* scr, int lane) {
    for (int i = 0; i < 32; ++i) { const int kk = 2 * i + (lane >> 5), j = j0 + (lane & 31); float s = 0.f;
#pragma unroll
        for (int r = 0; r < 16; ++r) s += w_in[(size_t)(k0 + kk) * NIN_SRC + 1536 + r] * w_gk_up[r * 256 + j];
        scr[kk * 33 + (lane & 31)] = s; }
    __builtin_amdgcn_wave_barrier(); asm volatile("s_waitcnt lgkmcnt(0)" ::: "memory");
    p0_tr_write(WT, D, PC_GK + j0, k0, scr, lane);
    asm volatile("s_waitcnt lgkmcnt(0)" ::: "memory"); __builtin_amdgcn_wave_barrier();
}
constexpr int IT_IN = (NPROJ / 32) * 16, IT_OUT = 32 * 16, IT_GU = NE * 64 * 16, IT_DN = NE * 32 * 16, IT_ALL = IT_IN + IT_OUT + IT_GU + IT_DN;
__device__ __forceinline__ void p0_weight_item(const Ptrs& P, int it, float* scr, int lane) {
    bf16* WinT = (bf16*)(P.ws + WS_WIN); bf16* WoutT = (bf16*)(P.ws + WS_WOUT); bf16* WguT = (bf16*)(P.ws + WS_WGU); bf16* WdT = (bf16*)(P.ws + WS_WD);
    if (it < IT_IN) { const int db = it / 16, kb = it % 16, d0 = db * 32;
        if (d0 >= PC_GK && d0 < PC_U) p0_gk_item(P.w_in, P.w_gk_up, d0 - PC_GK, kb * 64, WinT, scr, lane);
        else p0_transpose_item(P.w_in, NIN_SRC, d0 < PC_GK ? d0 : d0 - 240, kb * 64, WinT, D, d0, scr, lane);
        return; }
    it -= IT_IN;
    if (it < IT_OUT) { const int db = it / 16, kb = it % 16; p0_transpose_item(P.w_out, D, db * 32, kb * 64, WoutT, D, db * 32, scr, lane); return; }
    it -= IT_OUT;
    if (it < IT_GU) { const int e = it / 1024, r = it % 1024, db = r / 16, kb = r % 16, d0 = db * 32, pn = d0 >> 8, bj = (d0 >> 7) & 1, rr = d0 & 127;
        p0_transpose_item(P.w_gate_up + (size_t)e * D * 2048, 2048, bj * 1024 + 128 * pn + rr, kb * 64, WguT + (size_t)e * 2048 * D, D, d0, scr, lane); return; }
    it -= IT_GU;
    { const int e = it / 512, r = it % 512, db = r / 16, kb = r % 16;
      p0_transpose_item(P.w_down + (size_t)e * DE * D, D, db * 32, kb * 64, WdT + (size_t)e * D * DE, DE, db * 32, scr, lane); }
}
__device__ __forceinline__ void rms_row_to_bf16(const float* xrow, const float* w, bf16* orow, int lane) {
    const f32x4* xr = (const f32x4*)xrow + lane; const f32x4* wr = (const f32x4*)w + lane;
    f32x4 v[4]; float s = 0.f;
#pragma unroll
    for (int j = 0; j < 4; ++j) { v[j] = xr[64 * j]; s += (v[j].x * v[j].x + v[j].y * v[j].y) + (v[j].z * v[j].z + v[j].w * v[j].w); }
    const float rstd = 1.0f / sqrtf(wave_sum(s) * (1.f / D) + EPS);
    unsigned long long* o8 = (unsigned long long*)orow + lane;
#pragma unroll
    for (int j = 0; j < 4; ++j) { const f32x4 ww = wr[64 * j];
        o8[64 * j] = (unsigned long long)pk2(v[j].x * rstd * ww.x, v[j].y * rstd * ww.y) | ((unsigned long long)pk2(v[j].z * rstd * ww.z, v[j].w * rstd * ww.w) << 32); }
}
__global__ void __launch_bounds__(256) k_p0(Ptrs P) {
    __shared__ float scr_all[4 * 64 * 33];
    const int tid = threadIdx.x, lane = tid & 63, wave = tid >> 6;
    float* scr = scr_all + wave * 64 * 33;
    const int gw = blockIdx.x * 4 + wave, NGW = gridDim.x * 4;
    for (int it = gw; it < IT_ALL; it += NGW) p0_weight_item(P, it, scr, lane);
    bf16* Wsp = (bf16*)(P.ws + WS_WSP);
    for (int i = blockIdx.x * 256 + tid; i < 4 * 128 * 128; i += gridDim.x * 256) { const int t = (i >> 7) & 127, s = i & 127; Wsp[i] = (bf16)f2bf(s <= t ? P.w_spatial[i] : 0.f); }
    bf16* H = (bf16*)(P.ws + WS_H);
    for (int m = gw; m < T; m += NGW) rms_row_to_bf16(P.x + (size_t)m * D, P.norm_mix_w, H + (size_t)m * D, lane);
}

template <int MODE>
__global__ void __launch_bounds__(256) n_gemm(Ptrs P) {
    __shared__ __attribute__((aligned(16))) float As[32][68];
    __shared__ __attribute__((aligned(16))) float Bs[32][68];
    __shared__ __attribute__((aligned(16))) float Bs2[MODE == 2 ? 32 : 1][68];
    const int tid = threadIdx.x, ty = tid >> 4, tx = tid & 15;
    const unsigned* ctl = (const unsigned*)(P.ws + WS_CTL);
    const int e = (MODE >= 2) ? blockIdx.z : 0;
    const int m0 = blockIdx.y * 64, n0 = blockIdx.x * 64;
    int count = T; size_t slot0 = 0;
    if (MODE >= 2) { count = (int)ctl[CW_COUNTS + e]; slot0 = ctl[CW_PSTART + e]; if (m0 >= count) return; }
    const bf16* A; const bf16* Bt; const bf16* Bt2 = nullptr; int K = D;
    const int lr = tid >> 2, lk = (tid & 3) * 8;
    size_t arow;
    if (MODE == 0) { A = (const bf16*)(P.ws + WS_H); Bt = (const bf16*)(P.ws + WS_WIN) + (size_t)n0 * D; arow = m0 + lr; }
    else if (MODE == 1) { A = (const bf16*)(P.ws + WS_MIX); Bt = (const bf16*)(P.ws + WS_WOUT) + (size_t)n0 * D; arow = m0 + lr; }
    else if (MODE == 2) { A = (const bf16*)(P.ws + WS_H); const int* rowtok = (const int*)(P.ws + WS_ROUTE + RT_ROWTOK) + (size_t)e * T;
        const int mm = (m0 + lr < count) ? m0 + lr : 0; arow = rowtok[mm];
        const int pn = n0 >> 7, r0 = n0 & 127; Bt = (const bf16*)(P.ws + WS_WGU) + ((size_t)e * 2048 + 256 * pn + r0) * D; Bt2 = Bt + (size_t)128 * D; }
    else { A = (const bf16*)(P.ws + WS_ACT); arow = slot0 + ((m0 + lr < count) ? m0 + lr : 0); Bt = (const bf16*)(P.ws + WS_WD) + ((size_t)e * D + n0) * DE; K = DE; }
    float acc[4][4] = {}, acc2[4][4] = {};
    for (int k0 = 0; k0 < K; k0 += 32) {
        { const v4u a = *(const v4u*)(A + arow * K + k0 + lk); const unsigned aw[4] = {a.x, a.y, a.z, a.w};
#pragma unroll
          for (int j = 0; j < 4; ++j) { As[lk + 2 * j][lr] = bf2f(aw[j] & 0xffffu); As[lk + 2 * j + 1][lr] = bf2f(aw[j] >> 16); } }
        { const v4u b = *(const v4u*)(Bt + (size_t)lr * K + k0 + lk); const unsigned bw[4] = {b.x, b.y, b.z, b.w};
#pragma unroll
          for (int j = 0; j < 4; ++j) { Bs[lk + 2 * j][lr] = bf2f(bw[j] & 0xffffu); Bs[lk + 2 * j + 1][lr] = bf2f(bw[j] >> 16); } }
        if (MODE == 2) { const v4u b = *(const v4u*)(Bt2 + (size_t)lr * K + k0 + lk); const unsigned bw[4] = {b.x, b.y, b.z, b.w};
#pragma unroll
          for (int j = 0; j < 4; ++j) { Bs2[lk + 2 * j][lr] = bf2f(bw[j] & 0xffffu); Bs2[lk + 2 * j + 1][lr] = bf2f(bw[j] >> 16); } }
        __syncthreads();
#pragma unroll 8
        for (int k = 0; k < 32; ++k) {
            const f32x4 a = *(const f32x4*)&As[k][ty * 4], b = *(const f32x4*)&Bs[k][tx * 4];
#pragma unroll
            for (int i = 0; i < 4; ++i)
#pragma unroll
                for (int j = 0; j < 4; ++j) acc[i][j] += a[i] * b[j];
            if (MODE == 2) { const f32x4 b2 = *(const f32x4*)&Bs2[k][tx * 4];
#pragma unroll
                for (int i = 0; i < 4; ++i)
#pragma unroll
                    for (int j = 0; j < 4; ++j) acc2[i][j] += a[i] * b2[j]; }
        }
        __syncthreads();
    }
#pragma unroll
    for (int i = 0; i < 4; ++i) {
        const int m = m0 + ty * 4 + i, n = n0 + tx * 4;
        if (MODE == 0) { bf16* o = (bf16*)(P.ws + WS_PROJ) + (size_t)m * NPROJ + n; *(uint2*)o = make_uint2(pk2(acc[i][0], acc[i][1]), pk2(acc[i][2], acc[i][3])); }
        else if (MODE == 1) { const f32x4 xr = *(const f32x4*)(P.x + (size_t)m * D + n); float* o = (float*)(P.ws + WS_X1) + (size_t)m * D + n;
            *(f32x4*)o = (f32x4){xr.x + acc[i][0], xr.y + acc[i][1], xr.z + acc[i][2], xr.w + acc[i][3]}; }
        else if (MODE == 2) { if (m < count) { float y[4];
#pragma unroll
                for (int j = 0; j < 4; ++j) { float g = acc[i][j] + P.b_gate_up[(size_t)e * 2048 + n + j], u = acc2[i][j] + P.b_gate_up[(size_t)e * 2048 + 1024 + n + j];
                    g = fminf(g, 7.0f); u = fminf(fmaxf(u, -7.0f), 7.0f); y[j] = (u + 1.0f) * (g / (1.0f + __expf(-1.702f * g))); }
                bf16* o = (bf16*)(P.ws + WS_ACT) + (slot0 + m) * DE + n; *(uint2*)o = make_uint2(pk2(y[0], y[1]), pk2(y[2], y[3])); } }
        else { if (m < count) { const float w = ((const float*)(P.ws + WS_ROUTE + RT_ROWW))[(size_t)e * T + m]; float y[4];
#pragma unroll
                for (int j = 0; j < 4; ++j) y[j] = (acc[i][j] + P.b_down[(size_t)e * D + n + j]) * w;
                bf16* o = (bf16*)(P.ws + WS_YBUF) + (slot0 + m) * D + n; *(uint2*)o = make_uint2(pk2(y[0], y[1]), pk2(y[2], y[3])); } }
    }
}

__global__ void __launch_bounds__(128) n_gla(Ptrs P) {
    __shared__ float sq[64], sk[64], sa[64], red[2];
    const int b = blockIdx.x >> 2, h = blockIdx.x & 3, v = threadIdx.x;
    const bf16* PROJ = (const bf16*)(P.ws + WS_PROJ); bf16* MIX = (bf16*)(P.ws + WS_MIX);
    float S[64];
#pragma unroll
    for (int k = 0; k < 64; ++k) S[k] = 0.f;
    const float nw = P.gla_norm_w[v];
    for (int t = 0; t < SEQ; ++t) {
        const size_t row = (size_t)(b * SEQ + t) * NPROJ;
        if (v < 64) { sq[v] = bf2f(PROJ[row + PC_Q + h * 64 + v]) * 0.125f; sk[v] = bf2f(PROJ[row + PC_K + h * 64 + v]);
            sa[v] = __expf(log_sigmoid(bf2f(PROJ[row + PC_GK + h * 64 + v]) + P.b_gk[h * 64 + v]) * (1.0f / 16.0f)); }
        const float vv = bf2f(PROJ[row + PC_V + h * 128 + v]), g = bf2f(PROJ[row + PC_G + h * 128 + v]);
        __syncthreads();
        float o = 0.f;
#pragma unroll
        for (int k = 0; k < 64; ++k) { S[k] = sa[k] * S[k] + sk[k] * vv; o += sq[k] * S[k]; }
        const float ss = wave_sum(o * o);
        if ((v & 63) == 0) red[v >> 6] = ss;
        __syncthreads();
        const float rstd = 1.0f / sqrtf((red[0] + red[1]) * (1.0f / 128.0f) + EPS);
        MIX[(size_t)(b * SEQ + t) * D + h * 128 + v] = (bf16)f2bf(o * rstd * nw * silu(g));
    }
}
__global__ void __launch_bounds__(256) n_sgu_vn(Ptrs P) {
    const int lane = threadIdx.x & 63, m = blockIdx.x * 4 + (threadIdx.x >> 6);
    const bf16* PROJ = (const bf16*)(P.ws + WS_PROJ); float* VN = (float*)(P.ws + WS_VN);
    const v4u raw = *(const v4u*)(PROJ + (size_t)m * NPROJ + PC_VS + lane * 8); const unsigned w[4] = {raw.x, raw.y, raw.z, raw.w};
    float g[8]; float s = 0.f;
#pragma unroll
    for (int j = 0; j < 4; ++j) { g[2 * j] = gelu_tanh(bf2f(w[j] & 0xffffu)); g[2 * j + 1] = gelu_tanh(bf2f(w[j] >> 16)); s += g[2 * j] + g[2 * j + 1]; }
    const float mu = wave_sum(s) * (1.0f / 512.0f); float q = 0.f;
#pragma unroll
    for (int j = 0; j < 8; ++j) { g[j] -= mu; q += g[j] * g[j]; }
    const float rstd = 1.0f / sqrtf(wave_sum(q) * (1.0f / 512.0f) + EPS);
#pragma unroll
    for (int j = 0; j < 8; ++j) VN[(size_t)m * 512 + lane * 8 + j] = g[j] * rstd * P.sg_ln_w[lane * 8 + j] + P.sg_ln_b[lane * 8 + j];
}
__global__ void __launch_bounds__(256) n_sgu_mix(Ptrs P) {
    const int bn = blockIdx.x >> 2, g = blockIdx.x & 3, c = threadIdx.x & 127;
    const float* VN = (const float*)(P.ws + WS_VN); const bf16* PROJ = (const bf16*)(P.ws + WS_PROJ); bf16* MIX = (bf16*)(P.ws + WS_MIX);
    const size_t base = (size_t)bn * 128;
    for (int t = threadIdx.x >> 7; t < 128; t += 2) {
        float acc = 0.f; const float* wrow = P.w_spatial + ((size_t)g * 128 + t) * 128;
        for (int s = 0; s <= t; ++s) acc += wrow[s] * VN[(base + s) * 512 + g * 128 + c];
        acc += P.b_spatial[g * 128 + t];
        const float u = gelu_tanh(bf2f(PROJ[(base + t) * NPROJ + PC_U + g * 128 + c]));
        MIX[(base + t) * D + 512 + g * 128 + c] = (bf16)f2bf(u * acc);
    }
}
__global__ void __launch_bounds__(256) n_router(Ptrs P) {
    const int lane = threadIdx.x & 63, m = blockIdx.x * 4 + (threadIdx.x >> 6);
    const float* X1 = (const float*)(P.ws + WS_X1) + (size_t)m * D; bf16* H2 = (bf16*)(P.ws + WS_H) + (size_t)m * D;
    unsigned* ctl = (unsigned*)(P.ws + WS_CTL);
    f32x4 v[4]; float s = 0.f;
#pragma unroll
    for (int j = 0; j < 4; ++j) { v[j] = ((const f32x4*)X1)[lane + 64 * j]; s += (v[j].x * v[j].x + v[j].y * v[j].y) + (v[j].z * v[j].z + v[j].w * v[j].w); }
    const float rstd = 1.0f / sqrtf(wave_sum(s) * (1.f / D) + EPS);
#pragma unroll
    for (int j = 0; j < 4; ++j) { const f32x4 ww = ((const f32x4*)P.norm_ffn_w)[lane + 64 * j];
        ((unsigned long long*)H2)[lane + 64 * j] = (unsigned long long)pk2(v[j].x * rstd * ww.x, v[j].y * rstd * ww.y) | ((unsigned long long)pk2(v[j].z * rstd * ww.z, v[j].w * rstd * ww.w) << 32); }
    const int e = lane & 31, half = lane >> 5; float acc = 0.f;
    for (int k = half * 512; k < half * 512 + 512; ++k) acc += X1[k] * P.norm_ffn_w[k] * P.w_router[(size_t)k * NE + e];
    acc += __shfl_xor(acc, 32);
    float logit = acc * rstd + P.b_router[e];
    int sel_e[4]; float sel_v[4];
#pragma unroll
    for (int r = 0; r < 4; ++r) { float bv = logit; int bi = e;
#pragma unroll
        for (int o = 1; o < 32; o <<= 1) { const float ov = __shfl_xor(bv, o); const int oi = __shfl_xor(bi, o); if (ov > bv || (ov == bv && oi < bi)) { bv = ov; bi = oi; } }
        sel_e[r] = bi; sel_v[r] = bv; if (e == bi) logit = -3.0e38f; }
    float den = 0.f, pw[4];
#pragma unroll
    for (int r = 0; r < 4; ++r) { pw[r] = __expf(sel_v[r] - sel_v[0]); den += pw[r]; }
    if (lane < 4) { int ee = sel_e[0]; float ww = pw[0];
#pragma unroll
        for (int r = 1; r < 4; ++r) if (lane == r) { ee = sel_e[r]; ww = pw[r]; }
        ww /= den;
        const unsigned rank = atomicAdd(&ctl[CW_COUNTS + ee], 1u);
        ((int*)(P.ws + WS_ROUTE + RT_ROWTOK))[(size_t)ee * T + rank] = m;
        ((float*)(P.ws + WS_ROUTE + RT_ROWW))[(size_t)ee * T + rank] = ww;
        ((int*)(P.ws + WS_ROUTE + RT_TOKSLOT))[(size_t)m * 4 + lane] = (ee << 16) | (int)rank; }
}
__global__ void n_pstart(Ptrs P) { unsigned* ctl = (unsigned*)(P.ws + WS_CTL); unsigned s = 0; for (int e = 0; e < NE; ++e) { ctl[CW_PSTART + e] = s; s += (ctl[CW_COUNTS + e] + MT - 1) / MT * MT; } ctl[CW_PSTART + NE] = s; }
__global__ void __launch_bounds__(256) n_final(Ptrs P) {
    const int lane = threadIdx.x & 63, m = blockIdx.x * 4 + (threadIdx.x >> 6);
    const unsigned* ctl = (const unsigned*)(P.ws + WS_CTL);
    const float* X1 = (const float*)(P.ws + WS_X1) + (size_t)m * D; const bf16* Y = (const bf16*)(P.ws + WS_YBUF);
    const int* ts = (const int*)(P.ws + WS_ROUTE + RT_TOKSLOT) + (size_t)m * 4;
    f32x4 v[4];
#pragma unroll
    for (int j = 0; j < 4; ++j) v[j] = ((const f32x4*)X1)[lane + 64 * j];
#pragma unroll
    for (int r = 0; r < 4; ++r) { const int pk = ts[r]; const size_t slot = (size_t)ctl[CW_PSTART + (pk >> 16)] + (pk & 0xffff);
#pragma unroll
        for (int j = 0; j < 4; ++j) { const uint2 y = ((const uint2*)(Y + slot * D))[lane + 64 * j];
            v[j].x += bf2f(y.x & 0xffffu); v[j].y += bf2f(y.x >> 16); v[j].z += bf2f(y.y & 0xffffu); v[j].w += bf2f(y.y >> 16); } }
    float s = 0.f;
#pragma unroll
    for (int j = 0; j < 4; ++j) s += (v[j].x * v[j].x + v[j].y * v[j].y) + (v[j].z * v[j].z + v[j].w * v[j].w);
    const float rstd = 1.0f / sqrtf(wave_sum(s) * (1.f / D) + EPS);
#pragma unroll
    for (int j = 0; j < 4; ++j) { const f32x4 ww = ((const f32x4*)P.norm_final_w)[lane + 64 * j];
        ((f32x4*)(P.out + (size_t)m * D))[lane + 64 * j] = (f32x4){v[j].x * rstd * ww.x, v[j].y * rstd * ww.y, v[j].z * rstd * ww.z, v[j].w * rstd * ww.w}; }
}

extern "C" void kernel_launch(void* const* d_in, const int* in_sizes, int n_in, void* d_out, int out_size, void* d_ws, size_t ws_size, hipStream_t stream) {
    if (n_in != 19 || out_size != T * D || ws_size < WS_END) { fprintf(stderr, "kernel_launch: unexpected shapes n_in %d out %d ws %zu (need %zu)\n", n_in, out_size, ws_size, (size_t)WS_END); return; }
    Ptrs P{};
    const float** pp = (const float**)&P;
    for (int i = 0; i < 19; ++i) pp[i] = (const float*)d_in[i];
    P.out = (float*)d_out; P.ws = (unsigned char*)d_ws;
    hipMemsetAsync((char*)d_ws + WS_CTL, 0, MiB, stream);
    k_p0<<<2048, 256, 0, stream>>>(P);
    n_gemm<0><<<dim3(NPROJ / 64, T / 64, 1), 256, 0, stream>>>(P);
    n_gla<<<NB * 4, 128, 0, stream>>>(P);
    n_sgu_vn<<<T / 4, 256, 0, stream>>>(P);
    n_sgu_mix<<<NB * 16 * 4, 256, 0, stream>>>(P);
    n_gemm<1><<<dim3(D / 64, T / 64, 1), 256, 0, stream>>>(P);
    n_router<<<T / 4, 256, 0, stream>>>(P);
    n_pstart<<<1, 1, 0, stream>>>(P);
    n_gemm<2><<<dim3(DE / 64, T / 64, NE), 256, 0, stream>>>(P);
    n_gemm<3><<<dim3(D / 64, T / 64, NE), 256, 0, stream>>>(P);
    n_final<<<T / 4, 256, 0, stream>>>(P);
}
```

```cpp
#include <hip/hip_runtime.h>
#include <cstdio>
#include <cstdint>

constexpr int T = 32768, D = 1024, SEQ = 2048, NB = 16;
constexpr int NIN_SRC = 2576, NPROJ = 2816;
constexpr int PC_Q = 0, PC_K = 256, PC_V = 512, PC_G = 1024, PC_GK = 1536, PC_U = 1792, PC_VS = 2304;
constexpr int NE = 32, TOPK = 4, DE = 1024;
constexpr int MT = 256;
constexpr int MAXSLOTS = T * TOPK + NE * MT;
constexpr float EPS = 1e-6f;

typedef unsigned short bf16;
typedef unsigned v4u __attribute__((ext_vector_type(4)));
typedef float f32x4 __attribute__((ext_vector_type(4)));

constexpr size_t MiB = 1u << 20;
constexpr size_t WS_CTL   = 0;
constexpr size_t WS_WIN   = 1 * MiB;
constexpr size_t WS_WOUT  = 7 * MiB;
constexpr size_t WS_WSP   = 9 * MiB;
constexpr size_t WS_ROUTE = 10 * MiB;
constexpr size_t WS_WGU   = 20 * MiB;
constexpr size_t WS_WD    = 148 * MiB;
constexpr size_t WS_X1    = 212 * MiB;
constexpr size_t WS_ACT   = 340 * MiB;
constexpr size_t WS_PROJ  = 612 * MiB;
constexpr size_t WS_MIX   = 788 * MiB;
constexpr size_t WS_H     = 852 * MiB;
constexpr size_t WS_YBUF  = WS_PROJ;
constexpr size_t WS_VN    = WS_ACT;
constexpr size_t WS_END   = 916 * MiB;
static_assert(WS_YBUF + (size_t)MAXSLOTS * 1024 * 2 <= WS_END, "ybuf fits");
static_assert(WS_ACT + (size_t)MAXSLOTS * 1024 * 2 <= WS_PROJ, "act fits");
constexpr size_t RT_ROWTOK = 0;
constexpr size_t RT_ROWW   = 4 * MiB;
constexpr size_t RT_TOKSLOT= 8 * MiB;
constexpr int CW_COUNTS = 64;
constexpr int CW_PSTART = 128;

__device__ __forceinline__ unsigned f2bf(float f) { unsigned u = __builtin_bit_cast(unsigned, f); return (u + 0x7fffu + ((u >> 16) & 1u)) >> 16; }
__device__ __forceinline__ float bf2f(unsigned h) { return __builtin_bit_cast(float, h << 16); }
__device__ __forceinline__ unsigned pk2(float lo, float hi) { return f2bf(lo) | (f2bf(hi) << 16); }
__device__ __forceinline__ float gelu_tanh(float x) { const float u = 0.7978845608028654f * (x + 0.044715f * x * x * x); return x / (1.0f + __expf(-2.0f * u)); }
__device__ __forceinline__ float silu(float x) { return x / (1.0f + __expf(-x)); }
__device__ __forceinline__ float log_sigmoid(float x) { return fminf(x, 0.0f) - log1pf(__expf(-fabsf(x))); }
__device__ __forceinline__ float wave_sum(float v) {
#pragma unroll
    for (int o = 1; o < 64; o <<= 1) v += __shfl_xor(v, o);
    return v;
}

struct Ptrs {
    const float *x, *norm_mix_w, *w_in, *w_gk_up, *b_gk, *gla_norm_w, *sg_ln_w, *sg_ln_b, *w_spatial, *b_spatial, *w_out, *norm_ffn_w,
                *w_router, *b_router, *w_gate_up, *b_gate_up, *w_down, *b_down, *norm_final_w;
    float* out; unsigned char* ws;
};

__device__ __forceinline__ void p0_tr_write(bf16* WT, int K, int d0, int k0, const float* scr, int lane) {
    const int c = lane & 7;
#pragma unroll
    for (int j = 0; j < 4; ++j) { const int n = (lane >> 3) + 8 * j; const float* s = scr + (8 * c) * 33 + n;
        v4u o; o.x = pk2(s[0 * 33], s[1 * 33]); o.y = pk2(s[2 * 33], s[3 * 33]); o.z = pk2(s[4 * 33], s[5 * 33]); o.w = pk2(s[6 * 33], s[7 * 33]);
        *(v4u*)(WT + (size_t)(d0 + n) * K + k0 + 8 * c) = o; }
}
__device__ __forceinline__ void p0_transpose_item(const float* W, int ldn, int n0, int k0, bf16* WT, int K, int d0, float* scr, int lane) {
#pragma unroll 8
    for (int i = 0; i < 32; ++i) { const int kk = 2 * i + (lane >> 5); scr[kk * 33 + (lane & 31)] = W[(size_t)(k0 + kk) * ldn + n0 + (lane & 31)]; }
    __builtin_amdgcn_wave_barrier(); asm volatile("s_waitcnt lgkmcnt(0)" ::: "memory");
    p0_tr_write(WT, K, d0, k0, scr, lane);
    asm volatile("s_waitcnt lgkmcnt(0)" ::: "memory"); __builtin_amdgcn_wave_barrier();
}
__device__ __forceinline__ void p0_gk_item(const float* w_in, const float* w_gk_up, int j0, int k0, bf16* WT, float* scr, int lane) {
    for (int i = 0; i < 32; ++i) { const int kk = 2 * i + (lane >> 5), j = j0 + (lane & 31); float s = 0.f;
#pragma unroll
        for (int r = 0; r < 16; ++r) s += w_in[(size_t)(k0 + kk) * NIN_SRC + 1536 + r] * w_gk_up[r * 256 + j];
        scr[kk * 33 + (lane & 31)] = s; }
    __builtin_amdgcn_wave_barrier(); asm volatile("s_waitcnt lgkmcnt(0)" ::: "memory");
    p0_tr_write(WT, D, PC_GK + j0, k0, scr, lane);
    asm volatile("s_waitcnt lgkmcnt(0)" ::: "memory"); __builtin_amdgcn_wave_barrier();
}
constexpr int IT_IN = (NPROJ / 32) * 16, IT_OUT = 32 * 16, IT_GU = NE * 64 * 16, IT_DN = NE * 32 * 16, IT_ALL = IT_IN + IT_OUT + IT_GU + IT_DN;
__device__ __forceinline__ void p0_weight_item(const Ptrs& P, int it, float* scr, int lane) {
    bf16* WinT = (bf16*)(P.ws + WS_WIN); bf16* WoutT = (bf16*)(P.ws + WS_WOUT); bf16* WguT = (bf16*)(P.ws + WS_WGU); bf16* WdT = (bf16*)(P.ws + WS_WD);
    if (it < IT_IN) { const int db = it / 16, kb = it % 16, d0 = db * 32;
        if (d0 >= PC_GK && d0 < PC_U) p0_gk_item(P.w_in, P.w_gk_up, d0 - PC_GK, kb * 64, WinT, scr, lane);
        else p0_transpose_item(P.w_in, NIN_SRC, d0 < PC_GK ? d0 : d0 - 240, kb * 64, WinT, D, d0, scr, lane);
        return; }
    it -= IT_IN;
    if (it < IT_OUT) { const int db = it / 16, kb = it % 16; p0_transpose_item(P.w_out, D, db * 32, kb * 64, WoutT, D, db * 32, scr, lane); return; }
    it -= IT_OUT;
    if (it < IT_GU) { const int e = it / 1024, r = it % 1024, db = r / 16, kb = r % 16, d0 = db * 32, pn = d0 >> 8, bj = (d0 >> 7) & 1, rr = d0 & 127;
        p0_transpose_item(P.w_gate_up + (size_t)e * D * 2048, 2048, bj * 1024 + 128 * pn + rr, kb * 64, WguT + (size_t)e * 2048 * D, D, d0, scr, lane); return; }
    it -= IT_GU;
    { const int e = it / 512, r = it % 512, db = r / 16, kb = r % 16;
      p0_transpose_item(P.w_down + (size_t)e * DE * D, D, db * 32, kb * 64, WdT + (size_t)e * D * DE, DE, db * 32, scr, lane); }
}
__device__ __forceinline__ void rms_row_to_bf16(const float* xrow, const float* w, bf16* orow, int lane) {
    const f32x4* xr = (const f32x4*)xrow + lane; const f32x4* wr = (const f32x4*)w + lane;
    f32x4 v[4]; float s = 0.f;
#pragma unroll
    for (int j = 0; j < 4; ++j) { v[j] = xr[64 * j]; s += (v[j].x * v[j].x + v[j].y * v[j].y) + (v[j].z * v[j].z + v[j].w * v[j].w); }
    const float rstd = 1.0f / sqrtf(wave_sum(s) * (1.f / D) + EPS);
    unsigned long long* o8 = (unsigned long long*)orow + lane;
#pragma unroll
    for (int j = 0; j < 4; ++j) { const f32x4 ww = wr[64 * j];
        o8[64 * j] = (unsigned long long)pk2(v[j].x * rstd * ww.x, v[j].y * rstd * ww.y) | ((unsigned long long)pk2(v[j].z * rstd * ww.z, v[j].w * rstd * ww.w) << 32); }
}
__global__ void __launch_bounds__(256) k_p0(Ptrs P) {
    __shared__ float scr_all[4 * 64 * 33];
    const int tid = threadIdx.x, lane = tid & 63, wave = tid >> 6;
    float* scr = scr_all + wave * 64 * 33;
    const int gw = blockIdx.x * 4 + wave, NGW = gridDim.x * 4;
    for (int it = gw; it < IT_ALL; it += NGW) p0_weight_item(P, it, scr, lane);
    bf16* Wsp = (bf16*)(P.ws + WS_WSP);
    for (int i = blockIdx.x * 256 + tid; i < 4 * 128 * 128; i += gridDim.x * 256) { const int t = (i >> 7) & 127, s = i & 127; Wsp[i] = (bf16)f2bf(s <= t ? P.w_spatial[i] : 0.f); }
    bf16* H = (bf16*)(P.ws + WS_H);
    for (int m = gw; m < T; m += NGW) rms_row_to_bf16(P.x + (size_t)m * D, P.norm_mix_w, H + (size_t)m * D, lane);
}

template <int MODE>
__global__ void __launch_bounds__(256) n_gemm(Ptrs P) {
    __shared__ __attribute__((aligned(16))) float As[32][68];
    __shared__ __attribute__((aligned(16))) float Bs[32][68];
    __shared__ __attribute__((aligned(16))) float Bs2[MODE == 2 ? 32 : 1][68];
    const int tid = threadIdx.x, ty = tid >> 4, tx = tid & 15;
    const unsigned* ctl = (const unsigned*)(P.ws + WS_CTL);
    const int e = (MODE >= 2) ? blockIdx.z : 0;
    const int m0 = blockIdx.y * 64, n0 = blockIdx.x * 64;
    int count = T; size_t slot0 = 0;
    if (MODE >= 2) { count = (int)ctl[CW_COUNTS + e]; slot0 = ctl[CW_PSTART + e]; if (m0 >= count) return; }
    const bf16* A; const bf16* Bt; const bf16* Bt2 = nullptr; int K = D;
    const int lr = tid >> 2, lk = (tid & 3) * 8;
    size_t arow;
    if (MODE == 0) { A = (const bf16*)(P.ws + WS_H); Bt = (const bf16*)(P.ws + WS_WIN) + (size_t)n0 * D; arow = m0 + lr; }
    else if (MODE == 1) { A = (const bf16*)(P.ws + WS_MIX); Bt = (const bf16*)(P.ws + WS_WOUT) + (size_t)n0 * D; arow = m0 + lr; }
    else if (MODE == 2) { A = (const bf16*)(P.ws + WS_H); const int* rowtok = (const int*)(P.ws + WS_ROUTE + RT_ROWTOK) + (size_t)e * T;
        const int mm = (m0 + lr < count) ? m0 + lr : 0; arow = rowtok[mm];
        const int pn = n0 >> 7, r0 = n0 & 127; Bt = (const bf16*)(P.ws + WS_WGU) + ((size_t)e * 2048 + 256 * pn + r0) * D; Bt2 = Bt + (size_t)128 * D; }
    else { A = (const bf16*)(P.ws + WS_ACT); arow = slot0 + ((m0 + lr < count) ? m0 + lr : 0); Bt = (const bf16*)(P.ws + WS_WD) + ((size_t)e * D + n0) * DE; K = DE; }
    float acc[4][4] = {}, acc2[4][4] = {};
    for (int k0 = 0; k0 < K; k0 += 32) {
        { const v4u a = *(const v4u*)(A + arow * K + k0 + lk); const unsigned aw[4] = {a.x, a.y, a.z, a.w};
#pragma unroll
          for (int j = 0; j < 4; ++j) { As[lk + 2 * j][lr] = bf2f(aw[j] & 0xffffu); As[lk + 2 * j + 1][lr] = bf2f(aw[j] >> 16); } }
        { const v4u b = *(const v4u*)(Bt + (size_t)lr * K + k0 + lk); const unsigned bw[4] = {b.x, b.y, b.z, b.w};
#pragma unroll
          for (int j = 0; j < 4; ++j) { Bs[lk + 2 * j][lr] = bf2f(bw[j] & 0xffffu); Bs[lk + 2 * j + 1][lr] = bf2f(bw[j] >> 16); } }
        if (MODE == 2) { const v4u b = *(const v4u*)(Bt2 + (size_t)lr * K + k0 + lk); const unsigned bw[4] = {b.x, b.y, b.z, b.w};
#pragma unroll
          for (int j = 0; j < 4; ++j) { Bs2[lk + 2 * j][lr] = bf2f(bw[j] & 0xffffu); Bs2[lk + 2 * j + 1][lr] = bf2f(bw[j] >> 16); } }
        __syncthreads();
#pragma unroll 8
        for (int k = 0; k < 32; ++k) {
            const f32x4 a = *(const f32x4*)&As[k][ty * 4], b = *(const f32x4*)&Bs[k][tx * 4];
#pragma unroll
            for (int i = 0; i < 4; ++i)
#pragma unroll
                for (int j = 0; j < 4; ++j) acc[i][j] += a[i] * b[j];
            if (MODE == 2) { const f32x4 b2 = *(const f32x4*)&Bs2[k][tx * 4];
#pragma unroll
                for (int i = 0; i < 4; ++i)
#pragma unroll
                    for (int j = 0; j < 4; ++j) acc2[i][j] += a[i] * b2[j]; }
        }
        __syncthreads();
    }
#pragma unroll
    for (int i = 0; i < 4; ++i) {
        const int m = m0 + ty * 4 + i, n = n0 + tx * 4;
        if (MODE == 0) { bf16* o = (bf16*)(P.ws + WS_PROJ) + (size_t)m * NPROJ + n; *(uint2*)o = make_uint2(pk2(acc[i][0], acc[i][1]), pk2(acc[i][2], acc[i][3])); }
        else if (MODE == 1) { const f32x4 xr = *(const f32x4*)(P.x + (size_t)m * D + n); float* o = (float*)(P.ws + WS_X1) + (size_t)m * D + n;
            *(f32x4*)o = (f32x4){xr.x + acc[i][0], xr.y + acc[i][1], xr.z + acc[i][2], xr.w + acc[i][3]}; }
        else if (MODE == 2) { if (m < count) { float y[4];
#pragma unroll
                for (int j = 0; j < 4; ++j) { float g = acc[i][j] + P.b_gate_up[(size_t)e * 2048 + n + j], u = acc2[i][j] + P.b_gate_up[(size_t)e * 2048 + 1024 + n + j];
                    g = fminf(g, 7.0f); u = fminf(fmaxf(u, -7.0f), 7.0f); y[j] = (u + 1.0f) * (g / (1.0f + __expf(-1.702f * g))); }
                bf16* o = (bf16*)(P.ws + WS_ACT) + (slot0 + m) * DE + n; *(uint2*)o = make_uint2(pk2(y[0], y[1]), pk2(y[2], y[3])); } }
        else { if (m < count) { const float w = ((const float*)(P.ws + WS_ROUTE + RT_ROWW))[(size_t)e * T + m]; float y[4];
#pragma unroll
                for (int j = 0; j < 4; ++j) y[j] = (acc[i][j] + P.b_down[(size_t)e * D + n + j]) * w;
                bf16* o = (bf16*)(P.ws + WS_YBUF) + (slot0 + m) * D + n; *(uint2*)o = make_uint2(pk2(y[0], y[1]), pk2(y[2], y[3])); } }
    }
}

__global__ void __launch_bounds__(128) n_gla(Ptrs P) {
    __shared__ float sq[64], sk[64], sa[64], red[2];
    const int b = blockIdx.x >> 2, h = blockIdx.x & 3, v = threadIdx.x;
    const bf16* PROJ = (const bf16*)(P.ws + WS_PROJ); bf16* MIX = (bf16*)(P.ws + WS_MIX);
    float S[64];
#pragma unroll
    for (int k = 0; k < 64; ++k) S[k] = 0.f;
    const float nw = P.gla_norm_w[v];
    for (int t = 0; t < SEQ; ++t) {
        const size_t row = (size_t)(b * SEQ + t) * NPROJ;
        if (v < 64) { sq[v] = bf2f(PROJ[row + PC_Q + h * 64 + v]) * 0.125f; sk[v] = bf2f(PROJ[row + PC_K + h * 64 + v]);
            sa[v] = __expf(log_sigmoid(bf2f(PROJ[row + PC_GK + h * 64 + v]) + P.b_gk[h * 64 + v]) * (1.0f / 16.0f)); }
        const float vv = bf2f(PROJ[row + PC_V + h * 128 + v]), g = bf2f(PROJ[row + PC_G + h * 128 + v]);
        __syncthreads();
        float o = 0.f;
#pragma unroll
        for (int k = 0; k < 64; ++k) { S[k] = sa[k] * S[k] + sk[k] * vv; o += sq[k] * S[k]; }
        const float ss = wave_sum(o * o);
        if ((v & 63) == 0) red[v >> 6] = ss;
        __syncthreads();
        const float rstd = 1.0f / sqrtf((red[0] + red[1]) * (1.0f / 128.0f) + EPS);
        MIX[(size_t)(b * SEQ + t) * D + h * 128 + v] = (bf16)f2bf(o * rstd * nw * silu(g));
    }
}
__global__ void __launch_bounds__(256) n_sgu_vn(Ptrs P) {
    const int lane = threadIdx.x & 63, m = blockIdx.x * 4 + (threadIdx.x >> 6);
    const bf16* PROJ = (const bf16*)(P.ws + WS_PROJ); float* VN = (float*)(P.ws + WS_VN);
    const v4u raw = *(const v4u*)(PROJ + (size_t)m * NPROJ + PC_VS + lane * 8); const unsigned w[4] = {raw.x, raw.y, raw.z, raw.w};
    float g[8]; float s = 0.f;
#pragma unroll
    for (int j = 0; j < 4; ++j) { g[2 * j] = gelu_tanh(bf2f(w[j] & 0xffffu)); g[2 * j + 1] = gelu_tanh(bf2f(w[j] >> 16)); s += g[2 * j] + g[2 * j + 1]; }
    const float mu = wave_sum(s) * (1.0f / 512.0f); float q = 0.f;
#pragma unroll
    for (int j = 0; j < 8; ++j) { g[j] -= mu; q += g[j] * g[j]; }
    const float rstd = 1.0f / sqrtf(wave_sum(q) * (1.0f / 512.0f) + EPS);
#pragma unroll
    for (int j = 0; j < 8; ++j) VN[(size_t)m * 512 + lane * 8 + j] = g[j] * rstd * P.sg_ln_w[lane * 8 + j] + P.sg_ln_b[lane * 8 + j];
}
__global__ void __launch_bounds__(256) n_sgu_mix(Ptrs P) {
    const int bn = blockIdx.x >> 2, g = blockIdx.x & 3, c = threadIdx.x & 127;
    const float* VN = (const float*)(P.ws + WS_VN); const bf16* PROJ = (const bf16*)(P.ws + WS_PROJ); bf16* MIX = (bf16*)(P.ws + WS_MIX);
    const size_t base = (size_t)bn * 128;
    for (int t = threadIdx.x >> 7; t < 128; t += 2) {
        float acc = 0.f; const float* wrow = P.w_spatial + ((size_t)g * 128 + t) * 128;
        for (int s = 0; s <= t; ++s) acc += wrow[s] * VN[(base + s) * 512 + g * 128 + c];
        acc += P.b_spatial[g * 128 + t];
        const float u = gelu_tanh(bf2f(PROJ[(base + t) * NPROJ + PC_U + g * 128 + c]));
        MIX[(base + t) * D + 512 + g * 128 + c] = (bf16)f2bf(u * acc);
    }
}
__global__ void __launch_bounds__(256) n_router(Ptrs P) {
    const int lane = threadIdx.x & 63, m = blockIdx.x * 4 + (threadIdx.x >> 6);
    const float* X1 = (const float*)(P.ws + WS_X1) + (size_t)m * D; bf16* H2 = (bf16*)(P.ws + WS_H) + (size_t)m * D;
    unsigned* ctl = (unsigned*)(P.ws + WS_CTL);
    f32x4 v[4]; float s = 0.f;
#pragma unroll
    for (int j = 0; j < 4; ++j) { v[j] = ((const f32x4*)X1)[lane + 64 * j]; s += (v[j].x * v[j].x + v[j].y * v[j].y) + (v[j].z * v[j].z + v[j].w * v[j].w); }
    const float rstd = 1.0f / sqrtf(wave_sum(s) * (1.f / D) + EPS);
#pragma unroll
    for (int j = 0; j < 4; ++j) { const f32x4 ww = ((const f32x4*)P.norm_ffn_w)[lane + 64 * j];
        ((unsigned long long*)H2)[lane + 64 * j] = (unsigned long long)pk2(v[j].x * rstd * ww.x, v[j].y * rstd * ww.y) | ((unsigned long long)pk2(v[j].z * rstd * ww.z, v[j].w * rstd * ww.w) << 32); }
    const int e = lane & 31, half = lane >> 5; float acc = 0.f;
    for (int k = half * 512; k < half * 512 + 512; ++k) acc += X1[k] * P.norm_ffn_w[k] * P.w_router[(size_t)k * NE + e];
    acc += __shfl_xor(acc, 32);
    float logit = acc * rstd + P.b_router[e];
    int sel_e[4]; float sel_v[4];
#pragma unroll
    for (int r = 0; r < 4; ++r) { float bv = logit; int bi = e;
#pragma unroll
        for (int o = 1; o < 32; o <<= 1) { const float ov = __shfl_xor(bv, o); const int oi = __shfl_xor(bi, o); if (ov > bv || (ov == bv && oi < bi)) { bv = ov; bi = oi; } }
        sel_e[r] = bi; sel_v[r] = bv; if (e == bi) logit = -3.0e38f; }
    float den = 0.f, pw[4];
#pragma unroll
    for (int r = 0; r < 4; ++r) { pw[r] = __expf(sel_v[r] - sel_v[0]); den += pw[r]; }
    if (lane < 4) { int ee = sel_e[0]; float ww = pw[0];
#pragma unroll
        for (int r = 1; r < 4; ++r) if (lane == r) { ee = sel_e[r]; ww = pw[r]; }
        ww /= den;
        const unsigned rank = atomicAdd(&ctl[CW_COUNTS + ee], 1u);
        ((int*)(P.ws + WS_ROUTE + RT_ROWTOK))[(size_t)ee * T + rank] = m;
        ((float*)(P.ws + WS_ROUTE + RT_ROWW))[(size_t)ee * T + rank] = ww;
        ((int*)(P.ws + WS_ROUTE + RT_TOKSLOT))[(size_t)m * 4 + lane] = (ee << 16) | (int)rank; }
}
__global__ void n_pstart(Ptrs P) { unsigned* ctl = (unsigned*)(P.ws + WS_CTL); unsigned s = 0; for (int e = 0; e < NE; ++e) { ctl[CW_PSTART + e] = s; s += (ctl[CW_COUNTS + e] + MT - 1) / MT * MT; } ctl[CW_PSTART + NE] = s; }
__global__ void __launch_bounds__(256) n_final(Ptrs P) {
    const int lane = threadIdx.x & 63, m = blockIdx.x * 4 + (threadIdx.x >> 6);
    const unsigned* ctl = (const unsigned*)(P.ws + WS_CTL);
    const float* X1 = (const float*)(P.ws + WS_X1) + (size_t)m * D; const bf16* Y = (const bf16*)(P.ws + WS_YBUF);
    const int* ts = (const int*)(P.ws + WS_ROUTE + RT_TOKSLOT) + (size_t)m * 4;
    f32x4 v[4];
#pragma unroll
    for (int j = 0; j < 4; ++j) v[j] = ((const f32x4*)X1)[lane + 64 * j];
#pragma unroll
    for (int r = 0; r < 4; ++r) { const int pk = ts[r]; const size_t slot = (size_t)ctl[CW_PSTART + (pk >> 16)] + (pk & 0xffff);
#pragma unroll
        for (int j = 0; j < 4; ++j) { const uint2 y = ((const uint2*)(Y + slot * D))[lane + 64 * j];
            v[j].x += bf2f(y.x & 0xffffu); v[j].y += bf2f(y.x >> 16); v[j].z += bf2f(y.y & 0xffffu); v[j].w += bf2f(y.y >> 16); } }
    float s = 0.f;
#pragma unroll
    for (int j = 0; j < 4; ++j) s += (v[j].x * v[j].x + v[j].y * v[j].y) + (v[j].z * v[j].z + v[j].w * v[j].w);
    const float rstd = 1.0f / sqrtf(wave_sum(s) * (1.f / D) + EPS);
#pragma unroll
    for (int j = 0; j < 4; ++j) { const f32x4 ww = ((const f32x4*)P.norm_final_w)[lane + 64 * j];
        ((f32x4*)(P.out + (size_t)m * D))[lane + 64 * j] = (f32x4){v[j].x * rstd * ww.x, v[j].y * rstd * ww.y, v[j].z * rstd * ww.z, v[j].w * rstd * ww.w}; }
}


#define LAS __attribute__((address_space(3)))
typedef short bf16x8 __attribute__((ext_vector_type(8)));
typedef unsigned u32x4 __attribute__((ext_vector_type(4)));
constexpr int NWAVES = 8, NTHR = 512;
constexpr int RING_BYTES = 131072, TAB_OFF = RING_BYTES, MISC_OFF = RING_BYTES + 1024, LDS_BYTES = 147456;
constexpr int CW_BAR = 4096;
#define RLX_AGENT __ATOMIC_RELAXED, __HIP_MEMORY_SCOPE_AGENT

#define XB_TMO      128
#define XB_XCNT(j)  (256  + 64 * (j))
#define XB_XSUB(j)  (1280 + 64 * (j))
#define XB_XGEN(j)  (2304 + 64 * (j))
#define XB_TOP      3328
#define XB_TOPGEN   3392
#define XCD_BAR_WORDS 3456
#define XB_SPIN_CAP (1u << 20)
__device__ __forceinline__ unsigned xb_ld(unsigned* p)              { return __hip_atomic_load(p, __ATOMIC_RELAXED, __HIP_MEMORY_SCOPE_AGENT); }
__device__ __forceinline__ unsigned xb_add(unsigned* p, unsigned v) { return __hip_atomic_fetch_add(p, v, __ATOMIC_RELAXED, __HIP_MEMORY_SCOPE_AGENT); }
__device__ __forceinline__ unsigned xb_xcc_id() { return (unsigned)__builtin_amdgcn_s_getreg((3 << 11) | 20) & 0xFu; }
#define XB_SPIN(cond, bar) do { unsigned _sp = 0; while (cond) { __builtin_amdgcn_s_sleep(1); \
    if ((++_sp & 255u) == 0u) { if (xb_ld(&(bar)[XB_TMO])) break; if (_sp > XB_SPIN_CAP) { atomicAdd(&(bar)[XB_TMO], 1u); break; } } } } while (0)
struct XcdBarrier { unsigned* bar; unsigned x; volatile LAS unsigned* st; };
__device__ __forceinline__ XcdBarrier xcd_barrier_post(unsigned* bar, volatile LAS unsigned* st) {
    XcdBarrier b; b.bar = bar; b.x = xb_xcc_id(); b.st = st;
    if (threadIdx.x == 0) (void)xb_add(&bar[XB_XCNT(b.x)], 1u);
    return b;
}
__device__ __forceinline__ void xcd_barrier_complete(unsigned* bar, unsigned x, unsigned& nloc, unsigned& nx) {
    const unsigned G = gridDim.x * gridDim.y * gridDim.z;
    unsigned sum, cnt, mine, sp = 0u;
    for (;;) {
        sum = 0u; cnt = 0u; mine = 0u;
#pragma unroll
        for (unsigned j = 0; j < 16; ++j) { const unsigned c = xb_ld(&bar[XB_XCNT(j)]); sum += c; cnt += (c > 0u) ? 1u : 0u; mine = (j == x) ? c : mine; }
        if (sum == G) break;
        __builtin_amdgcn_s_sleep(1);
        if ((++sp & 255u) == 0u) { if (xb_ld(&bar[XB_TMO])) break; if (sp > XB_SPIN_CAP) { atomicAdd(&bar[XB_TMO], 1u); break; } }
    }
    nloc = mine > 0u ? mine : 1u; nx = cnt > 0u ? cnt : 1u;
}
__device__ __forceinline__ void xcd_barrier(const XcdBarrier& b) {
    asm volatile("s_waitcnt vmcnt(0)" ::: "memory");
    __syncthreads();
    if (threadIdx.x == 0) {
        unsigned* bar = b.bar;
        __builtin_amdgcn_s_waitcnt(0);
        unsigned nloc = b.st[0], nx = b.st[1];
        if (nloc == 0u) { xcd_barrier_complete(bar, b.x, nloc, nx); b.st[0] = nloc; b.st[1] = nx; }
        const unsigned old = xb_add(&bar[XB_XSUB(b.x)], 1u);
        const unsigned gen = old / nloc;
        if (old + 1u == (gen + 1u) * nloc) {
            __builtin_amdgcn_fence(__ATOMIC_RELEASE, "agent");
            asm volatile("s_waitcnt vmcnt(0)" ::: "memory");
            const unsigned og = xb_add(&bar[XB_TOP], 1u);
            const unsigned tg = og / nx;
            if (og + 1u == (tg + 1u) * nx) xb_add(&bar[XB_TOPGEN], 1u);
            else XB_SPIN(xb_ld(&bar[XB_TOPGEN]) == tg, bar);
            __builtin_amdgcn_fence(__ATOMIC_ACQUIRE, "agent");
            xb_add(&bar[XB_XGEN(b.x)], 1u);
            asm volatile("s_waitcnt vmcnt(0)" ::: "memory");
        } else {
            XB_SPIN(xb_ld(&bar[XB_XGEN(b.x)]) == gen, bar);
            __builtin_amdgcn_fence(__ATOMIC_ACQUIRE, "agent");
            asm volatile("s_waitcnt vmcnt(0)" ::: "memory");
        }
    }
    __syncthreads();
}

namespace pg8 {
constexpr int BM = 256, BK = 64, HALF = 128, HTB = HALF * BK * 2, NXCD = 8, WGM = 8;
__device__ __forceinline__ int lds_byte(int r, int c) { const int st = (r >> 4) * 2 + (c >> 5), rr = r & 15, cc = c & 31, ob = rr * 64 + cc * 2; return st * 1024 + (ob ^ (((ob >> 9) & 1) << 5)); }
__device__ __forceinline__ void stage_rc(int b, int& R, int& C) { const int st = b / 1024, sb = b % 1024, swz = sb ^ (((sb >> 9) & 1) << 5); R = (st >> 1) * 16 + swz / 64; C = (st & 1) * 32 + (swz % 64) / 2; }
__device__ __forceinline__ int perm32(int rho) { const int n = rho >> 4, i = rho & 15; return 8 * (i >> 2) + 4 * n + (i & 3); }
__device__ __forceinline__ unsigned cvt_pk_bf16(float lo, float hi) { unsigned r; asm volatile("v_cvt_pk_bf16_f32 %0, %1, %2" : "=v"(r) : "v"(lo), "v"(hi)); return r; }
__device__ __forceinline__ int xcd_remap(int wgid, int nwg) { const int q = nwg / NXCD, r = nwg % NXCD, xcd = wgid % NXCD, off = wgid / NXCD; return (xcd < r ? xcd * (q + 1) : r * (q + 1) + (xcd - r) * q) + off; }

struct Unit { int pm, pn, e, m0, count, slot0; };
typedef f32x4 Acc[2][2][4][2];

struct DenseSched {
    int nM, nN, nwg, G, c, K;
    __device__ __forceinline__ void init(int M, int N, int K_, int G_, int c_) { nM = M / BM; nN = N / BM; nwg = nM * nN; G = G_; c = c_; K = K_; }
    __device__ __forceinline__ bool next(int i, Unit& u) const {
        const long L = (long)i * G + c; if (L >= nwg) return false;
        const int wgid = xcd_remap((int)L, nwg);
        const int nig = WGM * nN, gid = wgid / nig, fm = gid * WGM, gsz = (nM - fm) < WGM ? (nM - fm) : WGM;
        u.pm = fm + ((wgid % nig) % gsz); u.pn = (wgid % nig) / gsz; u.e = 0; u.m0 = 0; u.count = 0; u.slot0 = 0; return true;
    }
    __device__ __forceinline__ unsigned a_off(const Unit& u, int r) const { return (unsigned)(u.pm * BM + r) * (unsigned)(K * 2); }
    __device__ __forceinline__ size_t b_off(const Unit& u) const { return (size_t)u.pn * BM * K * 2; }
};
struct MoeSched {
    const LAS int* tab; const int* rowtok; int NPN, G, c, ntile, K, NB_E  ; bool gather;
    __device__ __forceinline__ bool next(int i, Unit& u) const {
        const long L = (long)i * G + c; if (L >= ntile) return false;
        const int wgid = xcd_remap((int)L, ntile);
        int lo = 0, hi = NE;
#pragma unroll
        for (int s = 0; s < 5; ++s) { const int mid = (lo + hi) >> 1; if (tab[mid] * NPN <= wgid) lo = mid; else hi = mid; }
        const int e = lo, mte = tab[e + 1] - tab[e], local = wgid - tab[e] * NPN;
        u.e = e; u.pn = local / mte; u.pm = 0; u.m0 = (local % mte) * BM; u.count = tab[66 + e]; u.slot0 = tab[33 + e]; return true;
    }
    __device__ __forceinline__ unsigned a_off(const Unit& u, int r) const {
        int m = u.m0 + r; if (gather) { m = m < u.count ? m : u.count - 1; return (unsigned)rowtok[(size_t)u.e * T + m] * (unsigned)(K * 2); }
        return (unsigned)(u.slot0 + m) * (unsigned)(K * 2);
    }
    __device__ __forceinline__ size_t b_off(const Unit& u) const { return ((size_t)u.e * NB_E + (size_t)u.pn * BM) * K * 2; }
};

struct EpiProj {
    static constexpr bool PERM = true;
    bf16* O;
    __device__ __forceinline__ void operator()(const Acc& acc, const Unit& u, int wr, int wc, int fr, int fq) const {
        const int row0 = u.pm * BM + wr * 64 + fr, col0 = u.pn * BM + wc * 32 + 8 * fq;
#pragma unroll
        for (int ai = 0; ai < 2; ++ai)
#pragma unroll
            for (int m = 0; m < 4; ++m) { bf16* rowp = O + (size_t)(row0 + ai * HALF + m * 16) * NPROJ + col0;
#pragma unroll
                for (int bj = 0; bj < 2; ++bj) { const f32x4 v0 = acc[ai][bj][m][0], v1 = acc[ai][bj][m][1];
                    u32x4 w; w.x = cvt_pk_bf16(v0[0], v0[1]); w.y = cvt_pk_bf16(v0[2], v0[3]); w.z = cvt_pk_bf16(v1[0], v1[1]); w.w = cvt_pk_bf16(v1[2], v1[3]);
                    *(u32x4*)(rowp + bj * HALF) = w; } }
    }
};
struct EpiX1 {
    static constexpr bool PERM = false;
    const float* X; float* O;
    __device__ __forceinline__ void operator()(const Acc& acc, const Unit& u, int wr, int wc, int fr, int fq) const {
        const int row0 = u.pm * BM + wr * 64 + fr, col0 = u.pn * BM + wc * 32 + 4 * fq;
#pragma unroll
        for (int ai = 0; ai < 2; ++ai)
#pragma unroll
            for (int m = 0; m < 4; ++m) { const size_t off = (size_t)(row0 + ai * HALF + m * 16) * D + col0;
#pragma unroll
                for (int bj = 0; bj < 2; ++bj)
#pragma unroll
                    for (int n = 0; n < 2; ++n) { const f32x4 xr = *(const f32x4*)(X + off + bj * HALF + n * 16); *(f32x4*)(O + off + bj * HALF + n * 16) = xr + acc[ai][bj][m][n]; }
                asm volatile("" ::: "memory"); }
    }
};
struct EpiAct {
    static constexpr bool PERM = true;
    bf16* O; const float* bgu;
    __device__ __forceinline__ void operator()(const Acc& acc, const Unit& u, int wr, int wc, int fr, int fq) const {
        const int colj = u.pn * 128 + wc * 32 + 8 * fq;
        const float* bg = bgu + (size_t)u.e * 2048 + colj;
        const f32x4 g0 = *(const f32x4*)bg, g1 = *(const f32x4*)(bg + 4), u0 = *(const f32x4*)(bg + 1024), u1 = *(const f32x4*)(bg + 1028);
#pragma unroll
        for (int ai = 0; ai < 2; ++ai)
#pragma unroll
            for (int m = 0; m < 4; ++m) { const int r = ai * HALF + wr * 64 + m * 16 + fr;
                if (u.m0 + r < u.count) { float y[8];
#pragma unroll
                    for (int n = 0; n < 2; ++n)
#pragma unroll
                        for (int i = 0; i < 4; ++i) { float g = acc[ai][0][m][n][i] + (n ? g1[i] : g0[i]), up = acc[ai][1][m][n][i] + (n ? u1[i] : u0[i]);
                            g = fminf(g, 7.0f); up = fminf(fmaxf(up, -7.0f), 7.0f); y[n * 4 + i] = (up + 1.0f) * (g / (1.0f + __expf(-1.702f * g))); }
                    u32x4 w; w.x = cvt_pk_bf16(y[0], y[1]); w.y = cvt_pk_bf16(y[2], y[3]); w.z = cvt_pk_bf16(y[4], y[5]); w.w = cvt_pk_bf16(y[6], y[7]);
                    *(u32x4*)(O + (size_t)(u.slot0 + u.m0 + r) * DE + colj) = w; } }
    }
};
struct EpiDown {
    static constexpr bool PERM = true;
    bf16* O; const float* bd; const float* roww;
    __device__ __forceinline__ void operator()(const Acc& acc, const Unit& u, int wr, int wc, int fr, int fq) const {
        const int col0 = u.pn * BM + wc * 32 + 8 * fq;
        const float* bp = bd + (size_t)u.e * D + col0;
        f32x4 bv[2][2];
#pragma unroll
        for (int bj = 0; bj < 2; ++bj)
#pragma unroll
            for (int n = 0; n < 2; ++n) bv[bj][n] = *(const f32x4*)(bp + bj * HALF + 4 * n);
#pragma unroll
        for (int ai = 0; ai < 2; ++ai)
#pragma unroll
            for (int m = 0; m < 4; ++m) { const int r = ai * HALF + wr * 64 + m * 16 + fr;
                if (u.m0 + r < u.count) { const float w8 = roww[(size_t)u.e * T + u.m0 + r]; bf16* rowp = O + (size_t)(u.slot0 + u.m0 + r) * D + col0;
#pragma unroll
                    for (int bj = 0; bj < 2; ++bj) { const f32x4 v0 = (acc[ai][bj][m][0] + bv[bj][0]) * w8, v1 = (acc[ai][bj][m][1] + bv[bj][1]) * w8;
                        u32x4 w; w.x = cvt_pk_bf16(v0[0], v0[1]); w.y = cvt_pk_bf16(v0[2], v0[3]); w.z = cvt_pk_bf16(v1[0], v1[1]); w.w = cvt_pk_bf16(v1[2], v1[3]);
                        *(u32x4*)(rowp + bj * HALF) = w; } } }
    }
};

template <class Epi, class Sched>
__device__ __forceinline__ void gemm_phase(LAS unsigned char* lds, const char* gA, const char* gB, int K, const Sched& S, const Epi& E) {
    const int tid = threadIdx.x, wid = __builtin_amdgcn_readfirstlane(tid >> 6), lane = tid & 63, wr = wid >> 2, wc = wid & 3, fr = lane & 15, fq = lane >> 4;
    const int nt = K / BK;
    int Rr[2], Cc[2]; unsigned voffB[2];
#pragma unroll
    for (int i = 0; i < 2; ++i) { int R, C; stage_rc(tid * 16 + i * 8192, R, C); Rr[i] = R; Cc[i] = C; const int Rb = Epi::PERM ? ((R & ~31) + perm32(R & 31)) : R; voffB[i] = (unsigned)(Rb * K + C) * 2u; }
    const size_t hstep = (size_t)HALF * K * 2;
    const unsigned ldsw = (unsigned)wid * 1024u;
    const int aoff = lds_byte(wr * 64 + fr, fq * 8), boff = lds_byte(wc * 32 + fr, fq * 8);
#define PG8_SA(b, h) (((b) * 2 + (h)) * HTB)
#define PG8_SB(b, h) ((4 + (b) * 2 + (h)) * HTB)
#define PG8_STAGEB(bufoff, gbase) do { _Pragma("unroll") for (int _i = 0; _i < 2; ++_i) \
        __builtin_amdgcn_global_load_lds((const unsigned*)((const char*)(gbase) + voffB[_i]), (LAS unsigned*)(lds + (bufoff) + ldsw + _i * 8192), 16, 0, 0); } while (0)
#define PG8_STAGEA(bufoff, voff2, kb) do { _Pragma("unroll") for (int _i = 0; _i < 2; ++_i) \
        __builtin_amdgcn_global_load_lds((const unsigned*)(gA + (size_t)(voff2)[_i] + (size_t)(kb)), (LAS unsigned*)(lds + (bufoff) + ldsw + _i * 8192), 16, 0, 0); } while (0)
#define PG8_LDA(dst, b, h) do { _Pragma("unroll") for (int m = 0; m < 4; ++m) _Pragma("unroll") for (int k = 0; k < 2; ++k) dst[m][k] = *(const LAS bf16x8*)(lds + PG8_SA(b, h) + aoff + m * 2048 + k * 1024); } while (0)
#define PG8_LDB(dst, b, h) do { _Pragma("unroll") for (int n = 0; n < 2; ++n) _Pragma("unroll") for (int k = 0; k < 2; ++k) dst[n][k] = *(const LAS bf16x8*)(lds + PG8_SB(b, h) + boff + n * 2048 + k * 1024); } while (0)
#define PG8_MMA(ai, bj, At, Bt) do { __builtin_amdgcn_s_setprio(1); _Pragma("unroll") for (int m = 0; m < 4; ++m) _Pragma("unroll") for (int n = 0; n < 2; ++n) _Pragma("unroll") for (int k = 0; k < 2; ++k) \
        acc[ai][bj][m][n] = __builtin_amdgcn_mfma_f32_16x16x32_bf16(Bt[n][k], At[m][k], acc[ai][bj][m][n], 0, 0, 0); __builtin_amdgcn_s_setprio(0); } while (0)
#define PG8_WAIT_V(n) asm volatile("s_waitcnt vmcnt(" #n ")" ::: "memory")
#define PG8_WAIT_L(n) asm volatile("s_waitcnt lgkmcnt(" #n ")" ::: "memory")
#define PG8_BAR __builtin_amdgcn_s_barrier()
#define PG8_SCHED __builtin_amdgcn_sched_barrier(0)
    Unit cur, nxt; int ui = 0;
    if (!S.next(0, cur)) return;
    Acc acc;
#pragma unroll
    for (int a = 0; a < 2; ++a)
#pragma unroll
        for (int b = 0; b < 2; ++b)
#pragma unroll
            for (int m = 0; m < 4; ++m)
#pragma unroll
                for (int n = 0; n < 2; ++n) acc[a][b][m][n] = (f32x4){0.f, 0.f, 0.f, 0.f};
    bf16x8 At[4][2], B0[2][2], B1[2][2];
    unsigned cA0[2], cA1[2], nA0[2], nA1[2];
#pragma unroll
    for (int i = 0; i < 2; ++i) { cA0[i] = S.a_off(cur, Rr[i]) + (unsigned)Cc[i] * 2u; cA1[i] = S.a_off(cur, HALF + Rr[i]) + (unsigned)Cc[i] * 2u; }
    const char* cB = gB + S.b_off(cur);
    PG8_STAGEB(PG8_SB(0, 0), cB); PG8_STAGEB(PG8_SB(0, 1), cB + hstep); PG8_STAGEA(PG8_SA(0, 0), cA0, 0); PG8_STAGEA(PG8_SA(0, 1), cA1, 0);
    if (wr == 1) PG8_BAR;
    PG8_WAIT_V(2); PG8_BAR;
    PG8_STAGEB(PG8_SB(1, 0), cB + BK * 2); PG8_STAGEA(PG8_SA(1, 0), cA0, BK * 2); PG8_STAGEB(PG8_SB(1, 1), cB + hstep + BK * 2);
    PG8_WAIT_V(6); PG8_BAR;
    for (;;) {
        const bool has_next = S.next(ui + 1, nxt);
        const char* nB = cB;
        if (has_next) {
#pragma unroll
            for (int i = 0; i < 2; ++i) { nA0[i] = S.a_off(nxt, Rr[i]) + (unsigned)Cc[i] * 2u; nA1[i] = S.a_off(nxt, HALF + Rr[i]) + (unsigned)Cc[i] * 2u; }
            nB = gB + S.b_off(nxt);
        } else {
#pragma unroll
            for (int i = 0; i < 2; ++i) { nA0[i] = cA0[i]; nA1[i] = cA1[i]; }
        }
        for (int t = 0; t < nt; t += 2) {
            const bool last = (t == nt - 2);
            const unsigned k1 = (unsigned)(t + 1) * (BK * 2), k2 = last ? 0u : (unsigned)(t + 2) * (BK * 2), k3 = k2 + BK * 2;
            unsigned a20[2], a21[2];
#pragma unroll
            for (int i = 0; i < 2; ++i) { a20[i] = last ? nA0[i] : cA0[i]; a21[i] = last ? nA1[i] : cA1[i]; }
            const char* b2 = (last ? nB : cB) + k2; const char* b3 = b2 + BK * 2;
            PG8_LDB(B0, 0, 0); PG8_LDB(B1, 0, 1); PG8_SCHED; PG8_LDA(At, 0, 0); PG8_STAGEA(PG8_SA(1, 1), cA1, k1);
            PG8_WAIT_V(8); PG8_WAIT_L(0); PG8_BAR; PG8_MMA(0, 0, At, B0); PG8_MMA(0, 1, At, B1); PG8_BAR; PG8_SCHED;
            PG8_LDA(At, 0, 1); PG8_STAGEB(PG8_SB(0, 0), b2); PG8_STAGEB(PG8_SB(0, 1), b2 + hstep); PG8_STAGEA(PG8_SA(0, 0), a20, k2);
            PG8_WAIT_V(8); PG8_WAIT_L(0); PG8_BAR; PG8_MMA(1, 0, At, B0); PG8_MMA(1, 1, At, B1); PG8_BAR; PG8_SCHED;
            PG8_LDB(B0, 1, 0); PG8_LDB(B1, 1, 1); PG8_SCHED; PG8_LDA(At, 1, 0); PG8_STAGEA(PG8_SA(0, 1), a21, k2);
            PG8_WAIT_V(8); PG8_WAIT_L(0); PG8_BAR; PG8_MMA(0, 0, At, B0); PG8_MMA(0, 1, At, B1); PG8_BAR; PG8_SCHED;
            PG8_LDA(At, 1, 1); PG8_STAGEB(PG8_SB(1, 0), b3); PG8_STAGEB(PG8_SB(1, 1), b3 + hstep); PG8_STAGEA(PG8_SA(1, 0), a20, k3);
            PG8_WAIT_V(8); PG8_WAIT_L(0); PG8_BAR; PG8_MMA(1, 0, At, B0); PG8_MMA(1, 1, At, B1); PG8_BAR; PG8_SCHED;
        }
        if (wr == 0) PG8_BAR;
        E(acc, cur, wr, wc, fr, fq);
        if (!has_next) break;
#pragma unroll
        for (int a = 0; a < 2; ++a)
#pragma unroll
            for (int b = 0; b < 2; ++b)
#pragma unroll
                for (int m = 0; m < 4; ++m)
#pragma unroll
                    for (int n = 0; n < 2; ++n) acc[a][b][m][n] = (f32x4){0.f, 0.f, 0.f, 0.f};
        cur = nxt; cB = nB; ++ui;
#pragma unroll
        for (int i = 0; i < 2; ++i) { cA0[i] = nA0[i]; cA1[i] = nA1[i]; }
        if (wr == 1) PG8_BAR;
    }
    PG8_WAIT_V(0);
    PG8_BAR;
#undef PG8_SA
#undef PG8_SB
#undef PG8_STAGEA
#undef PG8_STAGEB
#undef PG8_LDA
#undef PG8_LDB
#undef PG8_MMA
#undef PG8_WAIT_V
#undef PG8_WAIT_L
#undef PG8_BAR
#undef PG8_SCHED
}
}

struct Args { Ptrs P; int ph_lo, ph_hi, li, pad; };

__device__ __forceinline__ void ph0_prep(const Ptrs& P, unsigned char* lds_generic, int vcu, int G) {
    const int tid = threadIdx.x, lane = tid & 63, wave = __builtin_amdgcn_readfirstlane(tid >> 6);
    float* scr = (float*)(lds_generic + wave * 16384);
    const int gw = vcu * NWAVES + wave, NGW = G * NWAVES;
    for (int it = gw; it < IT_ALL; it += NGW) p0_weight_item(P, it, scr, lane);
    bf16* Wsp = (bf16*)(P.ws + WS_WSP);
    for (int i = blockIdx.x * NTHR + tid; i < 4 * 128 * 128; i += G * NTHR) { const int t = (i >> 7) & 127, s = i & 127; Wsp[i] = (bf16)f2bf(s <= t ? P.w_spatial[i] : 0.f); }
    bf16* H = (bf16*)(P.ws + WS_H);
    for (int m = gw; m < T; m += NGW) rms_row_to_bf16(P.x + (size_t)m * D, P.norm_mix_w, H + (size_t)m * D, lane);
}
__device__ __forceinline__ void ph2a_naive(const Ptrs& P, LAS unsigned char* lds, int G) {
    const int tid = threadIdx.x, lane = tid & 63, wave = tid >> 6;
    LAS float* sm = (LAS float*)lds;
    const bf16* PROJ = (const bf16*)(P.ws + WS_PROJ); bf16* MIX = (bf16*)(P.ws + WS_MIX);
    for (int item = blockIdx.x; item < 16; item += G) {
        const int sub = tid >> 7, v = tid & 127, bh = item * 4 + sub, b = bh >> 2, h = bh & 3;
        LAS float* sq = sm + sub * 192; LAS float* sk = sq + 64; LAS float* sa = sk + 64; LAS float* red = sm + 768 + sub * 2;
        float S[64];
#pragma unroll
        for (int k = 0; k < 64; ++k) S[k] = 0.f;
        const float nw = P.gla_norm_w[v];
        for (int t = 0; t < SEQ; ++t) {
            const size_t row = (size_t)(b * SEQ + t) * NPROJ;
            if (v < 64) { sq[v] = bf2f(PROJ[row + PC_Q + h * 64 + v]) * 0.125f; sk[v] = bf2f(PROJ[row + PC_K + h * 64 + v]);
                sa[v] = __expf(log_sigmoid(bf2f(PROJ[row + PC_GK + h * 64 + v]) + P.b_gk[h * 64 + v]) * (1.0f / 16.0f)); }
            const float vv = bf2f(PROJ[row + PC_V + h * 128 + v]), g = bf2f(PROJ[row + PC_G + h * 128 + v]);
            __syncthreads();
            float o = 0.f;
#pragma unroll
            for (int k = 0; k < 64; ++k) { S[k] = sa[k] * S[k] + sk[k] * vv; o += sq[k] * S[k]; }
            const float ss = wave_sum(o * o);
            if ((v & 63) == 0) red[v >> 6] = ss;
            __syncthreads();
            const float rstd = 1.0f / sqrtf((red[0] + red[1]) * (1.0f / 128.0f) + EPS);
            MIX[(size_t)(b * SEQ + t) * D + h * 128 + v] = (bf16)f2bf(o * rstd * nw * silu(g));
        }
    }
    float* VN = (float*)(P.ws + WS_VN);
    for (int m = blockIdx.x * NWAVES + wave; m < T; m += G * NWAVES) {
        const v4u raw = *(const v4u*)(PROJ + (size_t)m * NPROJ + PC_VS + lane * 8); const unsigned w[4] = {raw.x, raw.y, raw.z, raw.w};
        float g[8]; float s = 0.f;
#pragma unroll
        for (int j = 0; j < 4; ++j) { g[2 * j] = gelu_tanh(bf2f(w[j] & 0xffffu)); g[2 * j + 1] = gelu_tanh(bf2f(w[j] >> 16)); s += g[2 * j] + g[2 * j + 1]; }
        const float mu = wave_sum(s) * (1.0f / 512.0f); float q = 0.f;
#pragma unroll
        for (int j = 0; j < 8; ++j) { g[j] -= mu; q += g[j] * g[j]; }
        const float rstd = 1.0f / sqrtf(wave_sum(q) * (1.0f / 512.0f) + EPS);
#pragma unroll
        for (int j = 0; j < 8; ++j) VN[(size_t)m * 512 + lane * 8 + j] = g[j] * rstd * P.sg_ln_w[lane * 8 + j] + P.sg_ln_b[lane * 8 + j];
    }
}
__device__ __forceinline__ void ph2b_naive(const Ptrs& P, int G) {
    const int tid = threadIdx.x, c = tid & 127;
    const float* VN = (const float*)(P.ws + WS_VN); const bf16* PROJ = (const bf16*)(P.ws + WS_PROJ); bf16* MIX = (bf16*)(P.ws + WS_MIX);
    for (int item = blockIdx.x; item < NB * 16 * 4; item += G) {
        const int bn = item >> 2, g = item & 3; const size_t base = (size_t)bn * 128;
        for (int t = tid >> 7; t < 128; t += 4) {
            float acc = 0.f; const float* wrow = P.w_spatial + ((size_t)g * 128 + t) * 128;
            for (int s = 0; s <= t; ++s) acc += wrow[s] * VN[(base + s) * 512 + g * 128 + c];
            acc += P.b_spatial[g * 128 + t];
            const float u = gelu_tanh(bf2f(PROJ[(base + t) * NPROJ + PC_U + g * 128 + c]));
            MIX[(base + t) * D + 512 + g * 128 + c] = (bf16)f2bf(u * acc);
        }
    }
}
__device__ __forceinline__ void ph4_router_naive(const Ptrs& P, int G) {
    const int tid = threadIdx.x, lane = tid & 63, wave = tid >> 6;
    unsigned* ctl = (unsigned*)(P.ws + WS_CTL);
    for (int m = blockIdx.x * NWAVES + wave; m < T; m += G * NWAVES) {
        const float* X1 = (const float*)(P.ws + WS_X1) + (size_t)m * D; bf16* H2 = (bf16*)(P.ws + WS_H) + (size_t)m * D;
        f32x4 v[4]; float s = 0.f;
#pragma unroll
        for (int j = 0; j < 4; ++j) { v[j] = ((const f32x4*)X1)[lane + 64 * j]; s += (v[j].x * v[j].x + v[j].y * v[j].y) + (v[j].z * v[j].z + v[j].w * v[j].w); }
        const float rstd = 1.0f / sqrtf(wave_sum(s) * (1.f / D) + EPS);
#pragma unroll
        for (int j = 0; j < 4; ++j) { const f32x4 ww = ((const f32x4*)P.norm_ffn_w)[lane + 64 * j];
            ((unsigned long long*)H2)[lane + 64 * j] = (unsigned long long)pk2(v[j].x * rstd * ww.x, v[j].y * rstd * ww.y) | ((unsigned long long)pk2(v[j].z * rstd * ww.z, v[j].w * rstd * ww.w) << 32); }
        const int e = lane & 31, half = lane >> 5; float acc = 0.f;
        for (int k = half * 512; k < half * 512 + 512; ++k) acc += X1[k] * P.norm_ffn_w[k] * P.w_router[(size_t)k * NE + e];
        acc += __shfl_xor(acc, 32);
        float logit = acc * rstd + P.b_router[e];
        int sel_e[4]; float sel_v[4];
#pragma unroll
        for (int r = 0; r < 4; ++r) { float bv = logit; int bi = e;
#pragma unroll
            for (int o = 1; o < 32; o <<= 1) { const float ov = __shfl_xor(bv, o); const int oi = __shfl_xor(bi, o); if (ov > bv || (ov == bv && oi < bi)) { bv = ov; bi = oi; } }
            sel_e[r] = bi; sel_v[r] = bv; if (e == bi) logit = -3.0e38f; }
        float den = 0.f, pw[4];
#pragma unroll
        for (int r = 0; r < 4; ++r) { pw[r] = __expf(sel_v[r] - sel_v[0]); den += pw[r]; }
        if (lane < 4) { int ee = sel_e[0]; float ww = pw[0];
#pragma unroll
            for (int r = 1; r < 4; ++r) if (lane == r) { ee = sel_e[r]; ww = pw[r]; }
            ww /= den;
            const unsigned rank = atomicAdd(&ctl[CW_COUNTS + ee], 1u);
            ((int*)(P.ws + WS_ROUTE + RT_ROWTOK))[(size_t)ee * T + rank] = m;
            ((float*)(P.ws + WS_ROUTE + RT_ROWW))[(size_t)ee * T + rank] = ww;
            ((int*)(P.ws + WS_ROUTE + RT_TOKSLOT))[(size_t)m * 4 + lane] = (ee << 16) | (int)rank; }
    }
}
__device__ __forceinline__ void moe_tables(const Ptrs& P, LAS int* tab) {
    const unsigned* ctl = (const unsigned*)(P.ws + WS_CTL);
    if (threadIdx.x < NE) tab[66 + threadIdx.x] = (int)__hip_atomic_load(ctl + CW_COUNTS + threadIdx.x, RLX_AGENT);
    __syncthreads();
    if (threadIdx.x == 0) { int a = 0; for (int e = 0; e < NE; ++e) { tab[e] = a; tab[33 + e] = a * MT; a += (tab[66 + e] + MT - 1) / MT; } tab[NE] = a; tab[33 + NE] = a * MT; }
    __syncthreads();
}
__device__ __forceinline__ void ph7_final(const Ptrs& P, const LAS int* tab, int G) {
    const int tid = threadIdx.x, lane = tid & 63, wave = tid >> 6;
    const bf16* Y = (const bf16*)(P.ws + WS_YBUF);
    for (int m = blockIdx.x * NWAVES + wave; m < T; m += G * NWAVES) {
        const float* X1 = (const float*)(P.ws + WS_X1) + (size_t)m * D;
        const int* ts = (const int*)(P.ws + WS_ROUTE + RT_TOKSLOT) + (size_t)m * 4;
        f32x4 v[4];
#pragma unroll
        for (int j = 0; j < 4; ++j) v[j] = ((const f32x4*)X1)[lane + 64 * j];
#pragma unroll
        for (int r = 0; r < 4; ++r) { const int pk = ts[r]; const size_t slot = (size_t)tab[33 + (pk >> 16)] + (pk & 0xffff);
#pragma unroll
            for (int j = 0; j < 4; ++j) { const uint2 y = ((const uint2*)(Y + slot * D))[lane + 64 * j];
                v[j].x += bf2f(y.x & 0xffffu); v[j].y += bf2f(y.x >> 16); v[j].z += bf2f(y.y & 0xffffu); v[j].w += bf2f(y.y >> 16); } }
        float s = 0.f;
#pragma unroll
        for (int j = 0; j < 4; ++j) s += (v[j].x * v[j].x + v[j].y * v[j].y) + (v[j].z * v[j].z + v[j].w * v[j].w);
        const float rstd = 1.0f / sqrtf(wave_sum(s) * (1.f / D) + EPS);
#pragma unroll
        for (int j = 0; j < 4; ++j) { const f32x4 ww = ((const f32x4*)P.norm_final_w)[lane + 64 * j];
            ((f32x4*)(P.out + (size_t)m * D))[lane + 64 * j] = (f32x4){v[j].x * rstd * ww.x, v[j].y * rstd * ww.y, v[j].z * rstd * ww.z, v[j].w * rstd * ww.w}; }
    }
}

constexpr int NPHASE = 9;
__global__ void __launch_bounds__(NTHR, 2) mk_fwd(Args args) {
    extern __shared__ __attribute__((aligned(16))) unsigned char lds_raw[];
    LAS unsigned char* lds = (LAS unsigned char*)lds_raw;
    const Ptrs& P = args.P;
    const int tid = threadIdx.x, G = gridDim.x;
    const int vcu = (G % 8 == 0) ? ((int)blockIdx.x % 8) * (G / 8) + (int)blockIdx.x / 8 : (int)blockIdx.x;
    volatile LAS unsigned* MISC = (volatile LAS unsigned*)(lds + MISC_OFF);
    LAS int* tab = (LAS int*)(lds + TAB_OFF);
    if (tid < 64) MISC[tid] = 0u;
    __syncthreads();
    unsigned* ctl = (unsigned*)(P.ws + WS_CTL);
    XcdBarrier bar = xcd_barrier_post(ctl + CW_BAR + args.li * XCD_BAR_WORDS, MISC + 8);
    const int lo = args.ph_lo, hi = args.ph_hi;
#define IN(k) (lo <= (k) && (k) < hi)
#define SEAM(k) do { if (IN(k) && IN((k) + 1)) xcd_barrier(bar); } while (0)
    if (IN(0)) { ph0_prep(P, lds_raw, vcu, G); } SEAM(0);
    if (IN(1)) { pg8::DenseSched S; S.init(T, NPROJ, D, G, (int)blockIdx.x); pg8::EpiProj E{(bf16*)(P.ws + WS_PROJ)};
        pg8::gemm_phase(lds, (const char*)(P.ws + WS_H), (const char*)(P.ws + WS_WIN), D, S, E); } SEAM(1);
    if (IN(2)) { ph2a_naive(P, lds, G); } SEAM(2);
    if (IN(3)) { ph2b_naive(P, G); } SEAM(3);
    if (IN(4)) { pg8::DenseSched S; S.init(T, D, D, G, (int)blockIdx.x); pg8::EpiX1 E{P.x, (float*)(P.ws + WS_X1)};
        pg8::gemm_phase(lds, (const char*)(P.ws + WS_MIX), (const char*)(P.ws + WS_WOUT), D, S, E); } SEAM(4);
    if (IN(5)) { ph4_router_naive(P, G); } SEAM(5);
    if (IN(6) || IN(7) || IN(8)) moe_tables(P, tab);
    if (IN(6)) { pg8::MoeSched S{tab, (const int*)(P.ws + WS_ROUTE + RT_ROWTOK), 8, G, (int)blockIdx.x, tab[NE] * 8, D, 2048, true};
        pg8::EpiAct E{(bf16*)(P.ws + WS_ACT), P.b_gate_up};
        pg8::gemm_phase(lds, (const char*)(P.ws + WS_H), (const char*)(P.ws + WS_WGU), D, S, E); } SEAM(6);
    if (IN(7)) { pg8::MoeSched S{tab, nullptr, 4, G, (int)blockIdx.x, tab[NE] * 4, DE, 1024, false};
        pg8::EpiDown E{(bf16*)(P.ws + WS_YBUF), P.b_down, (const float*)(P.ws + WS_ROUTE + RT_ROWW)};
        pg8::gemm_phase(lds, (const char*)(P.ws + WS_ACT), (const char*)(P.ws + WS_WD), DE, S, E); } SEAM(7);
    if (IN(8)) { ph7_final(P, tab, G); }
#undef IN
#undef SEAM
}

#ifndef MK_SEGMENTS
#define MK_SEGMENTS 1
#endif
extern "C" void kernel_launch(void* const* d_in, const int* in_sizes, int n_in, void* d_out, int out_size, void* d_ws, size_t ws_size, hipStream_t stream) {
    if (n_in != 19 || out_size != T * D || ws_size < WS_END) { fprintf(stderr, "kernel_launch: unexpected shapes n_in %d out %d ws %zu (need %zu)\n", n_in, out_size, ws_size, (size_t)WS_END); return; }
    static int grid = 0;
    if (grid == 0) {
        int dev = 0, cus = 0, per_cu = 0;
        if (hipGetDevice(&dev) != hipSuccess || hipDeviceGetAttribute(&cus, hipDeviceAttributeMultiprocessorCount, dev) != hipSuccess) { fprintf(stderr, "kernel_launch: device query failed\n"); grid = -1; return; }
        if (hipFuncSetAttribute((const void*)mk_fwd, hipFuncAttributeMaxDynamicSharedMemorySize, LDS_BYTES) != hipSuccess) { fprintf(stderr, "kernel_launch: hipFuncSetAttribute failed\n"); grid = -1; return; }
        if (hipOccupancyMaxActiveBlocksPerMultiprocessor(&per_cu, (const void*)mk_fwd, NTHR, LDS_BYTES) != hipSuccess || per_cu < 1) { fprintf(stderr, "kernel_launch: occupancy query says %d\n", per_cu); per_cu = 1; }
        (void)hipGetLastError();
        grid = cus;
        fprintf(stderr, "kernel_launch: cus %d per_cu %d grid %d\n", cus, per_cu, grid);
    }
    if (grid < 0) return;
    Args a{};
    const float** pp = (const float**)&a.P;
    for (int i = 0; i < 19; ++i) pp[i] = (const float*)d_in[i];
    a.P.out = (float*)d_out; a.P.ws = (unsigned char*)d_ws;
    (void)hipMemsetAsync((char*)d_ws + WS_CTL, 0, MiB, stream);
#if MK_SEGMENTS == 1
    a.ph_lo = 0; a.ph_hi = NPHASE; a.li = 0;
    void* kargs[] = {&a};
    hipError_t e = hipLaunchCooperativeKernel((const void*)mk_fwd, dim3(grid), dim3(NTHR), kargs, LDS_BYTES, stream);
    if (e != hipSuccess) fprintf(stderr, "kernel_launch: cooperative launch failed: %s (grid %d)\n", hipGetErrorString(e), grid);
#else
    for (int ph = 0; ph < NPHASE; ++ph) { a.ph_lo = ph; a.ph_hi = ph + 1; a.li = ph; hipLaunchKernelGGL(mk_fwd, dim3(grid), dim3(NTHR), LDS_BYTES, stream, a); }
#endif
}
```

```cpp
#include <hip/hip_runtime.h>
#include <cstdio>
#include <cstdint>

constexpr int T = 32768, D = 1024, SEQ = 2048, NB = 16;
constexpr int NIN_SRC = 2576, NPROJ = 2816;
constexpr int PC_Q = 0, PC_K = 256, PC_V = 512, PC_G = 1024, PC_GK = 1536, PC_U = 1792, PC_VS = 2304;
constexpr int NE = 32, TOPK = 4, DE = 1024;
constexpr int MT = 256;
constexpr int MAXSLOTS = T * TOPK + NE * MT;
constexpr float EPS = 1e-6f;

typedef unsigned short bf16;
typedef unsigned v4u __attribute__((ext_vector_type(4)));
typedef float f32x4 __attribute__((ext_vector_type(4)));

constexpr size_t MiB = 1u << 20;
constexpr size_t WS_CTL   = 0;
constexpr size_t WS_WIN   = 1 * MiB;
constexpr size_t WS_WOUT  = 7 * MiB;
constexpr size_t WS_WSP   = 9 * MiB;
constexpr size_t WS_ROUTE = 10 * MiB;
constexpr size_t WS_WGU   = 20 * MiB;
constexpr size_t WS_WD    = 148 * MiB;
constexpr size_t WS_X1    = 212 * MiB;
constexpr size_t WS_ACT   = 340 * MiB;
constexpr size_t WS_PROJ  = 612 * MiB;
constexpr size_t WS_MIX   = 788 * MiB;
constexpr size_t WS_H     = 852 * MiB;
constexpr size_t WS_YBUF  = WS_PROJ;
constexpr size_t WS_VN    = WS_ACT;
constexpr size_t WS_END   = 916 * MiB;
static_assert(WS_YBUF + (size_t)MAXSLOTS * 1024 * 2 <= WS_END, "ybuf fits");
static_assert(WS_ACT + (size_t)MAXSLOTS * 1024 * 2 <= WS_PROJ, "act fits");
constexpr size_t RT_ROWTOK = 0;
constexpr size_t RT_ROWW   = 4 * MiB;
constexpr size_t RT_TOKSLOT= 8 * MiB;
constexpr int CW_COUNTS = 64;
constexpr int CW_PSTART = 128;

__device__ __forceinline__ unsigned f2bf(float f) { unsigned u = __builtin_bit_cast(unsigned, f); return (u + 0x7fffu + ((u >> 16) & 1u)) >> 16; }
__device__ __forceinline__ float bf2f(unsigned h) { return __builtin_bit_cast(float, h << 16); }
__device__ __forceinline__ unsigned pk2(float lo, float hi) { return f2bf(lo) | (f2bf(hi) << 16); }
__device__ __forceinline__ float gelu_tanh(float x) { const float u = 0.7978845608028654f * (x + 0.044715f * x * x * x); return x / (1.0f + __expf(-2.0f * u)); }
__device__ __forceinline__ float silu(float x) { return x / (1.0f + __expf(-x)); }
__device__ __forceinline__ float log_sigmoid(float x) { return fminf(x, 0.0f) - log1pf(__expf(-fabsf(x))); }
__device__ __forceinline__ float wave_sum(float v) {
#pragma unroll
    for (int o = 1; o < 64; o <<= 1) v += __shfl_xor(v, o);
    return v;
}

struct Ptrs {
    const float *x, *norm_mix_w, *w_in, *w_gk_up, *b_gk, *gla_norm_w, *sg_ln_w, *sg_ln_b, *w_spatial, *b_spatial, *w_out, *norm_ffn_w,
                *w_router, *b_router, *w_gate_up, *b_gate_up, *w_down, *b_down, *norm_final_w;
    float* out; unsigned char* ws;
};

__device__ __forceinline__ void p0_tr_write(bf16* WT, int K, int d0, int k0, const float* scr, int lane) {
    const int c = lane & 7;
#pragma unroll
    for (int j = 0; j < 4; ++j) { const int n = (lane >> 3) + 8 * j; const float* s = scr + (8 * c) * 33 + n;
        v4u o; o.x = pk2(s[0 * 33], s[1 * 33]); o.y = pk2(s[2 * 33], s[3 * 33]); o.z = pk2(s[4 * 33], s[5 * 33]); o.w = pk2(s[6 * 33], s[7 * 33]);
        *(v4u*)(WT + (size_t)(d0 + n) * K + k0 + 8 * c) = o; }
}
__device__ __forceinline__ void p0_transpose_item(const float* W, int ldn, int n0, int k0, bf16* WT, int K, int d0, float* scr, int lane) {
#pragma unroll 8
    for (int i = 0; i < 32; ++i) { const int kk = 2 * i + (lane >> 5); scr[kk * 33 + (lane & 31)] = W[(size_t)(k0 + kk) * ldn + n0 + (lane & 31)]; }
    __builtin_amdgcn_wave_barrier(); asm volatile("s_waitcnt lgkmcnt(0)" ::: "memory");
    p0_tr_write(WT, K, d0, k0, scr, lane);
    asm volatile("s_waitcnt lgkmcnt(0)" ::: "memory"); __builtin_amdgcn_wave_barrier();
}
__device__ __forceinline__ void p0_gk_item(const float* w_in, const float* w_gk_up, int j0, int k0, bf16* WT, float* scr, int lane) {
    for (int i = 0; i < 32; ++i) { const int kk = 2 * i + (lane >> 5), j = j0 + (lane & 31); float s = 0.f;
#pragma unroll
        for (int r = 0; r < 16; ++r) s += w_in[(size_t)(k0 + kk) * NIN_SRC + 1536 + r] * w_gk_up[r * 256 + j];
        scr[kk * 33 + (lane & 31)] = s; }
    __builtin_amdgcn_wave_barrier(); asm volatile("s_waitcnt lgkmcnt(0)" ::: "memory");
    p0_tr_write(WT, D, PC_GK + j0, k0, scr, lane);
    asm volatile("s_waitcnt lgkmcnt(0)" ::: "memory"); __builtin_amdgcn_wave_barrier();
}
constexpr int IT_IN = (NPROJ / 32) * 16, IT_OUT = 32 * 16, IT_GU = NE * 64 * 16, IT_DN = NE * 32 * 16, IT_ALL = IT_IN + IT_OUT + IT_GU + IT_DN;
__device__ __forceinline__ void p0_weight_item(const Ptrs& P, int it, float* scr, int lane) {
    bf16* WinT = (bf16*)(P.ws + WS_WIN); bf16* WoutT = (bf16*)(P.ws + WS_WOUT); bf16* WguT = (bf16*)(P.ws + WS_WGU); bf16* WdT = (bf16*)(P.ws + WS_WD);
    if (it < IT_IN) { const int db = it / 16, kb = it % 16, d0 = db * 32;
        if (d0 >= PC_GK && d0 < PC_U) p0_gk_item(P.w_in, P.w_gk_up, d0 - PC_GK, kb * 64, WinT, scr, lane);
        else p0_transpose_item(P.w_in, NIN_SRC, d0 < PC_GK ? d0 : d0 - 240, kb * 64, WinT, D, d0, scr, lane);
        return; }
    it -= IT_IN;
    if (it < IT_OUT) { const int db = it / 16, kb = it % 16; p0_transpose_item(P.w_out, D, db * 32, kb * 64, WoutT, D, db * 32, scr, lane); return; }
    it -= IT_OUT;
    if (it < IT_GU) { const int e = it / 1024, r = it % 1024, db = r / 16, kb = r % 16, d0 = db * 32, pn = d0 >> 8, bj = (d0 >> 7) & 1, rr = d0 & 127;
        p0_transpose_item(P.w_gate_up + (size_t)e * D * 2048, 2048, bj * 1024 + 128 * pn + rr, kb * 64, WguT + (size_t)e * 2048 * D, D, d0, scr, lane); return; }
    it -= IT_GU;
    { const int e = it / 512, r = it % 512, db = r / 16, kb = r % 16;
      p0_transpose_item(P.w_down + (size_t)e * DE * D, D, db * 32, kb * 64, WdT + (size_t)e * D * DE, DE, db * 32, scr, lane); }
}
__device__ __forceinline__ void rms_row_to_bf16(const float* xrow, const float* w, bf16* orow, int lane) {
    const f32x4* xr = (const f32x4*)xrow + lane; const f32x4* wr = (const f32x4*)w + lane;
    f32x4 v[4]; float s = 0.f;
#pragma unroll
    for (int j = 0; j < 4; ++j) { v[j] = xr[64 * j]; s += (v[j].x * v[j].x + v[j].y * v[j].y) + (v[j].z * v[j].z + v[j].w * v[j].w); }
    const float rstd = 1.0f / sqrtf(wave_sum(s) * (1.f / D) + EPS);
    unsigned long long* o8 = (unsigned long long*)orow + lane;
#pragma unroll
    for (int j = 0; j < 4; ++j) { const f32x4 ww = wr[64 * j];
        o8[64 * j] = (unsigned long long)pk2(v[j].x * rstd * ww.x, v[j].y * rstd * ww.y) | ((unsigned long long)pk2(v[j].z * rstd * ww.z, v[j].w * rstd * ww.w) << 32); }
}
__global__ void __launch_bounds__(256) k_p0(Ptrs P) {
    __shared__ float scr_all[4 * 64 * 33];
    const int tid = threadIdx.x, lane = tid & 63, wave = tid >> 6;
    float* scr = scr_all + wave * 64 * 33;
    const int gw = blockIdx.x * 4 + wave, NGW = gridDim.x * 4;
    for (int it = gw; it < IT_ALL; it += NGW) p0_weight_item(P, it, scr, lane);
    bf16* Wsp = (bf16*)(P.ws + WS_WSP);
    for (int i = blockIdx.x * 256 + tid; i < 4 * 128 * 128; i += gridDim.x * 256) { const int t = (i >> 7) & 127, s = i & 127; Wsp[i] = (bf16)f2bf(s <= t ? P.w_spatial[i] : 0.f); }
    bf16* H = (bf16*)(P.ws + WS_H);
    for (int m = gw; m < T; m += NGW) rms_row_to_bf16(P.x + (size_t)m * D, P.norm_mix_w, H + (size_t)m * D, lane);
}

template <int MODE>
__global__ void __launch_bounds__(256) n_gemm(Ptrs P) {
    __shared__ __attribute__((aligned(16))) float As[32][68];
    __shared__ __attribute__((aligned(16))) float Bs[32][68];
    __shared__ __attribute__((aligned(16))) float Bs2[MODE == 2 ? 32 : 1][68];
    const int tid = threadIdx.x, ty = tid >> 4, tx = tid & 15;
    const unsigned* ctl = (const unsigned*)(P.ws + WS_CTL);
    const int e = (MODE >= 2) ? blockIdx.z : 0;
    const int m0 = blockIdx.y * 64, n0 = blockIdx.x * 64;
    int count = T; size_t slot0 = 0;
    if (MODE >= 2) { count = (int)ctl[CW_COUNTS + e]; slot0 = ctl[CW_PSTART + e]; if (m0 >= count) return; }
    const bf16* A; const bf16* Bt; const bf16* Bt2 = nullptr; int K = D;
    const int lr = tid >> 2, lk = (tid & 3) * 8;
    size_t arow;
    if (MODE == 0) { A = (const bf16*)(P.ws + WS_H); Bt = (const bf16*)(P.ws + WS_WIN) + (size_t)n0 * D; arow = m0 + lr; }
    else if (MODE == 1) { A = (const bf16*)(P.ws + WS_MIX); Bt = (const bf16*)(P.ws + WS_WOUT) + (size_t)n0 * D; arow = m0 + lr; }
    else if (MODE == 2) { A = (const bf16*)(P.ws + WS_H); const int* rowtok = (const int*)(P.ws + WS_ROUTE + RT_ROWTOK) + (size_t)e * T;
        const int mm = (m0 + lr < count) ? m0 + lr : 0; arow = rowtok[mm];
        const int pn = n0 >> 7, r0 = n0 & 127; Bt = (const bf16*)(P.ws + WS_WGU) + ((size_t)e * 2048 + 256 * pn + r0) * D; Bt2 = Bt + (size_t)128 * D; }
    else { A = (const bf16*)(P.ws + WS_ACT); arow = slot0 + ((m0 + lr < count) ? m0 + lr : 0); Bt = (const bf16*)(P.ws + WS_WD) + ((size_t)e * D + n0) * DE; K = DE; }
    float acc[4][4] = {}, acc2[4][4] = {};
    for (int k0 = 0; k0 < K; k0 += 32) {
        { const v4u a = *(const v4u*)(A + arow * K + k0 + lk); const unsigned aw[4] = {a.x, a.y, a.z, a.w};
#pragma unroll
          for (int j = 0; j < 4; ++j) { As[lk + 2 * j][lr] = bf2f(aw[j] & 0xffffu); As[lk + 2 * j + 1][lr] = bf2f(aw[j] >> 16); } }
        { const v4u b = *(const v4u*)(Bt + (size_t)lr * K + k0 + lk); const unsigned bw[4] = {b.x, b.y, b.z, b.w};
#pragma unroll
          for (int j = 0; j < 4; ++j) { Bs[lk + 2 * j][lr] = bf2f(bw[j] & 0xffffu); Bs[lk + 2 * j + 1][lr] = bf2f(bw[j] >> 16); } }
        if (MODE == 2) { const v4u b = *(const v4u*)(Bt2 + (size_t)lr * K + k0 + lk); const unsigned bw[4] = {b.x, b.y, b.z, b.w};
#pragma unroll
          for (int j = 0; j < 4; ++j) { Bs2[lk + 2 * j][lr] = bf2f(bw[j] & 0xffffu); Bs2[lk + 2 * j + 1][lr] = bf2f(bw[j] >> 16); } }
        __syncthreads();
#pragma unroll 8
        for (int k = 0; k < 32; ++k) {
            const f32x4 a = *(const f32x4*)&As[k][ty * 4], b = *(const f32x4*)&Bs[k][tx * 4];
#pragma unroll
            for (int i = 0; i < 4; ++i)
#pragma unroll
                for (int j = 0; j < 4; ++j) acc[i][j] += a[i] * b[j];
            if (MODE == 2) { const f32x4 b2 = *(const f32x4*)&Bs2[k][tx * 4];
#pragma unroll
                for (int i = 0; i < 4; ++i)
#pragma unroll
                    for (int j = 0; j < 4; ++j) acc2[i][j] += a[i] * b2[j]; }
        }
        __syncthreads();
    }
#pragma unroll
    for (int i = 0; i < 4; ++i) {
        const int m = m0 + ty * 4 + i, n = n0 + tx * 4;
        if (MODE == 0) { bf16* o = (bf16*)(P.ws + WS_PROJ) + (size_t)m * NPROJ + n; *(uint2*)o = make_uint2(pk2(acc[i][0], acc[i][1]), pk2(acc[i][2], acc[i][3])); }
        else if (MODE == 1) { const f32x4 xr = *(const f32x4*)(P.x + (size_t)m * D + n); float* o = (float*)(P.ws + WS_X1) + (size_t)m * D + n;
            *(f32x4*)o = (f32x4){xr.x + acc[i][0], xr.y + acc[i][1], xr.z + acc[i][2], xr.w + acc[i][3]}; }
        else if (MODE == 2) { if (m < count) { float y[4];
#pragma unroll
                for (int j = 0; j < 4; ++j) { float g = acc[i][j] + P.b_gate_up[(size_t)e * 2048 + n + j], u = acc2[i][j] + P.b_gate_up[(size_t)e * 2048 + 1024 + n + j];
                    g = fminf(g, 7.0f); u = fminf(fmaxf(u, -7.0f), 7.0f); y[j] = (u + 1.0f) * (g / (1.0f + __expf(-1.702f * g))); }
                bf16* o = (bf16*)(P.ws + WS_ACT) + (slot0 + m) * DE + n; *(uint2*)o = make_uint2(pk2(y[0], y[1]), pk2(y[2], y[3])); } }
        else { if (m < count) { const float w = ((const float*)(P.ws + WS_ROUTE + RT_ROWW))[(size_t)e * T + m]; float y[4];
#pragma unroll
                for (int j = 0; j < 4; ++j) y[j] = (acc[i][j] + P.b_down[(size_t)e * D + n + j]) * w;
                bf16* o = (bf16*)(P.ws + WS_YBUF) + (slot0 + m) * D + n; *(uint2*)o = make_uint2(pk2(y[0], y[1]), pk2(y[2], y[3])); } }
    }
}

__global__ void __launch_bounds__(128) n_gla(Ptrs P) {
    __shared__ float sq[64], sk[64], sa[64], red[2];
    const int b = blockIdx.x >> 2, h = blockIdx.x & 3, v = threadIdx.x;
    const bf16* PROJ = (const bf16*)(P.ws + WS_PROJ); bf16* MIX = (bf16*)(P.ws + WS_MIX);
    float S[64];
#pragma unroll
    for (int k = 0; k < 64; ++k) S[k] = 0.f;
    const float nw = P.gla_norm_w[v];
    for (int t = 0; t < SEQ; ++t) {
        const size_t row = (size_t)(b * SEQ + t) * NPROJ;
        if (v < 64) { sq[v] = bf2f(PROJ[row + PC_Q + h * 64 + v]) * 0.125f; sk[v] = bf2f(PROJ[row + PC_K + h * 64 + v]);
            sa[v] = __expf(log_sigmoid(bf2f(PROJ[row + PC_GK + h * 64 + v]) + P.b_gk[h * 64 + v]) * (1.0f / 16.0f)); }
        const float vv = bf2f(PROJ[row + PC_V + h * 128 + v]), g = bf2f(PROJ[row + PC_G + h * 128 + v]);
        __syncthreads();
        float o = 0.f;
#pragma unroll
        for (int k = 0; k < 64; ++k) { S[k] = sa[k] * S[k] + sk[k] * vv; o += sq[k] * S[k]; }
        const float ss = wave_sum(o * o);
        if ((v & 63) == 0) red[v >> 6] = ss;
        __syncthreads();
        const float rstd = 1.0f / sqrtf((red[0] + red[1]) * (1.0f / 128.0f) + EPS);
        MIX[(size_t)(b * SEQ + t) * D + h * 128 + v] = (bf16)f2bf(o * rstd * nw * silu(g));
    }
}
__global__ void __launch_bounds__(256) n_sgu_vn(Ptrs P) {
    const int lane = threadIdx.x & 63, m = blockIdx.x * 4 + (threadIdx.x >> 6);
    const bf16* PROJ = (const bf16*)(P.ws + WS_PROJ); float* VN = (float*)(P.ws + WS_VN);
    const v4u raw = *(const v4u*)(PROJ + (size_t)m * NPROJ + PC_VS + lane * 8); const unsigned w[4] = {raw.x, raw.y, raw.z, raw.w};
    float g[8]; float s = 0.f;
#pragma unroll
    for (int j = 0; j < 4; ++j) { g[2 * j] = gelu_tanh(bf2f(w[j] & 0xffffu)); g[2 * j + 1] = gelu_tanh(bf2f(w[j] >> 16)); s += g[2 * j] + g[2 * j + 1]; }
    const float mu = wave_sum(s) * (1.0f / 512.0f); float q = 0.f;
#pragma unroll
    for (int j = 0; j < 8; ++j) { g[j] -= mu; q += g[j] * g[j]; }
    const float rstd = 1.0f / sqrtf(wave_sum(q) * (1.0f / 512.0f) + EPS);
#pragma unroll
    for (int j = 0; j < 8; ++j) VN[(size_t)m * 512 + lane * 8 + j] = g[j] * rstd * P.sg_ln_w[lane * 8 + j] + P.sg_ln_b[lane * 8 + j];
}
__global__ void __launch_bounds__(256) n_sgu_mix(Ptrs P) {
    const int bn = blockIdx.x >> 2, g = blockIdx.x & 3, c = threadIdx.x & 127;
    const float* VN = (const float*)(P.ws + WS_VN); const bf16* PROJ = (const bf16*)(P.ws + WS_PROJ); bf16* MIX = (bf16*)(P.ws + WS_MIX);
    const size_t base = (size_t)bn * 128;
    for (int t = threadIdx.x >> 7; t < 128; t += 2) {
        float acc = 0.f; const float* wrow = P.w_spatial + ((size_t)g * 128 + t) * 128;
        for (int s = 0; s <= t; ++s) acc += wrow[s] * VN[(base + s) * 512 + g * 128 + c];
        acc += P.b_spatial[g * 128 + t];
        const float u = gelu_tanh(bf2f(PROJ[(base + t) * NPROJ + PC_U + g * 128 + c]));
        MIX[(base + t) * D + 512 + g * 128 + c] = (bf16)f2bf(u * acc);
    }
}
__global__ void __launch_bounds__(256) n_router(Ptrs P) {
    const int lane = threadIdx.x & 63, m = blockIdx.x * 4 + (threadIdx.x >> 6);
    const float* X1 = (const float*)(P.ws + WS_X1) + (size_t)m * D; bf16* H2 = (bf16*)(P.ws + WS_H) + (size_t)m * D;
    unsigned* ctl = (unsigned*)(P.ws + WS_CTL);
    f32x4 v[4]; float s = 0.f;
#pragma unroll
    for (int j = 0; j < 4; ++j) { v[j] = ((const f32x4*)X1)[lane + 64 * j]; s += (v[j].x * v[j].x + v[j].y * v[j].y) + (v[j].z * v[j].z + v[j].w * v[j].w); }
    const float rstd = 1.0f / sqrtf(wave_sum(s) * (1.f / D) + EPS);
#pragma unroll
    for (int j = 0; j < 4; ++j) { const f32x4 ww = ((const f32x4*)P.norm_ffn_w)[lane + 64 * j];
        ((unsigned long long*)H2)[lane + 64 * j] = (unsigned long long)pk2(v[j].x * rstd * ww.x, v[j].y * rstd * ww.y) | ((unsigned long long)pk2(v[j].z * rstd * ww.z, v[j].w * rstd * ww.w) << 32); }
    const int e = lane & 31, half = lane >> 5; float acc = 0.f;
    for (int k = half * 512; k < half * 512 + 512; ++k) acc += X1[k] * P.norm_ffn_w[k] * P.w_router[(size_t)k * NE + e];
    acc += __shfl_xor(acc, 32);
    float logit = acc * rstd + P.b_router[e];
    int sel_e[4]; float sel_v[4];
#pragma unroll
    for (int r = 0; r < 4; ++r) { float bv = logit; int bi = e;
#pragma unroll
        for (int o = 1; o < 32; o <<= 1) { const float ov = __shfl_xor(bv, o); const int oi = __shfl_xor(bi, o); if (ov > bv || (ov == bv && oi < bi)) { bv = ov; bi = oi; } }
        sel_e[r] = bi; sel_v[r] = bv; if (e == bi) logit = -3.0e38f; }
    float den = 0.f, pw[4];
#pragma unroll
    for (int r = 0; r < 4; ++r) { pw[r] = __expf(sel_v[r] - sel_v[0]); den += pw[r]; }
    if (lane < 4) { int ee = sel_e[0]; float ww = pw[0];
#pragma unroll
        for (int r = 1; r < 4; ++r) if (lane == r) { ee = sel_e[r]; ww = pw[r]; }
        ww /= den;
        const unsigned rank = atomicAdd(&ctl[CW_COUNTS + ee], 1u);
        ((int*)(P.ws + WS_ROUTE + RT_ROWTOK))[(size_t)ee * T + rank] = m;
        ((float*)(P.ws + WS_ROUTE + RT_ROWW))[(size_t)ee * T + rank] = ww;
        ((int*)(P.ws + WS_ROUTE + RT_TOKSLOT))[(size_t)m * 4 + lane] = (ee << 16) | (int)rank; }
}
__global__ void n_pstart(Ptrs P) { unsigned* ctl = (unsigned*)(P.ws + WS_CTL); unsigned s = 0; for (int e = 0; e < NE; ++e) { ctl[CW_PSTART + e] = s; s += (ctl[CW_COUNTS + e] + MT - 1) / MT * MT; } ctl[CW_PSTART + NE] = s; }
__global__ void __launch_bounds__(256) n_final(Ptrs P) {
    const int lane = threadIdx.x & 63, m = blockIdx.x * 4 + (threadIdx.x >> 6);
    const unsigned* ctl = (const unsigned*)(P.ws + WS_CTL);
    const float* X1 = (const float*)(P.ws + WS_X1) + (size_t)m * D; const bf16* Y = (const bf16*)(P.ws + WS_YBUF);
    const int* ts = (const int*)(P.ws + WS_ROUTE + RT_TOKSLOT) + (size_t)m * 4;
    f32x4 v[4];
#pragma unroll
    for (int j = 0; j < 4; ++j) v[j] = ((const f32x4*)X1)[lane + 64 * j];
#pragma unroll
    for (int r = 0; r < 4; ++r) { const int pk = ts[r]; const size_t slot = (size_t)ctl[CW_PSTART + (pk >> 16)] + (pk & 0xffff);
#pragma unroll
        for (int j = 0; j < 4; ++j) { const uint2 y = ((const uint2*)(Y + slot * D))[lane + 64 * j];
            v[j].x += bf2f(y.x & 0xffffu); v[j].y += bf2f(y.x >> 16); v[j].z += bf2f(y.y & 0xffffu); v[j].w += bf2f(y.y >> 16); } }
    float s = 0.f;
#pragma unroll
    for (int j = 0; j < 4; ++j) s += (v[j].x * v[j].x + v[j].y * v[j].y) + (v[j].z * v[j].z + v[j].w * v[j].w);
    const float rstd = 1.0f / sqrtf(wave_sum(s) * (1.f / D) + EPS);
#pragma unroll
    for (int j = 0; j < 4; ++j) { const f32x4 ww = ((const f32x4*)P.norm_final_w)[lane + 64 * j];
        ((f32x4*)(P.out + (size_t)m * D))[lane + 64 * j] = (f32x4){v[j].x * rstd * ww.x, v[j].y * rstd * ww.y, v[j].z * rstd * ww.z, v[j].w * rstd * ww.w}; }
}


#define LAS __attribute__((address_space(3)))
typedef short bf16x8 __attribute__((ext_vector_type(8)));
typedef unsigned u32x4 __attribute__((ext_vector_type(4)));
constexpr int NWAVES = 8, NTHR = 512;
constexpr int RING_BYTES = 131072, TAB_OFF = RING_BYTES, MISC_OFF = RING_BYTES + 1024, LDS_BYTES = 147456;
constexpr int CW_BAR = 4096;
#define RLX_AGENT __ATOMIC_RELAXED, __HIP_MEMORY_SCOPE_AGENT

#define XB_TMO      128
#define XB_XCNT(j)  (256  + 64 * (j))
#define XB_XSUB(j)  (1280 + 64 * (j))
#define XB_XGEN(j)  (2304 + 64 * (j))
#define XB_TOP      3328
#define XB_TOPGEN   3392
#define XCD_BAR_WORDS 3456
#define XB_SPIN_CAP (1u << 20)
__device__ __forceinline__ unsigned xb_ld(unsigned* p)              { return __hip_atomic_load(p, __ATOMIC_RELAXED, __HIP_MEMORY_SCOPE_AGENT); }
__device__ __forceinline__ unsigned xb_add(unsigned* p, unsigned v) { return __hip_atomic_fetch_add(p, v, __ATOMIC_RELAXED, __HIP_MEMORY_SCOPE_AGENT); }
__device__ __forceinline__ unsigned xb_xcc_id() { return (unsigned)__builtin_amdgcn_s_getreg((3 << 11) | 20) & 0xFu; }
#define XB_SPIN(cond, bar) do { unsigned _sp = 0; while (cond) { __builtin_amdgcn_s_sleep(1); \
    if ((++_sp & 255u) == 0u) { if (xb_ld(&(bar)[XB_TMO])) break; if (_sp > XB_SPIN_CAP) { atomicAdd(&(bar)[XB_TMO], 1u); break; } } } } while (0)
struct XcdBarrier { unsigned* bar; unsigned x; volatile LAS unsigned* st; };
__device__ __forceinline__ XcdBarrier xcd_barrier_post(unsigned* bar, volatile LAS unsigned* st) {
    XcdBarrier b; b.bar = bar; b.x = xb_xcc_id(); b.st = st;
    if (threadIdx.x == 0) (void)xb_add(&bar[XB_XCNT(b.x)], 1u);
    return b;
}
__device__ __forceinline__ void xcd_barrier_complete(unsigned* bar, unsigned x, unsigned& nloc, unsigned& nx) {
    const unsigned G = gridDim.x * gridDim.y * gridDim.z;
    unsigned sum, cnt, mine, sp = 0u;
    for (;;) {
        sum = 0u; cnt = 0u; mine = 0u;
#pragma unroll
        for (unsigned j = 0; j < 16; ++j) { const unsigned c = xb_ld(&bar[XB_XCNT(j)]); sum += c; cnt += (c > 0u) ? 1u : 0u; mine = (j == x) ? c : mine; }
        if (sum == G) break;
        __builtin_amdgcn_s_sleep(1);
        if ((++sp & 255u) == 0u) { if (xb_ld(&bar[XB_TMO])) break; if (sp > XB_SPIN_CAP) { atomicAdd(&bar[XB_TMO], 1u); break; } }
    }
    nloc = mine > 0u ? mine : 1u; nx = cnt > 0u ? cnt : 1u;
}
__device__ __forceinline__ void xcd_barrier(const XcdBarrier& b) {
    asm volatile("s_waitcnt vmcnt(0)" ::: "memory");
    __syncthreads();
    if (threadIdx.x == 0) {
        unsigned* bar = b.bar;
        __builtin_amdgcn_s_waitcnt(0);
        unsigned nloc = b.st[0], nx = b.st[1];
        if (nloc == 0u) { xcd_barrier_complete(bar, b.x, nloc, nx); b.st[0] = nloc; b.st[1] = nx; }
        const unsigned old = xb_add(&bar[XB_XSUB(b.x)], 1u);
        const unsigned gen = old / nloc;
        if (old + 1u == (gen + 1u) * nloc) {
            __builtin_amdgcn_fence(__ATOMIC_RELEASE, "agent");
            asm volatile("s_waitcnt vmcnt(0)" ::: "memory");
            const unsigned og = xb_add(&bar[XB_TOP], 1u);
            const unsigned tg = og / nx;
            if (og + 1u == (tg + 1u) * nx) xb_add(&bar[XB_TOPGEN], 1u);
            else XB_SPIN(xb_ld(&bar[XB_TOPGEN]) == tg, bar);
            __builtin_amdgcn_fence(__ATOMIC_ACQUIRE, "agent");
            xb_add(&bar[XB_XGEN(b.x)], 1u);
            asm volatile("s_waitcnt vmcnt(0)" ::: "memory");
        } else {
            XB_SPIN(xb_ld(&bar[XB_XGEN(b.x)]) == gen, bar);
            __builtin_amdgcn_fence(__ATOMIC_ACQUIRE, "agent");
            asm volatile("s_waitcnt vmcnt(0)" ::: "memory");
        }
    }
    __syncthreads();
}

namespace pg8 {
constexpr int BM = 256, BK = 64, HALF = 128, HTB = HALF * BK * 2, NXCD = 8, WGM = 8;
__device__ __forceinline__ int lds_byte(int r, int c) { const int st = (r >> 4) * 2 + (c >> 5), rr = r & 15, cc = c & 31, ob = rr * 64 + cc * 2; return st * 1024 + (ob ^ (((ob >> 9) & 1) << 5)); }
__device__ __forceinline__ void stage_rc(int b, int& R, int& C) { const int st = b / 1024, sb = b % 1024, swz = sb ^ (((sb >> 9) & 1) << 5); R = (st >> 1) * 16 + swz / 64; C = (st & 1) * 32 + (swz % 64) / 2; }
__device__ __forceinline__ int perm32(int rho) { const int n = rho >> 4, i = rho & 15; return 8 * (i >> 2) + 4 * n + (i & 3); }
typedef float f32x2_t __attribute__((ext_vector_type(2)));
typedef __bf16 bf16x2_t __attribute__((ext_vector_type(2)));
__device__ __forceinline__ unsigned cvt_pk_bf16(float lo, float hi) { const f32x2_t v = {lo, hi}; const bf16x2_t b = __builtin_convertvector(v, bf16x2_t); return __builtin_bit_cast(unsigned, b); }
__device__ __forceinline__ int xcd_remap(int wgid, int nwg) { const int q = nwg / NXCD, r = nwg % NXCD, xcd = wgid % NXCD, off = wgid / NXCD; return (xcd < r ? xcd * (q + 1) : r * (q + 1) + (xcd - r) * q) + off; }

struct Unit { int pm, pn, e, m0, count, slot0; };
typedef f32x4 Acc[2][2][4][2];

struct DenseSched {
    int nM, nN, nwg, G, c, K;
    __device__ __forceinline__ void init(int M, int N, int K_, int G_, int c_) { nM = M / BM; nN = N / BM; nwg = nM * nN; G = G_; c = c_; K = K_; }
    __device__ __forceinline__ bool next(int i, Unit& u) const {
        const long L = (long)i * G + c; if (L >= nwg) return false;
        const int wgid = xcd_remap((int)L, nwg);
        const int nig = WGM * nN, gid = wgid / nig, fm = gid * WGM, gsz = (nM - fm) < WGM ? (nM - fm) : WGM;
        u.pm = fm + ((wgid % nig) % gsz); u.pn = (wgid % nig) / gsz; u.e = 0; u.m0 = 0; u.count = 0; u.slot0 = 0; return true;
    }
    __device__ __forceinline__ unsigned a_off(const Unit& u, int r) const { return (unsigned)(u.pm * BM + r) * (unsigned)(K * 2); }
    __device__ __forceinline__ size_t b_off(const Unit& u) const { return (size_t)u.pn * BM * K * 2; }
};
struct MoeSched {
    const LAS int* tab; const int* rowtok; int NPN, G, c, ntile, K, NB_E  ; bool gather;
    __device__ __forceinline__ bool next(int i, Unit& u) const {
        const long L = (long)i * G + c; if (L >= ntile) return false;
        const int wgid = xcd_remap((int)L, ntile);
        int lo = 0, hi = NE;
#pragma unroll
        for (int s = 0; s < 5; ++s) { const int mid = (lo + hi) >> 1; if (tab[mid] * NPN <= wgid) lo = mid; else hi = mid; }
        const int e = lo, mte = tab[e + 1] - tab[e], local = wgid - tab[e] * NPN;
        u.e = e; u.pn = local / mte; u.pm = 0; u.m0 = (local % mte) * BM; u.count = tab[66 + e]; u.slot0 = tab[33 + e]; return true;
    }
    __device__ __forceinline__ unsigned a_off(const Unit& u, int r) const {
        int m = u.m0 + r; if (gather) { m = m < u.count ? m : u.count - 1; return (unsigned)rowtok[(size_t)u.e * T + m] * (unsigned)(K * 2); }
        return (unsigned)(u.slot0 + m) * (unsigned)(K * 2);
    }
    __device__ __forceinline__ size_t b_off(const Unit& u) const { return ((size_t)u.e * NB_E + (size_t)u.pn * BM) * K * 2; }
};

struct EpiProj {
    static constexpr bool PERM = true;
    bf16* O;
    __device__ __forceinline__ void operator()(const Acc& acc, const Unit& u, int wr, int wc, int fr, int fq) const {
        const int row0 = u.pm * BM + wr * 64 + fr, col0 = u.pn * BM + wc * 32 + 8 * fq;
#pragma unroll
        for (int ai = 0; ai < 2; ++ai)
#pragma unroll
            for (int m = 0; m < 4; ++m) { bf16* rowp = O + (size_t)(row0 + ai * HALF + m * 16) * NPROJ + col0;
#pragma unroll
                for (int bj = 0; bj < 2; ++bj) { const f32x4 v0 = acc[ai][bj][m][0], v1 = acc[ai][bj][m][1];
                    u32x4 w; w.x = cvt_pk_bf16(v0[0], v0[1]); w.y = cvt_pk_bf16(v0[2], v0[3]); w.z = cvt_pk_bf16(v1[0], v1[1]); w.w = cvt_pk_bf16(v1[2], v1[3]);
                    *(u32x4*)(rowp + bj * HALF) = w; } }
    }
};
struct EpiX1 {
    static constexpr bool PERM = false;
    const float* X; float* O;
    __device__ __forceinline__ void operator()(const Acc& acc, const Unit& u, int wr, int wc, int fr, int fq) const {
        const int row0 = u.pm * BM + wr * 64 + fr, col0 = u.pn * BM + wc * 32 + 4 * fq;
#pragma unroll
        for (int ai = 0; ai < 2; ++ai)
#pragma unroll
            for (int m = 0; m < 4; ++m) { const size_t off = (size_t)(row0 + ai * HALF + m * 16) * D + col0;
#pragma unroll
                for (int bj = 0; bj < 2; ++bj)
#pragma unroll
                    for (int n = 0; n < 2; ++n) { const f32x4 xr = *(const f32x4*)(X + off + bj * HALF + n * 16); *(f32x4*)(O + off + bj * HALF + n * 16) = xr + acc[ai][bj][m][n]; }
                asm volatile("" ::: "memory"); }
    }
};
struct EpiAct {
    static constexpr bool PERM = true;
    bf16* O; const float* bgu;
    __device__ __forceinline__ void operator()(const Acc& acc, const Unit& u, int wr, int wc, int fr, int fq) const {
        const int colj = u.pn * 128 + wc * 32 + 8 * fq;
        const float* bg = bgu + (size_t)u.e * 2048 + colj;
        const f32x4 g0 = *(const f32x4*)bg, g1 = *(const f32x4*)(bg + 4), u0 = *(const f32x4*)(bg + 1024), u1 = *(const f32x4*)(bg + 1028);
#pragma unroll
        for (int ai = 0; ai < 2; ++ai)
#pragma unroll
            for (int m = 0; m < 4; ++m) { const int r = ai * HALF + wr * 64 + m * 16 + fr;
                if (u.m0 + r < u.count) { float y[8];
#pragma unroll
                    for (int n = 0; n < 2; ++n)
#pragma unroll
                        for (int i = 0; i < 4; ++i) { float g = acc[ai][0][m][n][i] + (n ? g1[i] : g0[i]), up = acc[ai][1][m][n][i] + (n ? u1[i] : u0[i]);
                            g = fminf(g, 7.0f); up = fminf(fmaxf(up, -7.0f), 7.0f); y[n * 4 + i] = (up + 1.0f) * (g / (1.0f + __expf(-1.702f * g))); }
                    u32x4 w; w.x = cvt_pk_bf16(y[0], y[1]); w.y = cvt_pk_bf16(y[2], y[3]); w.z = cvt_pk_bf16(y[4], y[5]); w.w = cvt_pk_bf16(y[6], y[7]);
                    *(u32x4*)(O + (size_t)(u.slot0 + u.m0 + r) * DE + colj) = w; } }
    }
};
struct EpiDown {
    static constexpr bool PERM = true;
    bf16* O; const float* bd; const float* roww;
    __device__ __forceinline__ void operator()(const Acc& acc, const Unit& u, int wr, int wc, int fr, int fq) const {
        const int col0 = u.pn * BM + wc * 32 + 8 * fq;
        const float* bp = bd + (size_t)u.e * D + col0;
        f32x4 bv[2][2];
#pragma unroll
        for (int bj = 0; bj < 2; ++bj)
#pragma unroll
            for (int n = 0; n < 2; ++n) bv[bj][n] = *(const f32x4*)(bp + bj * HALF + 4 * n);
#pragma unroll
        for (int ai = 0; ai < 2; ++ai)
#pragma unroll
            for (int m = 0; m < 4; ++m) { const int r = ai * HALF + wr * 64 + m * 16 + fr;
                if (u.m0 + r < u.count) { const float w8 = roww[(size_t)u.e * T + u.m0 + r]; bf16* rowp = O + (size_t)(u.slot0 + u.m0 + r) * D + col0;
#pragma unroll
                    for (int bj = 0; bj < 2; ++bj) { const f32x4 v0 = (acc[ai][bj][m][0] + bv[bj][0]) * w8, v1 = (acc[ai][bj][m][1] + bv[bj][1]) * w8;
                        u32x4 w; w.x = cvt_pk_bf16(v0[0], v0[1]); w.y = cvt_pk_bf16(v0[2], v0[3]); w.z = cvt_pk_bf16(v1[0], v1[1]); w.w = cvt_pk_bf16(v1[2], v1[3]);
                        *(u32x4*)(rowp + bj * HALF) = w; } } }
    }
};

template <class Epi, class Sched>
__device__ __forceinline__ void gemm_phase(LAS unsigned char* lds, const char* gA, const char* gB, int K, const Sched& S, const Epi& E) {
    const int tid = threadIdx.x, wid = __builtin_amdgcn_readfirstlane(tid >> 6), lane = tid & 63, wr = wid >> 2, wc = wid & 3, fr = lane & 15, fq = lane >> 4;
    const int nt = K / BK;
    int Rr[2], Cc[2]; unsigned voffB[2];
#pragma unroll
    for (int i = 0; i < 2; ++i) { int R, C; stage_rc(tid * 16 + i * 8192, R, C); Rr[i] = R; Cc[i] = C; const int Rb = Epi::PERM ? ((R & ~31) + perm32(R & 31)) : R; voffB[i] = (unsigned)(Rb * K + C) * 2u; }
    const size_t hstep = (size_t)HALF * K * 2;
    const unsigned ldsw = (unsigned)wid * 1024u;
    const int aoff = lds_byte(wr * 64 + fr, fq * 8), boff = lds_byte(wc * 32 + fr, fq * 8);
#define PG8_SA(b, h) (((b) * 2 + (h)) * HTB)
#define PG8_SB(b, h) ((4 + (b) * 2 + (h)) * HTB)
#define PG8_STAGEB(bufoff, gbase) do { _Pragma("unroll") for (int _i = 0; _i < 2; ++_i) \
        __builtin_amdgcn_global_load_lds((const unsigned*)((const char*)(gbase) + voffB[_i]), (LAS unsigned*)(lds + (bufoff) + ldsw + _i * 8192), 16, 0, 0); } while (0)
#define PG8_STAGEA(bufoff, voff2, kb) do { _Pragma("unroll") for (int _i = 0; _i < 2; ++_i) \
        __builtin_amdgcn_global_load_lds((const unsigned*)(gA + (size_t)(voff2)[_i] + (size_t)(kb)), (LAS unsigned*)(lds + (bufoff) + ldsw + _i * 8192), 16, 0, 0); } while (0)
#define PG8_LDA(dst, b, h) do { _Pragma("unroll") for (int m = 0; m < 4; ++m) _Pragma("unroll") for (int k = 0; k < 2; ++k) dst[m][k] = *(const LAS bf16x8*)(lds + PG8_SA(b, h) + aoff + m * 2048 + k * 1024); } while (0)
#define PG8_LDB(dst, b, h) do { _Pragma("unroll") for (int n = 0; n < 2; ++n) _Pragma("unroll") for (int k = 0; k < 2; ++k) dst[n][k] = *(const LAS bf16x8*)(lds + PG8_SB(b, h) + boff + n * 2048 + k * 1024); } while (0)
#define PG8_MMA(ai, bj, At, Bt) do { __builtin_amdgcn_s_setprio(1); _Pragma("unroll") for (int m = 0; m < 4; ++m) _Pragma("unroll") for (int n = 0; n < 2; ++n) _Pragma("unroll") for (int k = 0; k < 2; ++k) \
        acc[ai][bj][m][n] = __builtin_amdgcn_mfma_f32_16x16x32_bf16(Bt[n][k], At[m][k], acc[ai][bj][m][n], 0, 0, 0); __builtin_amdgcn_s_setprio(0); } while (0)
#define PG8_WAIT_V(n) asm volatile("s_waitcnt vmcnt(" #n ")" ::: "memory")
#define PG8_WAIT_L(n) asm volatile("s_waitcnt lgkmcnt(" #n ")" ::: "memory")
#define PG8_BAR __builtin_amdgcn_s_barrier()
#define PG8_SCHED __builtin_amdgcn_sched_barrier(0)
    Unit cur, nxt; int ui = 0;
    if (!S.next(0, cur)) return;
    Acc acc;
#pragma unroll
    for (int a = 0; a < 2; ++a)
#pragma unroll
        for (int b = 0; b < 2; ++b)
#pragma unroll
            for (int m = 0; m < 4; ++m)
#pragma unroll
                for (int n = 0; n < 2; ++n) acc[a][b][m][n] = (f32x4){0.f, 0.f, 0.f, 0.f};
    bf16x8 At[4][2], B0[2][2], B1[2][2];
    unsigned cA0[2], cA1[2], nA0[2], nA1[2];
#pragma unroll
    for (int i = 0; i < 2; ++i) { cA0[i] = S.a_off(cur, Rr[i]) + (unsigned)Cc[i] * 2u; cA1[i] = S.a_off(cur, HALF + Rr[i]) + (unsigned)Cc[i] * 2u; }
    const char* cB = gB + S.b_off(cur);
    PG8_STAGEB(PG8_SB(0, 0), cB); PG8_STAGEB(PG8_SB(0, 1), cB + hstep); PG8_STAGEA(PG8_SA(0, 0), cA0, 0); PG8_STAGEA(PG8_SA(0, 1), cA1, 0);
    if (wr == 1) PG8_BAR;
    PG8_WAIT_V(2); PG8_BAR;
    PG8_STAGEB(PG8_SB(1, 0), cB + BK * 2); PG8_STAGEA(PG8_SA(1, 0), cA0, BK * 2); PG8_STAGEB(PG8_SB(1, 1), cB + hstep + BK * 2);
    PG8_WAIT_V(6); PG8_BAR;
    for (;;) {
        const bool has_next = S.next(ui + 1, nxt);
        const char* nB = cB;
        if (has_next) {
#pragma unroll
            for (int i = 0; i < 2; ++i) { nA0[i] = S.a_off(nxt, Rr[i]) + (unsigned)Cc[i] * 2u; nA1[i] = S.a_off(nxt, HALF + Rr[i]) + (unsigned)Cc[i] * 2u; }
            nB = gB + S.b_off(nxt);
        } else {
#pragma unroll
            for (int i = 0; i < 2; ++i) { nA0[i] = cA0[i]; nA1[i] = cA1[i]; }
        }
        for (int t = 0; t < nt; t += 2) {
            const bool last = (t == nt - 2);
            const unsigned k1 = (unsigned)(t + 1) * (BK * 2), k2 = last ? 0u : (unsigned)(t + 2) * (BK * 2), k3 = k2 + BK * 2;
            unsigned a20[2], a21[2];
#pragma unroll
            for (int i = 0; i < 2; ++i) { a20[i] = last ? nA0[i] : cA0[i]; a21[i] = last ? nA1[i] : cA1[i]; }
            const char* b2 = (last ? nB : cB) + k2; const char* b3 = b2 + BK * 2;
            PG8_LDB(B0, 0, 0); PG8_LDB(B1, 0, 1); PG8_SCHED; PG8_LDA(At, 0, 0); PG8_STAGEA(PG8_SA(1, 1), cA1, k1);
            PG8_WAIT_V(8); PG8_WAIT_L(0); PG8_BAR; PG8_MMA(0, 0, At, B0); PG8_MMA(0, 1, At, B1); PG8_BAR; PG8_SCHED;
            PG8_LDA(At, 0, 1); PG8_STAGEB(PG8_SB(0, 0), b2); PG8_STAGEB(PG8_SB(0, 1), b2 + hstep); PG8_STAGEA(PG8_SA(0, 0), a20, k2);
            PG8_WAIT_V(8); PG8_WAIT_L(0); PG8_BAR; PG8_MMA(1, 0, At, B0); PG8_MMA(1, 1, At, B1); PG8_BAR; PG8_SCHED;
            PG8_LDB(B0, 1, 0); PG8_LDB(B1, 1, 1); PG8_SCHED; PG8_LDA(At, 1, 0); PG8_STAGEA(PG8_SA(0, 1), a21, k2);
            PG8_WAIT_V(8); PG8_WAIT_L(0); PG8_BAR; PG8_MMA(0, 0, At, B0); PG8_MMA(0, 1, At, B1); PG8_BAR; PG8_SCHED;
            PG8_LDA(At, 1, 1); PG8_STAGEB(PG8_SB(1, 0), b3); PG8_STAGEB(PG8_SB(1, 1), b3 + hstep); PG8_STAGEA(PG8_SA(1, 0), a20, k3);
            PG8_WAIT_V(8); PG8_WAIT_L(0); PG8_BAR; PG8_MMA(1, 0, At, B0); PG8_MMA(1, 1, At, B1); PG8_BAR; PG8_SCHED;
        }
        if (wr == 0) PG8_BAR;
        E(acc, cur, wr, wc, fr, fq);
        if (!has_next) break;
#pragma unroll
        for (int a = 0; a < 2; ++a)
#pragma unroll
            for (int b = 0; b < 2; ++b)
#pragma unroll
                for (int m = 0; m < 4; ++m)
#pragma unroll
                    for (int n = 0; n < 2; ++n) acc[a][b][m][n] = (f32x4){0.f, 0.f, 0.f, 0.f};
        cur = nxt; cB = nB; ++ui;
#pragma unroll
        for (int i = 0; i < 2; ++i) { cA0[i] = nA0[i]; cA1[i] = nA1[i]; }
        if (wr == 1) PG8_BAR;
    }
    PG8_WAIT_V(0);
    PG8_BAR;
#undef PG8_SA
#undef PG8_SB
#undef PG8_STAGEA
#undef PG8_STAGEB
#undef PG8_LDA
#undef PG8_LDB
#undef PG8_MMA
#undef PG8_WAIT_V
#undef PG8_WAIT_L
#undef PG8_BAR
#undef PG8_SCHED
}
}


typedef float f32x16 __attribute__((ext_vector_type(16)));
typedef short bf16x4 __attribute__((ext_vector_type(4)));
typedef unsigned u32x2 __attribute__((ext_vector_type(2)));
typedef float f32x2_t __attribute__((ext_vector_type(2)));
typedef __bf16 bf16x2_t __attribute__((ext_vector_type(2)));
__device__ __forceinline__ unsigned cvtpk(float lo, float hi) { const f32x2_t v = {lo, hi}; const bf16x2_t b = __builtin_convertvector(v, bf16x2_t); return __builtin_bit_cast(unsigned, b); }
template <int S8> __device__ __forceinline__ bf16x8 pack8(const f32x16& X) {
    u32x4 w; w.x = cvtpk(X[8 * S8 + 0], X[8 * S8 + 1]); w.y = cvtpk(X[8 * S8 + 2], X[8 * S8 + 3]); w.z = cvtpk(X[8 * S8 + 4], X[8 * S8 + 5]); w.w = cvtpk(X[8 * S8 + 6], X[8 * S8 + 7]);
    return __builtin_bit_cast(bf16x8, w);
}
__device__ __forceinline__ bf16x8 lds_b128(const LAS unsigned char* p) { return *(const LAS bf16x8*)p; }
__device__ __forceinline__ bf16x8 lds_2xb64(const LAS unsigned char* p) {
    const bf16x4 a = *(const LAS bf16x4*)p, b = *(const LAS bf16x4*)(p + 16);
    return __builtin_shufflevector(a, b, 0, 1, 2, 3, 4, 5, 6, 7);
}
__device__ __forceinline__ float fast_log_sigmoid(float x) { return fminf(x, 0.0f) - __logf(1.0f + __expf(-fabsf(x))); }

constexpr int GP = 144;
constexpr int GL_QD = 0, GL_KI = GL_QD + 64 * GP, GL_KET = GL_KI + 64 * GP, GL_VT = GL_KET + 64 * GP, GL_DEC = GL_VT + 128 * GP, GL_SSP = GL_DEC + 256, GL_OT = GL_SSP + 1024;
constexpr int OTP = 132;
constexpr int GL_END = GL_OT + 64 * OTP * 4;
static_assert(GL_END <= RING_BYTES && (GL_OT % 16) == 0 && (GL_DEC % 16) == 0, "gla lds");

__device__ __forceinline__ void gla_item(const Ptrs& P, LAS unsigned char* lds, int bh) {
    const int tid = threadIdx.x, lane = tid & 63, w = __builtin_amdgcn_readfirstlane(tid >> 6), l31 = lane & 31, hh = lane >> 5;
    const int b = bh >> 2, h = bh & 3, cr = w >> 2, vc = w & 3;
    const bf16* PROJ = (const bf16*)(P.ws + WS_PROJ); bf16* MIX = (bf16*)(P.ws + WS_MIX);
    const size_t tok0 = (size_t)b * SEQ;
    const bf16* pq = PROJ + (tok0 + lane) * NPROJ + PC_Q + h * 64 + 8 * w;
    const bf16* pk = PROJ + (tok0 + lane) * NPROJ + PC_K + h * 64 + 8 * w;
    const bf16* pg = PROJ + (tok0 + lane) * NPROJ + PC_GK + h * 64 + 8 * w;
    const bf16* pv = PROJ + (tok0 + lane) * NPROJ + PC_V + h * 128 + 16 * w;
    const int oc = tid >> 3, ov = (tid & 7) * 16;
    const bf16* pgate = PROJ + (tok0 + oc) * NPROJ + PC_G + h * 128 + ov;
    float bgk[8], nw[16];
#pragma unroll
    for (int j = 0; j < 8; ++j) bgk[j] = P.b_gk[h * 64 + 8 * w + j];
#pragma unroll
    for (int j = 0; j < 16; ++j) nw[j] = P.gla_norm_w[ov + j];
    f32x16 S0, S1;
#pragma unroll
    for (int r = 0; r < 16; ++r) { S0[r] = 0.f; S1[r] = 0.f; }
    v4u nq = *(const v4u*)pq, nk = *(const v4u*)pk, ng = *(const v4u*)pg, nv0 = *(const v4u*)pv, nv1 = *(const v4u*)(pv + 8);
    for (int n = 0; n < SEQ / 64; ++n) {
        const v4u cq = nq, ck = nk, cg = ng, cv0 = nv0, cv1 = nv1;
        const size_t adv = (size_t)(n + 1 < SEQ / 64 ? (n + 1) * 64 : n * 64) * NPROJ;
        nq = *(const v4u*)(pq + adv); nk = *(const v4u*)(pk + adv); ng = *(const v4u*)(pg + adv); nv0 = *(const v4u*)(pv + adv); nv1 = *(const v4u*)(pv + adv + 8);
        const size_t gadv = (size_t)n * 64 * NPROJ;
        const v4u gate0 = *(const v4u*)(pgate + gadv), gate1 = *(const v4u*)(pgate + gadv + 8);
        {
            const unsigned qw[4] = {cq.x, cq.y, cq.z, cq.w}, kw[4] = {ck.x, ck.y, ck.z, ck.w}, gw[4] = {cg.x, cg.y, cg.z, cg.w};
            float bb[8];
#pragma unroll
            for (int j = 0; j < 8; ++j) { const float x = bf2f((gw[j >> 1] >> (16 * (j & 1))) & 0xffffu) + bgk[j]; bb[j] = fast_log_sigmoid(x) * (1.0f / 16.0f); }
#pragma unroll
            for (int d = 1; d < 64; d <<= 1) {
#pragma unroll
                for (int j = 0; j < 8; ++j) { const float t = __shfl_up(bb[j], d); if (lane >= d) bb[j] += t; }
            }
            float qd[8], ki[8], ke[8];
#pragma unroll
            for (int j = 0; j < 8; ++j) { const float bl = __builtin_bit_cast(float, __builtin_amdgcn_readlane(__builtin_bit_cast(int, bb[j]), 63));
                const float qv = bf2f((qw[j >> 1] >> (16 * (j & 1))) & 0xffffu), kv = bf2f((kw[j >> 1] >> (16 * (j & 1))) & 0xffffu);
                qd[j] = qv * 0.125f * __expf(bb[j]); ki[j] = kv * __expf(-bb[j]); ke[j] = kv * __expf(bl - bb[j]);
                if (lane == 63) *(LAS float*)(lds + GL_DEC + (8 * w + j) * 4) = __expf(bl); }
            u32x4 t; t.x = cvtpk(qd[0], qd[1]); t.y = cvtpk(qd[2], qd[3]); t.z = cvtpk(qd[4], qd[5]); t.w = cvtpk(qd[6], qd[7]);
            *(LAS u32x4*)(lds + GL_QD + lane * GP + 16 * w) = t;
            t.x = cvtpk(ki[0], ki[1]); t.y = cvtpk(ki[2], ki[3]); t.z = cvtpk(ki[4], ki[5]); t.w = cvtpk(ki[6], ki[7]);
            *(LAS u32x4*)(lds + GL_KI + lane * GP + 16 * w) = t;
#pragma unroll
            for (int j = 0; j < 8; ++j) *(LAS unsigned short*)(lds + GL_KET + (8 * w + j) * GP + lane * 2) = (unsigned short)f2bf(ke[j]);
            const unsigned vw[8] = {cv0.x, cv0.y, cv0.z, cv0.w, cv1.x, cv1.y, cv1.z, cv1.w};
#pragma unroll
            for (int j = 0; j < 16; ++j) *(LAS unsigned short*)(lds + GL_VT + (16 * w + j) * GP + lane * 2) = (unsigned short)((vw[j >> 1] >> (16 * (j & 1))) & 0xffffu);
        }
        __syncthreads();
        f32x16 O;
#pragma unroll
        for (int r = 0; r < 16; ++r) O[r] = 0.f;
        {
            const LAS unsigned char* qrow = lds + GL_QD + (cr * 32 + l31) * GP + 8 * hh;
            O = __builtin_amdgcn_mfma_f32_32x32x16_bf16(pack8<0>(S0), lds_2xb64(qrow + 0), O, 0, 0, 0);
            O = __builtin_amdgcn_mfma_f32_32x32x16_bf16(pack8<1>(S0), lds_2xb64(qrow + 32), O, 0, 0, 0);
            O = __builtin_amdgcn_mfma_f32_32x32x16_bf16(pack8<0>(S1), lds_2xb64(qrow + 64), O, 0, 0, 0);
            O = __builtin_amdgcn_mfma_f32_32x32x16_bf16(pack8<1>(S1), lds_2xb64(qrow + 96), O, 0, 0, 0);
        }
        {
            const LAS unsigned char* qb = lds + GL_QD + (cr * 32 + l31) * GP + 16 * hh;
            const LAS unsigned char* vrow = lds + GL_VT + (vc * 32 + l31) * GP + 8 * hh;
            f32x16 X;
#pragma unroll
            for (int r = 0; r < 16; ++r) X[r] = 0.f;
            if (cr == 1) {
                const LAS unsigned char* ka = lds + GL_KI + l31 * GP + 16 * hh;
#pragma unroll
                for (int kk = 0; kk < 4; ++kk) X = __builtin_amdgcn_mfma_f32_32x32x16_bf16(lds_b128(ka + 32 * kk), lds_b128(qb + 32 * kk), X, 0, 0, 0);
                O = __builtin_amdgcn_mfma_f32_32x32x16_bf16(lds_2xb64(vrow + 0), pack8<0>(X), O, 0, 0, 0);
                O = __builtin_amdgcn_mfma_f32_32x32x16_bf16(lds_2xb64(vrow + 32), pack8<1>(X), O, 0, 0, 0);
#pragma unroll
                for (int r = 0; r < 16; ++r) X[r] = 0.f;
            }
            {
                const LAS unsigned char* ka = lds + GL_KI + (cr * 32 + l31) * GP + 16 * hh;
#pragma unroll
                for (int kk = 0; kk < 4; ++kk) X = __builtin_amdgcn_mfma_f32_32x32x16_bf16(lds_b128(ka + 32 * kk), lds_b128(qb + 32 * kk), X, 0, 0, 0);
#pragma unroll
                for (int r = 0; r < 16; ++r) { const int srow = (r & 3) + 8 * (r >> 2) + 4 * hh; X[r] = (srow <= l31) ? X[r] : 0.f; }
                O = __builtin_amdgcn_mfma_f32_32x32x16_bf16(lds_2xb64(vrow + cr * 64 + 0), pack8<0>(X), O, 0, 0, 0);
                O = __builtin_amdgcn_mfma_f32_32x32x16_bf16(lds_2xb64(vrow + cr * 64 + 32), pack8<1>(X), O, 0, 0, 0);
            }
        }
        {
            const LAS float* dec = (const LAS float*)(lds + GL_DEC);
#pragma unroll
            for (int g4 = 0; g4 < 4; ++g4) { const f32x4 d0 = *(const LAS f32x4*)(dec + 8 * g4 + 4 * hh), d1 = *(const LAS f32x4*)(dec + 32 + 8 * g4 + 4 * hh);
#pragma unroll
                for (int i = 0; i < 4; ++i) { S0[4 * g4 + i] *= d0[i]; S1[4 * g4 + i] *= d1[i]; } }
            const LAS unsigned char* ka0 = lds + GL_KET + l31 * GP + 16 * hh;
            const LAS unsigned char* ka1 = lds + GL_KET + (32 + l31) * GP + 16 * hh;
            const LAS unsigned char* vb = lds + GL_VT + (vc * 32 + l31) * GP + 16 * hh;
#pragma unroll
            for (int ss = 0; ss < 4; ++ss) { const bf16x8 bfr = lds_b128(vb + 32 * ss);
                S0 = __builtin_amdgcn_mfma_f32_32x32x16_bf16(lds_b128(ka0 + 32 * ss), bfr, S0, 0, 0, 0);
                S1 = __builtin_amdgcn_mfma_f32_32x32x16_bf16(lds_b128(ka1 + 32 * ss), bfr, S1, 0, 0, 0); }
        }
        float ssq = 0.f;
#pragma unroll
        for (int r = 0; r < 16; ++r) ssq += O[r] * O[r];
        ssq += __shfl_xor(ssq, 32);
        if (hh == 0) *(LAS float*)(lds + GL_SSP + (vc * 64 + cr * 32 + l31) * 4) = ssq;
        __syncthreads();
        {
            const LAS float* ssp = (const LAS float*)(lds + GL_SSP) + cr * 32 + l31;
            const float tot = (ssp[0] + ssp[64]) + (ssp[128] + ssp[192]);
            const float rstd = 1.0f / sqrtf(tot * (1.0f / 128.0f) + EPS);
            LAS float* ot = (LAS float*)(lds + GL_OT) + (cr * 32 + l31) * OTP + vc * 32 + 4 * hh;
#pragma unroll
            for (int g4 = 0; g4 < 4; ++g4) *(LAS f32x4*)(ot + 8 * g4) = (f32x4){O[4 * g4] * rstd, O[4 * g4 + 1] * rstd, O[4 * g4 + 2] * rstd, O[4 * g4 + 3] * rstd};
        }
        __syncthreads();
        {
            const LAS float* ot = (const LAS float*)(lds + GL_OT) + oc * OTP + ov;
            const unsigned gw[8] = {gate0.x, gate0.y, gate0.z, gate0.w, gate1.x, gate1.y, gate1.z, gate1.w};
            float y[16];
#pragma unroll
            for (int q4 = 0; q4 < 4; ++q4) { const f32x4 o4 = *(const LAS f32x4*)(ot + 4 * q4);
#pragma unroll
                for (int i = 0; i < 4; ++i) { const int j = 4 * q4 + i; const float gv = bf2f((gw[j >> 1] >> (16 * (j & 1))) & 0xffffu); y[j] = o4[i] * nw[j] * (gv / (1.0f + __expf(-gv))); } }
            bf16* orow = MIX + (tok0 + (size_t)n * 64 + oc) * D + h * 128 + ov;
            u32x4 t; t.x = cvtpk(y[0], y[1]); t.y = cvtpk(y[2], y[3]); t.z = cvtpk(y[4], y[5]); t.w = cvtpk(y[6], y[7]); *(u32x4*)orow = t;
            t.x = cvtpk(y[8], y[9]); t.y = cvtpk(y[10], y[11]); t.z = cvtpk(y[12], y[13]); t.w = cvtpk(y[14], y[15]); *(u32x4*)(orow + 8) = t;
        }
        __syncthreads();
    }
}

constexpr int SP = 272;
constexpr int SG_W = 0, SG_VN = SG_W + 128 * SP, SG_OT = SG_VN + 128 * SP, SG_ST = SG_OT + 128 * SP, SG_END = SG_ST + 1024;
static_assert(SG_END <= RING_BYTES, "sgu lds");
__device__ __forceinline__ void sgu_item(const Ptrs& P, LAS unsigned char* lds, int bn) {
    const int tid = threadIdx.x, lane = tid & 63, w = __builtin_amdgcn_readfirstlane(tid >> 6), l31 = lane & 31, hh = lane >> 5;
    const bf16* PROJ = (const bf16*)(P.ws + WS_PROJ); bf16* MIX = (bf16*)(P.ws + WS_MIX); const bf16* Wsp = (const bf16*)(P.ws + WS_WSP);
    const size_t tok0 = (size_t)bn * 128;
    LAS float* st = (LAS float*)(lds + SG_ST);
#pragma unroll 4
    for (int rr = 0; rr < 16; ++rr) { const int row = 16 * w + rr;
        const v4u raw = *(const v4u*)(PROJ + (tok0 + row) * NPROJ + PC_VS + lane * 8); const unsigned rw[4] = {raw.x, raw.y, raw.z, raw.w};
        float s = 0.f, q = 0.f;
#pragma unroll
        for (int j = 0; j < 8; ++j) { const float g = gelu_tanh(bf2f((rw[j >> 1] >> (16 * (j & 1))) & 0xffffu)); s += g; q += g * g; }
        s = wave_sum(s); q = wave_sum(q);
        const float mu = s * (1.0f / 512.0f), var = fmaxf(q * (1.0f / 512.0f) - mu * mu, 0.f);
        if (lane == 0) { st[row] = mu; st[128 + row] = 1.0f / sqrtf(var + EPS); } }
    __syncthreads();
    for (int g = 0; g < 4; ++g) {
#pragma unroll
        for (int ps = 0; ps < 4; ++ps) { const int idx = ps * NTHR + tid, row = idx >> 4, c16 = idx & 15;
            *(LAS v4u*)(lds + SG_W + row * SP + c16 * 16) = *(const v4u*)(Wsp + ((size_t)g * 128 + row) * 128 + c16 * 8); }
        { const int s = tid & 127, c0 = (tid >> 7) * 32; const float mu = st[s], rs = st[128 + s];
#pragma unroll
          for (int q4 = 0; q4 < 4; ++q4) { const int cb = c0 + q4 * 8;
              const v4u raw = *(const v4u*)(PROJ + (tok0 + s) * NPROJ + PC_VS + g * 128 + cb); const unsigned rw[4] = {raw.x, raw.y, raw.z, raw.w};
              const f32x4 lw0 = *(const f32x4*)(P.sg_ln_w + g * 128 + cb), lw1 = *(const f32x4*)(P.sg_ln_w + g * 128 + cb + 4), lb0 = *(const f32x4*)(P.sg_ln_b + g * 128 + cb), lb1 = *(const f32x4*)(P.sg_ln_b + g * 128 + cb + 4);
#pragma unroll
              for (int j = 0; j < 8; ++j) { const float gv = gelu_tanh(bf2f((rw[j >> 1] >> (16 * (j & 1))) & 0xffffu));
                  const float vn = (gv - mu) * rs * (j < 4 ? lw0[j & 3] : lw1[j & 3]) + (j < 4 ? lb0[j & 3] : lb1[j & 3]);
                  *(LAS unsigned short*)(lds + SG_VN + (cb + j) * SP + s * 2) = (unsigned short)f2bf(vn); } } }
        __syncthreads();
        { const int ct = w >> 1;
          const LAS unsigned char* arow = lds + SG_VN + (ct * 32 + l31) * SP + 16 * hh;
#pragma unroll
          for (int ti = 0; ti < 2; ++ti) { const int tt = (w & 1) * 2 + ti;
              const LAS unsigned char* brow = lds + SG_W + (tt * 32 + l31) * SP + 16 * hh;
              f32x16 acc;
#pragma unroll
              for (int r = 0; r < 16; ++r) acc[r] = 0.f;
              for (int ks = 0; ks < 2 * (tt + 1); ++ks) acc = __builtin_amdgcn_mfma_f32_32x32x16_bf16(lds_b128(arow + 32 * ks), lds_b128(brow + 32 * ks), acc, 0, 0, 0);
              const float bs = P.b_spatial[g * 128 + tt * 32 + l31];
              LAS unsigned char* orow = lds + SG_OT + (tt * 32 + l31) * SP + (ct * 32 + 4 * hh) * 2;
#pragma unroll
              for (int g4 = 0; g4 < 4; ++g4) { u32x2 pk; pk.x = cvtpk(acc[4 * g4] + bs, acc[4 * g4 + 1] + bs); pk.y = cvtpk(acc[4 * g4 + 2] + bs, acc[4 * g4 + 3] + bs); *(LAS u32x2*)(orow + 16 * g4) = pk; } } }
        __syncthreads();
        { const int t = tid >> 2, cg = (tid & 3) * 32;
#pragma unroll
          for (int q4 = 0; q4 < 4; ++q4) { const v4u mx = *(const LAS v4u*)(lds + SG_OT + t * SP + (cg + q4 * 8) * 2);
              const v4u ur = *(const v4u*)(PROJ + (tok0 + t) * NPROJ + PC_U + g * 128 + cg + q4 * 8);
              const unsigned mw[4] = {mx.x, mx.y, mx.z, mx.w}, uw[4] = {ur.x, ur.y, ur.z, ur.w}; unsigned ow[4];
#pragma unroll
              for (int j = 0; j < 4; ++j) { const float a0 = gelu_tanh(bf2f(uw[j] & 0xffffu)) * bf2f(mw[j] & 0xffffu), a1 = gelu_tanh(bf2f(uw[j] >> 16)) * bf2f(mw[j] >> 16); ow[j] = cvtpk(a0, a1); }
              *(v4u*)(MIX + (tok0 + t) * D + 512 + g * 128 + cg + q4 * 8) = (v4u){ow[0], ow[1], ow[2], ow[3]}; } }
    }
    __syncthreads();
}
__device__ __forceinline__ void ph2_mix_fast(const Ptrs& P, LAS unsigned char* lds, int G) {
    const int bid = blockIdx.x;
    if (G >= 128) {
        if (bid < 64) gla_item(P, lds, bid);
        else for (int it = bid - 64; it < NB * 16; it += G - 64) sgu_item(P, lds, it);
    } else {
        for (int it = bid; it < 64; it += G) gla_item(P, lds, it);
        for (int it = bid; it < NB * 16; it += G) sgu_item(P, lds, it);
    }
}

constexpr size_t WS_WR2 = WS_WSP + 256 * 1024;
__device__ __forceinline__ void p0_wr2(const Ptrs& P, int gtid, int gthreads) {
    f32x4* WR2 = (f32x4*)(P.ws + WS_WR2);
    for (int idx = gtid; idx < 64 * 2 * 64; idx += gthreads) { const int j = idx >> 7, tl = (idx >> 6) & 1, q = (idx >> 4) & 3, e = tl * 16 + (idx & 15); f32x4 o;
#pragma unroll
        for (int i = 0; i < 4; ++i) { const int k = 16 * j + 4 * q + i; o[i] = P.w_router[(size_t)k * NE + e] * P.norm_ffn_w[k]; }
        WR2[idx] = o; }
}
__device__ __forceinline__ bool rt_better(float va, int ia, float vb, int ib) { return va > vb || (va == vb && ia < ib); }
__device__ __forceinline__ void ph4_router_fast(const Ptrs& P, LAS unsigned char* lds, int G) {
    const int tid = threadIdx.x, lane = tid & 63, wave = __builtin_amdgcn_readfirstlane(tid >> 6), tk = lane & 15, q = lane >> 4;
    unsigned* ctl = (unsigned*)(P.ws + WS_CTL);
    LAS unsigned* lcnt = (LAS unsigned*)lds; LAS unsigned* lbase = lcnt + 32;
    const f32x4* WR2 = (const f32x4*)(P.ws + WS_WR2);
    const int NGRP = T / 16, rounds = (NGRP + G * NWAVES - 1) / (G * NWAVES);
    for (int rd = 0; rd < rounds; ++rd) {
        if (tid < 32) lcnt[tid] = 0u;
        __syncthreads();
        const int grp = (rd * G + (int)blockIdx.x) * NWAVES + wave; const bool act = grp < NGRP;
        const int m0 = (act ? grp : 0) * 16;
        const float* xrow = (const float*)(P.ws + WS_X1) + (size_t)(m0 + tk) * D + 4 * q;
        f32x4 d0 = {0.f, 0.f, 0.f, 0.f}, d1 = {0.f, 0.f, 0.f, 0.f}; float ssq = 0.f;
#pragma unroll 4
        for (int j = 0; j < 64; ++j) { const f32x4 xv = *(const f32x4*)(xrow + 16 * j); const f32x4 w0 = WR2[(j * 2 + 0) * 64 + lane], w1 = WR2[(j * 2 + 1) * 64 + lane];
            ssq += (xv[0] * xv[0] + xv[1] * xv[1]) + (xv[2] * xv[2] + xv[3] * xv[3]);
#pragma unroll
            for (int i = 0; i < 4; ++i) { d0 = __builtin_amdgcn_mfma_f32_16x16x4f32(w0[i], xv[i], d0, 0, 0, 0); d1 = __builtin_amdgcn_mfma_f32_16x16x4f32(w1[i], xv[i], d1, 0, 0, 0); } }
        ssq += __shfl_xor(ssq, 16); ssq += __shfl_xor(ssq, 32);
        const float rstd = 1.0f / sqrtf(ssq * (1.f / D) + EPS);
        float cv[8]; int ci[8];
#pragma unroll
        for (int r = 0; r < 4; ++r) { cv[r] = d0[r] * rstd + P.b_router[4 * q + r]; ci[r] = 4 * q + r; cv[4 + r] = d1[r] * rstd + P.b_router[16 + 4 * q + r]; ci[4 + r] = 16 + 4 * q + r; }
        float sv[4]; int si[4];
#pragma unroll
        for (int r = 0; r < 4; ++r) { float bv = cv[0]; int bi = ci[0];
#pragma unroll
            for (int c = 1; c < 8; ++c) if (rt_better(cv[c], ci[c], bv, bi)) { bv = cv[c]; bi = ci[c]; }
            sv[r] = bv; si[r] = bi;
#pragma unroll
            for (int c = 0; c < 8; ++c) if (ci[c] == bi) cv[c] = -3.0e38f; }
#pragma unroll
        for (int off = 16; off <= 32; off <<= 1) {
            float ov[4]; int oi[4];
#pragma unroll
            for (int r = 0; r < 4; ++r) { ov[r] = __shfl_xor(sv[r], off); oi[r] = __shfl_xor(si[r], off); }
            float mv[8]; int mi[8];
#pragma unroll
            for (int r = 0; r < 4; ++r) { mv[r] = sv[r]; mi[r] = si[r]; mv[4 + r] = ov[r]; mi[4 + r] = oi[r]; }
#pragma unroll
            for (int r = 0; r < 4; ++r) { float bv = mv[0]; int bi = mi[0];
#pragma unroll
                for (int c = 1; c < 8; ++c) if (rt_better(mv[c], mi[c], bv, bi)) { bv = mv[c]; bi = mi[c]; }
                sv[r] = bv; si[r] = bi;
#pragma unroll
                for (int c = 0; c < 8; ++c) if (mi[c] == bi) mv[c] = -3.0e38f; }
        }
        float pw[4], den = 0.f;
#pragma unroll
        for (int r = 0; r < 4; ++r) { pw[r] = __expf(sv[r] - sv[0]); den += pw[r]; }
        int ee = si[0]; float ww = pw[0];
#pragma unroll
        for (int r = 1; r < 4; ++r) if (q == r) { ee = si[r]; ww = pw[r]; }
        ww /= den;
        unsigned lr = 0u;
        if (act) lr = __hip_atomic_fetch_add(lcnt + ee, 1u, __ATOMIC_RELAXED, __HIP_MEMORY_SCOPE_WORKGROUP);
        __syncthreads();
        if (tid < 32) lbase[tid] = __hip_atomic_fetch_add(ctl + CW_COUNTS + tid, lcnt[tid], RLX_AGENT);
        __syncthreads();
        if (act) { const unsigned rank = lbase[ee] + lr; const int m = m0 + tk;
            ((int*)(P.ws + WS_ROUTE + RT_ROWTOK))[(size_t)ee * T + rank] = m;
            ((float*)(P.ws + WS_ROUTE + RT_ROWW))[(size_t)ee * T + rank] = ww;
            ((int*)(P.ws + WS_ROUTE + RT_TOKSLOT))[(size_t)m * 4 + q] = (ee << 16) | (int)rank;
            bf16* H2 = (bf16*)(P.ws + WS_H);
            for (int tt = 0; tt < 16; ++tt) { const float rs = __shfl(rstd, tt); const f32x4* xr = (const f32x4*)((const float*)(P.ws + WS_X1) + (size_t)(m0 + tt) * D);
#pragma unroll
                for (int j = 0; j < 4; ++j) { const f32x4 v = xr[lane + 64 * j], nwv = ((const f32x4*)P.norm_ffn_w)[lane + 64 * j];
                    ((uint2*)(H2 + (size_t)(m0 + tt) * D))[lane + 64 * j] = make_uint2(cvtpk(v[0] * rs * nwv[0], v[1] * rs * nwv[1]), cvtpk(v[2] * rs * nwv[2], v[3] * rs * nwv[3])); } } }
        __syncthreads();
    }
}

struct Args { Ptrs P; int ph_lo, ph_hi, li, pad; };

__device__ __forceinline__ void ph0_prep(const Ptrs& P, unsigned char* lds_generic, int vcu, int G) {
    const int tid = threadIdx.x, lane = tid & 63, wave = __builtin_amdgcn_readfirstlane(tid >> 6);
    float* scr = (float*)(lds_generic + wave * 16384);
    const int gw = vcu * NWAVES + wave, NGW = G * NWAVES;
    for (int it = gw; it < IT_ALL; it += NGW) p0_weight_item(P, it, scr, lane);
    bf16* Wsp = (bf16*)(P.ws + WS_WSP);
    for (int i = blockIdx.x * NTHR + tid; i < 4 * 128 * 128; i += G * NTHR) { const int t = (i >> 7) & 127, s = i & 127; Wsp[i] = (bf16)f2bf(s <= t ? P.w_spatial[i] : 0.f); }
    p0_wr2(P, blockIdx.x * NTHR + tid, G * NTHR);
    bf16* H = (bf16*)(P.ws + WS_H);
    for (int m = gw; m < T; m += NGW) rms_row_to_bf16(P.x + (size_t)m * D, P.norm_mix_w, H + (size_t)m * D, lane);
}
__device__ __forceinline__ void ph2a_naive(const Ptrs& P, LAS unsigned char* lds, int G) {
    const int tid = threadIdx.x, lane = tid & 63, wave = tid >> 6;
    LAS float* sm = (LAS float*)lds;
    const bf16* PROJ = (const bf16*)(P.ws + WS_PROJ); bf16* MIX = (bf16*)(P.ws + WS_MIX);
    for (int item = blockIdx.x; item < 16; item += G) {
        const int sub = tid >> 7, v = tid & 127, bh = item * 4 + sub, b = bh >> 2, h = bh & 3;
        LAS float* sq = sm + sub * 192; LAS float* sk = sq + 64; LAS float* sa = sk + 64; LAS float* red = sm + 768 + sub * 2;
        float S[64];
#pragma unroll
        for (int k = 0; k < 64; ++k) S[k] = 0.f;
        const float nw = P.gla_norm_w[v];
        for (int t = 0; t < SEQ; ++t) {
            const size_t row = (size_t)(b * SEQ + t) * NPROJ;
            if (v < 64) { sq[v] = bf2f(PROJ[row + PC_Q + h * 64 + v]) * 0.125f; sk[v] = bf2f(PROJ[row + PC_K + h * 64 + v]);
                sa[v] = __expf(log_sigmoid(bf2f(PROJ[row + PC_GK + h * 64 + v]) + P.b_gk[h * 64 + v]) * (1.0f / 16.0f)); }
            const float vv = bf2f(PROJ[row + PC_V + h * 128 + v]), g = bf2f(PROJ[row + PC_G + h * 128 + v]);
            __syncthreads();
            float o = 0.f;
#pragma unroll
            for (int k = 0; k < 64; ++k) { S[k] = sa[k] * S[k] + sk[k] * vv; o += sq[k] * S[k]; }
            const float ss = wave_sum(o * o);
            if ((v & 63) == 0) red[v >> 6] = ss;
            __syncthreads();
            const float rstd = 1.0f / sqrtf((red[0] + red[1]) * (1.0f / 128.0f) + EPS);
            MIX[(size_t)(b * SEQ + t) * D + h * 128 + v] = (bf16)f2bf(o * rstd * nw * silu(g));
        }
    }
    float* VN = (float*)(P.ws + WS_VN);
    for (int m = blockIdx.x * NWAVES + wave; m < T; m += G * NWAVES) {
        const v4u raw = *(const v4u*)(PROJ + (size_t)m * NPROJ + PC_VS + lane * 8); const unsigned w[4] = {raw.x, raw.y, raw.z, raw.w};
        float g[8]; float s = 0.f;
#pragma unroll
        for (int j = 0; j < 4; ++j) { g[2 * j] = gelu_tanh(bf2f(w[j] & 0xffffu)); g[2 * j + 1] = gelu_tanh(bf2f(w[j] >> 16)); s += g[2 * j] + g[2 * j + 1]; }
        const float mu = wave_sum(s) * (1.0f / 512.0f); float q = 0.f;
#pragma unroll
        for (int j = 0; j < 8; ++j) { g[j] -= mu; q += g[j] * g[j]; }
        const float rstd = 1.0f / sqrtf(wave_sum(q) * (1.0f / 512.0f) + EPS);
#pragma unroll
        for (int j = 0; j < 8; ++j) VN[(size_t)m * 512 + lane * 8 + j] = g[j] * rstd * P.sg_ln_w[lane * 8 + j] + P.sg_ln_b[lane * 8 + j];
    }
}
__device__ __forceinline__ void ph2b_naive(const Ptrs& P, int G) {
    const int tid = threadIdx.x, c = tid & 127;
    const float* VN = (const float*)(P.ws + WS_VN); const bf16* PROJ = (const bf16*)(P.ws + WS_PROJ); bf16* MIX = (bf16*)(P.ws + WS_MIX);
    for (int item = blockIdx.x; item < NB * 16 * 4; item += G) {
        const int bn = item >> 2, g = item & 3; const size_t base = (size_t)bn * 128;
        for (int t = tid >> 7; t < 128; t += 4) {
            float acc = 0.f; const float* wrow = P.w_spatial + ((size_t)g * 128 + t) * 128;
            for (int s = 0; s <= t; ++s) acc += wrow[s] * VN[(base + s) * 512 + g * 128 + c];
            acc += P.b_spatial[g * 128 + t];
            const float u = gelu_tanh(bf2f(PROJ[(base + t) * NPROJ + PC_U + g * 128 + c]));
            MIX[(base + t) * D + 512 + g * 128 + c] = (bf16)f2bf(u * acc);
        }
    }
}
__device__ __forceinline__ void ph4_router_naive(const Ptrs& P, int G) {
    const int tid = threadIdx.x, lane = tid & 63, wave = tid >> 6;
    unsigned* ctl = (unsigned*)(P.ws + WS_CTL);
    for (int m = blockIdx.x * NWAVES + wave; m < T; m += G * NWAVES) {
        const float* X1 = (const float*)(P.ws + WS_X1) + (size_t)m * D; bf16* H2 = (bf16*)(P.ws + WS_H) + (size_t)m * D;
        f32x4 v[4]; float s = 0.f;
#pragma unroll
        for (int j = 0; j < 4; ++j) { v[j] = ((const f32x4*)X1)[lane + 64 * j]; s += (v[j].x * v[j].x + v[j].y * v[j].y) + (v[j].z * v[j].z + v[j].w * v[j].w); }
        const float rstd = 1.0f / sqrtf(wave_sum(s) * (1.f / D) + EPS);
#pragma unroll
        for (int j = 0; j < 4; ++j) { const f32x4 ww = ((const f32x4*)P.norm_ffn_w)[lane + 64 * j];
            ((unsigned long long*)H2)[lane + 64 * j] = (unsigned long long)pk2(v[j].x * rstd * ww.x, v[j].y * rstd * ww.y) | ((unsigned long long)pk2(v[j].z * rstd * ww.z, v[j].w * rstd * ww.w) << 32); }
        const int e = lane & 31, half = lane >> 5; float acc = 0.f;
        for (int k = half * 512; k < half * 512 + 512; ++k) acc += X1[k] * P.norm_ffn_w[k] * P.w_router[(size_t)k * NE + e];
        acc += __shfl_xor(acc, 32);
        float logit = acc * rstd + P.b_router[e];
        int sel_e[4]; float sel_v[4];
#pragma unroll
        for (int r = 0; r < 4; ++r) { float bv = logit; int bi = e;
#pragma unroll
            for (int o = 1; o < 32; o <<= 1) { const float ov = __shfl_xor(bv, o); const int oi = __shfl_xor(bi, o); if (ov > bv || (ov == bv && oi < bi)) { bv = ov; bi = oi; } }
            sel_e[r] = bi; sel_v[r] = bv; if (e == bi) logit = -3.0e38f; }
        float den = 0.f, pw[4];
#pragma unroll
        for (int r = 0; r < 4; ++r) { pw[r] = __expf(sel_v[r] - sel_v[0]); den += pw[r]; }
        if (lane < 4) { int ee = sel_e[0]; float ww = pw[0];
#pragma unroll
            for (int r = 1; r < 4; ++r) if (lane == r) { ee = sel_e[r]; ww = pw[r]; }
            ww /= den;
            const unsigned rank = atomicAdd(&ctl[CW_COUNTS + ee], 1u);
            ((int*)(P.ws + WS_ROUTE + RT_ROWTOK))[(size_t)ee * T + rank] = m;
            ((float*)(P.ws + WS_ROUTE + RT_ROWW))[(size_t)ee * T + rank] = ww;
            ((int*)(P.ws + WS_ROUTE + RT_TOKSLOT))[(size_t)m * 4 + lane] = (ee << 16) | (int)rank; }
    }
}
__device__ __forceinline__ void moe_tables(const Ptrs& P, LAS int* tab) {
    const unsigned* ctl = (const unsigned*)(P.ws + WS_CTL);
    if (threadIdx.x < NE) tab[66 + threadIdx.x] = (int)__hip_atomic_load(ctl + CW_COUNTS + threadIdx.x, RLX_AGENT);
    __syncthreads();
    if (threadIdx.x == 0) { int a = 0; for (int e = 0; e < NE; ++e) { tab[e] = a; tab[33 + e] = a * MT; a += (tab[66 + e] + MT - 1) / MT; } tab[NE] = a; tab[33 + NE] = a * MT; }
    __syncthreads();
}
__device__ __forceinline__ void ph7_final(const Ptrs& P, const LAS int* tab, int G) {
    const int tid = threadIdx.x, lane = tid & 63, wave = tid >> 6;
    const bf16* Y = (const bf16*)(P.ws + WS_YBUF);
    for (int m = blockIdx.x * NWAVES + wave; m < T; m += G * NWAVES) {
        const float* X1 = (const float*)(P.ws + WS_X1) + (size_t)m * D;
        const int* ts = (const int*)(P.ws + WS_ROUTE + RT_TOKSLOT) + (size_t)m * 4;
        f32x4 v[4];
#pragma unroll
        for (int j = 0; j < 4; ++j) v[j] = ((const f32x4*)X1)[lane + 64 * j];
#pragma unroll
        for (int r = 0; r < 4; ++r) { const int pk = ts[r]; const size_t slot = (size_t)tab[33 + (pk >> 16)] + (pk & 0xffff);
#pragma unroll
            for (int j = 0; j < 4; ++j) { const uint2 y = ((const uint2*)(Y + slot * D))[lane + 64 * j];
                v[j].x += bf2f(y.x & 0xffffu); v[j].y += bf2f(y.x >> 16); v[j].z += bf2f(y.y & 0xffffu); v[j].w += bf2f(y.y >> 16); } }
        float s = 0.f;
#pragma unroll
        for (int j = 0; j < 4; ++j) s += (v[j].x * v[j].x + v[j].y * v[j].y) + (v[j].z * v[j].z + v[j].w * v[j].w);
        const float rstd = 1.0f / sqrtf(wave_sum(s) * (1.f / D) + EPS);
#pragma unroll
        for (int j = 0; j < 4; ++j) { const f32x4 ww = ((const f32x4*)P.norm_final_w)[lane + 64 * j];
            ((f32x4*)(P.out + (size_t)m * D))[lane + 64 * j] = (f32x4){v[j].x * rstd * ww.x, v[j].y * rstd * ww.y, v[j].z * rstd * ww.z, v[j].w * rstd * ww.w}; }
    }
}

#ifndef FAST_MIX
#define FAST_MIX 1
#endif
#ifndef FAST_ROUTER
#define FAST_ROUTER 1
#endif
constexpr int NPHASE = 9;
__global__ void __launch_bounds__(NTHR, 2) mk_fwd(Args args) {
    extern __shared__ __attribute__((aligned(16))) unsigned char lds_raw[];
    LAS unsigned char* lds = (LAS unsigned char*)lds_raw;
    const Ptrs& P = args.P;
    const int tid = threadIdx.x, G = gridDim.x;
    const int vcu = (G % 8 == 0) ? ((int)blockIdx.x % 8) * (G / 8) + (int)blockIdx.x / 8 : (int)blockIdx.x;
    volatile LAS unsigned* MISC = (volatile LAS unsigned*)(lds + MISC_OFF);
    LAS int* tab = (LAS int*)(lds + TAB_OFF);
    if (tid < 64) MISC[tid] = 0u;
    __syncthreads();
    unsigned* ctl = (unsigned*)(P.ws + WS_CTL);
    XcdBarrier bar = xcd_barrier_post(ctl + CW_BAR + args.li * XCD_BAR_WORDS, MISC + 8);
    const int lo = args.ph_lo, hi = args.ph_hi;
#define IN(k) (lo <= (k) && (k) < hi)
#define SEAM(k) do { if (IN(k) && IN((k) + 1)) xcd_barrier(bar); } while (0)
    if (IN(0)) { ph0_prep(P, lds_raw, vcu, G); } SEAM(0);
    if (IN(1)) { pg8::DenseSched S; S.init(T, NPROJ, D, G, (int)blockIdx.x); pg8::EpiProj E{(bf16*)(P.ws + WS_PROJ)};
        pg8::gemm_phase(lds, (const char*)(P.ws + WS_H), (const char*)(P.ws + WS_WIN), D, S, E); } SEAM(1);
#if FAST_MIX
    if (IN(2)) { ph2_mix_fast(P, lds, G); } SEAM(2);
#else
    if (IN(2)) { ph2a_naive(P, lds, G); } SEAM(2);
    if (IN(3)) { ph2b_naive(P, G); } SEAM(3);
#endif
    if (IN(4)) { pg8::DenseSched S; S.init(T, D, D, G, (int)blockIdx.x); pg8::EpiX1 E{P.x, (float*)(P.ws + WS_X1)};
        pg8::gemm_phase(lds, (const char*)(P.ws + WS_MIX), (const char*)(P.ws + WS_WOUT), D, S, E); } SEAM(4);
#if FAST_ROUTER
    if (IN(5)) { ph4_router_fast(P, lds, G); } SEAM(5);
#else
    if (IN(5)) { ph4_router_naive(P, G); } SEAM(5);
#endif
    if (IN(6) || IN(7) || IN(8)) moe_tables(P, tab);
    if (IN(6)) { pg8::MoeSched S{tab, (const int*)(P.ws + WS_ROUTE + RT_ROWTOK), 8, G, (int)blockIdx.x, tab[NE] * 8, D, 2048, true};
        pg8::EpiAct E{(bf16*)(P.ws + WS_ACT), P.b_gate_up};
        pg8::gemm_phase(lds, (const char*)(P.ws + WS_H), (const char*)(P.ws + WS_WGU), D, S, E); } SEAM(6);
    if (IN(7)) { pg8::MoeSched S{tab, nullptr, 4, G, (int)blockIdx.x, tab[NE] * 4, DE, 1024, false};
        pg8::EpiDown E{(bf16*)(P.ws + WS_YBUF), P.b_down, (const float*)(P.ws + WS_ROUTE + RT_ROWW)};
        pg8::gemm_phase(lds, (const char*)(P.ws + WS_ACT), (const char*)(P.ws + WS_WD), DE, S, E); } SEAM(7);
    if (IN(8)) { ph7_final(P, tab, G); }
#undef IN
#undef SEAM
}

#ifndef MK_SEGMENTS
#define MK_SEGMENTS 1
#endif
extern "C" void kernel_launch(void* const* d_in, const int* in_sizes, int n_in, void* d_out, int out_size, void* d_ws, size_t ws_size, hipStream_t stream) {
    if (n_in != 19 || out_size != T * D || ws_size < WS_END) { fprintf(stderr, "kernel_launch: unexpected shapes n_in %d out %d ws %zu (need %zu)\n", n_in, out_size, ws_size, (size_t)WS_END); return; }
    static int grid = 0;
    if (grid == 0) {
        int dev = 0, cus = 0, per_cu = 0;
        if (hipGetDevice(&dev) != hipSuccess || hipDeviceGetAttribute(&cus, hipDeviceAttributeMultiprocessorCount, dev) != hipSuccess) { fprintf(stderr, "kernel_launch: device query failed\n"); grid = -1; return; }
        if (hipFuncSetAttribute((const void*)mk_fwd, hipFuncAttributeMaxDynamicSharedMemorySize, LDS_BYTES) != hipSuccess) { fprintf(stderr, "kernel_launch: hipFuncSetAttribute failed\n"); grid = -1; return; }
        if (hipOccupancyMaxActiveBlocksPerMultiprocessor(&per_cu, (const void*)mk_fwd, NTHR, LDS_BYTES) != hipSuccess || per_cu < 1) { fprintf(stderr, "kernel_launch: occupancy query says %d\n", per_cu); per_cu = 1; }
        (void)hipGetLastError();
        grid = cus;
        fprintf(stderr, "kernel_launch: cus %d per_cu %d grid %d\n", cus, per_cu, grid);
    }
    if (grid < 0) return;
    Args a{};
    const float** pp = (const float**)&a.P;
    for (int i = 0; i < 19; ++i) pp[i] = (const float*)d_in[i];
    a.P.out = (float*)d_out; a.P.ws = (unsigned char*)d_ws;
    (void)hipMemsetAsync((char*)d_ws + WS_CTL, 0, MiB, stream);
#if MK_SEGMENTS == 1
    a.ph_lo = 0; a.ph_hi = NPHASE; a.li = 0;
    void* kargs[] = {&a};
    hipError_t e = hipLaunchCooperativeKernel((const void*)mk_fwd, dim3(grid), dim3(NTHR), kargs, LDS_BYTES, stream);
    if (e != hipSuccess) fprintf(stderr, "kernel_launch: cooperative launch failed: %s (grid %d)\n", hipGetErrorString(e), grid);
#else
    for (int ph = 0; ph < NPHASE; ++ph) { a.ph_lo = ph; a.ph_hi = ph + 1; a.li = ph; hipLaunchKernelGGL(mk_fwd, dim3(grid), dim3(NTHR), LDS_BYTES, stream, a); }
#endif
}
```

```cpp
#include <hip/hip_runtime.h>
#include <cstdio>
#include <cstdint>

constexpr int T = 32768, D = 1024, SEQ = 2048, NB = 16;
constexpr int NIN_SRC = 2576, NPROJ = 2816;
constexpr int PC_Q = 0, PC_K = 256, PC_V = 512, PC_G = 1024, PC_GK = 1536, PC_U = 1792, PC_VS = 2304;
constexpr int NE = 32, TOPK = 4, DE = 1024;
constexpr int MT = 256;
constexpr int MAXSLOTS = T * TOPK + NE * MT;
constexpr float EPS = 1e-6f;

typedef unsigned short bf16;
typedef unsigned v4u __attribute__((ext_vector_type(4)));
typedef float f32x4 __attribute__((ext_vector_type(4)));

constexpr size_t MiB = 1u << 20;
constexpr size_t WS_CTL   = 0;
constexpr size_t WS_WIN   = 1 * MiB;
constexpr size_t WS_WOUT  = 7 * MiB;
constexpr size_t WS_WSP   = 9 * MiB;
constexpr size_t WS_ROUTE = 10 * MiB;
constexpr size_t WS_WGU   = 20 * MiB;
constexpr size_t WS_WD    = 148 * MiB;
constexpr size_t WS_X1    = 212 * MiB;
constexpr size_t WS_ACT   = 340 * MiB;
constexpr size_t WS_PROJ  = 612 * MiB;
constexpr size_t WS_MIX   = 788 * MiB;
constexpr size_t WS_H     = 852 * MiB;
constexpr size_t WS_YBUF  = WS_PROJ;
constexpr size_t WS_VN    = WS_ACT;
constexpr size_t WS_END   = 916 * MiB;
static_assert(WS_YBUF + (size_t)MAXSLOTS * 1024 * 2 <= WS_END, "ybuf fits");
static_assert(WS_ACT + (size_t)MAXSLOTS * 1024 * 2 <= WS_PROJ, "act fits");
constexpr size_t RT_ROWTOK = 0;
constexpr size_t RT_ROWW   = 4 * MiB;
constexpr size_t RT_TOKSLOT= 8 * MiB;
constexpr int CW_COUNTS = 64;
constexpr int CW_PSTART = 128;

__device__ __forceinline__ unsigned f2bf(float f) { unsigned u = __builtin_bit_cast(unsigned, f); return (u + 0x7fffu + ((u >> 16) & 1u)) >> 16; }
__device__ __forceinline__ float bf2f(unsigned h) { return __builtin_bit_cast(float, h << 16); }
__device__ __forceinline__ unsigned pk2(float lo, float hi) { return f2bf(lo) | (f2bf(hi) << 16); }
__device__ __forceinline__ float gelu_tanh(float x) { const float u = 0.7978845608028654f * (x + 0.044715f * x * x * x); return x / (1.0f + __expf(-2.0f * u)); }
__device__ __forceinline__ float silu(float x) { return x / (1.0f + __expf(-x)); }
__device__ __forceinline__ float log_sigmoid(float x) { return fminf(x, 0.0f) - log1pf(__expf(-fabsf(x))); }
__device__ __forceinline__ float wave_sum(float v) {
#pragma unroll
    for (int o = 1; o < 64; o <<= 1) v += __shfl_xor(v, o);
    return v;
}

struct Ptrs {
    const float *x, *norm_mix_w, *w_in, *w_gk_up, *b_gk, *gla_norm_w, *sg_ln_w, *sg_ln_b, *w_spatial, *b_spatial, *w_out, *norm_ffn_w,
                *w_router, *b_router, *w_gate_up, *b_gate_up, *w_down, *b_down, *norm_final_w;
    float* out; unsigned char* ws;
};

__device__ __forceinline__ void p0_tr_write(bf16* WT, int K, int d0, int k0, const float* scr, int lane) {
    const int c = lane & 7;
#pragma unroll
    for (int j = 0; j < 4; ++j) { const int n = (lane >> 3) + 8 * j; const float* s = scr + (8 * c) * 33 + n;
        v4u o; o.x = pk2(s[0 * 33], s[1 * 33]); o.y = pk2(s[2 * 33], s[3 * 33]); o.z = pk2(s[4 * 33], s[5 * 33]); o.w = pk2(s[6 * 33], s[7 * 33]);
        *(v4u*)(WT + (size_t)(d0 + n) * K + k0 + 8 * c) = o; }
}
__device__ __forceinline__ void p0_transpose_item(const float* W, int ldn, int n0, int k0, bf16* WT, int K, int d0, float* scr, int lane) {
    float v[32];
    const float* src = W + (size_t)(k0 + (lane >> 5)) * ldn + n0 + (lane & 31);
#pragma unroll
    for (int i = 0; i < 32; ++i) v[i] = __builtin_nontemporal_load(src + (size_t)(2 * i) * ldn);
#pragma unroll
    for (int i = 0; i < 32; ++i) scr[(2 * i + (lane >> 5)) * 33 + (lane & 31)] = v[i];
    __builtin_amdgcn_wave_barrier(); asm volatile("s_waitcnt lgkmcnt(0)" ::: "memory");
    p0_tr_write(WT, K, d0, k0, scr, lane);
    asm volatile("s_waitcnt lgkmcnt(0)" ::: "memory"); __builtin_amdgcn_wave_barrier();
}
__device__ __forceinline__ void p0_gk_item(const float* w_in, const float* w_gk_up, int j0, int k0, bf16* WT, float* scr, int lane) {
    for (int i = 0; i < 32; ++i) { const int kk = 2 * i + (lane >> 5), j = j0 + (lane & 31); float s = 0.f;
#pragma unroll
        for (int r = 0; r < 16; ++r) s += w_in[(size_t)(k0 + kk) * NIN_SRC + 1536 + r] * w_gk_up[r * 256 + j];
        scr[kk * 33 + (lane & 31)] = s; }
    __builtin_amdgcn_wave_barrier(); asm volatile("s_waitcnt lgkmcnt(0)" ::: "memory");
    p0_tr_write(WT, D, PC_GK + j0, k0, scr, lane);
    asm volatile("s_waitcnt lgkmcnt(0)" ::: "memory"); __builtin_amdgcn_wave_barrier();
}
constexpr int IT_IN = (NPROJ / 32) * 16, IT_OUT = 32 * 16, IT_GU = NE * 64 * 16, IT_DN = NE * 32 * 16, IT_ALL = IT_IN + IT_OUT + IT_GU + IT_DN;
__device__ __forceinline__ void p0_weight_item(const Ptrs& P, int it, float* scr, int lane) {
    bf16* WinT = (bf16*)(P.ws + WS_WIN); bf16* WoutT = (bf16*)(P.ws + WS_WOUT); bf16* WguT = (bf16*)(P.ws + WS_WGU); bf16* WdT = (bf16*)(P.ws + WS_WD);
    if (it < IT_IN) { const int db = it / 16, kb = it % 16, d0 = db * 32;
        if (d0 >= PC_GK && d0 < PC_U) p0_gk_item(P.w_in, P.w_gk_up, d0 - PC_GK, kb * 64, WinT, scr, lane);
        else p0_transpose_item(P.w_in, NIN_SRC, d0 < PC_GK ? d0 : d0 - 240, kb * 64, WinT, D, d0, scr, lane);
        return; }
    it -= IT_IN;
    if (it < IT_OUT) { const int db = it / 16, kb = it % 16; p0_transpose_item(P.w_out, D, db * 32, kb * 64, WoutT, D, db * 32, scr, lane); return; }
    it -= IT_OUT;
    if (it < IT_GU) { const int e = it / 1024, r = it % 1024, db = r / 16, kb = r % 16, d0 = db * 32, pn = d0 >> 8, bj = (d0 >> 7) & 1, rr = d0 & 127;
        p0_transpose_item(P.w_gate_up + (size_t)e * D * 2048, 2048, bj * 1024 + 128 * pn + rr, kb * 64, WguT + (size_t)e * 2048 * D, D, d0, scr, lane); return; }
    it -= IT_GU;
    { const int e = it / 512, r = it % 512, db = r / 16, kb = r % 16;
      p0_transpose_item(P.w_down + (size_t)e * DE * D, D, db * 32, kb * 64, WdT + (size_t)e * D * DE, DE, db * 32, scr, lane); }
}
__device__ __forceinline__ void rms_row_to_bf16(const float* xrow, const float* w, bf16* orow, int lane) {
    const f32x4* xr = (const f32x4*)xrow + lane; const f32x4* wr = (const f32x4*)w + lane;
    f32x4 v[4]; float s = 0.f;
#pragma unroll
    for (int j = 0; j < 4; ++j) { v[j] = xr[64 * j]; s += (v[j].x * v[j].x + v[j].y * v[j].y) + (v[j].z * v[j].z + v[j].w * v[j].w); }
    const float rstd = 1.0f / sqrtf(wave_sum(s) * (1.f / D) + EPS);
    unsigned long long* o8 = (unsigned long long*)orow + lane;
#pragma unroll
    for (int j = 0; j < 4; ++j) { const f32x4 ww = wr[64 * j];
        o8[64 * j] = (unsigned long long)pk2(v[j].x * rstd * ww.x, v[j].y * rstd * ww.y) | ((unsigned long long)pk2(v[j].z * rstd * ww.z, v[j].w * rstd * ww.w) << 32); }
}

#ifndef PROBE_REPEAT
#define PROBE_REPEAT -1
#endif
#define LAS __attribute__((address_space(3)))
typedef short bf16x8 __attribute__((ext_vector_type(8)));
typedef unsigned u32x4 __attribute__((ext_vector_type(4)));
constexpr int NWAVES = 8, NTHR = 512;
constexpr int RING_BYTES = 131072, TAB_OFF = RING_BYTES, MISC_OFF = RING_BYTES + 1024, LDS_BYTES = 147456;
constexpr int CW_BAR = 4096;
#define RLX_AGENT __ATOMIC_RELAXED, __HIP_MEMORY_SCOPE_AGENT

#define XB_TMO      128
#define XB_XCNT(j)  (256  + 64 * (j))
#define XB_XSUB(j)  (1280 + 64 * (j))
#define XB_XGEN(j)  (2304 + 64 * (j))
#define XB_TOP      3328
#define XB_TOPGEN   3392
#define XCD_BAR_WORDS 3456
#define XB_SPIN_CAP (1u << 20)
__device__ __forceinline__ unsigned xb_ld(unsigned* p)              { return __hip_atomic_load(p, __ATOMIC_RELAXED, __HIP_MEMORY_SCOPE_AGENT); }
__device__ __forceinline__ unsigned xb_add(unsigned* p, unsigned v) { return __hip_atomic_fetch_add(p, v, __ATOMIC_RELAXED, __HIP_MEMORY_SCOPE_AGENT); }
__device__ __forceinline__ unsigned xb_xcc_id() { return (unsigned)__builtin_amdgcn_s_getreg((3 << 11) | 20) & 0xFu; }
#define XB_SPIN(cond, bar) do { unsigned _sp = 0; while (cond) { __builtin_amdgcn_s_sleep(1); \
    if ((++_sp & 255u) == 0u) { if (xb_ld(&(bar)[XB_TMO])) break; if (_sp > XB_SPIN_CAP) { atomicAdd(&(bar)[XB_TMO], 1u); break; } } } } while (0)
struct XcdBarrier { unsigned* bar; unsigned x; volatile LAS unsigned* st; };
__device__ __forceinline__ XcdBarrier xcd_barrier_post(unsigned* bar, volatile LAS unsigned* st) {
    XcdBarrier b; b.bar = bar; b.x = xb_xcc_id(); b.st = st;
    if (threadIdx.x == 0) (void)xb_add(&bar[XB_XCNT(b.x)], 1u);
    return b;
}
__device__ __forceinline__ void xcd_barrier_complete(unsigned* bar, unsigned x, unsigned& nloc, unsigned& nx) {
    const unsigned G = gridDim.x * gridDim.y * gridDim.z;
    unsigned sum, cnt, mine, sp = 0u;
    for (;;) {
        sum = 0u; cnt = 0u; mine = 0u;
#pragma unroll
        for (unsigned j = 0; j < 16; ++j) { const unsigned c = xb_ld(&bar[XB_XCNT(j)]); sum += c; cnt += (c > 0u) ? 1u : 0u; mine = (j == x) ? c : mine; }
        if (sum == G) break;
        __builtin_amdgcn_s_sleep(1);
        if ((++sp & 255u) == 0u) { if (xb_ld(&bar[XB_TMO])) break; if (sp > XB_SPIN_CAP) { atomicAdd(&bar[XB_TMO], 1u); break; } }
    }
    nloc = mine > 0u ? mine : 1u; nx = cnt > 0u ? cnt : 1u;
}
__device__ __forceinline__ void xcd_barrier(const XcdBarrier& b) {
    asm volatile("s_waitcnt vmcnt(0)" ::: "memory");
    __syncthreads();
    if (threadIdx.x == 0) {
        unsigned* bar = b.bar;
        __builtin_amdgcn_s_waitcnt(0);
        unsigned nloc = b.st[0], nx = b.st[1];
        if (nloc == 0u) { xcd_barrier_complete(bar, b.x, nloc, nx); b.st[0] = nloc; b.st[1] = nx; }
        const unsigned old = xb_add(&bar[XB_XSUB(b.x)], 1u);
        const unsigned gen = old / nloc;
        if (old + 1u == (gen + 1u) * nloc) {
            __builtin_amdgcn_fence(__ATOMIC_RELEASE, "agent");
            asm volatile("s_waitcnt vmcnt(0)" ::: "memory");
            const unsigned og = xb_add(&bar[XB_TOP], 1u);
            const unsigned tg = og / nx;
            if (og + 1u == (tg + 1u) * nx) xb_add(&bar[XB_TOPGEN], 1u);
            else XB_SPIN(xb_ld(&bar[XB_TOPGEN]) == tg, bar);
            __builtin_amdgcn_fence(__ATOMIC_ACQUIRE, "agent");
            xb_add(&bar[XB_XGEN(b.x)], 1u);
            asm volatile("s_waitcnt vmcnt(0)" ::: "memory");
        } else {
            XB_SPIN(xb_ld(&bar[XB_XGEN(b.x)]) == gen, bar);
            __builtin_amdgcn_fence(__ATOMIC_ACQUIRE, "agent");
            asm volatile("s_waitcnt vmcnt(0)" ::: "memory");
        }
    }
    __syncthreads();
}

namespace pg8 {
constexpr int BM = 256, BK = 64, HALF = 128, HTB = HALF * BK * 2, NXCD = 8, WGM = 8;
__device__ __forceinline__ int lds_byte(int r, int c) { const int st = (r >> 4) * 2 + (c >> 5), rr = r & 15, cc = c & 31, ob = rr * 64 + cc * 2; return st * 1024 + (ob ^ (((ob >> 9) & 1) << 5)); }
__device__ __forceinline__ void stage_rc(int b, int& R, int& C) { const int st = b / 1024, sb = b % 1024, swz = sb ^ (((sb >> 9) & 1) << 5); R = (st >> 1) * 16 + swz / 64; C = (st & 1) * 32 + (swz % 64) / 2; }
__device__ __forceinline__ int perm32(int rho) { const int n = rho >> 4, i = rho & 15; return 8 * (i >> 2) + 4 * n + (i & 3); }
typedef float f32x2_t __attribute__((ext_vector_type(2)));
typedef __bf16 bf16x2_t __attribute__((ext_vector_type(2)));
__device__ __forceinline__ unsigned cvt_pk_bf16(float lo, float hi) { const f32x2_t v = {lo, hi}; const bf16x2_t b = __builtin_convertvector(v, bf16x2_t); return __builtin_bit_cast(unsigned, b); }
__device__ __forceinline__ int xcd_remap(int wgid, int nwg) { const int q = nwg / NXCD, r = nwg % NXCD, xcd = wgid % NXCD, off = wgid / NXCD; return (xcd < r ? xcd * (q + 1) : r * (q + 1) + (xcd - r) * q) + off; }

struct Unit { int pm, pn, e, m0, count, slot0; };
typedef f32x4 Acc[2][2][4][2];

struct DenseSched {
    int nM, nN, nwg, G, c, K;
    __device__ __forceinline__ void init(int M, int N, int K_, int G_, int c_) { nM = M / BM; nN = N / BM; nwg = nM * nN; G = G_; c = c_; K = K_; }
    __device__ __forceinline__ bool next(int i, Unit& u) const {
        const long L = (long)i * G + c; if (L >= nwg) return false;
        const int wgid = xcd_remap((int)L, nwg);
        const int nig = WGM * nN, gid = wgid / nig, fm = gid * WGM, gsz = (nM - fm) < WGM ? (nM - fm) : WGM;
        u.pm = fm + ((wgid % nig) % gsz); u.pn = (wgid % nig) / gsz; u.e = 0; u.m0 = 0; u.count = 0; u.slot0 = 0; return true;
    }
    __device__ __forceinline__ unsigned a_off(const Unit& u, int r) const { return (unsigned)(u.pm * BM + r) * (unsigned)(K * 2); }
    __device__ __forceinline__ size_t b_off(const Unit& u) const { return (size_t)u.pn * BM * K * 2; }
};
struct MoeSched {
    const LAS int* tab; const int* rowtok; int NPN, G, c, ntile, K, NB_E  ; bool gather;
    __device__ __forceinline__ bool next(int i, Unit& u) const {
        const long L = (long)i * G + c; if (L >= ntile) return false;
        const int wgid = xcd_remap((int)L, ntile);
        int lo = 0, hi = NE;
#pragma unroll
        for (int s = 0; s < 5; ++s) { const int mid = (lo + hi) >> 1; if (tab[mid] * NPN <= wgid) lo = mid; else hi = mid; }
        const int e = lo, mte = tab[e + 1] - tab[e], local = wgid - tab[e] * NPN;
        u.e = e; u.pn = local / mte; u.pm = 0; u.m0 = (local % mte) * BM; u.count = tab[66 + e]; u.slot0 = tab[33 + e]; return true;
    }
    __device__ __forceinline__ unsigned a_off(const Unit& u, int r) const {
        int m = u.m0 + r; if (gather) { m = m < u.count ? m : u.count - 1; return (unsigned)rowtok[(size_t)u.e * T + m] * (unsigned)(K * 2); }
        return (unsigned)(u.slot0 + m) * (unsigned)(K * 2);
    }
    __device__ __forceinline__ size_t b_off(const Unit& u) const { return ((size_t)u.e * NB_E + (size_t)u.pn * BM) * K * 2; }
};

struct EpiProj {
    static constexpr bool PERM = true;
    bf16* O;
    __device__ __forceinline__ void operator()(const Acc& acc, const Unit& u, int wr, int wc, int fr, int fq) const {
        const int row0 = u.pm * BM + wr * 64 + fr, col0 = u.pn * BM + wc * 32 + 8 * fq;
#pragma unroll
        for (int ai = 0; ai < 2; ++ai)
#pragma unroll
            for (int m = 0; m < 4; ++m) { bf16* rowp = O + (size_t)(row0 + ai * HALF + m * 16) * NPROJ + col0;
#pragma unroll
                for (int bj = 0; bj < 2; ++bj) { const f32x4 v0 = acc[ai][bj][m][0], v1 = acc[ai][bj][m][1];
                    u32x4 w; w.x = cvt_pk_bf16(v0[0], v0[1]); w.y = cvt_pk_bf16(v0[2], v0[3]); w.z = cvt_pk_bf16(v1[0], v1[1]); w.w = cvt_pk_bf16(v1[2], v1[3]);
                    *(u32x4*)(rowp + bj * HALF) = w; } }
    }
};
struct EpiX1 {
    static constexpr bool PERM = false;
    const float* X; float* O;
    __device__ __forceinline__ void operator()(const Acc& acc, const Unit& u, int wr, int wc, int fr, int fq) const {
        const int row0 = u.pm * BM + wr * 64 + fr, col0 = u.pn * BM + wc * 32 + 4 * fq;
#pragma unroll
        for (int ai = 0; ai < 2; ++ai)
#pragma unroll
            for (int m = 0; m < 4; ++m) { const size_t off = (size_t)(row0 + ai * HALF + m * 16) * D + col0;
#pragma unroll
                for (int bj = 0; bj < 2; ++bj)
#pragma unroll
                    for (int n = 0; n < 2; ++n) { const f32x4 xr = *(const f32x4*)(X + off + bj * HALF + n * 16); *(f32x4*)(O + off + bj * HALF + n * 16) = xr + acc[ai][bj][m][n]; }
                asm volatile("" ::: "memory"); }
    }
};
struct EpiAct {
    static constexpr bool PERM = true;
    bf16* O; const float* bgu;
    __device__ __forceinline__ void operator()(const Acc& acc, const Unit& u, int wr, int wc, int fr, int fq) const {
        const int colj = u.pn * 128 + wc * 32 + 8 * fq;
        const float* bg = bgu + (size_t)u.e * 2048 + colj;
        const f32x4 g0 = *(const f32x4*)bg, g1 = *(const f32x4*)(bg + 4), u0 = *(const f32x4*)(bg + 1024), u1 = *(const f32x4*)(bg + 1028);
#pragma unroll
        for (int ai = 0; ai < 2; ++ai)
#pragma unroll
            for (int m = 0; m < 4; ++m) { const int r = ai * HALF + wr * 64 + m * 16 + fr;
                if (u.m0 + r < u.count) { float y[8];
#pragma unroll
                    for (int n = 0; n < 2; ++n)
#pragma unroll
                        for (int i = 0; i < 4; ++i) { float g = acc[ai][0][m][n][i] + (n ? g1[i] : g0[i]), up = acc[ai][1][m][n][i] + (n ? u1[i] : u0[i]);
                            g = fminf(g, 7.0f); up = fminf(fmaxf(up, -7.0f), 7.0f); y[n * 4 + i] = (up + 1.0f) * (g / (1.0f + __expf(-1.702f * g))); }
                    u32x4 w; w.x = cvt_pk_bf16(y[0], y[1]); w.y = cvt_pk_bf16(y[2], y[3]); w.z = cvt_pk_bf16(y[4], y[5]); w.w = cvt_pk_bf16(y[6], y[7]);
                    *(u32x4*)(O + (size_t)(u.slot0 + u.m0 + r) * DE + colj) = w; } }
    }
};
struct EpiDown {
    static constexpr bool PERM = true;
    bf16* O; const float* bd; const float* roww;
    __device__ __forceinline__ void operator()(const Acc& acc, const Unit& u, int wr, int wc, int fr, int fq) const {
        const int col0 = u.pn * BM + wc * 32 + 8 * fq;
        const float* bp = bd + (size_t)u.e * D + col0;
        f32x4 bv[2][2];
#pragma unroll
        for (int bj = 0; bj < 2; ++bj)
#pragma unroll
            for (int n = 0; n < 2; ++n) bv[bj][n] = *(const f32x4*)(bp + bj * HALF + 4 * n);
#pragma unroll
        for (int ai = 0; ai < 2; ++ai)
#pragma unroll
            for (int m = 0; m < 4; ++m) { const int r = ai * HALF + wr * 64 + m * 16 + fr;
                if (u.m0 + r < u.count) { const float w8 = roww[(size_t)u.e * T + u.m0 + r]; bf16* rowp = O + (size_t)(u.slot0 + u.m0 + r) * D + col0;
#pragma unroll
                    for (int bj = 0; bj < 2; ++bj) { const f32x4 v0 = (acc[ai][bj][m][0] + bv[bj][0]) * w8, v1 = (acc[ai][bj][m][1] + bv[bj][1]) * w8;
                        u32x4 w; w.x = cvt_pk_bf16(v0[0], v0[1]); w.y = cvt_pk_bf16(v0[2], v0[3]); w.z = cvt_pk_bf16(v1[0], v1[1]); w.w = cvt_pk_bf16(v1[2], v1[3]);
                        *(u32x4*)(rowp + bj * HALF) = w; } } }
    }
};

template <class Epi, class Sched>
__device__ __forceinline__ void gemm_phase(LAS unsigned char* lds, const char* gA, const char* gB, int K, const Sched& S, const Epi& E) {
    const int tid = threadIdx.x, wid = __builtin_amdgcn_readfirstlane(tid >> 6), lane = tid & 63, wr = wid >> 2, wc = wid & 3, fr = lane & 15, fq = lane >> 4;
    const int nt = K / BK;
    int Rr[2], Cc[2]; unsigned voffB[2];
#pragma unroll
    for (int i = 0; i < 2; ++i) { int R, C; stage_rc(tid * 16 + i * 8192, R, C); Rr[i] = R; Cc[i] = C; const int Rb = Epi::PERM ? ((R & ~31) + perm32(R & 31)) : R; voffB[i] = (unsigned)(Rb * K + C) * 2u; }
    const size_t hstep = (size_t)HALF * K * 2;
    const unsigned ldsw = (unsigned)wid * 1024u;
    const int aoff = lds_byte(wr * 64 + fr, fq * 8), boff = lds_byte(wc * 32 + fr, fq * 8);
#define PG8_SA(b, h) (((b) * 2 + (h)) * HTB)
#define PG8_SB(b, h) ((4 + (b) * 2 + (h)) * HTB)
#define PG8_STAGEB(bufoff, gbase) do { _Pragma("unroll") for (int _i = 0; _i < 2; ++_i) \
        __builtin_amdgcn_global_load_lds((const unsigned*)((const char*)(gbase) + voffB[_i]), (LAS unsigned*)(lds + (bufoff) + ldsw + _i * 8192), 16, 0, 0); } while (0)
#define PG8_STAGEA(bufoff, voff2, kb) do { _Pragma("unroll") for (int _i = 0; _i < 2; ++_i) \
        __builtin_amdgcn_global_load_lds((const unsigned*)(gA + (size_t)(voff2)[_i] + (size_t)(kb)), (LAS unsigned*)(lds + (bufoff) + ldsw + _i * 8192), 16, 0, 0); } while (0)
#define PG8_LDA(dst, b, h) do { _Pragma("unroll") for (int m = 0; m < 4; ++m) _Pragma("unroll") for (int k = 0; k < 2; ++k) dst[m][k] = *(const LAS bf16x8*)(lds + PG8_SA(b, h) + aoff + m * 2048 + k * 1024); } while (0)
#define PG8_LDB(dst, b, h) do { _Pragma("unroll") for (int n = 0; n < 2; ++n) _Pragma("unroll") for (int k = 0; k < 2; ++k) dst[n][k] = *(const LAS bf16x8*)(lds + PG8_SB(b, h) + boff + n * 2048 + k * 1024); } while (0)
#define PG8_MMA(ai, bj, At, Bt) do { __builtin_amdgcn_s_setprio(1); _Pragma("unroll") for (int m = 0; m < 4; ++m) _Pragma("unroll") for (int n = 0; n < 2; ++n) _Pragma("unroll") for (int k = 0; k < 2; ++k) \
        acc[ai][bj][m][n] = __builtin_amdgcn_mfma_f32_16x16x32_bf16(Bt[n][k], At[m][k], acc[ai][bj][m][n], 0, 0, 0); __builtin_amdgcn_s_setprio(0); } while (0)
#define PG8_WAIT_V(n) asm volatile("s_waitcnt vmcnt(" #n ")" ::: "memory")
#define PG8_WAIT_L(n) asm volatile("s_waitcnt lgkmcnt(" #n ")" ::: "memory")
#define PG8_BAR __builtin_amdgcn_s_barrier()
#define PG8_SCHED __builtin_amdgcn_sched_barrier(0)
    Unit cur, nxt; int ui = 0;
    if (!S.next(0, cur)) return;
    Acc acc;
#pragma unroll
    for (int a = 0; a < 2; ++a)
#pragma unroll
        for (int b = 0; b < 2; ++b)
#pragma unroll
            for (int m = 0; m < 4; ++m)
#pragma unroll
                for (int n = 0; n < 2; ++n) acc[a][b][m][n] = (f32x4){0.f, 0.f, 0.f, 0.f};
    bf16x8 At[4][2], B0[2][2], B1[2][2];
    unsigned cA0[2], cA1[2], nA0[2], nA1[2];
#pragma unroll
    for (int i = 0; i < 2; ++i) { cA0[i] = S.a_off(cur, Rr[i]) + (unsigned)Cc[i] * 2u; cA1[i] = S.a_off(cur, HALF + Rr[i]) + (unsigned)Cc[i] * 2u; }
    const char* cB = gB + S.b_off(cur);
    PG8_STAGEB(PG8_SB(0, 0), cB); PG8_STAGEB(PG8_SB(0, 1), cB + hstep); PG8_STAGEA(PG8_SA(0, 0), cA0, 0); PG8_STAGEA(PG8_SA(0, 1), cA1, 0);
    if (wr == 1) PG8_BAR;
    PG8_WAIT_V(2); PG8_BAR;
    PG8_STAGEB(PG8_SB(1, 0), cB + BK * 2); PG8_STAGEA(PG8_SA(1, 0), cA0, BK * 2); PG8_STAGEB(PG8_SB(1, 1), cB + hstep + BK * 2);
    PG8_WAIT_V(6); PG8_BAR;
    for (;;) {
        const bool has_next = S.next(ui + 1, nxt);
        const char* nB = cB;
        if (has_next) {
#pragma unroll
            for (int i = 0; i < 2; ++i) { nA0[i] = S.a_off(nxt, Rr[i]) + (unsigned)Cc[i] * 2u; nA1[i] = S.a_off(nxt, HALF + Rr[i]) + (unsigned)Cc[i] * 2u; }
            nB = gB + S.b_off(nxt);
        } else {
#pragma unroll
            for (int i = 0; i < 2; ++i) { nA0[i] = cA0[i]; nA1[i] = cA1[i]; }
        }
        for (int t = 0; t < nt; t += 2) {
            const bool last = (t == nt - 2);
            const unsigned k1 = (unsigned)(t + 1) * (BK * 2), k2 = last ? 0u : (unsigned)(t + 2) * (BK * 2), k3 = k2 + BK * 2;
            unsigned a20[2], a21[2];
#pragma unroll
            for (int i = 0; i < 2; ++i) { a20[i] = last ? nA0[i] : cA0[i]; a21[i] = last ? nA1[i] : cA1[i]; }
            const char* b2 = (last ? nB : cB) + k2; const char* b3 = b2 + BK * 2;
            PG8_LDB(B0, 0, 0); PG8_LDB(B1, 0, 1); PG8_SCHED; PG8_LDA(At, 0, 0); PG8_STAGEA(PG8_SA(1, 1), cA1, k1);
            PG8_WAIT_V(8); PG8_WAIT_L(0); PG8_BAR; PG8_MMA(0, 0, At, B0); PG8_MMA(0, 1, At, B1); PG8_BAR; PG8_SCHED;
            PG8_LDA(At, 0, 1); PG8_STAGEB(PG8_SB(0, 0), b2); PG8_STAGEB(PG8_SB(0, 1), b2 + hstep); PG8_STAGEA(PG8_SA(0, 0), a20, k2);
            PG8_WAIT_V(8); PG8_WAIT_L(0); PG8_BAR; PG8_MMA(1, 0, At, B0); PG8_MMA(1, 1, At, B1); PG8_BAR; PG8_SCHED;
            PG8_LDB(B0, 1, 0); PG8_LDB(B1, 1, 1); PG8_SCHED; PG8_LDA(At, 1, 0); PG8_STAGEA(PG8_SA(0, 1), a21, k2);
            PG8_WAIT_V(8); PG8_WAIT_L(0); PG8_BAR; PG8_MMA(0, 0, At, B0); PG8_MMA(0, 1, At, B1); PG8_BAR; PG8_SCHED;
            PG8_LDA(At, 1, 1); PG8_STAGEB(PG8_SB(1, 0), b3); PG8_STAGEB(PG8_SB(1, 1), b3 + hstep); PG8_STAGEA(PG8_SA(1, 0), a20, k3);
            PG8_WAIT_V(8); PG8_WAIT_L(0); PG8_BAR; PG8_MMA(1, 0, At, B0); PG8_MMA(1, 1, At, B1); PG8_BAR; PG8_SCHED;
        }
        if (wr == 0) PG8_BAR;
        E(acc, cur, wr, wc, fr, fq);
        if (!has_next) break;
#pragma unroll
        for (int a = 0; a < 2; ++a)
#pragma unroll
            for (int b = 0; b < 2; ++b)
#pragma unroll
                for (int m = 0; m < 4; ++m)
#pragma unroll
                    for (int n = 0; n < 2; ++n) acc[a][b][m][n] = (f32x4){0.f, 0.f, 0.f, 0.f};
        cur = nxt; cB = nB; ++ui;
#pragma unroll
        for (int i = 0; i < 2; ++i) { cA0[i] = nA0[i]; cA1[i] = nA1[i]; }
        if (wr == 1) PG8_BAR;
    }
    PG8_WAIT_V(0);
    PG8_BAR;
#undef PG8_SA
#undef PG8_SB
#undef PG8_STAGEA
#undef PG8_STAGEB
#undef PG8_LDA
#undef PG8_LDB
#undef PG8_MMA
#undef PG8_WAIT_V
#undef PG8_WAIT_L
#undef PG8_BAR
#undef PG8_SCHED
}
}


typedef float f32x16 __attribute__((ext_vector_type(16)));
typedef short bf16x4 __attribute__((ext_vector_type(4)));
typedef unsigned u32x2 __attribute__((ext_vector_type(2)));
typedef float f32x2_t __attribute__((ext_vector_type(2)));
typedef __bf16 bf16x2_t __attribute__((ext_vector_type(2)));
__device__ __forceinline__ unsigned cvtpk(float lo, float hi) { const f32x2_t v = {lo, hi}; const bf16x2_t b = __builtin_convertvector(v, bf16x2_t); return __builtin_bit_cast(unsigned, b); }
template <int S8> __device__ __forceinline__ bf16x8 pack8(const f32x16& X) {
    u32x4 w; w.x = cvtpk(X[8 * S8 + 0], X[8 * S8 + 1]); w.y = cvtpk(X[8 * S8 + 2], X[8 * S8 + 3]); w.z = cvtpk(X[8 * S8 + 4], X[8 * S8 + 5]); w.w = cvtpk(X[8 * S8 + 6], X[8 * S8 + 7]);
    return __builtin_bit_cast(bf16x8, w);
}
__device__ __forceinline__ bf16x8 lds_b128(const LAS unsigned char* p) { return *(const LAS bf16x8*)p; }
__device__ __forceinline__ bf16x8 lds_2xb64(const LAS unsigned char* p) {
    const bf16x4 a = *(const LAS bf16x4*)p, b = *(const LAS bf16x4*)(p + 16);
    return __builtin_shufflevector(a, b, 0, 1, 2, 3, 4, 5, 6, 7);
}
template <int CTRL, int ROWMASK> __device__ __forceinline__ float dpp_f(float v) {
    return __builtin_bit_cast(float, __builtin_amdgcn_update_dpp(0, __builtin_bit_cast(int, v), CTRL, ROWMASK, 0xF, true)); }
__device__ __forceinline__ float wave_incl_scan(float v) {
    v += dpp_f<0x111, 0xF>(v); v += dpp_f<0x112, 0xF>(v); v += dpp_f<0x114, 0xF>(v); v += dpp_f<0x118, 0xF>(v);
    v += dpp_f<0x142, 0xA>(v); v += dpp_f<0x143, 0xC>(v); return v; }
__device__ __forceinline__ float fast_log_sigmoid(float x) { return fminf(x, 0.0f) - __logf(1.0f + __expf(-fabsf(x))); }

constexpr int GP = 144;
constexpr int GL_QD = 0, GL_KI = GL_QD + 64 * GP, GL_KET = GL_KI + 64 * GP, GL_VT = GL_KET + 64 * GP, GL_DEC = GL_VT + 128 * GP, GL_SSP = GL_DEC + 256, GL_OT = GL_SSP + 1024;
constexpr int OTP = 132;
constexpr int GL_END = GL_OT + 64 * OTP * 4;
static_assert(GL_END <= RING_BYTES && (GL_OT % 16) == 0 && (GL_DEC % 16) == 0, "gla lds");

__device__ __forceinline__ void gla_item(const Ptrs& P, LAS unsigned char* lds, int bh) {
    const int tid = threadIdx.x, lane = tid & 63, w = __builtin_amdgcn_readfirstlane(tid >> 6), l31 = lane & 31, hh = lane >> 5;
    const int b = bh >> 2, h = bh & 3, cr = w >> 2, vc = w & 3;
    const bf16* PROJ = (const bf16*)(P.ws + WS_PROJ); bf16* MIX = (bf16*)(P.ws + WS_MIX);
    const size_t tok0 = (size_t)b * SEQ;
    const bf16* pq = PROJ + (tok0 + lane) * NPROJ + PC_Q + h * 64 + 8 * w;
    const bf16* pk = PROJ + (tok0 + lane) * NPROJ + PC_K + h * 64 + 8 * w;
    const bf16* pg = PROJ + (tok0 + lane) * NPROJ + PC_GK + h * 64 + 8 * w;
    const bf16* pv = PROJ + (tok0 + lane) * NPROJ + PC_V + h * 128 + 16 * w;
    const int oc = tid >> 3, ov = (tid & 7) * 16;
    const bf16* pgate = PROJ + (tok0 + oc) * NPROJ + PC_G + h * 128 + ov;
    float bgk[8], nw[16];
#pragma unroll
    for (int j = 0; j < 8; ++j) bgk[j] = P.b_gk[h * 64 + 8 * w + j];
#pragma unroll
    for (int j = 0; j < 16; ++j) nw[j] = P.gla_norm_w[ov + j];
    f32x16 S0, S1;
#pragma unroll
    for (int r = 0; r < 16; ++r) { S0[r] = 0.f; S1[r] = 0.f; }
    v4u nq = *(const v4u*)pq, nk = *(const v4u*)pk, ng = *(const v4u*)pg, nv0 = *(const v4u*)pv, nv1 = *(const v4u*)(pv + 8);
    for (int n = 0; n < SEQ / 64; ++n) {
        const v4u cq = nq, ck = nk, cg = ng, cv0 = nv0, cv1 = nv1;
        const size_t adv = (size_t)(n + 1 < SEQ / 64 ? (n + 1) * 64 : n * 64) * NPROJ;
        nq = *(const v4u*)(pq + adv); nk = *(const v4u*)(pk + adv); ng = *(const v4u*)(pg + adv); nv0 = *(const v4u*)(pv + adv); nv1 = *(const v4u*)(pv + adv + 8);
        const size_t gadv = (size_t)n * 64 * NPROJ;
        const v4u gate0 = *(const v4u*)(pgate + gadv), gate1 = *(const v4u*)(pgate + gadv + 8);
        {
            const unsigned qw[4] = {cq.x, cq.y, cq.z, cq.w}, kw[4] = {ck.x, ck.y, ck.z, ck.w}, gw[4] = {cg.x, cg.y, cg.z, cg.w};
            float bb[8];
#pragma unroll
            for (int j = 0; j < 8; ++j) { const float x = bf2f((gw[j >> 1] >> (16 * (j & 1))) & 0xffffu) + bgk[j]; bb[j] = fast_log_sigmoid(x) * (1.0f / 16.0f); }
#pragma unroll
            for (int j = 0; j < 8; ++j) bb[j] = wave_incl_scan(bb[j]);
            float qd[8], ki[8], ke[8];
#pragma unroll
            for (int j = 0; j < 8; ++j) { const float bl = __builtin_bit_cast(float, __builtin_amdgcn_readlane(__builtin_bit_cast(int, bb[j]), 63));
                const float qv = bf2f((qw[j >> 1] >> (16 * (j & 1))) & 0xffffu), kv = bf2f((kw[j >> 1] >> (16 * (j & 1))) & 0xffffu);
                qd[j] = qv * 0.125f * __expf(bb[j]); ki[j] = kv * __expf(-bb[j]); ke[j] = kv * __expf(bl - bb[j]);
                if (lane == 63) *(LAS float*)(lds + GL_DEC + (8 * w + j) * 4) = __expf(bl); }
            u32x4 t; t.x = cvtpk(qd[0], qd[1]); t.y = cvtpk(qd[2], qd[3]); t.z = cvtpk(qd[4], qd[5]); t.w = cvtpk(qd[6], qd[7]);
            *(LAS u32x4*)(lds + GL_QD + lane * GP + 16 * w) = t;
            t.x = cvtpk(ki[0], ki[1]); t.y = cvtpk(ki[2], ki[3]); t.z = cvtpk(ki[4], ki[5]); t.w = cvtpk(ki[6], ki[7]);
            *(LAS u32x4*)(lds + GL_KI + lane * GP + 16 * w) = t;
#pragma unroll
            for (int j = 0; j < 8; ++j) *(LAS unsigned short*)(lds + GL_KET + (8 * w + j) * GP + lane * 2) = (unsigned short)f2bf(ke[j]);
            const unsigned vw[8] = {cv0.x, cv0.y, cv0.z, cv0.w, cv1.x, cv1.y, cv1.z, cv1.w};
#pragma unroll
            for (int j = 0; j < 16; ++j) *(LAS unsigned short*)(lds + GL_VT + (16 * w + j) * GP + lane * 2) = (unsigned short)((vw[j >> 1] >> (16 * (j & 1))) & 0xffffu);
        }
        __syncthreads();
        f32x16 O;
#pragma unroll
        for (int r = 0; r < 16; ++r) O[r] = 0.f;
        {
            const LAS unsigned char* qrow = lds + GL_QD + (cr * 32 + l31) * GP + 8 * hh;
            O = __builtin_amdgcn_mfma_f32_32x32x16_bf16(pack8<0>(S0), lds_2xb64(qrow + 0), O, 0, 0, 0);
            O = __builtin_amdgcn_mfma_f32_32x32x16_bf16(pack8<1>(S0), lds_2xb64(qrow + 32), O, 0, 0, 0);
            O = __builtin_amdgcn_mfma_f32_32x32x16_bf16(pack8<0>(S1), lds_2xb64(qrow + 64), O, 0, 0, 0);
            O = __builtin_amdgcn_mfma_f32_32x32x16_bf16(pack8<1>(S1), lds_2xb64(qrow + 96), O, 0, 0, 0);
        }
        {
            const LAS unsigned char* qb = lds + GL_QD + (cr * 32 + l31) * GP + 16 * hh;
            const LAS unsigned char* vrow = lds + GL_VT + (vc * 32 + l31) * GP + 8 * hh;
            f32x16 X;
#pragma unroll
            for (int r = 0; r < 16; ++r) X[r] = 0.f;
            if (cr == 1) {
                const LAS unsigned char* ka = lds + GL_KI + l31 * GP + 16 * hh;
#pragma unroll
                for (int kk = 0; kk < 4; ++kk) X = __builtin_amdgcn_mfma_f32_32x32x16_bf16(lds_b128(ka + 32 * kk), lds_b128(qb + 32 * kk), X, 0, 0, 0);
                O = __builtin_amdgcn_mfma_f32_32x32x16_bf16(lds_2xb64(vrow + 0), pack8<0>(X), O, 0, 0, 0);
                O = __builtin_amdgcn_mfma_f32_32x32x16_bf16(lds_2xb64(vrow + 32), pack8<1>(X), O, 0, 0, 0);
#pragma unroll
                for (int r = 0; r < 16; ++r) X[r] = 0.f;
            }
            {
                const LAS unsigned char* ka = lds + GL_KI + (cr * 32 + l31) * GP + 16 * hh;
#pragma unroll
                for (int kk = 0; kk < 4; ++kk) X = __builtin_amdgcn_mfma_f32_32x32x16_bf16(lds_b128(ka + 32 * kk), lds_b128(qb + 32 * kk), X, 0, 0, 0);
#pragma unroll
                for (int r = 0; r < 16; ++r) { const int srow = (r & 3) + 8 * (r >> 2) + 4 * hh; X[r] = (srow <= l31) ? X[r] : 0.f; }
                O = __builtin_amdgcn_mfma_f32_32x32x16_bf16(lds_2xb64(vrow + cr * 64 + 0), pack8<0>(X), O, 0, 0, 0);
                O = __builtin_amdgcn_mfma_f32_32x32x16_bf16(lds_2xb64(vrow + cr * 64 + 32), pack8<1>(X), O, 0, 0, 0);
            }
        }
        {
            const LAS float* dec = (const LAS float*)(lds + GL_DEC);
#pragma unroll
            for (int g4 = 0; g4 < 4; ++g4) { const f32x4 d0 = *(const LAS f32x4*)(dec + 8 * g4 + 4 * hh), d1 = *(const LAS f32x4*)(dec + 32 + 8 * g4 + 4 * hh);
#pragma unroll
                for (int i = 0; i < 4; ++i) { S0[4 * g4 + i] *= d0[i]; S1[4 * g4 + i] *= d1[i]; } }
            const LAS unsigned char* ka0 = lds + GL_KET + l31 * GP + 16 * hh;
            const LAS unsigned char* ka1 = lds + GL_KET + (32 + l31) * GP + 16 * hh;
            const LAS unsigned char* vb = lds + GL_VT + (vc * 32 + l31) * GP + 16 * hh;
#pragma unroll
            for (int ss = 0; ss < 4; ++ss) { const bf16x8 bfr = lds_b128(vb + 32 * ss);
                S0 = __builtin_amdgcn_mfma_f32_32x32x16_bf16(lds_b128(ka0 + 32 * ss), bfr, S0, 0, 0, 0);
                S1 = __builtin_amdgcn_mfma_f32_32x32x16_bf16(lds_b128(ka1 + 32 * ss), bfr, S1, 0, 0, 0); }
        }
        {
            float ssq = 0.f;
#pragma unroll
            for (int r = 0; r < 16; ++r) ssq += O[r] * O[r];
            ssq += __shfl_xor(ssq, 32);
            if (hh == 0) *(LAS float*)(lds + GL_SSP + (vc * 64 + cr * 32 + l31) * 4) = ssq;
            LAS float* ot = (LAS float*)(lds + GL_OT) + (cr * 32 + l31) * OTP + vc * 32 + 4 * hh;
#pragma unroll
            for (int g4 = 0; g4 < 4; ++g4) *(LAS f32x4*)(ot + 8 * g4) = (f32x4){O[4 * g4], O[4 * g4 + 1], O[4 * g4 + 2], O[4 * g4 + 3]};
        }
        __syncthreads();
        {
            const LAS float* ssp = (const LAS float*)(lds + GL_SSP) + oc;
            const float tot = (ssp[0] + ssp[64]) + (ssp[128] + ssp[192]);
            const float rstd = 1.0f / sqrtf(tot * (1.0f / 128.0f) + EPS);
            const LAS float* ot = (const LAS float*)(lds + GL_OT) + oc * OTP + ov;
            const unsigned gw[8] = {gate0.x, gate0.y, gate0.z, gate0.w, gate1.x, gate1.y, gate1.z, gate1.w};
            float y[16];
#pragma unroll
            for (int q4 = 0; q4 < 4; ++q4) { const f32x4 o4 = *(const LAS f32x4*)(ot + 4 * q4);
#pragma unroll
                for (int i = 0; i < 4; ++i) { const int j = 4 * q4 + i; const float gv = bf2f((gw[j >> 1] >> (16 * (j & 1))) & 0xffffu); y[j] = o4[i] * rstd * nw[j] * (gv / (1.0f + __expf(-gv))); } }
            bf16* orow = MIX + (tok0 + (size_t)n * 64 + oc) * D + h * 128 + ov;
            u32x4 t; t.x = cvtpk(y[0], y[1]); t.y = cvtpk(y[2], y[3]); t.z = cvtpk(y[4], y[5]); t.w = cvtpk(y[6], y[7]); *(u32x4*)orow = t;
            t.x = cvtpk(y[8], y[9]); t.y = cvtpk(y[10], y[11]); t.z = cvtpk(y[12], y[13]); t.w = cvtpk(y[14], y[15]); *(u32x4*)(orow + 8) = t;
        }
    }
    __syncthreads();
}

constexpr int SP = 272;
constexpr int SG_W = 0, SG_VN = SG_W + 128 * SP, SG_OT = SG_VN + 128 * SP, SG_ST = SG_OT + 128 * SP, SG_END = SG_ST + 1024;
static_assert(SG_END <= RING_BYTES, "sgu lds");
__device__ __forceinline__ void sgu_item(const Ptrs& P, LAS unsigned char* lds, int bn) {
    const int tid = threadIdx.x, lane = tid & 63, w = __builtin_amdgcn_readfirstlane(tid >> 6), l31 = lane & 31, hh = lane >> 5;
    const bf16* PROJ = (const bf16*)(P.ws + WS_PROJ); bf16* MIX = (bf16*)(P.ws + WS_MIX); const bf16* Wsp = (const bf16*)(P.ws + WS_WSP);
    const size_t tok0 = (size_t)bn * 128;
    LAS float* st = (LAS float*)(lds + SG_ST);
#pragma unroll 4
    for (int rr = 0; rr < 16; ++rr) { const int row = 16 * w + rr;
        const v4u raw = *(const v4u*)(PROJ + (tok0 + row) * NPROJ + PC_VS + lane * 8); const unsigned rw[4] = {raw.x, raw.y, raw.z, raw.w};
        float s = 0.f, q = 0.f;
#pragma unroll
        for (int j = 0; j < 8; ++j) { const float g = gelu_tanh(bf2f((rw[j >> 1] >> (16 * (j & 1))) & 0xffffu)); s += g; q += g * g; }
        s = wave_sum(s); q = wave_sum(q);
        const float mu = s * (1.0f / 512.0f), var = fmaxf(q * (1.0f / 512.0f) - mu * mu, 0.f);
        if (lane == 0) { st[row] = mu; st[128 + row] = 1.0f / sqrtf(var + EPS); } }
    __syncthreads();
    for (int g = 0; g < 4; ++g) {
#pragma unroll
        for (int ps = 0; ps < 4; ++ps) { const int idx = ps * NTHR + tid, row = idx >> 4, c16 = idx & 15;
            *(LAS v4u*)(lds + SG_W + row * SP + c16 * 16) = *(const v4u*)(Wsp + ((size_t)g * 128 + row) * 128 + c16 * 8); }
        { const int s = tid & 127, c0 = (tid >> 7) * 32; const float mu = st[s], rs = st[128 + s];
#pragma unroll
          for (int q4 = 0; q4 < 4; ++q4) { const int cb = c0 + q4 * 8;
              const v4u raw = *(const v4u*)(PROJ + (tok0 + s) * NPROJ + PC_VS + g * 128 + cb); const unsigned rw[4] = {raw.x, raw.y, raw.z, raw.w};
              const f32x4 lw0 = *(const f32x4*)(P.sg_ln_w + g * 128 + cb), lw1 = *(const f32x4*)(P.sg_ln_w + g * 128 + cb + 4), lb0 = *(const f32x4*)(P.sg_ln_b + g * 128 + cb), lb1 = *(const f32x4*)(P.sg_ln_b + g * 128 + cb + 4);
#pragma unroll
              for (int j = 0; j < 8; ++j) { const float gv = gelu_tanh(bf2f((rw[j >> 1] >> (16 * (j & 1))) & 0xffffu));
                  const float vn = (gv - mu) * rs * (j < 4 ? lw0[j & 3] : lw1[j & 3]) + (j < 4 ? lb0[j & 3] : lb1[j & 3]);
                  *(LAS unsigned short*)(lds + SG_VN + (cb + j) * SP + s * 2) = (unsigned short)f2bf(vn); } } }
        __syncthreads();
        { const int ct = w >> 1;
          const LAS unsigned char* arow = lds + SG_VN + (ct * 32 + l31) * SP + 16 * hh;
#pragma unroll
          for (int ti = 0; ti < 2; ++ti) { const int tt = (w & 1) * 2 + ti;
              const LAS unsigned char* brow = lds + SG_W + (tt * 32 + l31) * SP + 16 * hh;
              f32x16 acc;
#pragma unroll
              for (int r = 0; r < 16; ++r) acc[r] = 0.f;
              for (int ks = 0; ks < 2 * (tt + 1); ++ks) acc = __builtin_amdgcn_mfma_f32_32x32x16_bf16(lds_b128(arow + 32 * ks), lds_b128(brow + 32 * ks), acc, 0, 0, 0);
              const float bs = P.b_spatial[g * 128 + tt * 32 + l31];
              LAS unsigned char* orow = lds + SG_OT + (tt * 32 + l31) * SP + (ct * 32 + 4 * hh) * 2;
#pragma unroll
              for (int g4 = 0; g4 < 4; ++g4) { u32x2 pk; pk.x = cvtpk(acc[4 * g4] + bs, acc[4 * g4 + 1] + bs); pk.y = cvtpk(acc[4 * g4 + 2] + bs, acc[4 * g4 + 3] + bs); *(LAS u32x2*)(orow + 16 * g4) = pk; } } }
        __syncthreads();
        { const int t = tid >> 2, cg = (tid & 3) * 32;
#pragma unroll
          for (int q4 = 0; q4 < 4; ++q4) { const v4u mx = *(const LAS v4u*)(lds + SG_OT + t * SP + (cg + q4 * 8) * 2);
              const v4u ur = *(const v4u*)(PROJ + (tok0 + t) * NPROJ + PC_U + g * 128 + cg + q4 * 8);
              const unsigned mw[4] = {mx.x, mx.y, mx.z, mx.w}, uw[4] = {ur.x, ur.y, ur.z, ur.w}; unsigned ow[4];
#pragma unroll
              for (int j = 0; j < 4; ++j) { const float a0 = gelu_tanh(bf2f(uw[j] & 0xffffu)) * bf2f(mw[j] & 0xffffu), a1 = gelu_tanh(bf2f(uw[j] >> 16)) * bf2f(mw[j] >> 16); ow[j] = cvtpk(a0, a1); }
              *(v4u*)(MIX + (tok0 + t) * D + 512 + g * 128 + cg + q4 * 8) = (v4u){ow[0], ow[1], ow[2], ow[3]}; } }
    }
    __syncthreads();
}
__device__ __forceinline__ void moe_weight_items(const Ptrs& P, unsigned char* lds_generic, int gw, int ngw) {
    const int lane = threadIdx.x & 63, wave = __builtin_amdgcn_readfirstlane(threadIdx.x >> 6);
    float* scr = (float*)(lds_generic + wave * 16384);
    for (int it = gw; it < IT_GU + IT_DN; it += ngw) p0_weight_item(P, IT_IN + IT_OUT + it, scr, lane);
}
__device__ __forceinline__ void ph2_mix_fast(const Ptrs& P, LAS unsigned char* lds, unsigned char* lds_generic, int G) {
    const int bid = blockIdx.x, wave = __builtin_amdgcn_readfirstlane(threadIdx.x >> 6);
    if (G >= 128) {
        if (bid < 64) { for (int rep = 0; rep < ((PROBE_REPEAT == 21) ? 2 : 1); ++rep) gla_item(P, lds, bid); }
        else { for (int rep = 0; rep < ((PROBE_REPEAT == 20) ? 2 : 1); ++rep) for (int it = bid - 64; it < NB * 16; it += G - 64) sgu_item(P, lds, it);
               for (int rep = 0; rep < ((PROBE_REPEAT == 22) ? 2 : 1); ++rep) moe_weight_items(P, lds_generic, (bid - 64) * NWAVES + wave, (G - 64) * NWAVES); }
    } else {
        for (int it = bid; it < 64; it += G) gla_item(P, lds, it);
        for (int it = bid; it < NB * 16; it += G) sgu_item(P, lds, it);
        moe_weight_items(P, lds_generic, bid * NWAVES + wave, G * NWAVES);
    }
}

constexpr size_t WS_WR2 = WS_WSP + 256 * 1024;
__device__ __forceinline__ void p0_wr2(const Ptrs& P, int gtid, int gthreads) {
    f32x4* WR2 = (f32x4*)(P.ws + WS_WR2);
    for (int idx = gtid; idx < 64 * 2 * 64; idx += gthreads) { const int j = idx >> 7, tl = (idx >> 6) & 1, q = (idx >> 4) & 3, e = tl * 16 + (idx & 15); f32x4 o;
#pragma unroll
        for (int i = 0; i < 4; ++i) { const int k = 16 * j + 4 * q + i; o[i] = P.w_router[(size_t)k * NE + e] * P.norm_ffn_w[k]; }
        WR2[idx] = o; }
}
__device__ __forceinline__ bool rt_better(float va, int ia, float vb, int ib) { return va > vb || (va == vb && ia < ib); }
__device__ __forceinline__ void ph4_router_fast(const Ptrs& P, LAS unsigned char* lds, int G) {
    const int tid = threadIdx.x, lane = tid & 63, wave = __builtin_amdgcn_readfirstlane(tid >> 6), tk = lane & 15, q = lane >> 4;
    unsigned* ctl = (unsigned*)(P.ws + WS_CTL);
    LAS unsigned* lcnt = (LAS unsigned*)lds; LAS unsigned* lbase = lcnt + 32;
    const f32x4* WR2 = (const f32x4*)(P.ws + WS_WR2);
    const int NGRP = T / 16, rounds = (NGRP + G * NWAVES - 1) / (G * NWAVES);
    for (int rd = 0; rd < rounds; ++rd) {
        if (tid < 32) lcnt[tid] = 0u;
        __syncthreads();
        const int grp = (rd * G + (int)blockIdx.x) * NWAVES + wave; const bool act = grp < NGRP;
        const int m0 = (act ? grp : 0) * 16;
        const float* xrow = (const float*)(P.ws + WS_X1) + (size_t)(m0 + tk) * D + 4 * q;
        f32x4 d0 = {0.f, 0.f, 0.f, 0.f}, d1 = {0.f, 0.f, 0.f, 0.f}; float ssq = 0.f;
#pragma unroll 4
        for (int j = 0; j < 64; ++j) { const f32x4 xv = *(const f32x4*)(xrow + 16 * j); const f32x4 w0 = WR2[(j * 2 + 0) * 64 + lane], w1 = WR2[(j * 2 + 1) * 64 + lane];
            ssq += (xv[0] * xv[0] + xv[1] * xv[1]) + (xv[2] * xv[2] + xv[3] * xv[3]);
#pragma unroll
            for (int i = 0; i < 4; ++i) { d0 = __builtin_amdgcn_mfma_f32_16x16x4f32(w0[i], xv[i], d0, 0, 0, 0); d1 = __builtin_amdgcn_mfma_f32_16x16x4f32(w1[i], xv[i], d1, 0, 0, 0); } }
        ssq += __shfl_xor(ssq, 16); ssq += __shfl_xor(ssq, 32);
        const float rstd = 1.0f / sqrtf(ssq * (1.f / D) + EPS);
        float cv[8]; int ci[8];
#pragma unroll
        for (int r = 0; r < 4; ++r) { cv[r] = d0[r] * rstd + P.b_router[4 * q + r]; ci[r] = 4 * q + r; cv[4 + r] = d1[r] * rstd + P.b_router[16 + 4 * q + r]; ci[4 + r] = 16 + 4 * q + r; }
        float sv[4]; int si[4];
#pragma unroll
        for (int r = 0; r < 4; ++r) { float bv = cv[0]; int bi = ci[0];
#pragma unroll
            for (int c = 1; c < 8; ++c) if (rt_better(cv[c], ci[c], bv, bi)) { bv = cv[c]; bi = ci[c]; }
            sv[r] = bv; si[r] = bi;
#pragma unroll
            for (int c = 0; c < 8; ++c) if (ci[c] == bi) cv[c] = -3.0e38f; }
#pragma unroll
        for (int off = 16; off <= 32; off <<= 1) {
            float ov[4]; int oi[4];
#pragma unroll
            for (int r = 0; r < 4; ++r) { ov[r] = __shfl_xor(sv[r], off); oi[r] = __shfl_xor(si[r], off); }
            float mv[8]; int mi[8];
#pragma unroll
            for (int r = 0; r < 4; ++r) { mv[r] = sv[r]; mi[r] = si[r]; mv[4 + r] = ov[r]; mi[4 + r] = oi[r]; }
#pragma unroll
            for (int r = 0; r < 4; ++r) { float bv = mv[0]; int bi = mi[0];
#pragma unroll
                for (int c = 1; c < 8; ++c) if (rt_better(mv[c], mi[c], bv, bi)) { bv = mv[c]; bi = mi[c]; }
                sv[r] = bv; si[r] = bi;
#pragma unroll
                for (int c = 0; c < 8; ++c) if (mi[c] == bi) mv[c] = -3.0e38f; }
        }
        float pw[4], den = 0.f;
#pragma unroll
        for (int r = 0; r < 4; ++r) { pw[r] = __expf(sv[r] - sv[0]); den += pw[r]; }
        int ee = si[0]; float ww = pw[0];
#pragma unroll
        for (int r = 1; r < 4; ++r) if (q == r) { ee = si[r]; ww = pw[r]; }
        ww /= den;
        unsigned lr = 0u;
        if (act) lr = __hip_atomic_fetch_add(lcnt + ee, 1u, __ATOMIC_RELAXED, __HIP_MEMORY_SCOPE_WORKGROUP);
        __syncthreads();
        if (tid < 32) lbase[tid] = __hip_atomic_fetch_add(ctl + CW_COUNTS + tid, lcnt[tid], RLX_AGENT);
        __syncthreads();
        if (act) { const unsigned rank = lbase[ee] + lr; const int m = m0 + tk;
            ((int*)(P.ws + WS_ROUTE + RT_ROWTOK))[(size_t)ee * T + rank] = m;
            ((float*)(P.ws + WS_ROUTE + RT_ROWW))[(size_t)ee * T + rank] = ww;
            ((int*)(P.ws + WS_ROUTE + RT_TOKSLOT))[(size_t)m * 4 + q] = (ee << 16) | (int)rank;
            bf16* H2 = (bf16*)(P.ws + WS_H);
            for (int tt = 0; tt < 16; ++tt) { const float rs = __shfl(rstd, tt); const f32x4* xr = (const f32x4*)((const float*)(P.ws + WS_X1) + (size_t)(m0 + tt) * D);
#pragma unroll
                for (int j = 0; j < 4; ++j) { const f32x4 v = xr[lane + 64 * j], nwv = ((const f32x4*)P.norm_ffn_w)[lane + 64 * j];
                    ((uint2*)(H2 + (size_t)(m0 + tt) * D))[lane + 64 * j] = make_uint2(cvtpk(v[0] * rs * nwv[0], v[1] * rs * nwv[1]), cvtpk(v[2] * rs * nwv[2], v[3] * rs * nwv[3])); } } }
        __syncthreads();
    }
}

struct Args { Ptrs P; int ph_lo, ph_hi, li, pad; };

__device__ __forceinline__ void ph0_prep(const Ptrs& P, unsigned char* lds_generic, int vcu, int G) {
    const int tid = threadIdx.x, lane = tid & 63, wave = __builtin_amdgcn_readfirstlane(tid >> 6);
    float* scr = (float*)(lds_generic + wave * 16384);
    const int gw = vcu * NWAVES + wave, NGW = G * NWAVES;
    for (int it = gw; it < IT_IN + IT_OUT; it += NGW) p0_weight_item(P, it, scr, lane);
    bf16* Wsp = (bf16*)(P.ws + WS_WSP);
    for (int i = blockIdx.x * NTHR + tid; i < 4 * 128 * 128; i += G * NTHR) { const int t = (i >> 7) & 127, s = i & 127; Wsp[i] = (bf16)f2bf(s <= t ? P.w_spatial[i] : 0.f); }
    p0_wr2(P, blockIdx.x * NTHR + tid, G * NTHR);
    bf16* H = (bf16*)(P.ws + WS_H);
    for (int m = gw; m < T; m += NGW) rms_row_to_bf16(P.x + (size_t)m * D, P.norm_mix_w, H + (size_t)m * D, lane);
}
__device__ __forceinline__ void moe_tables(const Ptrs& P, LAS int* tab) {
    const unsigned* ctl = (const unsigned*)(P.ws + WS_CTL);
    if (threadIdx.x < NE) tab[66 + threadIdx.x] = (int)__hip_atomic_load(ctl + CW_COUNTS + threadIdx.x, RLX_AGENT);
    __syncthreads();
    if (threadIdx.x == 0) { int a = 0; for (int e = 0; e < NE; ++e) { tab[e] = a; tab[33 + e] = a * MT; a += (tab[66 + e] + MT - 1) / MT; } tab[NE] = a; tab[33 + NE] = a * MT; }
    __syncthreads();
}
__device__ __forceinline__ void ph7_final(const Ptrs& P, const LAS int* tab, int G) {
    const int tid = threadIdx.x, lane = tid & 63, wave = tid >> 6;
    const bf16* Y = (const bf16*)(P.ws + WS_YBUF);
    for (int m = blockIdx.x * NWAVES + wave; m < T; m += G * NWAVES) {
        const float* X1 = (const float*)(P.ws + WS_X1) + (size_t)m * D;
        const int* ts = (const int*)(P.ws + WS_ROUTE + RT_TOKSLOT) + (size_t)m * 4;
        f32x4 v[4];
#pragma unroll
        for (int j = 0; j < 4; ++j) v[j] = ((const f32x4*)X1)[lane + 64 * j];
#pragma unroll
        for (int r = 0; r < 4; ++r) { const int pk = ts[r]; const size_t slot = (size_t)tab[33 + (pk >> 16)] + (pk & 0xffff);
#pragma unroll
            for (int j = 0; j < 4; ++j) { const uint2 y = ((const uint2*)(Y + slot * D))[lane + 64 * j];
                v[j].x += bf2f(y.x & 0xffffu); v[j].y += bf2f(y.x >> 16); v[j].z += bf2f(y.y & 0xffffu); v[j].w += bf2f(y.y >> 16); } }
        float s = 0.f;
#pragma unroll
        for (int j = 0; j < 4; ++j) s += (v[j].x * v[j].x + v[j].y * v[j].y) + (v[j].z * v[j].z + v[j].w * v[j].w);
        const float rstd = 1.0f / sqrtf(wave_sum(s) * (1.f / D) + EPS);
#pragma unroll
        for (int j = 0; j < 4; ++j) { const f32x4 ww = ((const f32x4*)P.norm_final_w)[lane + 64 * j];
            ((f32x4*)(P.out + (size_t)m * D))[lane + 64 * j] = (f32x4){v[j].x * rstd * ww.x, v[j].y * rstd * ww.y, v[j].z * rstd * ww.z, v[j].w * rstd * ww.w}; }
    }
}

constexpr int NPHASE = 8;
__global__ void __launch_bounds__(NTHR, 2) mk_fwd(Args args) {
    extern __shared__ __attribute__((aligned(16))) unsigned char lds_raw[];
    LAS unsigned char* lds = (LAS unsigned char*)lds_raw;
    const Ptrs& P = args.P;
    const int tid = threadIdx.x, G = gridDim.x;
    const int vcu = (G % 8 == 0) ? ((int)blockIdx.x % 8) * (G / 8) + (int)blockIdx.x / 8 : (int)blockIdx.x;
    volatile LAS unsigned* MISC = (volatile LAS unsigned*)(lds + MISC_OFF);
    LAS int* tab = (LAS int*)(lds + TAB_OFF);
    if (tid < 64) MISC[tid] = 0u;
    __syncthreads();
    unsigned* ctl = (unsigned*)(P.ws + WS_CTL);
    XcdBarrier bar = xcd_barrier_post(ctl + CW_BAR + args.li * XCD_BAR_WORDS, MISC + 8);
    const int lo = args.ph_lo, hi = args.ph_hi;
#define IN(k) (lo <= (k) && (k) < hi)
#define NREP(k) ((PROBE_REPEAT == (k)) ? 2 : 1)
#define PH(k, ...) if (IN(k)) { for (int rep = 0; rep < NREP(k); ++rep) { __VA_ARGS__; if (rep + 1 < NREP(k) || IN((k) + 1)) xcd_barrier(bar); } }
    PH(0, ph0_prep(P, lds_raw, vcu, G));
    PH(1, { pg8::DenseSched S; S.init(T, NPROJ, D, G, (int)blockIdx.x); pg8::EpiProj E{(bf16*)(P.ws + WS_PROJ)};
            pg8::gemm_phase(lds, (const char*)(P.ws + WS_H), (const char*)(P.ws + WS_WIN), D, S, E); });
    PH(2, ph2_mix_fast(P, lds, lds_raw, G));
    PH(3, { pg8::DenseSched S; S.init(T, D, D, G, (int)blockIdx.x); pg8::EpiX1 E{P.x, (float*)(P.ws + WS_X1)};
            pg8::gemm_phase(lds, (const char*)(P.ws + WS_MIX), (const char*)(P.ws + WS_WOUT), D, S, E); });
    PH(4, ph4_router_fast(P, lds, G));
    if (IN(5) || IN(6) || IN(7)) moe_tables(P, tab);
    PH(5, { pg8::MoeSched S{tab, (const int*)(P.ws + WS_ROUTE + RT_ROWTOK), 8, G, (int)blockIdx.x, tab[NE] * 8, D, 2048, true};
            pg8::EpiAct E{(bf16*)(P.ws + WS_ACT), P.b_gate_up};
            pg8::gemm_phase(lds, (const char*)(P.ws + WS_H), (const char*)(P.ws + WS_WGU), D, S, E); });
    PH(6, { pg8::MoeSched S{tab, nullptr, 4, G, (int)blockIdx.x, tab[NE] * 4, DE, 1024, false};
            pg8::EpiDown E{(bf16*)(P.ws + WS_YBUF), P.b_down, (const float*)(P.ws + WS_ROUTE + RT_ROWW)};
            pg8::gemm_phase(lds, (const char*)(P.ws + WS_ACT), (const char*)(P.ws + WS_WD), DE, S, E); });
    PH(7, ph7_final(P, tab, G));
#undef IN
#undef NREP
#undef PH
}

#ifndef MK_SEGMENTS
#define MK_SEGMENTS 1
#endif
extern "C" void kernel_launch(void* const* d_in, const int* in_sizes, int n_in, void* d_out, int out_size, void* d_ws, size_t ws_size, hipStream_t stream) {
    if (n_in != 19 || out_size != T * D || ws_size < WS_END) { fprintf(stderr, "kernel_launch: unexpected shapes n_in %d out %d ws %zu (need %zu)\n", n_in, out_size, ws_size, (size_t)WS_END); return; }
    static int grid = 0;
    if (grid == 0) {
        int dev = 0, cus = 0, per_cu = 0;
        if (hipGetDevice(&dev) != hipSuccess || hipDeviceGetAttribute(&cus, hipDeviceAttributeMultiprocessorCount, dev) != hipSuccess) { fprintf(stderr, "kernel_launch: device query failed\n"); grid = -1; return; }
        if (hipFuncSetAttribute((const void*)mk_fwd, hipFuncAttributeMaxDynamicSharedMemorySize, LDS_BYTES) != hipSuccess) { fprintf(stderr, "kernel_launch: hipFuncSetAttribute failed\n"); grid = -1; return; }
        if (hipOccupancyMaxActiveBlocksPerMultiprocessor(&per_cu, (const void*)mk_fwd, NTHR, LDS_BYTES) != hipSuccess || per_cu < 1) { fprintf(stderr, "kernel_launch: occupancy query says %d\n", per_cu); per_cu = 1; }
        (void)hipGetLastError();
        grid = cus;
        fprintf(stderr, "kernel_launch: cus %d per_cu %d grid %d\n", cus, per_cu, grid);
    }
    if (grid < 0) return;
    Args a{};
    const float** pp = (const float**)&a.P;
    for (int i = 0; i < 19; ++i) pp[i] = (const float*)d_in[i];
    a.P.out = (float*)d_out; a.P.ws = (unsigned char*)d_ws;
    (void)hipMemsetAsync((char*)d_ws + WS_CTL, 0, MiB, stream);
#if MK_SEGMENTS == 1
    a.ph_lo = 0; a.ph_hi = NPHASE; a.li = 0;
    void* kargs[] = {&a};
    hipError_t e = hipLaunchCooperativeKernel((const void*)mk_fwd, dim3(grid), dim3(NTHR), kargs, LDS_BYTES, stream);
    if (e != hipSuccess) fprintf(stderr, "kernel_launch: cooperative launch failed: %s (grid %d)\n", hipGetErrorString(e), grid);
#else
    for (int ph = 0; ph < NPHASE; ++ph) { a.ph_lo = ph; a.ph_hi = ph + 1; a.li = ph; hipLaunchKernelGGL(mk_fwd, dim3(grid), dim3(NTHR), LDS_BYTES, stream, a); }
#endif
}
```

```cpp
#include <hip/hip_runtime.h>
#include <cstdio>
#include <cstdint>

constexpr int T = 32768, D = 1024, SEQ = 2048, NB = 16;
constexpr int NIN_SRC = 2576, NPROJ = 2816;
constexpr int PC_Q = 0, PC_K = 256, PC_V = 512, PC_G = 1024, PC_GK = 1536, PC_U = 1792, PC_VS = 2304;
constexpr int NE = 32, TOPK = 4, DE = 1024;
constexpr int MT = 256;
constexpr int MAXSLOTS = T * TOPK + NE * MT;
constexpr float EPS = 1e-6f;

typedef unsigned short bf16;
typedef unsigned v4u __attribute__((ext_vector_type(4)));
typedef float f32x4 __attribute__((ext_vector_type(4)));

constexpr size_t MiB = 1u << 20;
constexpr size_t WS_CTL   = 0;
constexpr size_t WS_WIN   = 1 * MiB;
constexpr size_t WS_WOUT  = 7 * MiB;
constexpr size_t WS_WSP   = 9 * MiB;
constexpr size_t WS_ROUTE = 10 * MiB;
constexpr size_t WS_WGU   = 20 * MiB;
constexpr size_t WS_WD    = 148 * MiB;
constexpr size_t WS_X1    = 212 * MiB;
constexpr size_t WS_ACT   = 340 * MiB;
constexpr size_t WS_PROJ  = 612 * MiB;
constexpr size_t WS_MIX   = 788 * MiB;
constexpr size_t WS_H     = 852 * MiB;
constexpr size_t WS_YBUF  = WS_PROJ;
constexpr size_t WS_VN    = WS_ACT;
constexpr size_t WS_END   = 916 * MiB;
static_assert(WS_YBUF + (size_t)MAXSLOTS * 1024 * 2 <= WS_END, "ybuf fits");
static_assert(WS_ACT + (size_t)MAXSLOTS * 1024 * 2 <= WS_PROJ, "act fits");
constexpr size_t RT_ROWTOK = 0;
constexpr size_t RT_ROWW   = 4 * MiB;
constexpr size_t RT_TOKSLOT= 8 * MiB;
constexpr int CW_COUNTS = 64;
constexpr int CW_PSTART = 128;

__device__ __forceinline__ unsigned f2bf(float f) { unsigned u = __builtin_bit_cast(unsigned, f); return (u + 0x7fffu + ((u >> 16) & 1u)) >> 16; }
__device__ __forceinline__ float bf2f(unsigned h) { return __builtin_bit_cast(float, h << 16); }
__device__ __forceinline__ unsigned pk2(float lo, float hi) { return f2bf(lo) | (f2bf(hi) << 16); }
#ifndef MOE_FP8
#define MOE_FP8 1
#endif
constexpr float F8S_H = 8.0f, F8S_W = 32.0f, F8S_ACT = 4.0f;
__device__ __forceinline__ float f8clamp(float x) { return fminf(fmaxf(x, -448.0f), 448.0f); }
__device__ __forceinline__ unsigned pk4_fp8(float a, float b, float c, float d) {
    int w = 0; w = __builtin_amdgcn_cvt_pk_fp8_f32(f8clamp(a), f8clamp(b), w, false); w = __builtin_amdgcn_cvt_pk_fp8_f32(f8clamp(c), f8clamp(d), w, true); return (unsigned)w; }
__device__ __forceinline__ float gelu_tanh(float x) { const float u = 0.7978845608028654f * (x + 0.044715f * x * x * x); return x / (1.0f + __expf(-2.0f * u)); }
__device__ __forceinline__ float silu(float x) { return x / (1.0f + __expf(-x)); }
__device__ __forceinline__ float log_sigmoid(float x) { return fminf(x, 0.0f) - log1pf(__expf(-fabsf(x))); }
__device__ __forceinline__ float wave_sum(float v) {
#pragma unroll
    for (int o = 1; o < 64; o <<= 1) v += __shfl_xor(v, o);
    return v;
}

struct Ptrs {
    const float *x, *norm_mix_w, *w_in, *w_gk_up, *b_gk, *gla_norm_w, *sg_ln_w, *sg_ln_b, *w_spatial, *b_spatial, *w_out, *norm_ffn_w,
                *w_router, *b_router, *w_gate_up, *b_gate_up, *w_down, *b_down, *norm_final_w;
    float* out; unsigned char* ws;
};

__device__ __forceinline__ void p0_tr_write(bf16* WT, int K, int d0, int k0, const float* scr, int lane) {
    const int c = lane & 7;
#pragma unroll
    for (int j = 0; j < 4; ++j) { const int n = (lane >> 3) + 8 * j; const float* s = scr + (8 * c) * 33 + n;
        v4u o; o.x = pk2(s[0 * 33], s[1 * 33]); o.y = pk2(s[2 * 33], s[3 * 33]); o.z = pk2(s[4 * 33], s[5 * 33]); o.w = pk2(s[6 * 33], s[7 * 33]);
        *(v4u*)(WT + (size_t)(d0 + n) * K + k0 + 8 * c) = o; }
}
__device__ __forceinline__ void p0_tr_write_f8(unsigned char* WT, int K, int d0, int k0, const float* scr, int lane, float sc) {
    const int c = lane & 7;
#pragma unroll
    for (int j = 0; j < 4; ++j) { const int n = (lane >> 3) + 8 * j; const float* s = scr + (8 * c) * 33 + n;
        uint2 o; o.x = pk4_fp8(s[0 * 33] * sc, s[1 * 33] * sc, s[2 * 33] * sc, s[3 * 33] * sc); o.y = pk4_fp8(s[4 * 33] * sc, s[5 * 33] * sc, s[6 * 33] * sc, s[7 * 33] * sc);
        *(uint2*)(WT + (size_t)(d0 + n) * K + k0 + 8 * c) = o; }
}
template <bool F8 = false>
__device__ __forceinline__ void p0_transpose_item(const float* W, int ldn, int n0, int k0, bf16* WT, int K, int d0, float* scr, int lane) {
    float v[32];
    const float* src = W + (size_t)(k0 + (lane >> 5)) * ldn + n0 + (lane & 31);
#pragma unroll
    for (int i = 0; i < 32; ++i) v[i] = __builtin_nontemporal_load(src + (size_t)(2 * i) * ldn);
#pragma unroll
    for (int i = 0; i < 32; ++i) scr[(2 * i + (lane >> 5)) * 33 + (lane & 31)] = v[i];
    __builtin_amdgcn_wave_barrier(); asm volatile("s_waitcnt lgkmcnt(0)" ::: "memory");
    if constexpr (F8) p0_tr_write_f8((unsigned char*)WT, K, d0, k0, scr, lane, F8S_W); else p0_tr_write(WT, K, d0, k0, scr, lane);
    asm volatile("s_waitcnt lgkmcnt(0)" ::: "memory"); __builtin_amdgcn_wave_barrier();
}
__device__ __forceinline__ void p0_gk_item(const float* w_in, const float* w_gk_up, int j0, int k0, bf16* WT, float* scr, int lane) {
    for (int i = 0; i < 32; ++i) { const int kk = 2 * i + (lane >> 5), j = j0 + (lane & 31); float s = 0.f;
#pragma unroll
        for (int r = 0; r < 16; ++r) s += w_in[(size_t)(k0 + kk) * NIN_SRC + 1536 + r] * w_gk_up[r * 256 + j];
        scr[kk * 33 + (lane & 31)] = s; }
    __builtin_amdgcn_wave_barrier(); asm volatile("s_waitcnt lgkmcnt(0)" ::: "memory");
    p0_tr_write(WT, D, PC_GK + j0, k0, scr, lane);
    asm volatile("s_waitcnt lgkmcnt(0)" ::: "memory"); __builtin_amdgcn_wave_barrier();
}
constexpr int IT_IN = (NPROJ / 32) * 16, IT_OUT = 32 * 16, IT_GU = NE * 64 * 16, IT_DN = NE * 32 * 16, IT_ALL = IT_IN + IT_OUT + IT_GU + IT_DN;
__device__ __forceinline__ void p0_weight_item(const Ptrs& P, int it, float* scr, int lane) {
    bf16* WinT = (bf16*)(P.ws + WS_WIN); bf16* WoutT = (bf16*)(P.ws + WS_WOUT); bf16* WguT = (bf16*)(P.ws + WS_WGU); bf16* WdT = (bf16*)(P.ws + WS_WD);
    if (it < IT_IN) { const int db = it / 16, kb = it % 16, d0 = db * 32;
        if (d0 >= PC_GK && d0 < PC_U) p0_gk_item(P.w_in, P.w_gk_up, d0 - PC_GK, kb * 64, WinT, scr, lane);
        else p0_transpose_item(P.w_in, NIN_SRC, d0 < PC_GK ? d0 : d0 - 240, kb * 64, WinT, D, d0, scr, lane);
        return; }
    it -= IT_IN;
    if (it < IT_OUT) { const int db = it / 16, kb = it % 16; p0_transpose_item(P.w_out, D, db * 32, kb * 64, WoutT, D, db * 32, scr, lane); return; }
    it -= IT_OUT;
    if (it < IT_GU) { const int e = it / 1024, r = it % 1024, db = r / 16, kb = r % 16, d0 = db * 32, pn = d0 >> 8, bj = (d0 >> 7) & 1, rr = d0 & 127;
        if (MOE_FP8) p0_transpose_item<true>(P.w_gate_up + (size_t)e * D * 2048, 2048, bj * 1024 + 128 * pn + rr, kb * 64, (bf16*)((unsigned char*)WguT + (size_t)e * 2048 * D), D, d0, scr, lane);
        else p0_transpose_item(P.w_gate_up + (size_t)e * D * 2048, 2048, bj * 1024 + 128 * pn + rr, kb * 64, WguT + (size_t)e * 2048 * D, D, d0, scr, lane);
        return; }
    it -= IT_GU;
    { const int e = it / 512, r = it % 512, db = r / 16, kb = r % 16;
      if (MOE_FP8) p0_transpose_item<true>(P.w_down + (size_t)e * DE * D, D, db * 32, kb * 64, (bf16*)((unsigned char*)WdT + (size_t)e * D * DE), DE, db * 32, scr, lane);
      else p0_transpose_item(P.w_down + (size_t)e * DE * D, D, db * 32, kb * 64, WdT + (size_t)e * D * DE, DE, db * 32, scr, lane); }
}
__device__ __forceinline__ void rms_row_to_bf16(const float* xrow, const float* w, bf16* orow, int lane) {
    const f32x4* xr = (const f32x4*)xrow + lane; const f32x4* wr = (const f32x4*)w + lane;
    f32x4 v[4]; float s = 0.f;
#pragma unroll
    for (int j = 0; j < 4; ++j) { v[j] = xr[64 * j]; s += (v[j].x * v[j].x + v[j].y * v[j].y) + (v[j].z * v[j].z + v[j].w * v[j].w); }
    const float rstd = 1.0f / sqrtf(wave_sum(s) * (1.f / D) + EPS);
    unsigned long long* o8 = (unsigned long long*)orow + lane;
#pragma unroll
    for (int j = 0; j < 4; ++j) { const f32x4 ww = wr[64 * j];
        o8[64 * j] = (unsigned long long)pk2(v[j].x * rstd * ww.x, v[j].y * rstd * ww.y) | ((unsigned long long)pk2(v[j].z * rstd * ww.z, v[j].w * rstd * ww.w) << 32); }
}

#ifndef PROBE_REPEAT
#define PROBE_REPEAT -1
#endif
#define LAS __attribute__((address_space(3)))
typedef short bf16x8 __attribute__((ext_vector_type(8)));
typedef unsigned u32x4 __attribute__((ext_vector_type(4)));
constexpr int NWAVES = 8, NTHR = 512;
constexpr int RING_BYTES = 131072, TAB_OFF = RING_BYTES, MISC_OFF = RING_BYTES + 1024, LDS_BYTES = 147456;
constexpr int CW_BAR = 4096;
#define RLX_AGENT __ATOMIC_RELAXED, __HIP_MEMORY_SCOPE_AGENT

#define XB_TMO      128
#define XB_XCNT(j)  (256  + 64 * (j))
#define XB_XSUB(j)  (1280 + 64 * (j))
#define XB_XGEN(j)  (2304 + 64 * (j))
#define XB_TOP      3328
#define XB_TOPGEN   3392
#define XCD_BAR_WORDS 3456
#define XB_SPIN_CAP (1u << 20)
__device__ __forceinline__ unsigned xb_ld(unsigned* p)              { return __hip_atomic_load(p, __ATOMIC_RELAXED, __HIP_MEMORY_SCOPE_AGENT); }
__device__ __forceinline__ unsigned xb_add(unsigned* p, unsigned v) { return __hip_atomic_fetch_add(p, v, __ATOMIC_RELAXED, __HIP_MEMORY_SCOPE_AGENT); }
__device__ __forceinline__ unsigned xb_xcc_id() { return (unsigned)__builtin_amdgcn_s_getreg((3 << 11) | 20) & 0xFu; }
#define XB_SPIN(cond, bar) do { unsigned _sp = 0; while (cond) { __builtin_amdgcn_s_sleep(1); \
    if ((++_sp & 255u) == 0u) { if (xb_ld(&(bar)[XB_TMO])) break; if (_sp > XB_SPIN_CAP) { atomicAdd(&(bar)[XB_TMO], 1u); break; } } } } while (0)
struct XcdBarrier { unsigned* bar; unsigned x; volatile LAS unsigned* st; };
__device__ __forceinline__ XcdBarrier xcd_barrier_post(unsigned* bar, volatile LAS unsigned* st) {
    XcdBarrier b; b.bar = bar; b.x = xb_xcc_id(); b.st = st;
    if (threadIdx.x == 0) (void)xb_add(&bar[XB_XCNT(b.x)], 1u);
    return b;
}
__device__ __forceinline__ void xcd_barrier_complete(unsigned* bar, unsigned x, unsigned& nloc, unsigned& nx) {
    const unsigned G = gridDim.x * gridDim.y * gridDim.z;
    unsigned sum, cnt, mine, sp = 0u;
    for (;;) {
        sum = 0u; cnt = 0u; mine = 0u;
#pragma unroll
        for (unsigned j = 0; j < 16; ++j) { const unsigned c = xb_ld(&bar[XB_XCNT(j)]); sum += c; cnt += (c > 0u) ? 1u : 0u; mine = (j == x) ? c : mine; }
        if (sum == G) break;
        __builtin_amdgcn_s_sleep(1);
        if ((++sp & 255u) == 0u) { if (xb_ld(&bar[XB_TMO])) break; if (sp > XB_SPIN_CAP) { atomicAdd(&bar[XB_TMO], 1u); break; } }
    }
    nloc = mine > 0u ? mine : 1u; nx = cnt > 0u ? cnt : 1u;
}
__device__ __forceinline__ void xcd_barrier(const XcdBarrier& b) {
    asm volatile("s_waitcnt vmcnt(0)" ::: "memory");
    __syncthreads();
    if (threadIdx.x == 0) {
        unsigned* bar = b.bar;
        __builtin_amdgcn_s_waitcnt(0);
        unsigned nloc = b.st[0], nx = b.st[1];
        if (nloc == 0u) { xcd_barrier_complete(bar, b.x, nloc, nx); b.st[0] = nloc; b.st[1] = nx; }
        const unsigned old = xb_add(&bar[XB_XSUB(b.x)], 1u);
        const unsigned gen = old / nloc;
        if (old + 1u == (gen + 1u) * nloc) {
            __builtin_amdgcn_fence(__ATOMIC_RELEASE, "agent");
            asm volatile("s_waitcnt vmcnt(0)" ::: "memory");
            const unsigned og = xb_add(&bar[XB_TOP], 1u);
            const unsigned tg = og / nx;
            if (og + 1u == (tg + 1u) * nx) xb_add(&bar[XB_TOPGEN], 1u);
            else XB_SPIN(xb_ld(&bar[XB_TOPGEN]) == tg, bar);
            __builtin_amdgcn_fence(__ATOMIC_ACQUIRE, "agent");
            xb_add(&bar[XB_XGEN(b.x)], 1u);
            asm volatile("s_waitcnt vmcnt(0)" ::: "memory");
        } else {
            XB_SPIN(xb_ld(&bar[XB_XGEN(b.x)]) == gen, bar);
            __builtin_amdgcn_fence(__ATOMIC_ACQUIRE, "agent");
            asm volatile("s_waitcnt vmcnt(0)" ::: "memory");
        }
    }
    __syncthreads();
}

namespace pg8 {
constexpr int BM = 256, BK = 64, HALF = 128, HTB = HALF * BK * 2, NXCD = 8, WGM = 8;
__device__ __forceinline__ int lds_byte(int r, int c) { const int st = (r >> 4) * 2 + (c >> 5), rr = r & 15, cc = c & 31, ob = rr * 64 + cc * 2; return st * 1024 + (ob ^ (((ob >> 9) & 1) << 5)); }
__device__ __forceinline__ void stage_rc(int b, int& R, int& C) { const int st = b / 1024, sb = b % 1024, swz = sb ^ (((sb >> 9) & 1) << 5); R = (st >> 1) * 16 + swz / 64; C = (st & 1) * 32 + (swz % 64) / 2; }
__device__ __forceinline__ int perm32(int rho) { const int n = rho >> 4, i = rho & 15; return 8 * (i >> 2) + 4 * n + (i & 3); }
typedef float f32x2_t __attribute__((ext_vector_type(2)));
typedef __bf16 bf16x2_t __attribute__((ext_vector_type(2)));
__device__ __forceinline__ unsigned cvt_pk_bf16(float lo, float hi) { const f32x2_t v = {lo, hi}; const bf16x2_t b = __builtin_convertvector(v, bf16x2_t); return __builtin_bit_cast(unsigned, b); }
__device__ __forceinline__ int xcd_remap(int wgid, int nwg) { const int q = nwg / NXCD, r = nwg % NXCD, xcd = wgid % NXCD, off = wgid / NXCD; return (xcd < r ? xcd * (q + 1) : r * (q + 1) + (xcd - r) * q) + off; }

struct Unit { int pm, pn, e, m0, count, slot0; };
typedef f32x4 Acc[2][2][4][2];

struct DenseSched {
    int nM, nN, nwg, G, c, K;
    __device__ __forceinline__ void init(int M, int N, int K_, int G_, int c_) { nM = M / BM; nN = N / BM; nwg = nM * nN; G = G_; c = c_; K = K_; }
    __device__ __forceinline__ bool next(int i, Unit& u) const {
        const long L = (long)i * G + c; if (L >= nwg) return false;
        const int wgid = xcd_remap((int)L, nwg);
        const int nig = WGM * nN, gid = wgid / nig, fm = gid * WGM, gsz = (nM - fm) < WGM ? (nM - fm) : WGM;
        u.pm = fm + ((wgid % nig) % gsz); u.pn = (wgid % nig) / gsz; u.e = 0; u.m0 = 0; u.count = 0; u.slot0 = 0; return true;
    }
    __device__ __forceinline__ unsigned a_off(const Unit& u, int r) const { return (unsigned)(u.pm * BM + r) * (unsigned)(K * 2); }
    __device__ __forceinline__ size_t b_off(const Unit& u) const { return (size_t)u.pn * BM * K * 2; }
};
struct MoeSched {
    const LAS int* tab; const int* rowtok; int NPN, G, c, ntile, K, NB_E  ; bool gather;
    __device__ __forceinline__ bool next(int i, Unit& u) const {
        const long L = (long)i * G + c; if (L >= ntile) return false;
        const int wgid = xcd_remap((int)L, ntile);
        int lo = 0, hi = NE;
#pragma unroll
        for (int s = 0; s < 5; ++s) { const int mid = (lo + hi) >> 1; if (__builtin_amdgcn_readfirstlane(tab[mid]) * NPN <= wgid) lo = mid; else hi = mid; }
        const int e = lo, t0 = __builtin_amdgcn_readfirstlane(tab[e]), mte = __builtin_amdgcn_readfirstlane(tab[e + 1]) - t0, local = wgid - t0 * NPN;
        u.e = e; u.pn = local / mte; u.pm = 0; u.m0 = (local % mte) * BM; u.count = __builtin_amdgcn_readfirstlane(tab[66 + e]); u.slot0 = __builtin_amdgcn_readfirstlane(tab[33 + e]); return true;
    }
    __device__ __forceinline__ unsigned a_off(const Unit& u, int r) const {
        int m = u.m0 + r; if (gather) { m = m < u.count ? m : u.count - 1; return (unsigned)rowtok[(size_t)u.e * T + m] * (unsigned)(K * 2); }
        return (unsigned)(u.slot0 + m) * (unsigned)(K * 2);
    }
    __device__ __forceinline__ size_t b_off(const Unit& u) const { return ((size_t)u.e * NB_E + (size_t)u.pn * BM) * K * 2; }
};

struct EpiProj {
    static constexpr bool PERM = true;
    bf16* O;
    __device__ __forceinline__ void operator()(const Acc& acc, const Unit& u, int wr, int wc, int fr, int fq) const {
        const int row0 = u.pm * BM + wr * 64 + fr, col0 = u.pn * BM + wc * 32 + 8 * fq;
#pragma unroll
        for (int ai = 0; ai < 2; ++ai)
#pragma unroll
            for (int m = 0; m < 4; ++m) { bf16* rowp = O + (size_t)(row0 + ai * HALF + m * 16) * NPROJ + col0;
#pragma unroll
                for (int bj = 0; bj < 2; ++bj) { const f32x4 v0 = acc[ai][bj][m][0], v1 = acc[ai][bj][m][1];
                    u32x4 w; w.x = cvt_pk_bf16(v0[0], v0[1]); w.y = cvt_pk_bf16(v0[2], v0[3]); w.z = cvt_pk_bf16(v1[0], v1[1]); w.w = cvt_pk_bf16(v1[2], v1[3]);
                    *(u32x4*)(rowp + bj * HALF) = w; } }
    }
};
struct EpiX1 {
    static constexpr bool PERM = false;
    const float* X; float* O;
    __device__ __forceinline__ void operator()(const Acc& acc, const Unit& u, int wr, int wc, int fr, int fq) const {
        const int row0 = u.pm * BM + wr * 64 + fr, col0 = u.pn * BM + wc * 32 + 4 * fq;
#pragma unroll
        for (int ai = 0; ai < 2; ++ai)
#pragma unroll
            for (int m = 0; m < 4; ++m) { const size_t off = (size_t)(row0 + ai * HALF + m * 16) * D + col0;
#pragma unroll
                for (int bj = 0; bj < 2; ++bj)
#pragma unroll
                    for (int n = 0; n < 2; ++n) { const f32x4 xr = *(const f32x4*)(X + off + bj * HALF + n * 16); *(f32x4*)(O + off + bj * HALF + n * 16) = xr + acc[ai][bj][m][n]; }
                asm volatile("" ::: "memory"); }
    }
};
struct EpiAct {
    static constexpr bool PERM = true;
    bf16* O; const float* bgu;
    __device__ __forceinline__ void operator()(const Acc& acc, const Unit& u, int wr, int wc, int fr, int fq) const {
        const int colj = u.pn * 128 + wc * 32 + 8 * fq;
        const float* bg = bgu + (size_t)u.e * 2048 + colj;
        const f32x4 g0 = *(const f32x4*)bg, g1 = *(const f32x4*)(bg + 4), u0 = *(const f32x4*)(bg + 1024), u1 = *(const f32x4*)(bg + 1028);
#pragma unroll
        for (int ai = 0; ai < 2; ++ai)
#pragma unroll
            for (int m = 0; m < 4; ++m) { const int r = ai * HALF + wr * 64 + m * 16 + fr;
                if (u.m0 + r < u.count) { float y[8];
#pragma unroll
                    for (int n = 0; n < 2; ++n)
#pragma unroll
                        for (int i = 0; i < 4; ++i) { constexpr float isc = MOE_FP8 ? 1.0f / (F8S_H * F8S_W) : 1.0f;
                            float g = acc[ai][0][m][n][i] * isc + (n ? g1[i] : g0[i]), up = acc[ai][1][m][n][i] * isc + (n ? u1[i] : u0[i]);
                            g = fminf(g, 7.0f); up = fminf(fmaxf(up, -7.0f), 7.0f); y[n * 4 + i] = (up + 1.0f) * (g / (1.0f + __expf(-1.702f * g))); }
                    if (MOE_FP8) { uint2 w; w.x = pk4_fp8(y[0] * F8S_ACT, y[1] * F8S_ACT, y[2] * F8S_ACT, y[3] * F8S_ACT); w.y = pk4_fp8(y[4] * F8S_ACT, y[5] * F8S_ACT, y[6] * F8S_ACT, y[7] * F8S_ACT);
                        *(uint2*)((unsigned char*)O + (size_t)(u.slot0 + u.m0 + r) * DE + colj) = w; }
                    else { u32x4 w; w.x = cvt_pk_bf16(y[0], y[1]); w.y = cvt_pk_bf16(y[2], y[3]); w.z = cvt_pk_bf16(y[4], y[5]); w.w = cvt_pk_bf16(y[6], y[7]);
                        *(u32x4*)(O + (size_t)(u.slot0 + u.m0 + r) * DE + colj) = w; } } }
    }
};
struct EpiDown {
    static constexpr bool PERM = true;
    bf16* O; const float* bd; const float* roww;
    __device__ __forceinline__ void operator()(const Acc& acc, const Unit& u, int wr, int wc, int fr, int fq) const {
        const int col0 = u.pn * BM + wc * 32 + 8 * fq;
        const float* bp = bd + (size_t)u.e * D + col0;
        f32x4 bv[2][2];
#pragma unroll
        for (int bj = 0; bj < 2; ++bj)
#pragma unroll
            for (int n = 0; n < 2; ++n) bv[bj][n] = *(const f32x4*)(bp + bj * HALF + 4 * n);
#pragma unroll
        for (int ai = 0; ai < 2; ++ai)
#pragma unroll
            for (int m = 0; m < 4; ++m) { const int r = ai * HALF + wr * 64 + m * 16 + fr;
                if (u.m0 + r < u.count) { const float w8 = roww[(size_t)u.e * T + u.m0 + r]; bf16* rowp = O + (size_t)(u.slot0 + u.m0 + r) * D + col0;
#pragma unroll
                    for (int bj = 0; bj < 2; ++bj) { constexpr float isc = MOE_FP8 ? 1.0f / (F8S_ACT * F8S_W) : 1.0f;
                        const f32x4 v0 = (acc[ai][bj][m][0] * isc + bv[bj][0]) * w8, v1 = (acc[ai][bj][m][1] * isc + bv[bj][1]) * w8;
                        u32x4 w; w.x = cvt_pk_bf16(v0[0], v0[1]); w.y = cvt_pk_bf16(v0[2], v0[3]); w.z = cvt_pk_bf16(v1[0], v1[1]); w.w = cvt_pk_bf16(v1[2], v1[3]);
                        *(u32x4*)(rowp + bj * HALF) = w; } } }
    }
};

typedef int i32x4 __attribute__((ext_vector_type(4)));
typedef int i32x8 __attribute__((ext_vector_type(8)));
template <bool F8 = false, class Epi, class Sched>
__device__ __forceinline__ void gemm_phase(LAS unsigned char* lds, const char* gA, const char* gB, int K, const Sched& S, const Epi& E) {
    const int tid = threadIdx.x, wid = __builtin_amdgcn_readfirstlane(tid >> 6), lane = tid & 63, wr = wid >> 2, wc = wid & 3, fr = lane & 15, fq = lane >> 4;
    const int nt = K / BK;
    unsigned voffB[2];
#pragma unroll
    for (int i = 0; i < 2; ++i) { int R, C; stage_rc(tid * 16 + i * 8192, R, C); const int Rb = Epi::PERM ? ((R & ~31) + perm32(R & 31)) : R; voffB[i] = (unsigned)(Rb * K + C) * 2u; }
#define PG8_AOFFS(U, o0, o1) do { int t_ = tid; asm volatile("" : "+v"(t_)); _Pragma("unroll") for (int i = 0; i < 2; ++i) { int R, C; stage_rc(t_ * 16 + i * 8192, R, C); \
        o0[i] = S.a_off(U, R) + (unsigned)C * 2u; o1[i] = S.a_off(U, HALF + R) + (unsigned)C * 2u; } } while (0)
    const size_t hstep = (size_t)HALF * K * 2;
    const unsigned ldsw = (unsigned)wid * 1024u;
    const int aoff = lds_byte(wr * 64 + fr, fq * 8), boff = lds_byte(wc * 32 + fr, fq * 8);
#define PG8_SA(b, h) (((b) * 2 + (h)) * HTB)
#define PG8_SB(b, h) ((4 + (b) * 2 + (h)) * HTB)
#define PG8_STAGEB(bufoff, gbase) do { _Pragma("unroll") for (int _i = 0; _i < 2; ++_i) { unsigned _o = voffB[_i]; asm volatile("" : "+v"(_o)); \
        __builtin_amdgcn_global_load_lds((const unsigned*)((const char*)(gbase) + _o), (LAS unsigned*)(lds + (bufoff) + ldsw + _i * 8192), 16, 0, 0); } } while (0)
#define PG8_STAGEA(bufoff, voff2, kb) do { _Pragma("unroll") for (int _i = 0; _i < 2; ++_i) { unsigned _o = (voff2)[_i]; asm volatile("" : "+v"(_o)); \
        __builtin_amdgcn_global_load_lds((const unsigned*)((gA + (size_t)(kb)) + _o), (LAS unsigned*)(lds + (bufoff) + ldsw + _i * 8192), 16, 0, 0); } } while (0)
#define PG8_LD8(p) __builtin_shufflevector(*(const LAS i32x4*)(p), *(const LAS i32x4*)((p) + 1024), 0, 1, 2, 3, 4, 5, 6, 7)
#define PG8_LDA(dst, b, h) do { _Pragma("unroll") for (int m = 0; m < 4; ++m) dst[m] = PG8_LD8(lds + PG8_SA(b, h) + aoff + m * 2048); } while (0)
#define PG8_LDB(dst, b, h) do { _Pragma("unroll") for (int n = 0; n < 2; ++n) dst[n] = PG8_LD8(lds + PG8_SB(b, h) + boff + n * 2048); } while (0)
#define PG8_LO(x) __builtin_bit_cast(bf16x8, __builtin_shufflevector(x, x, 0, 1, 2, 3))
#define PG8_HI(x) __builtin_bit_cast(bf16x8, __builtin_shufflevector(x, x, 4, 5, 6, 7))
#define PG8_MMA(ai, bj, At, Bt) do { if constexpr (F8) __builtin_amdgcn_sched_barrier(0); __builtin_amdgcn_s_setprio(1); _Pragma("unroll") for (int m = 0; m < 4; ++m) _Pragma("unroll") for (int n = 0; n < 2; ++n) { \
        if constexpr (F8) asm volatile("v_mfma_scale_f32_16x16x128_f8f6f4 %0, %1, %2, %0, %3, %3 op_sel_hi:[0,0,0]" : "+v"(acc[ai][bj][m][n]) : "v"(Bt[n]), "v"(At[m]), "v"(f8scale)); \
        else { acc[ai][bj][m][n] = __builtin_amdgcn_mfma_f32_16x16x32_bf16(PG8_LO(Bt[n]), PG8_LO(At[m]), acc[ai][bj][m][n], 0, 0, 0); \
               acc[ai][bj][m][n] = __builtin_amdgcn_mfma_f32_16x16x32_bf16(PG8_HI(Bt[n]), PG8_HI(At[m]), acc[ai][bj][m][n], 0, 0, 0); } } \
        __builtin_amdgcn_s_setprio(0); if constexpr (F8) __builtin_amdgcn_sched_barrier(0); } while (0)
#define PG8_WAIT_V(n) asm volatile("s_waitcnt vmcnt(" #n ")" ::: "memory")
#define PG8_WAIT_L(n) asm volatile("s_waitcnt lgkmcnt(" #n ")" ::: "memory")
#define PG8_BAR __builtin_amdgcn_s_barrier()
#define PG8_SCHED __builtin_amdgcn_sched_barrier(0)
    Unit cur, nxt; int ui = 0;
    if (!S.next(0, cur)) return;
    Acc acc;
#pragma unroll
    for (int a = 0; a < 2; ++a)
#pragma unroll
        for (int b = 0; b < 2; ++b)
#pragma unroll
            for (int m = 0; m < 4; ++m)
#pragma unroll
                for (int n = 0; n < 2; ++n) acc[a][b][m][n] = (f32x4){0.f, 0.f, 0.f, 0.f};
    i32x8 At[4], B0[2], B1[2];
    int f8scale = 0x7F7F7F7F; asm volatile("" : "+v"(f8scale));
    unsigned cA0[2], cA1[2], nA0[2], nA1[2];
    PG8_AOFFS(cur, cA0, cA1);
    const char* cB = gB + S.b_off(cur);
    PG8_STAGEB(PG8_SB(0, 0), cB); PG8_STAGEB(PG8_SB(0, 1), cB + hstep); PG8_STAGEA(PG8_SA(0, 0), cA0, 0); PG8_STAGEA(PG8_SA(0, 1), cA1, 0);
    if (wr == 1) PG8_BAR;
    PG8_WAIT_V(2); PG8_BAR;
    PG8_STAGEB(PG8_SB(1, 0), cB + BK * 2); PG8_STAGEA(PG8_SA(1, 0), cA0, BK * 2); PG8_STAGEB(PG8_SB(1, 1), cB + hstep + BK * 2);
    PG8_WAIT_V(6); PG8_BAR;
    for (;;) {
        const bool has_next = S.next(ui + 1, nxt);
        const char* nB = cB;
        if (has_next) {
            PG8_AOFFS(nxt, nA0, nA1);
            nB = gB + S.b_off(nxt);
        } else {
#pragma unroll
            for (int i = 0; i < 2; ++i) { nA0[i] = cA0[i]; nA1[i] = cA1[i]; }
        }
#pragma nounroll
        for (int t = 0; t < nt; t += 2) {
            const bool last = (t == nt - 2);
            const unsigned k1 = (unsigned)(t + 1) * (BK * 2), k2 = last ? 0u : (unsigned)(t + 2) * (BK * 2), k3 = k2 + BK * 2;
            unsigned a20[2], a21[2];
#pragma unroll
            for (int i = 0; i < 2; ++i) { a20[i] = last ? nA0[i] : cA0[i]; a21[i] = last ? nA1[i] : cA1[i]; }
            const char* b2 = (last ? nB : cB) + k2; const char* b3 = b2 + BK * 2;
            PG8_LDB(B0, 0, 0); PG8_LDB(B1, 0, 1); PG8_SCHED; PG8_LDA(At, 0, 0); PG8_STAGEA(PG8_SA(1, 1), cA1, k1);
            PG8_WAIT_V(8); PG8_WAIT_L(0); PG8_BAR; PG8_MMA(0, 0, At, B0); PG8_MMA(0, 1, At, B1); PG8_BAR; PG8_SCHED;
            PG8_LDA(At, 0, 1); PG8_STAGEB(PG8_SB(0, 0), b2); PG8_STAGEB(PG8_SB(0, 1), b2 + hstep); PG8_STAGEA(PG8_SA(0, 0), a20, k2);
            PG8_WAIT_V(8); PG8_WAIT_L(0); PG8_BAR; PG8_MMA(1, 0, At, B0); PG8_MMA(1, 1, At, B1); PG8_BAR; PG8_SCHED;
            PG8_LDB(B0, 1, 0); PG8_LDB(B1, 1, 1); PG8_SCHED; PG8_LDA(At, 1, 0); PG8_STAGEA(PG8_SA(0, 1), a21, k2);
            PG8_WAIT_V(8); PG8_WAIT_L(0); PG8_BAR; PG8_MMA(0, 0, At, B0); PG8_MMA(0, 1, At, B1); PG8_BAR; PG8_SCHED;
            PG8_LDA(At, 1, 1); PG8_STAGEB(PG8_SB(1, 0), b3); PG8_STAGEB(PG8_SB(1, 1), b3 + hstep); PG8_STAGEA(PG8_SA(1, 0), a20, k3);
            PG8_WAIT_V(8); PG8_WAIT_L(0); PG8_BAR; PG8_MMA(1, 0, At, B0); PG8_MMA(1, 1, At, B1); PG8_BAR; PG8_SCHED;
        }
        if constexpr (F8) asm volatile("s_nop 15\n\ts_nop 15" ::: "memory");
        if (wr == 0) PG8_BAR;
        int t_e = threadIdx.x; asm volatile("" : "+v"(t_e));
        const int fr_e = t_e & 15, fq_e = (t_e >> 4) & 3;
#pragma unroll
        for (int a = 0; a < 2; ++a)
#pragma unroll
            for (int b = 0; b < 2; ++b)
#pragma unroll
                for (int m = 0; m < 4; ++m)
#pragma unroll
                    for (int n = 0; n < 2; ++n) asm volatile("" : "+v"(acc[a][b][m][n]));
        E(acc, cur, wr, wc, fr_e, fq_e);
        if (!has_next) break;
#pragma unroll
        for (int a = 0; a < 2; ++a)
#pragma unroll
            for (int b = 0; b < 2; ++b)
#pragma unroll
                for (int m = 0; m < 4; ++m)
#pragma unroll
                    for (int n = 0; n < 2; ++n) acc[a][b][m][n] = (f32x4){0.f, 0.f, 0.f, 0.f};
        cur = nxt; cB = nB; ++ui;
#pragma unroll
        for (int i = 0; i < 2; ++i) { cA0[i] = nA0[i]; cA1[i] = nA1[i]; }
        if (wr == 1) PG8_BAR;
    }
    PG8_WAIT_V(0);
    PG8_BAR;
#undef PG8_SA
#undef PG8_SB
#undef PG8_STAGEA
#undef PG8_AOFFS
#undef PG8_STAGEB
#undef PG8_LDA
#undef PG8_LDB
#undef PG8_MMA
#undef PG8_LD8
#undef PG8_LO
#undef PG8_HI
#undef PG8_WAIT_V
#undef PG8_WAIT_L
#undef PG8_BAR
#undef PG8_SCHED
}
}


typedef float f32x16 __attribute__((ext_vector_type(16)));
typedef short bf16x4 __attribute__((ext_vector_type(4)));
typedef unsigned u32x2 __attribute__((ext_vector_type(2)));
typedef float f32x2_t __attribute__((ext_vector_type(2)));
typedef __bf16 bf16x2_t __attribute__((ext_vector_type(2)));
__device__ __forceinline__ unsigned cvtpk(float lo, float hi) { const f32x2_t v = {lo, hi}; const bf16x2_t b = __builtin_convertvector(v, bf16x2_t); return __builtin_bit_cast(unsigned, b); }
template <int S8> __device__ __forceinline__ bf16x8 pack8(const f32x16& X) {
    u32x4 w; w.x = cvtpk(X[8 * S8 + 0], X[8 * S8 + 1]); w.y = cvtpk(X[8 * S8 + 2], X[8 * S8 + 3]); w.z = cvtpk(X[8 * S8 + 4], X[8 * S8 + 5]); w.w = cvtpk(X[8 * S8 + 6], X[8 * S8 + 7]);
    return __builtin_bit_cast(bf16x8, w);
}
__device__ __forceinline__ bf16x8 lds_b128(const LAS unsigned char* p) { return *(const LAS bf16x8*)p; }
__device__ __forceinline__ bf16x8 lds_2xb64(const LAS unsigned char* p) {
    const bf16x4 a = *(const LAS bf16x4*)p, b = *(const LAS bf16x4*)(p + 16);
    return __builtin_shufflevector(a, b, 0, 1, 2, 3, 4, 5, 6, 7);
}
template <int CTRL, int ROWMASK> __device__ __forceinline__ float dpp_f(float v) {
    return __builtin_bit_cast(float, __builtin_amdgcn_update_dpp(0, __builtin_bit_cast(int, v), CTRL, ROWMASK, 0xF, true)); }
__device__ __forceinline__ float wave_incl_scan(float v) {
    v += dpp_f<0x111, 0xF>(v); v += dpp_f<0x112, 0xF>(v); v += dpp_f<0x114, 0xF>(v); v += dpp_f<0x118, 0xF>(v);
    v += dpp_f<0x142, 0xA>(v); v += dpp_f<0x143, 0xC>(v); return v; }
__device__ __forceinline__ float fast_log_sigmoid(float x) { return fminf(x, 0.0f) - __logf(1.0f + __expf(-fabsf(x))); }

constexpr int GP = 144;
constexpr int GL_QD = 0, GL_KI = GL_QD + 64 * GP, GL_KET = GL_KI + 64 * GP, GL_VT = GL_KET + 64 * GP, GL_DEC = GL_VT + 128 * GP, GL_SSP = GL_DEC + 256, GL_OT = GL_SSP + 1024;
constexpr int OTP = 132;
constexpr int GL_END = GL_OT + 64 * OTP * 4;
static_assert(GL_END <= RING_BYTES && (GL_OT % 16) == 0 && (GL_DEC % 16) == 0, "gla lds");

__device__ __forceinline__ void gla_item(const Ptrs& P, LAS unsigned char* lds, int bh) {
    const int tid = threadIdx.x, lane = tid & 63, w = __builtin_amdgcn_readfirstlane(tid >> 6), l31 = lane & 31, hh = lane >> 5;
    const int b = bh >> 2, h = bh & 3, cr = w >> 2, vc = w & 3;
    const bf16* PROJ = (const bf16*)(P.ws + WS_PROJ); bf16* MIX = (bf16*)(P.ws + WS_MIX);
    const size_t tok0 = (size_t)b * SEQ;
    const bf16* pq = PROJ + (tok0 + lane) * NPROJ + PC_Q + h * 64 + 8 * w;
    const bf16* pk = PROJ + (tok0 + lane) * NPROJ + PC_K + h * 64 + 8 * w;
    const bf16* pg = PROJ + (tok0 + lane) * NPROJ + PC_GK + h * 64 + 8 * w;
    const bf16* pv = PROJ + (tok0 + lane) * NPROJ + PC_V + h * 128 + 16 * w;
    const int oc = tid >> 3, ov = (tid & 7) * 16;
    const bf16* pgate = PROJ + (tok0 + oc) * NPROJ + PC_G + h * 128 + ov;
    float bgk[8], nw[16];
#pragma unroll
    for (int j = 0; j < 8; ++j) bgk[j] = P.b_gk[h * 64 + 8 * w + j];
#pragma unroll
    for (int j = 0; j < 16; ++j) nw[j] = P.gla_norm_w[ov + j];
    f32x16 S0, S1;
#pragma unroll
    for (int r = 0; r < 16; ++r) { S0[r] = 0.f; S1[r] = 0.f; }
    v4u nq = *(const v4u*)pq, nk = *(const v4u*)pk, ng = *(const v4u*)pg, nv0 = *(const v4u*)pv, nv1 = *(const v4u*)(pv + 8);
    for (int n = 0; n < SEQ / 64; ++n) {
        const v4u cq = nq, ck = nk, cg = ng, cv0 = nv0, cv1 = nv1;
        const size_t adv = (size_t)(n + 1 < SEQ / 64 ? (n + 1) * 64 : n * 64) * NPROJ;
        nq = *(const v4u*)(pq + adv); nk = *(const v4u*)(pk + adv); ng = *(const v4u*)(pg + adv); nv0 = *(const v4u*)(pv + adv); nv1 = *(const v4u*)(pv + adv + 8);
        const size_t gadv = (size_t)n * 64 * NPROJ;
        const v4u gate0 = *(const v4u*)(pgate + gadv), gate1 = *(const v4u*)(pgate + gadv + 8);
        {
            const unsigned qw[4] = {cq.x, cq.y, cq.z, cq.w}, kw[4] = {ck.x, ck.y, ck.z, ck.w}, gw[4] = {cg.x, cg.y, cg.z, cg.w};
            float bb[8];
#pragma unroll
            for (int j = 0; j < 8; ++j) { const float x = bf2f((gw[j >> 1] >> (16 * (j & 1))) & 0xffffu) + bgk[j]; bb[j] = fast_log_sigmoid(x) * (1.0f / 16.0f); }
#pragma unroll
            for (int j = 0; j < 8; ++j) bb[j] = wave_incl_scan(bb[j]);
            float qd[8], ki[8], ke[8];
#pragma unroll
            for (int j = 0; j < 8; ++j) { const float bl = __builtin_bit_cast(float, __builtin_amdgcn_readlane(__builtin_bit_cast(int, bb[j]), 63));
                const float qv = bf2f((qw[j >> 1] >> (16 * (j & 1))) & 0xffffu), kv = bf2f((kw[j >> 1] >> (16 * (j & 1))) & 0xffffu);
                qd[j] = qv * 0.125f * __expf(bb[j]); ki[j] = kv * __expf(-bb[j]); ke[j] = kv * __expf(bl - bb[j]);
                if (lane == 63) *(LAS float*)(lds + GL_DEC + (8 * w + j) * 4) = __expf(bl); }
            u32x4 t; t.x = cvtpk(qd[0], qd[1]); t.y = cvtpk(qd[2], qd[3]); t.z = cvtpk(qd[4], qd[5]); t.w = cvtpk(qd[6], qd[7]);
            *(LAS u32x4*)(lds + GL_QD + lane * GP + 16 * w) = t;
            t.x = cvtpk(ki[0], ki[1]); t.y = cvtpk(ki[2], ki[3]); t.z = cvtpk(ki[4], ki[5]); t.w = cvtpk(ki[6], ki[7]);
            *(LAS u32x4*)(lds + GL_KI + lane * GP + 16 * w) = t;
#pragma unroll
            for (int j = 0; j < 8; ++j) *(LAS unsigned short*)(lds + GL_KET + (8 * w + j) * GP + lane * 2) = (unsigned short)f2bf(ke[j]);
            const unsigned vw[8] = {cv0.x, cv0.y, cv0.z, cv0.w, cv1.x, cv1.y, cv1.z, cv1.w};
#pragma unroll
            for (int j = 0; j < 16; ++j) *(LAS unsigned short*)(lds + GL_VT + (16 * w + j) * GP + lane * 2) = (unsigned short)((vw[j >> 1] >> (16 * (j & 1))) & 0xffffu);
        }
        __syncthreads();
        f32x16 O;
#pragma unroll
        for (int r = 0; r < 16; ++r) O[r] = 0.f;
        {
            const LAS unsigned char* qrow = lds + GL_QD + (cr * 32 + l31) * GP + 8 * hh;
            O = __builtin_amdgcn_mfma_f32_32x32x16_bf16(pack8<0>(S0), lds_2xb64(qrow + 0), O, 0, 0, 0);
            O = __builtin_amdgcn_mfma_f32_32x32x16_bf16(pack8<1>(S0), lds_2xb64(qrow + 32), O, 0, 0, 0);
            O = __builtin_amdgcn_mfma_f32_32x32x16_bf16(pack8<0>(S1), lds_2xb64(qrow + 64), O, 0, 0, 0);
            O = __builtin_amdgcn_mfma_f32_32x32x16_bf16(pack8<1>(S1), lds_2xb64(qrow + 96), O, 0, 0, 0);
        }
        {
            const LAS unsigned char* qb = lds + GL_QD + (cr * 32 + l31) * GP + 16 * hh;
            const LAS unsigned char* vrow = lds + GL_VT + (vc * 32 + l31) * GP + 8 * hh;
            f32x16 X;
#pragma unroll
            for (int r = 0; r < 16; ++r) X[r] = 0.f;
            if (cr == 1) {
                const LAS unsigned char* ka = lds + GL_KI + l31 * GP + 16 * hh;
#pragma unroll
                for (int kk = 0; kk < 4; ++kk) X = __builtin_amdgcn_mfma_f32_32x32x16_bf16(lds_b128(ka + 32 * kk), lds_b128(qb + 32 * kk), X, 0, 0, 0);
                O = __builtin_amdgcn_mfma_f32_32x32x16_bf16(lds_2xb64(vrow + 0), pack8<0>(X), O, 0, 0, 0);
                O = __builtin_amdgcn_mfma_f32_32x32x16_bf16(lds_2xb64(vrow + 32), pack8<1>(X), O, 0, 0, 0);
#pragma unroll
                for (int r = 0; r < 16; ++r) X[r] = 0.f;
            }
            {
                const LAS unsigned char* ka = lds + GL_KI + (cr * 32 + l31) * GP + 16 * hh;
#pragma unroll
                for (int kk = 0; kk < 4; ++kk) X = __builtin_amdgcn_mfma_f32_32x32x16_bf16(lds_b128(ka + 32 * kk), lds_b128(qb + 32 * kk), X, 0, 0, 0);
#pragma unroll
                for (int r = 0; r < 16; ++r) { const int srow = (r & 3) + 8 * (r >> 2) + 4 * hh; X[r] = (srow <= l31) ? X[r] : 0.f; }
                O = __builtin_amdgcn_mfma_f32_32x32x16_bf16(lds_2xb64(vrow + cr * 64 + 0), pack8<0>(X), O, 0, 0, 0);
                O = __builtin_amdgcn_mfma_f32_32x32x16_bf16(lds_2xb64(vrow + cr * 64 + 32), pack8<1>(X), O, 0, 0, 0);
            }
        }
        {
            const LAS float* dec = (const LAS float*)(lds + GL_DEC);
#pragma unroll
            for (int g4 = 0; g4 < 4; ++g4) { const f32x4 d0 = *(const LAS f32x4*)(dec + 8 * g4 + 4 * hh), d1 = *(const LAS f32x4*)(dec + 32 + 8 * g4 + 4 * hh);
#pragma unroll
                for (int i = 0; i < 4; ++i) { S0[4 * g4 + i] *= d0[i]; S1[4 * g4 + i] *= d1[i]; } }
            const LAS unsigned char* ka0 = lds + GL_KET + l31 * GP + 16 * hh;
            const LAS unsigned char* ka1 = lds + GL_KET + (32 + l31) * GP + 16 * hh;
            const LAS unsigned char* vb = lds + GL_VT + (vc * 32 + l31) * GP + 16 * hh;
#pragma unroll
            for (int ss = 0; ss < 4; ++ss) { const bf16x8 bfr = lds_b128(vb + 32 * ss);
                S0 = __builtin_amdgcn_mfma_f32_32x32x16_bf16(lds_b128(ka0 + 32 * ss), bfr, S0, 0, 0, 0);
                S1 = __builtin_amdgcn_mfma_f32_32x32x16_bf16(lds_b128(ka1 + 32 * ss), bfr, S1, 0, 0, 0); }
        }
        {
            float ssq = 0.f;
#pragma unroll
            for (int r = 0; r < 16; ++r) ssq += O[r] * O[r];
            ssq += __shfl_xor(ssq, 32);
            if (hh == 0) *(LAS float*)(lds + GL_SSP + (vc * 64 + cr * 32 + l31) * 4) = ssq;
            LAS float* ot = (LAS float*)(lds + GL_OT) + (cr * 32 + l31) * OTP + vc * 32 + 4 * hh;
#pragma unroll
            for (int g4 = 0; g4 < 4; ++g4) *(LAS f32x4*)(ot + 8 * g4) = (f32x4){O[4 * g4], O[4 * g4 + 1], O[4 * g4 + 2], O[4 * g4 + 3]};
        }
        __syncthreads();
        {
            const LAS float* ssp = (const LAS float*)(lds + GL_SSP) + oc;
            const float tot = (ssp[0] + ssp[64]) + (ssp[128] + ssp[192]);
            const float rstd = 1.0f / sqrtf(tot * (1.0f / 128.0f) + EPS);
            const LAS float* ot = (const LAS float*)(lds + GL_OT) + oc * OTP + ov;
            const unsigned gw[8] = {gate0.x, gate0.y, gate0.z, gate0.w, gate1.x, gate1.y, gate1.z, gate1.w};
            float y[16];
#pragma unroll
            for (int q4 = 0; q4 < 4; ++q4) { const f32x4 o4 = *(const LAS f32x4*)(ot + 4 * q4);
#pragma unroll
                for (int i = 0; i < 4; ++i) { const int j = 4 * q4 + i; const float gv = bf2f((gw[j >> 1] >> (16 * (j & 1))) & 0xffffu); y[j] = o4[i] * rstd * nw[j] * (gv / (1.0f + __expf(-gv))); } }
            bf16* orow = MIX + (tok0 + (size_t)n * 64 + oc) * D + h * 128 + ov;
            u32x4 t; t.x = cvtpk(y[0], y[1]); t.y = cvtpk(y[2], y[3]); t.z = cvtpk(y[4], y[5]); t.w = cvtpk(y[6], y[7]); *(u32x4*)orow = t;
            t.x = cvtpk(y[8], y[9]); t.y = cvtpk(y[10], y[11]); t.z = cvtpk(y[12], y[13]); t.w = cvtpk(y[14], y[15]); *(u32x4*)(orow + 8) = t;
        }
    }
    __syncthreads();
}

constexpr int SP = 272;
constexpr int SG_W = 0, SG_VN = SG_W + 128 * SP, SG_OT = SG_VN + 128 * SP, SG_ST = SG_OT + 128 * SP, SG_END = SG_ST + 1024;
static_assert(SG_END <= RING_BYTES, "sgu lds");
__device__ __forceinline__ void sgu_item(const Ptrs& P, LAS unsigned char* lds, int bn) {
    const int tid = threadIdx.x, lane = tid & 63, w = __builtin_amdgcn_readfirstlane(tid >> 6), l31 = lane & 31, hh = lane >> 5;
    const bf16* PROJ = (const bf16*)(P.ws + WS_PROJ); bf16* MIX = (bf16*)(P.ws + WS_MIX); const bf16* Wsp = (const bf16*)(P.ws + WS_WSP);
    const size_t tok0 = (size_t)bn * 128;
    LAS float* st = (LAS float*)(lds + SG_ST);
#pragma unroll 4
    for (int rr = 0; rr < 16; ++rr) { const int row = 16 * w + rr;
        const v4u raw = *(const v4u*)(PROJ + (tok0 + row) * NPROJ + PC_VS + lane * 8); const unsigned rw[4] = {raw.x, raw.y, raw.z, raw.w};
        float s = 0.f, q = 0.f;
#pragma unroll
        for (int j = 0; j < 8; ++j) { const float g = gelu_tanh(bf2f((rw[j >> 1] >> (16 * (j & 1))) & 0xffffu)); s += g; q += g * g; }
        s = wave_sum(s); q = wave_sum(q);
        const float mu = s * (1.0f / 512.0f), var = fmaxf(q * (1.0f / 512.0f) - mu * mu, 0.f);
        if (lane == 0) { st[row] = mu; st[128 + row] = 1.0f / sqrtf(var + EPS); } }
    __syncthreads();
    for (int g = 0; g < 4; ++g) {
#pragma unroll
        for (int ps = 0; ps < 4; ++ps) { const int idx = ps * NTHR + tid, row = idx >> 4, c16 = idx & 15;
            *(LAS v4u*)(lds + SG_W + row * SP + c16 * 16) = *(const v4u*)(Wsp + ((size_t)g * 128 + row) * 128 + c16 * 8); }
        { const int s = tid & 127, c0 = (tid >> 7) * 32; const float mu = st[s], rs = st[128 + s];
#pragma unroll
          for (int q4 = 0; q4 < 4; ++q4) { const int cb = c0 + q4 * 8;
              const v4u raw = *(const v4u*)(PROJ + (tok0 + s) * NPROJ + PC_VS + g * 128 + cb); const unsigned rw[4] = {raw.x, raw.y, raw.z, raw.w};
              const f32x4 lw0 = *(const f32x4*)(P.sg_ln_w + g * 128 + cb), lw1 = *(const f32x4*)(P.sg_ln_w + g * 128 + cb + 4), lb0 = *(const f32x4*)(P.sg_ln_b + g * 128 + cb), lb1 = *(const f32x4*)(P.sg_ln_b + g * 128 + cb + 4);
#pragma unroll
              for (int j = 0; j < 8; ++j) { const float gv = gelu_tanh(bf2f((rw[j >> 1] >> (16 * (j & 1))) & 0xffffu));
                  const float vn = (gv - mu) * rs * (j < 4 ? lw0[j & 3] : lw1[j & 3]) + (j < 4 ? lb0[j & 3] : lb1[j & 3]);
                  *(LAS unsigned short*)(lds + SG_VN + (cb + j) * SP + s * 2) = (unsigned short)f2bf(vn); } } }
        __syncthreads();
        { const int ct = w >> 1;
          const LAS unsigned char* arow = lds + SG_VN + (ct * 32 + l31) * SP + 16 * hh;
#pragma unroll
          for (int ti = 0; ti < 2; ++ti) { const int tt = (w & 1) * 2 + ti;
              const LAS unsigned char* brow = lds + SG_W + (tt * 32 + l31) * SP + 16 * hh;
              f32x16 acc;
#pragma unroll
              for (int r = 0; r < 16; ++r) acc[r] = 0.f;
              for (int ks = 0; ks < 2 * (tt + 1); ++ks) acc = __builtin_amdgcn_mfma_f32_32x32x16_bf16(lds_b128(arow + 32 * ks), lds_b128(brow + 32 * ks), acc, 0, 0, 0);
              const float bs = P.b_spatial[g * 128 + tt * 32 + l31];
              LAS unsigned char* orow = lds + SG_OT + (tt * 32 + l31) * SP + (ct * 32 + 4 * hh) * 2;
#pragma unroll
              for (int g4 = 0; g4 < 4; ++g4) { u32x2 pk; pk.x = cvtpk(acc[4 * g4] + bs, acc[4 * g4 + 1] + bs); pk.y = cvtpk(acc[4 * g4 + 2] + bs, acc[4 * g4 + 3] + bs); *(LAS u32x2*)(orow + 16 * g4) = pk; } } }
        __syncthreads();
        { const int t = tid >> 2, cg = (tid & 3) * 32;
#pragma unroll
          for (int q4 = 0; q4 < 4; ++q4) { const v4u mx = *(const LAS v4u*)(lds + SG_OT + t * SP + (cg + q4 * 8) * 2);
              const v4u ur = *(const v4u*)(PROJ + (tok0 + t) * NPROJ + PC_U + g * 128 + cg + q4 * 8);
              const unsigned mw[4] = {mx.x, mx.y, mx.z, mx.w}, uw[4] = {ur.x, ur.y, ur.z, ur.w}; unsigned ow[4];
#pragma unroll
              for (int j = 0; j < 4; ++j) { const float a0 = gelu_tanh(bf2f(uw[j] & 0xffffu)) * bf2f(mw[j] & 0xffffu), a1 = gelu_tanh(bf2f(uw[j] >> 16)) * bf2f(mw[j] >> 16); ow[j] = cvtpk(a0, a1); }
              *(v4u*)(MIX + (tok0 + t) * D + 512 + g * 128 + cg + q4 * 8) = (v4u){ow[0], ow[1], ow[2], ow[3]}; } }
    }
    __syncthreads();
}
__device__ __forceinline__ void moe_weight_items(const Ptrs& P, unsigned char* lds_generic, int gw, int ngw) {
    const int lane = threadIdx.x & 63, wave = __builtin_amdgcn_readfirstlane(threadIdx.x >> 6);
    float* scr = (float*)(lds_generic + wave * 16384);
    for (int it = gw; it < IT_GU + IT_DN; it += ngw) p0_weight_item(P, IT_IN + IT_OUT + it, scr, lane);
}
__device__ __forceinline__ void ph2_mix_fast(const Ptrs& P, LAS unsigned char* lds, unsigned char* lds_generic, int G) {
    const int bid = blockIdx.x, wave = __builtin_amdgcn_readfirstlane(threadIdx.x >> 6);
    if (G >= 128) {
        if (bid < 64) { for (int rep = 0; rep < ((PROBE_REPEAT == 21) ? 2 : 1); ++rep) gla_item(P, lds, bid); }
        else { for (int rep = 0; rep < ((PROBE_REPEAT == 20) ? 2 : 1); ++rep) for (int it = bid - 64; it < NB * 16; it += G - 64) sgu_item(P, lds, it);
               for (int rep = 0; rep < ((PROBE_REPEAT == 22) ? 2 : 1); ++rep) moe_weight_items(P, lds_generic, (bid - 64) * NWAVES + wave, (G - 64) * NWAVES); }
    } else {
        for (int it = bid; it < 64; it += G) gla_item(P, lds, it);
        for (int it = bid; it < NB * 16; it += G) sgu_item(P, lds, it);
        moe_weight_items(P, lds_generic, bid * NWAVES + wave, G * NWAVES);
    }
}

constexpr size_t WS_WR2 = WS_WSP + 256 * 1024;
__device__ __forceinline__ void p0_wr2(const Ptrs& P, int gtid, int gthreads) {
    f32x4* WR2 = (f32x4*)(P.ws + WS_WR2);
    for (int idx = gtid; idx < 64 * 2 * 64; idx += gthreads) { const int j = idx >> 7, tl = (idx >> 6) & 1, q = (idx >> 4) & 3, e = tl * 16 + (idx & 15); f32x4 o;
#pragma unroll
        for (int i = 0; i < 4; ++i) { const int k = 16 * j + 4 * q + i; o[i] = P.w_router[(size_t)k * NE + e] * P.norm_ffn_w[k]; }
        WR2[idx] = o; }
}
__device__ __forceinline__ bool rt_better(float va, int ia, float vb, int ib) { return va > vb || (va == vb && ia < ib); }
__device__ __forceinline__ void ph4_router_fast(const Ptrs& P, LAS unsigned char* lds, int G) {
    const int tid = threadIdx.x, lane = tid & 63, wave = __builtin_amdgcn_readfirstlane(tid >> 6), tk = lane & 15, q = lane >> 4;
    unsigned* ctl = (unsigned*)(P.ws + WS_CTL);
    LAS unsigned* lcnt = (LAS unsigned*)lds; LAS unsigned* lbase = lcnt + 32;
    const f32x4* WR2 = (const f32x4*)(P.ws + WS_WR2);
    const int NGRP = T / 16, rounds = (NGRP + G * NWAVES - 1) / (G * NWAVES);
    for (int rd = 0; rd < rounds; ++rd) {
        if (tid < 32) lcnt[tid] = 0u;
        __syncthreads();
        const int grp = (rd * G + (int)blockIdx.x) * NWAVES + wave; const bool act = grp < NGRP;
        const int m0 = (act ? grp : 0) * 16;
        const float* xrow = (const float*)(P.ws + WS_X1) + (size_t)(m0 + tk) * D + 4 * q;
        f32x4 d0 = {0.f, 0.f, 0.f, 0.f}, d1 = {0.f, 0.f, 0.f, 0.f}; float ssq = 0.f;
#pragma unroll 4
        for (int j = 0; j < 64; ++j) { const f32x4 xv = *(const f32x4*)(xrow + 16 * j); const f32x4 w0 = WR2[(j * 2 + 0) * 64 + lane], w1 = WR2[(j * 2 + 1) * 64 + lane];
            ssq += (xv[0] * xv[0] + xv[1] * xv[1]) + (xv[2] * xv[2] + xv[3] * xv[3]);
#pragma unroll
            for (int i = 0; i < 4; ++i) { d0 = __builtin_amdgcn_mfma_f32_16x16x4f32(w0[i], xv[i], d0, 0, 0, 0); d1 = __builtin_amdgcn_mfma_f32_16x16x4f32(w1[i], xv[i], d1, 0, 0, 0); } }
        ssq += __shfl_xor(ssq, 16); ssq += __shfl_xor(ssq, 32);
        const float rstd = 1.0f / sqrtf(ssq * (1.f / D) + EPS);
        float cv[8]; int ci[8];
#pragma unroll
        for (int r = 0; r < 4; ++r) { cv[r] = d0[r] * rstd + P.b_router[4 * q + r]; ci[r] = 4 * q + r; cv[4 + r] = d1[r] * rstd + P.b_router[16 + 4 * q + r]; ci[4 + r] = 16 + 4 * q + r; }
        float sv[4]; int si[4];
#pragma unroll
        for (int r = 0; r < 4; ++r) { float bv = cv[0]; int bi = ci[0];
#pragma unroll
            for (int c = 1; c < 8; ++c) if (rt_better(cv[c], ci[c], bv, bi)) { bv = cv[c]; bi = ci[c]; }
            sv[r] = bv; si[r] = bi;
#pragma unroll
            for (int c = 0; c < 8; ++c) if (ci[c] == bi) cv[c] = -3.0e38f; }
#pragma unroll
        for (int off = 16; off <= 32; off <<= 1) {
            float ov[4]; int oi[4];
#pragma unroll
            for (int r = 0; r < 4; ++r) { ov[r] = __shfl_xor(sv[r], off); oi[r] = __shfl_xor(si[r], off); }
            float mv[8]; int mi[8];
#pragma unroll
            for (int r = 0; r < 4; ++r) { mv[r] = sv[r]; mi[r] = si[r]; mv[4 + r] = ov[r]; mi[4 + r] = oi[r]; }
#pragma unroll
            for (int r = 0; r < 4; ++r) { float bv = mv[0]; int bi = mi[0];
#pragma unroll
                for (int c = 1; c < 8; ++c) if (rt_better(mv[c], mi[c], bv, bi)) { bv = mv[c]; bi = mi[c]; }
                sv[r] = bv; si[r] = bi;
#pragma unroll
                for (int c = 0; c < 8; ++c) if (mi[c] == bi) mv[c] = -3.0e38f; }
        }
        float pw[4], den = 0.f;
#pragma unroll
        for (int r = 0; r < 4; ++r) { pw[r] = __expf(sv[r] - sv[0]); den += pw[r]; }
        int ee = si[0]; float ww = pw[0];
#pragma unroll
        for (int r = 1; r < 4; ++r) if (q == r) { ee = si[r]; ww = pw[r]; }
        ww /= den;
        unsigned lr = 0u;
        if (act) lr = __hip_atomic_fetch_add(lcnt + ee, 1u, __ATOMIC_RELAXED, __HIP_MEMORY_SCOPE_WORKGROUP);
        __syncthreads();
        if (tid < 32) lbase[tid] = __hip_atomic_fetch_add(ctl + CW_COUNTS + tid, lcnt[tid], RLX_AGENT);
        __syncthreads();
        if (act) { const unsigned rank = lbase[ee] + lr; const int m = m0 + tk;
            ((int*)(P.ws + WS_ROUTE + RT_ROWTOK))[(size_t)ee * T + rank] = m;
            ((float*)(P.ws + WS_ROUTE + RT_ROWW))[(size_t)ee * T + rank] = ww;
            ((int*)(P.ws + WS_ROUTE + RT_TOKSLOT))[(size_t)m * 4 + q] = (ee << 16) | (int)rank;
            bf16* H2 = (bf16*)(P.ws + WS_H);
            for (int tt = 0; tt < 16; ++tt) { const float rs = __shfl(rstd, tt); const f32x4* xr = (const f32x4*)((const float*)(P.ws + WS_X1) + (size_t)(m0 + tt) * D);
#pragma unroll
                for (int j = 0; j < 4; ++j) { const f32x4 v = xr[lane + 64 * j], nwv = ((const f32x4*)P.norm_ffn_w)[lane + 64 * j];
                    if (MOE_FP8) ((unsigned*)((unsigned char*)H2 + (size_t)(m0 + tt) * D))[lane + 64 * j] = pk4_fp8(v[0] * rs * nwv[0] * F8S_H, v[1] * rs * nwv[1] * F8S_H, v[2] * rs * nwv[2] * F8S_H, v[3] * rs * nwv[3] * F8S_H);
                    else ((uint2*)(H2 + (size_t)(m0 + tt) * D))[lane + 64 * j] = make_uint2(cvtpk(v[0] * rs * nwv[0], v[1] * rs * nwv[1]), cvtpk(v[2] * rs * nwv[2], v[3] * rs * nwv[3])); } } }
        __syncthreads();
    }
}

struct Args { Ptrs P; int ph_lo, ph_hi, li, pad; };

__device__ __forceinline__ void ph0_prep(const Ptrs& P, unsigned char* lds_generic, int vcu, int G) {
    const int tid = threadIdx.x, lane = tid & 63, wave = __builtin_amdgcn_readfirstlane(tid >> 6);
    float* scr = (float*)(lds_generic + wave * 16384);
    const int gw = vcu * NWAVES + wave, NGW = G * NWAVES;
    for (int it = gw; it < IT_IN + IT_OUT; it += NGW) p0_weight_item(P, it, scr, lane);
    bf16* Wsp = (bf16*)(P.ws + WS_WSP);
    for (int i = blockIdx.x * NTHR + tid; i < 4 * 128 * 128; i += G * NTHR) { const int t = (i >> 7) & 127, s = i & 127; Wsp[i] = (bf16)f2bf(s <= t ? P.w_spatial[i] : 0.f); }
    p0_wr2(P, blockIdx.x * NTHR + tid, G * NTHR);
    bf16* H = (bf16*)(P.ws + WS_H);
    for (int m = gw; m < T; m += NGW) rms_row_to_bf16(P.x + (size_t)m * D, P.norm_mix_w, H + (size_t)m * D, lane);
}
__device__ __forceinline__ void moe_tables(const Ptrs& P, LAS int* tab) {
    const unsigned* ctl = (const unsigned*)(P.ws + WS_CTL);
    if (threadIdx.x < NE) tab[66 + threadIdx.x] = (int)__hip_atomic_load(ctl + CW_COUNTS + threadIdx.x, RLX_AGENT);
    __syncthreads();
    if (threadIdx.x == 0) { int a = 0; for (int e = 0; e < NE; ++e) { tab[e] = a; tab[33 + e] = a * MT; a += (tab[66 + e] + MT - 1) / MT; } tab[NE] = a; tab[33 + NE] = a * MT; }
    __syncthreads();
}
__device__ __forceinline__ void ph7_final(const Ptrs& P, const LAS int* tab, int G) {
    const int tid = threadIdx.x, lane = tid & 63, wave = tid >> 6;
    const bf16* Y = (const bf16*)(P.ws + WS_YBUF);
    for (int m = blockIdx.x * NWAVES + wave; m < T; m += G * NWAVES) {
        const float* X1 = (const float*)(P.ws + WS_X1) + (size_t)m * D;
        const int* ts = (const int*)(P.ws + WS_ROUTE + RT_TOKSLOT) + (size_t)m * 4;
        f32x4 v[4];
#pragma unroll
        for (int j = 0; j < 4; ++j) v[j] = ((const f32x4*)X1)[lane + 64 * j];
#pragma unroll
        for (int r = 0; r < 4; ++r) { const int pk = ts[r]; const size_t slot = (size_t)tab[33 + (pk >> 16)] + (pk & 0xffff);
#pragma unroll
            for (int j = 0; j < 4; ++j) { const uint2 y = ((const uint2*)(Y + slot * D))[lane + 64 * j];
                v[j].x += bf2f(y.x & 0xffffu); v[j].y += bf2f(y.x >> 16); v[j].z += bf2f(y.y & 0xffffu); v[j].w += bf2f(y.y >> 16); } }
        float s = 0.f;
#pragma unroll
        for (int j = 0; j < 4; ++j) s += (v[j].x * v[j].x + v[j].y * v[j].y) + (v[j].z * v[j].z + v[j].w * v[j].w);
        const float rstd = 1.0f / sqrtf(wave_sum(s) * (1.f / D) + EPS);
#pragma unroll
        for (int j = 0; j < 4; ++j) { const f32x4 ww = ((const f32x4*)P.norm_final_w)[lane + 64 * j];
            ((f32x4*)(P.out + (size_t)m * D))[lane + 64 * j] = (f32x4){v[j].x * rstd * ww.x, v[j].y * rstd * ww.y, v[j].z * rstd * ww.z, v[j].w * rstd * ww.w}; }
    }
}

constexpr int NPHASE = 8;
__global__ void __launch_bounds__(NTHR, 2) mk_fwd(Args args) {
    extern __shared__ __attribute__((aligned(16))) unsigned char lds_raw[];
    LAS unsigned char* lds = (LAS unsigned char*)lds_raw;
    const Ptrs& P = args.P;
    const int tid = threadIdx.x, G = gridDim.x;
    const int vcu = (G % 8 == 0) ? ((int)blockIdx.x % 8) * (G / 8) + (int)blockIdx.x / 8 : (int)blockIdx.x;
    volatile LAS unsigned* MISC = (volatile LAS unsigned*)(lds + MISC_OFF);
    LAS int* tab = (LAS int*)(lds + TAB_OFF);
    if (tid < 64) MISC[tid] = 0u;
    __syncthreads();
    unsigned* ctl = (unsigned*)(P.ws + WS_CTL);
    XcdBarrier bar = xcd_barrier_post(ctl + CW_BAR + args.li * XCD_BAR_WORDS, MISC + 8);
    const int lo = args.ph_lo, hi = args.ph_hi;
#define IN(k) (lo <= (k) && (k) < hi)
#define NREP(k) ((PROBE_REPEAT == (k)) ? 2 : 1)
#define PH(k, ...) if (IN(k)) { for (int rep = 0; rep < NREP(k); ++rep) { __VA_ARGS__; if (rep + 1 < NREP(k) || IN((k) + 1)) xcd_barrier(bar); } }
    PH(0, ph0_prep(P, lds_raw, vcu, G));
    PH(1, { pg8::DenseSched S; S.init(T, NPROJ, D, G, (int)blockIdx.x); pg8::EpiProj E{(bf16*)(P.ws + WS_PROJ)};
            pg8::gemm_phase(lds, (const char*)(P.ws + WS_H), (const char*)(P.ws + WS_WIN), D, S, E); });
    PH(2, ph2_mix_fast(P, lds, lds_raw, G));
    PH(3, { pg8::DenseSched S; S.init(T, D, D, G, (int)blockIdx.x); pg8::EpiX1 E{P.x, (float*)(P.ws + WS_X1)};
            pg8::gemm_phase(lds, (const char*)(P.ws + WS_MIX), (const char*)(P.ws + WS_WOUT), D, S, E); });
    PH(4, ph4_router_fast(P, lds, G));
    if (IN(5) || IN(6) || IN(7)) moe_tables(P, tab);
    constexpr int KM = MOE_FP8 ? D / 2 : D;
    PH(5, { pg8::MoeSched S{tab, (const int*)(P.ws + WS_ROUTE + RT_ROWTOK), 8, G, (int)blockIdx.x, __builtin_amdgcn_readfirstlane(tab[NE]) * 8, KM, 2048, true};
            pg8::EpiAct E{(bf16*)(P.ws + WS_ACT), P.b_gate_up};
            pg8::gemm_phase<MOE_FP8 != 0>(lds, (const char*)(P.ws + WS_H), (const char*)(P.ws + WS_WGU), KM, S, E); });
    PH(6, { pg8::MoeSched S{tab, nullptr, 4, G, (int)blockIdx.x, __builtin_amdgcn_readfirstlane(tab[NE]) * 4, KM, 1024, false};
            pg8::EpiDown E{(bf16*)(P.ws + WS_YBUF), P.b_down, (const float*)(P.ws + WS_ROUTE + RT_ROWW)};
            pg8::gemm_phase<MOE_FP8 != 0>(lds, (const char*)(P.ws + WS_ACT), (const char*)(P.ws + WS_WD), KM, S, E); });
    PH(7, ph7_final(P, tab, G));
#undef IN
#undef NREP
#undef PH
}

#ifndef MK_SEGMENTS
#define MK_SEGMENTS 1
#endif
extern "C" void kernel_launch(void* const* d_in, const int* in_sizes, int n_in, void* d_out, int out_size, void* d_ws, size_t ws_size, hipStream_t stream) {
    if (n_in != 19 || out_size != T * D || ws_size < WS_END) { fprintf(stderr, "kernel_launch: unexpected shapes n_in %d out %d ws %zu (need %zu)\n", n_in, out_size, ws_size, (size_t)WS_END); return; }
    static int grid = 0;
    if (grid == 0) {
        int dev = 0, cus = 0, per_cu = 0;
        if (hipGetDevice(&dev) != hipSuccess || hipDeviceGetAttribute(&cus, hipDeviceAttributeMultiprocessorCount, dev) != hipSuccess) { fprintf(stderr, "kernel_launch: device query failed\n"); grid = -1; return; }
        if (hipFuncSetAttribute((const void*)mk_fwd, hipFuncAttributeMaxDynamicSharedMemorySize, LDS_BYTES) != hipSuccess) { fprintf(stderr, "kernel_launch: hipFuncSetAttribute failed\n"); grid = -1; return; }
        if (hipOccupancyMaxActiveBlocksPerMultiprocessor(&per_cu, (const void*)mk_fwd, NTHR, LDS_BYTES) != hipSuccess || per_cu < 1) { fprintf(stderr, "kernel_launch: occupancy query says %d\n", per_cu); per_cu = 1; }
        (void)hipGetLastError();
        grid = cus;
        fprintf(stderr, "kernel_launch: cus %d per_cu %d grid %d\n", cus, per_cu, grid);
    }
    if (grid < 0) return;
    Args a{};
    const float** pp = (const float**)&a.P;
    for (int i = 0; i < 19; ++i) pp[i] = (const float*)d_in[i];
    a.P.out = (float*)d_out; a.P.ws = (unsigned char*)d_ws;
    (void)hipMemsetAsync((char*)d_ws + WS_CTL, 0, MiB, stream);
#if MK_SEGMENTS == 1
    a.ph_lo = 0; a.ph_hi = NPHASE; a.li = 0;
    void* kargs[] = {&a};
    hipError_t e = hipLaunchCooperativeKernel((const void*)mk_fwd, dim3(grid), dim3(NTHR), kargs, LDS_BYTES, stream);
    if (e != hipSuccess) fprintf(stderr, "kernel_launch: cooperative launch failed: %s (grid %d)\n", hipGetErrorString(e), grid);
#else
    for (int ph = 0; ph < NPHASE; ++ph) { a.ph_lo = ph; a.ph_hi = ph + 1; a.li = ph; hipLaunchKernelGGL(mk_fwd, dim3(grid), dim3(NTHR), LDS_BYTES, stream, a); }
#endif
}
```

```cpp
#include <hip/hip_runtime.h>
#include <cstdio>
#include <cstdint>

constexpr int T = 32768, D = 1024, SEQ = 2048, NB = 16;
constexpr int NIN_SRC = 2576, NPROJ = 2816;
constexpr int PC_Q = 0, PC_K = 256, PC_V = 512, PC_G = 1024, PC_GK = 1536, PC_U = 1792, PC_VS = 2304;
constexpr int NE = 32, TOPK = 4, DE = 1024;
constexpr int MT = 256;
constexpr int MAXSLOTS = T * TOPK + NE * MT;
constexpr float EPS = 1e-6f;

typedef unsigned short bf16;
typedef unsigned v4u __attribute__((ext_vector_type(4)));
typedef float f32x4 __attribute__((ext_vector_type(4)));

constexpr size_t MiB = 1u << 20;
constexpr size_t WS_CTL   = 0;
constexpr size_t WS_WIN   = 1 * MiB;
constexpr size_t WS_WOUT  = 7 * MiB;
constexpr size_t WS_WSP   = 9 * MiB;
constexpr size_t WS_ROUTE = 10 * MiB;
constexpr size_t WS_WGU   = 20 * MiB;
constexpr size_t WS_WD    = 148 * MiB;
constexpr size_t WS_X1    = 212 * MiB;
constexpr size_t WS_ACT   = 340 * MiB;
constexpr size_t WS_PROJ  = 612 * MiB;
constexpr size_t WS_MIX   = 788 * MiB;
constexpr size_t WS_H     = 852 * MiB;
constexpr size_t WS_YBUF  = WS_PROJ;
constexpr size_t WS_VN    = WS_ACT;
constexpr size_t WS_END   = 916 * MiB;
static_assert(WS_YBUF + (size_t)MAXSLOTS * 1024 * 2 <= WS_END, "ybuf fits");
static_assert(WS_ACT + (size_t)MAXSLOTS * 1024 * 2 <= WS_PROJ, "act fits");
constexpr size_t RT_ROWTOK = 0;
constexpr size_t RT_ROWW   = 4 * MiB;
constexpr size_t RT_TOKSLOT= 8 * MiB;
constexpr int CW_COUNTS = 64;
constexpr int CW_PSTART = 128;

__device__ __forceinline__ unsigned f2bf(float f) { unsigned u = __builtin_bit_cast(unsigned, f); return (u + 0x7fffu + ((u >> 16) & 1u)) >> 16; }
__device__ __forceinline__ float bf2f(unsigned h) { return __builtin_bit_cast(float, h << 16); }
__device__ __forceinline__ unsigned pk2(float lo, float hi) { return f2bf(lo) | (f2bf(hi) << 16); }
#ifndef MOE_FP8
#define MOE_FP8 1
#endif
constexpr float F8S_H = 8.0f, F8S_W = 32.0f, F8S_ACT = 4.0f, F8S_Y = 64.0f;
__device__ __forceinline__ float f8clamp(float x) { return fminf(fmaxf(x, -448.0f), 448.0f); }
__device__ __forceinline__ unsigned pk4_fp8(float a, float b, float c, float d) {
    int w = 0; w = __builtin_amdgcn_cvt_pk_fp8_f32(f8clamp(a), f8clamp(b), w, false); w = __builtin_amdgcn_cvt_pk_fp8_f32(f8clamp(c), f8clamp(d), w, true); return (unsigned)w; }
__device__ __forceinline__ float gelu_tanh(float x) { const float u = 0.7978845608028654f * (x + 0.044715f * x * x * x); return x / (1.0f + __expf(-2.0f * u)); }
__device__ __forceinline__ float silu(float x) { return x / (1.0f + __expf(-x)); }
__device__ __forceinline__ float log_sigmoid(float x) { return fminf(x, 0.0f) - log1pf(__expf(-fabsf(x))); }
__device__ __forceinline__ float wave_sum(float v) {
#pragma unroll
    for (int o = 1; o < 64; o <<= 1) v += __shfl_xor(v, o);
    return v;
}

struct Ptrs {
    const float *x, *norm_mix_w, *w_in, *w_gk_up, *b_gk, *gla_norm_w, *sg_ln_w, *sg_ln_b, *w_spatial, *b_spatial, *w_out, *norm_ffn_w,
                *w_router, *b_router, *w_gate_up, *b_gate_up, *w_down, *b_down, *norm_final_w;
    float* out; unsigned char* ws;
};

__device__ __forceinline__ void p0_tr_write(bf16* WT, int K, int d0, int k0, const float* scr, int lane) {
    const int c = lane & 7;
#pragma unroll
    for (int j = 0; j < 4; ++j) { const int n = (lane >> 3) + 8 * j; const float* s = scr + (8 * c) * 33 + n;
        v4u o; o.x = pk2(s[0 * 33], s[1 * 33]); o.y = pk2(s[2 * 33], s[3 * 33]); o.z = pk2(s[4 * 33], s[5 * 33]); o.w = pk2(s[6 * 33], s[7 * 33]);
        *(v4u*)(WT + (size_t)(d0 + n) * K + k0 + 8 * c) = o; }
}
__device__ __forceinline__ void p0_tr_write_f8(unsigned char* WT, int K, int d0, int k0, const float* scr, int lane, float sc) {
    const int c = lane & 7;
#pragma unroll
    for (int j = 0; j < 4; ++j) { const int n = (lane >> 3) + 8 * j; const float* s = scr + (8 * c) * 33 + n;
        uint2 o; o.x = pk4_fp8(s[0 * 33] * sc, s[1 * 33] * sc, s[2 * 33] * sc, s[3 * 33] * sc); o.y = pk4_fp8(s[4 * 33] * sc, s[5 * 33] * sc, s[6 * 33] * sc, s[7 * 33] * sc);
        *(uint2*)(WT + (size_t)(d0 + n) * K + k0 + 8 * c) = o; }
}
template <bool F8 = false>
__device__ __forceinline__ void p0_transpose_item(const float* W, int ldn, int n0, int k0, bf16* WT, int K, int d0, float* scr, int lane) {
    float v[32];
    const float* src = W + (size_t)(k0 + (lane >> 5)) * ldn + n0 + (lane & 31);
#pragma unroll
    for (int i = 0; i < 32; ++i) v[i] = __builtin_nontemporal_load(src + (size_t)(2 * i) * ldn);
#pragma unroll
    for (int i = 0; i < 32; ++i) scr[(2 * i + (lane >> 5)) * 33 + (lane & 31)] = v[i];
    __builtin_amdgcn_wave_barrier(); asm volatile("s_waitcnt lgkmcnt(0)" ::: "memory");
    if constexpr (F8) p0_tr_write_f8((unsigned char*)WT, K, d0, k0, scr, lane, F8S_W); else p0_tr_write(WT, K, d0, k0, scr, lane);
    asm volatile("s_waitcnt lgkmcnt(0)" ::: "memory"); __builtin_amdgcn_wave_barrier();
}
__device__ __forceinline__ void p0_gk_item(const float* w_in, const float* w_gk_up, int j0, int k0, bf16* WT, float* scr, int lane) {
    for (int i = 0; i < 32; ++i) { const int kk = 2 * i + (lane >> 5), j = j0 + (lane & 31); float s = 0.f;
#pragma unroll
        for (int r = 0; r < 16; ++r) s += w_in[(size_t)(k0 + kk) * NIN_SRC + 1536 + r] * w_gk_up[r * 256 + j];
        scr[kk * 33 + (lane & 31)] = s; }
    __builtin_amdgcn_wave_barrier(); asm volatile("s_waitcnt lgkmcnt(0)" ::: "memory");
    p0_tr_write(WT, D, PC_GK + j0, k0, scr, lane);
    asm volatile("s_waitcnt lgkmcnt(0)" ::: "memory"); __builtin_amdgcn_wave_barrier();
}
constexpr int IT_IN = (NPROJ / 32) * 16, IT_OUT = 32 * 16, IT_GU = NE * 64 * 16, IT_DN = NE * 32 * 16, IT_ALL = IT_IN + IT_OUT + IT_GU + IT_DN;
__device__ __forceinline__ void p0_weight_item(const Ptrs& P, int it, float* scr, int lane) {
    bf16* WinT = (bf16*)(P.ws + WS_WIN); bf16* WoutT = (bf16*)(P.ws + WS_WOUT); bf16* WguT = (bf16*)(P.ws + WS_WGU); bf16* WdT = (bf16*)(P.ws + WS_WD);
    if (it < IT_IN) { const int db = it / 16, kb = it % 16, d0 = db * 32;
        if (d0 >= PC_GK && d0 < PC_U) p0_gk_item(P.w_in, P.w_gk_up, d0 - PC_GK, kb * 64, WinT, scr, lane);
        else p0_transpose_item(P.w_in, NIN_SRC, d0 < PC_GK ? d0 : d0 - 240, kb * 64, WinT, D, d0, scr, lane);
        return; }
    it -= IT_IN;
    if (it < IT_OUT) { const int db = it / 16, kb = it % 16; p0_transpose_item(P.w_out, D, db * 32, kb * 64, WoutT, D, db * 32, scr, lane); return; }
    it -= IT_OUT;
    if (it < IT_GU) { const int e = it / 1024, r = it % 1024, db = r / 16, kb = r % 16, d0 = db * 32, pn = d0 >> 8, bj = (d0 >> 7) & 1, rr = d0 & 127;
        if (MOE_FP8) p0_transpose_item<true>(P.w_gate_up + (size_t)e * D * 2048, 2048, bj * 1024 + 128 * pn + rr, kb * 64, (bf16*)((unsigned char*)WguT + (size_t)e * 2048 * D), D, d0, scr, lane);
        else p0_transpose_item(P.w_gate_up + (size_t)e * D * 2048, 2048, bj * 1024 + 128 * pn + rr, kb * 64, WguT + (size_t)e * 2048 * D, D, d0, scr, lane);
        return; }
    it -= IT_GU;
    { const int e = it / 512, r = it % 512, db = r / 16, kb = r % 16;
      if (MOE_FP8) p0_transpose_item<true>(P.w_down + (size_t)e * DE * D, D, db * 32, kb * 64, (bf16*)((unsigned char*)WdT + (size_t)e * D * DE), DE, db * 32, scr, lane);
      else p0_transpose_item(P.w_down + (size_t)e * DE * D, D, db * 32, kb * 64, WdT + (size_t)e * D * DE, DE, db * 32, scr, lane); }
}
__device__ __forceinline__ void rms_row_to_bf16(const float* xrow, const float* w, bf16* orow, int lane) {
    const f32x4* xr = (const f32x4*)xrow + lane; const f32x4* wr = (const f32x4*)w + lane;
    f32x4 v[4]; float s = 0.f;
#pragma unroll
    for (int j = 0; j < 4; ++j) { v[j] = xr[64 * j]; s += (v[j].x * v[j].x + v[j].y * v[j].y) + (v[j].z * v[j].z + v[j].w * v[j].w); }
    const float rstd = 1.0f / sqrtf(wave_sum(s) * (1.f / D) + EPS);
    unsigned long long* o8 = (unsigned long long*)orow + lane;
#pragma unroll
    for (int j = 0; j < 4; ++j) { const f32x4 ww = wr[64 * j];
        o8[64 * j] = (unsigned long long)pk2(v[j].x * rstd * ww.x, v[j].y * rstd * ww.y) | ((unsigned long long)pk2(v[j].z * rstd * ww.z, v[j].w * rstd * ww.w) << 32); }
}

#ifndef PROBE_REPEAT
#define PROBE_REPEAT -1
#endif
#define LAS __attribute__((address_space(3)))
typedef short bf16x8 __attribute__((ext_vector_type(8)));
typedef unsigned u32x4 __attribute__((ext_vector_type(4)));
constexpr int NWAVES = 8, NTHR = 512;
constexpr int RING_BYTES = 131072, TAB_OFF = RING_BYTES, MISC_OFF = RING_BYTES + 1024, AUX_OFF = RING_BYTES + 2048, AUX_ROWTAB = 0, AUX_SLOTS = 8192, AUX_SLOT_BYTES = 2048, LDS_BYTES = AUX_OFF + 16384;
constexpr int CW_BAR = 4096;
#define RLX_AGENT __ATOMIC_RELAXED, __HIP_MEMORY_SCOPE_AGENT

#define XB_TMO      128
#define XB_XCNT(j)  (256  + 64 * (j))
#define XB_XSUB(j)  (1280 + 64 * (j))
#define XB_XGEN(j)  (2304 + 64 * (j))
#define XB_TOP      3328
#define XB_TOPGEN   3392
#define XCD_BAR_WORDS 3456
#define XB_SPIN_CAP (1u << 20)
__device__ __forceinline__ unsigned xb_ld(unsigned* p)              { return __hip_atomic_load(p, __ATOMIC_RELAXED, __HIP_MEMORY_SCOPE_AGENT); }
__device__ __forceinline__ unsigned xb_add(unsigned* p, unsigned v) { return __hip_atomic_fetch_add(p, v, __ATOMIC_RELAXED, __HIP_MEMORY_SCOPE_AGENT); }
__device__ __forceinline__ unsigned xb_xcc_id() { return (unsigned)__builtin_amdgcn_s_getreg((3 << 11) | 20) & 0xFu; }
#define XB_SPIN(cond, bar) do { unsigned _sp = 0; while (cond) { __builtin_amdgcn_s_sleep(1); \
    if ((++_sp & 255u) == 0u) { if (xb_ld(&(bar)[XB_TMO])) break; if (_sp > XB_SPIN_CAP) { atomicAdd(&(bar)[XB_TMO], 1u); break; } } } } while (0)
struct XcdBarrier { unsigned* bar; unsigned x; volatile LAS unsigned* st; };
__device__ __forceinline__ XcdBarrier xcd_barrier_post(unsigned* bar, volatile LAS unsigned* st) {
    XcdBarrier b; b.bar = bar; b.x = xb_xcc_id(); b.st = st;
    if (threadIdx.x == 0) (void)xb_add(&bar[XB_XCNT(b.x)], 1u);
    return b;
}
__device__ __forceinline__ void xcd_barrier_complete(unsigned* bar, unsigned x, unsigned& nloc, unsigned& nx) {
    const unsigned G = gridDim.x * gridDim.y * gridDim.z;
    unsigned sum, cnt, mine, sp = 0u;
    for (;;) {
        sum = 0u; cnt = 0u; mine = 0u;
#pragma unroll
        for (unsigned j = 0; j < 16; ++j) { const unsigned c = xb_ld(&bar[XB_XCNT(j)]); sum += c; cnt += (c > 0u) ? 1u : 0u; mine = (j == x) ? c : mine; }
        if (sum == G) break;
        __builtin_amdgcn_s_sleep(1);
        if ((++sp & 255u) == 0u) { if (xb_ld(&bar[XB_TMO])) break; if (sp > XB_SPIN_CAP) { atomicAdd(&bar[XB_TMO], 1u); break; } }
    }
    nloc = mine > 0u ? mine : 1u; nx = cnt > 0u ? cnt : 1u;
}
__device__ __forceinline__ void xcd_barrier(const XcdBarrier& b) {
    asm volatile("s_waitcnt vmcnt(0)" ::: "memory");
    __syncthreads();
    if (threadIdx.x == 0) {
        unsigned* bar = b.bar;
        __builtin_amdgcn_s_waitcnt(0);
        unsigned nloc = b.st[0], nx = b.st[1];
        if (nloc == 0u) { xcd_barrier_complete(bar, b.x, nloc, nx); b.st[0] = nloc; b.st[1] = nx; }
        const unsigned old = xb_add(&bar[XB_XSUB(b.x)], 1u);
        const unsigned gen = old / nloc;
        if (old + 1u == (gen + 1u) * nloc) {
            __builtin_amdgcn_fence(__ATOMIC_RELEASE, "agent");
            asm volatile("s_waitcnt vmcnt(0)" ::: "memory");
            const unsigned og = xb_add(&bar[XB_TOP], 1u);
            const unsigned tg = og / nx;
            if (og + 1u == (tg + 1u) * nx) xb_add(&bar[XB_TOPGEN], 1u);
            else XB_SPIN(xb_ld(&bar[XB_TOPGEN]) == tg, bar);
            __builtin_amdgcn_fence(__ATOMIC_ACQUIRE, "agent");
            xb_add(&bar[XB_XGEN(b.x)], 1u);
            asm volatile("s_waitcnt vmcnt(0)" ::: "memory");
        } else {
            XB_SPIN(xb_ld(&bar[XB_XGEN(b.x)]) == gen, bar);
            __builtin_amdgcn_fence(__ATOMIC_ACQUIRE, "agent");
            asm volatile("s_waitcnt vmcnt(0)" ::: "memory");
        }
    }
    __syncthreads();
}

namespace pg8 {
constexpr int BM = 256, BK = 64, HALF = 128, HTB = HALF * BK * 2, NXCD = 8, WGM = 8;
__device__ __forceinline__ int lds_byte(int r, int c) { const int st = (r >> 4) * 2 + (c >> 5), rr = r & 15, cc = c & 31, ob = rr * 64 + cc * 2; return st * 1024 + (ob ^ (((ob >> 9) & 1) << 5)); }
__device__ __forceinline__ void stage_rc(int b, int& R, int& C) { const int st = b / 1024, sb = b % 1024, swz = sb ^ (((sb >> 9) & 1) << 5); R = (st >> 1) * 16 + swz / 64; C = (st & 1) * 32 + (swz % 64) / 2; }
__device__ __forceinline__ int perm32(int rho) { const int n = rho >> 4, i = rho & 15; return 8 * (i >> 2) + 4 * n + (i & 3); }
typedef float f32x2_t __attribute__((ext_vector_type(2)));
typedef __bf16 bf16x2_t __attribute__((ext_vector_type(2)));
__device__ __forceinline__ unsigned cvt_pk_bf16(float lo, float hi) { const f32x2_t v = {lo, hi}; const bf16x2_t b = __builtin_convertvector(v, bf16x2_t); return __builtin_bit_cast(unsigned, b); }
__device__ __forceinline__ int xcd_remap(int wgid, int nwg) { const int q = nwg / NXCD, r = nwg % NXCD, xcd = wgid % NXCD, off = wgid / NXCD; return (xcd < r ? xcd * (q + 1) : r * (q + 1) + (xcd - r) * q) + off; }

struct Unit { int pm, pn, e, m0, count, slot0; };
typedef f32x4 Acc[2][2][4][2];

struct DenseSched {
    int nM, nN, nwg, G, c, K;
    __device__ __forceinline__ void init(int M, int N, int K_, int G_, int c_) { nM = M / BM; nN = N / BM; nwg = nM * nN; G = G_; c = c_; K = K_; }
    __device__ __forceinline__ bool next(int i, Unit& u) const {
        const long L = (long)i * G + c; if (L >= nwg) return false;
        const int wgid = xcd_remap((int)L, nwg);
        const int nig = WGM * nN, gid = wgid / nig, fm = gid * WGM, gsz = (nM - fm) < WGM ? (nM - fm) : WGM;
        u.pm = fm + ((wgid % nig) % gsz); u.pn = (wgid % nig) / gsz; u.e = 0; u.m0 = 0; u.count = 0; u.slot0 = 0; return true;
    }
    static constexpr bool GATHER = false;
    __device__ __forceinline__ unsigned a_off(const Unit& u, int r) const { return (unsigned)(u.pm * BM + r) * (unsigned)(K * 2); }
    __device__ __forceinline__ const int* row_src(const Unit&, int) const { return nullptr; }
    __device__ __forceinline__ size_t b_off(const Unit& u) const { return (size_t)u.pn * BM * K * 2; }
};
template <bool GATHER_>
struct MoeSched {
    static constexpr bool GATHER = GATHER_;
    const LAS int* tab; const int* rowtok; int NPN, G, c, ntile, K, NB_E  ;
    __device__ __forceinline__ bool next(int i, Unit& u) const {
        const long L = (long)i * G + c; if (L >= ntile) return false;
        const int wgid = xcd_remap((int)L, ntile);
        int lo = 0, hi = NE;
#pragma unroll
        for (int s = 0; s < 5; ++s) { const int mid = (lo + hi) >> 1; if (__builtin_amdgcn_readfirstlane(tab[mid]) * NPN <= wgid) lo = mid; else hi = mid; }
        const int e = lo, t0 = __builtin_amdgcn_readfirstlane(tab[e]), mte = __builtin_amdgcn_readfirstlane(tab[e + 1]) - t0, local = wgid - t0 * NPN;
        u.e = e; u.pn = local / mte; u.pm = 0; u.m0 = (local % mte) * BM; u.count = __builtin_amdgcn_readfirstlane(tab[66 + e]); u.slot0 = __builtin_amdgcn_readfirstlane(tab[33 + e]); return true;
    }
    __device__ __forceinline__ const int* row_src(const Unit& u, int r) const { int m = u.m0 + r; m = m < u.count ? m : u.count - 1; return rowtok + (size_t)u.e * T + m; }
    __device__ __forceinline__ unsigned a_off(const Unit& u, int r) const {
        if (GATHER) return (unsigned)(*row_src(u, r)) * (unsigned)(K * 2);
        return (unsigned)(u.slot0 + u.m0 + r) * (unsigned)(K * 2);
    }
    __device__ __forceinline__ size_t b_off(const Unit& u) const { return ((size_t)u.e * NB_E + (size_t)u.pn * BM) * K * 2; }
};

struct EpiProj {
    static constexpr bool PERM = true, AUX = false;
    bf16* O;
    __device__ __forceinline__ const float* aux_src(const Unit&, int) const { return nullptr; }
    __device__ __forceinline__ void operator()(const Acc& acc, const Unit& u, int wr, int wc, int fr, int fq, const LAS float*) const {
        const int row0 = u.pm * BM + wr * 64 + fr, col0 = u.pn * BM + wc * 32 + 8 * fq;
#pragma unroll
        for (int ai = 0; ai < 2; ++ai)
#pragma unroll
            for (int m = 0; m < 4; ++m) { bf16* rowp = O + (size_t)(row0 + ai * HALF + m * 16) * NPROJ + col0;
#pragma unroll
                for (int bj = 0; bj < 2; ++bj) { const f32x4 v0 = acc[ai][bj][m][0], v1 = acc[ai][bj][m][1];
                    u32x4 w; w.x = cvt_pk_bf16(v0[0], v0[1]); w.y = cvt_pk_bf16(v0[2], v0[3]); w.z = cvt_pk_bf16(v1[0], v1[1]); w.w = cvt_pk_bf16(v1[2], v1[3]);
                    *(u32x4*)(rowp + bj * HALF) = w; } }
    }
};
struct EpiX1 {
    static constexpr bool PERM = false, AUX = false;
    const float* X; float* O;
    __device__ __forceinline__ const float* aux_src(const Unit&, int) const { return nullptr; }
    __device__ __forceinline__ void operator()(const Acc& acc, const Unit& u, int wr, int wc, int fr, int fq, const LAS float*) const {
        const int row0 = u.pm * BM + wr * 64 + fr, col0 = u.pn * BM + wc * 32 + 4 * fq;
#pragma unroll
        for (int ai = 0; ai < 2; ++ai)
#pragma unroll
            for (int m = 0; m < 4; ++m) { const size_t off = (size_t)(row0 + ai * HALF + m * 16) * D + col0;
#pragma unroll
                for (int bj = 0; bj < 2; ++bj)
#pragma unroll
                    for (int n = 0; n < 2; ++n) { const f32x4 xr = *(const f32x4*)(X + off + bj * HALF + n * 16); *(f32x4*)(O + off + bj * HALF + n * 16) = xr + acc[ai][bj][m][n]; }
                asm volatile("" ::: "memory"); }
    }
};
struct EpiAct {
    static constexpr bool PERM = true, AUX = true;
    bf16* O; const float* bgu;
    __device__ __forceinline__ const float* aux_src(const Unit& u, int idx) const { const int j = idx & 255; return bgu + (size_t)u.e * 2048 + (j < 128 ? u.pn * 128 + j : 1024 + u.pn * 128 + (j - 128)); }
    __device__ __forceinline__ void operator()(const Acc& acc, const Unit& u, int wr, int wc, int fr, int fq, const LAS float* aux) const {
        const int colj = u.pn * 128 + wc * 32 + 8 * fq;
        const LAS float* bg = aux + wc * 32 + 8 * fq;
        const f32x4 g0 = *(const LAS f32x4*)bg, g1 = *(const LAS f32x4*)(bg + 4), u0 = *(const LAS f32x4*)(bg + 128), u1 = *(const LAS f32x4*)(bg + 132);
#pragma unroll
        for (int ai = 0; ai < 2; ++ai)
#pragma unroll
            for (int m = 0; m < 4; ++m) { const int r = ai * HALF + wr * 64 + m * 16 + fr;
                if (u.m0 + r < u.count) { float y[8];
#pragma unroll
                    for (int n = 0; n < 2; ++n)
#pragma unroll
                        for (int i = 0; i < 4; ++i) { constexpr float isc = MOE_FP8 ? 1.0f / (F8S_H * F8S_W) : 1.0f;
                            float g = acc[ai][0][m][n][i] * isc + (n ? g1[i] : g0[i]), up = acc[ai][1][m][n][i] * isc + (n ? u1[i] : u0[i]);
                            g = fminf(g, 7.0f); up = fminf(fmaxf(up, -7.0f), 7.0f); y[n * 4 + i] = (up + 1.0f) * g * __builtin_amdgcn_rcpf(1.0f + __expf(-1.702f * g)); }
                    if (MOE_FP8) { uint2 w; w.x = pk4_fp8(y[0] * F8S_ACT, y[1] * F8S_ACT, y[2] * F8S_ACT, y[3] * F8S_ACT); w.y = pk4_fp8(y[4] * F8S_ACT, y[5] * F8S_ACT, y[6] * F8S_ACT, y[7] * F8S_ACT);
                        *(uint2*)((unsigned char*)O + (size_t)(u.slot0 + u.m0 + r) * DE + colj) = w; }
                    else { u32x4 w; w.x = cvt_pk_bf16(y[0], y[1]); w.y = cvt_pk_bf16(y[2], y[3]); w.z = cvt_pk_bf16(y[4], y[5]); w.w = cvt_pk_bf16(y[6], y[7]);
                        *(u32x4*)(O + (size_t)(u.slot0 + u.m0 + r) * DE + colj) = w; } } }
    }
};
struct EpiDown {
    static constexpr bool PERM = true, AUX = true;
    bf16* O; const float* bd; const float* roww;
    __device__ __forceinline__ const float* aux_src(const Unit& u, int idx) const {
        if (idx < 256) return bd + (size_t)u.e * D + u.pn * BM + idx;
        int m = u.m0 + (idx - 256); m = m < u.count ? m : u.count - 1; return roww + (size_t)u.e * T + m; }
    __device__ __forceinline__ void operator()(const Acc& acc, const Unit& u, int wr, int wc, int fr, int fq, const LAS float* aux) const {
        const int col0 = u.pn * BM + wc * 32 + 8 * fq;
        const LAS float* bp = aux + wc * 32 + 8 * fq;
        f32x4 bv[2][2];
#pragma unroll
        for (int bj = 0; bj < 2; ++bj)
#pragma unroll
            for (int n = 0; n < 2; ++n) bv[bj][n] = *(const LAS f32x4*)(bp + bj * HALF + 4 * n);
#pragma unroll
        for (int ai = 0; ai < 2; ++ai)
#pragma unroll
            for (int m = 0; m < 4; ++m) { const int r = ai * HALF + wr * 64 + m * 16 + fr;
                if (u.m0 + r < u.count) { const float w8 = aux[256 + r]; bf16* rowp = O + (size_t)(u.slot0 + u.m0 + r) * D + col0;
#pragma unroll
                    for (int bj = 0; bj < 2; ++bj) { constexpr float isc = MOE_FP8 ? 1.0f / (F8S_ACT * F8S_W) : 1.0f;
                        const f32x4 v0 = (acc[ai][bj][m][0] * isc + bv[bj][0]) * w8, v1 = (acc[ai][bj][m][1] * isc + bv[bj][1]) * w8;
                        if (MOE_FP8) { uint2 w; w.x = pk4_fp8(v0[0] * F8S_Y, v0[1] * F8S_Y, v0[2] * F8S_Y, v0[3] * F8S_Y); w.y = pk4_fp8(v1[0] * F8S_Y, v1[1] * F8S_Y, v1[2] * F8S_Y, v1[3] * F8S_Y);
                            *(uint2*)((unsigned char*)O + (size_t)(u.slot0 + u.m0 + r) * D + col0 + bj * HALF) = w; }
                        else { u32x4 w; w.x = cvt_pk_bf16(v0[0], v0[1]); w.y = cvt_pk_bf16(v0[2], v0[3]); w.z = cvt_pk_bf16(v1[0], v1[1]); w.w = cvt_pk_bf16(v1[2], v1[3]);
                            *(u32x4*)(rowp + bj * HALF) = w; } } } }
    }
};

typedef int i32x4 __attribute__((ext_vector_type(4)));
typedef int i32x8 __attribute__((ext_vector_type(8)));
template <bool F8 = false, class Epi, class Sched>
__device__ __forceinline__ void gemm_phase(LAS unsigned char* lds, LAS unsigned char* aux, const char* gA, const char* gB, int K, const Sched& S, const Epi& E) {
    const int tid = threadIdx.x, wid = __builtin_amdgcn_readfirstlane(tid >> 6), lane = tid & 63, wr = wid >> 2, wc = wid & 3, fr = lane & 15, fq = lane >> 4;
    const int nt = K / BK;
    unsigned voffB[2];
#pragma unroll
    for (int i = 0; i < 2; ++i) { int R, C; stage_rc(tid * 16 + i * 8192, R, C); const int Rb = Epi::PERM ? ((R & ~31) + perm32(R & 31)) : R; voffB[i] = (unsigned)(Rb * K + C) * 2u; }
#define PG8_AOFFS(U, o0, o1) do { int t_ = tid; asm volatile("" : "+v"(t_)); _Pragma("unroll") for (int i = 0; i < 2; ++i) { int R, C; stage_rc(t_ * 16 + i * 8192, R, C); \
        o0[i] = S.a_off(U, R) + (unsigned)C * 2u; o1[i] = S.a_off(U, HALF + R) + (unsigned)C * 2u; } } while (0)
    const size_t hstep = (size_t)HALF * K * 2;
    const unsigned ldsw = (unsigned)wid * 1024u;
    const int aoff = lds_byte(wr * 64 + fr, fq * 8), boff = lds_byte(wc * 32 + fr, fq * 8);
#define PG8_SA(b, h) (((b) * 2 + (h)) * HTB)
#define PG8_SB(b, h) ((4 + (b) * 2 + (h)) * HTB)
#define PG8_STAGEB(bufoff, gbase) do { _Pragma("unroll") for (int _i = 0; _i < 2; ++_i) { unsigned _o = voffB[_i]; asm volatile("" : "+v"(_o)); \
        __builtin_amdgcn_global_load_lds((const unsigned*)((const char*)(gbase) + _o), (LAS unsigned*)(lds + (bufoff) + ldsw + _i * 8192), 16, 0, 0); } } while (0)
#define PG8_STAGEA(bufoff, voff2, kb) do { _Pragma("unroll") for (int _i = 0; _i < 2; ++_i) { unsigned _o = (voff2)[_i]; asm volatile("" : "+v"(_o)); \
        __builtin_amdgcn_global_load_lds((const unsigned*)((gA + (size_t)(kb)) + _o), (LAS unsigned*)(lds + (bufoff) + ldsw + _i * 8192), 16, 0, 0); } } while (0)
#define PG8_LD8(p) __builtin_shufflevector(*(const LAS i32x4*)(p), *(const LAS i32x4*)((p) + 1024), 0, 1, 2, 3, 4, 5, 6, 7)
#define PG8_LDA(dst, b, h) do { _Pragma("unroll") for (int m = 0; m < 4; ++m) dst[m] = PG8_LD8(lds + PG8_SA(b, h) + aoff + m * 2048); } while (0)
#define PG8_LDB(dst, b, h) do { _Pragma("unroll") for (int n = 0; n < 2; ++n) dst[n] = PG8_LD8(lds + PG8_SB(b, h) + boff + n * 2048); } while (0)
#define PG8_LO(x) __builtin_bit_cast(bf16x8, __builtin_shufflevector(x, x, 0, 1, 2, 3))
#define PG8_HI(x) __builtin_bit_cast(bf16x8, __builtin_shufflevector(x, x, 4, 5, 6, 7))
#define PG8_MMA(ai, bj, At, Bt) do { if constexpr (F8) __builtin_amdgcn_sched_barrier(0); __builtin_amdgcn_s_setprio(1); _Pragma("unroll") for (int m = 0; m < 4; ++m) _Pragma("unroll") for (int n = 0; n < 2; ++n) { \
        if constexpr (F8) asm volatile("v_mfma_scale_f32_16x16x128_f8f6f4 %0, %1, %2, %0, %3, %3 op_sel_hi:[0,0,0]" : "+v"(acc[ai][bj][m][n]) : "v"(Bt[n]), "v"(At[m]), "v"(f8scale)); \
        else { acc[ai][bj][m][n] = __builtin_amdgcn_mfma_f32_16x16x32_bf16(PG8_LO(Bt[n]), PG8_LO(At[m]), acc[ai][bj][m][n], 0, 0, 0); \
               acc[ai][bj][m][n] = __builtin_amdgcn_mfma_f32_16x16x32_bf16(PG8_HI(Bt[n]), PG8_HI(At[m]), acc[ai][bj][m][n], 0, 0, 0); } } \
        __builtin_amdgcn_s_setprio(0); if constexpr (F8) __builtin_amdgcn_sched_barrier(0); } while (0)
#define PG8_WAIT_V(n) asm volatile("s_waitcnt vmcnt(" #n ")" ::: "memory")
#define PG8_WAIT_L(n) asm volatile("s_waitcnt lgkmcnt(" #n ")" ::: "memory")
#define PG8_BAR __builtin_amdgcn_s_barrier()
#define PG8_SCHED __builtin_amdgcn_sched_barrier(0)
    Unit cur, nxt; int ui = 0;
    if (!S.next(0, cur)) return;
    Acc acc;
#pragma unroll
    for (int a = 0; a < 2; ++a)
#pragma unroll
        for (int b = 0; b < 2; ++b)
#pragma unroll
            for (int m = 0; m < 4; ++m)
#pragma unroll
                for (int n = 0; n < 2; ++n) acc[a][b][m][n] = (f32x4){0.f, 0.f, 0.f, 0.f};
    i32x8 At[4], B0[2], B1[2];
    int f8scale = 0x7F7F7F7F; asm volatile("" : "+v"(f8scale));
    unsigned cA0[2], cA1[2];
#define PG8_DMA4(src, dstoff) __builtin_amdgcn_global_load_lds((const unsigned*)(src), (LAS unsigned*)(aux + (dstoff) + wid * 256), 4, 0, 0)
#define PG8_SIDE_DMA(U, UI) do { if constexpr (Sched::GATHER) { int t_ = tid; asm volatile("" : "+v"(t_)); _Pragma("unroll") for (int p = 0; p < 4; ++p) { int R, C; stage_rc(t_ * 16 + (p & 1) * 8192, R, C); \
            PG8_DMA4(S.row_src(U, (p >> 1) * HALF + R), AUX_ROWTAB + p * 2048); } } \
        if constexpr (Epi::AUX) PG8_DMA4(E.aux_src(U, wid * 64 + lane), AUX_SLOTS + ((UI) & 3) * AUX_SLOT_BYTES); } while (0)
    if constexpr (Epi::AUX) PG8_DMA4(E.aux_src(cur, wid * 64 + lane), AUX_SLOTS);
    PG8_AOFFS(cur, cA0, cA1);
    const char* cB = gB + S.b_off(cur);
    PG8_STAGEB(PG8_SB(0, 0), cB); PG8_STAGEB(PG8_SB(0, 1), cB + hstep); PG8_STAGEA(PG8_SA(0, 0), cA0, 0); PG8_STAGEA(PG8_SA(0, 1), cA1, 0);
    if (wr == 1) PG8_BAR;
    PG8_WAIT_V(2); PG8_BAR;
    PG8_STAGEB(PG8_SB(1, 0), cB + BK * 2); PG8_STAGEA(PG8_SA(1, 0), cA0, BK * 2); PG8_STAGEB(PG8_SB(1, 1), cB + hstep + BK * 2);
    PG8_WAIT_V(6); PG8_BAR;
    for (;;) {
        const bool has_next = S.next(ui + 1, nxt);
        const char* nB = cB;
        if (has_next) { PG8_SIDE_DMA(nxt, ui + 1); nB = gB + S.b_off(nxt); }
        unsigned a20[2], a21[2];
#pragma nounroll
        for (int t = 0; t < nt; t += 2) {
            const bool last = (t == nt - 2);
            const unsigned k1 = (unsigned)(t + 1) * (BK * 2), k2 = last ? 0u : (unsigned)(t + 2) * (BK * 2), k3 = k2 + BK * 2;
            if (last && has_next) {
                if constexpr (Sched::GATHER) { int t_ = tid; asm volatile("" : "+v"(t_));
#pragma unroll
                    for (int i = 0; i < 2; ++i) { int R, C; stage_rc(t_ * 16 + i * 8192, R, C);
                        a20[i] = *(volatile LAS unsigned*)(aux + AUX_ROWTAB + i * 2048 + t_ * 4) * (unsigned)(K * 2) + (unsigned)C * 2u;
                        a21[i] = *(volatile LAS unsigned*)(aux + AUX_ROWTAB + (2 + i) * 2048 + t_ * 4) * (unsigned)(K * 2) + (unsigned)C * 2u; } }
                else PG8_AOFFS(nxt, a20, a21);
            } else {
#pragma unroll
                for (int i = 0; i < 2; ++i) { a20[i] = cA0[i]; a21[i] = cA1[i]; }
            }
            const char* b2 = (last ? nB : cB) + k2; const char* b3 = b2 + BK * 2;
            PG8_LDB(B0, 0, 0); PG8_LDB(B1, 0, 1); PG8_SCHED; PG8_LDA(At, 0, 0); PG8_STAGEA(PG8_SA(1, 1), cA1, k1);
            PG8_WAIT_V(8); PG8_WAIT_L(0); PG8_BAR; PG8_MMA(0, 0, At, B0); PG8_MMA(0, 1, At, B1); PG8_BAR; PG8_SCHED;
            PG8_LDA(At, 0, 1); PG8_STAGEB(PG8_SB(0, 0), b2); PG8_STAGEB(PG8_SB(0, 1), b2 + hstep); PG8_STAGEA(PG8_SA(0, 0), a20, k2);
            PG8_WAIT_V(8); PG8_WAIT_L(0); PG8_BAR; PG8_MMA(1, 0, At, B0); PG8_MMA(1, 1, At, B1); PG8_BAR; PG8_SCHED;
            PG8_LDB(B0, 1, 0); PG8_LDB(B1, 1, 1); PG8_SCHED; PG8_LDA(At, 1, 0); PG8_STAGEA(PG8_SA(0, 1), a21, k2);
            PG8_WAIT_V(8); PG8_WAIT_L(0); PG8_BAR; PG8_MMA(0, 0, At, B0); PG8_MMA(0, 1, At, B1); PG8_BAR; PG8_SCHED;
            PG8_LDA(At, 1, 1); PG8_STAGEB(PG8_SB(1, 0), b3); PG8_STAGEB(PG8_SB(1, 1), b3 + hstep); PG8_STAGEA(PG8_SA(1, 0), a20, k3);
            PG8_WAIT_V(8); PG8_WAIT_L(0); PG8_BAR; PG8_MMA(1, 0, At, B0); PG8_MMA(1, 1, At, B1); PG8_BAR; PG8_SCHED;
        }
        if constexpr (F8) asm volatile("s_nop 15\n\ts_nop 15" ::: "memory");
        if (wr == 0) PG8_BAR;
        int t_e = threadIdx.x; asm volatile("" : "+v"(t_e));
        const int fr_e = t_e & 15, fq_e = (t_e >> 4) & 3;
#pragma unroll
        for (int a = 0; a < 2; ++a)
#pragma unroll
            for (int b = 0; b < 2; ++b)
#pragma unroll
                for (int m = 0; m < 4; ++m)
#pragma unroll
                    for (int n = 0; n < 2; ++n) asm volatile("" : "+v"(acc[a][b][m][n]));
        E(acc, cur, wr, wc, fr_e, fq_e, (const LAS float*)(aux + AUX_SLOTS + (ui & 3) * AUX_SLOT_BYTES));
        if (!has_next) break;
#pragma unroll
        for (int a = 0; a < 2; ++a)
#pragma unroll
            for (int b = 0; b < 2; ++b)
#pragma unroll
                for (int m = 0; m < 4; ++m)
#pragma unroll
                    for (int n = 0; n < 2; ++n) acc[a][b][m][n] = (f32x4){0.f, 0.f, 0.f, 0.f};
        cur = nxt; cB = nB; ++ui;
#pragma unroll
        for (int i = 0; i < 2; ++i) { cA0[i] = a20[i]; cA1[i] = a21[i]; }
        if (wr == 1) PG8_BAR;
    }
    PG8_WAIT_V(0);
    PG8_BAR;
#undef PG8_SA
#undef PG8_SB
#undef PG8_STAGEA
#undef PG8_AOFFS
#undef PG8_DMA4
#undef PG8_SIDE_DMA
#undef PG8_STAGEB
#undef PG8_LDA
#undef PG8_LDB
#undef PG8_MMA
#undef PG8_LD8
#undef PG8_LO
#undef PG8_HI
#undef PG8_WAIT_V
#undef PG8_WAIT_L
#undef PG8_BAR
#undef PG8_SCHED
}
}


typedef float f32x16 __attribute__((ext_vector_type(16)));
typedef short bf16x4 __attribute__((ext_vector_type(4)));
typedef unsigned u32x2 __attribute__((ext_vector_type(2)));
typedef float f32x2_t __attribute__((ext_vector_type(2)));
typedef __bf16 bf16x2_t __attribute__((ext_vector_type(2)));
__device__ __forceinline__ unsigned cvtpk(float lo, float hi) { const f32x2_t v = {lo, hi}; const bf16x2_t b = __builtin_convertvector(v, bf16x2_t); return __builtin_bit_cast(unsigned, b); }
template <int S8> __device__ __forceinline__ bf16x8 pack8(const f32x16& X) {
    u32x4 w; w.x = cvtpk(X[8 * S8 + 0], X[8 * S8 + 1]); w.y = cvtpk(X[8 * S8 + 2], X[8 * S8 + 3]); w.z = cvtpk(X[8 * S8 + 4], X[8 * S8 + 5]); w.w = cvtpk(X[8 * S8 + 6], X[8 * S8 + 7]);
    return __builtin_bit_cast(bf16x8, w);
}
__device__ __forceinline__ bf16x8 lds_b128(const LAS unsigned char* p) { return *(const LAS bf16x8*)p; }
__device__ __forceinline__ bf16x8 lds_2xb64(const LAS unsigned char* p) {
    const bf16x4 a = *(const LAS bf16x4*)p, b = *(const LAS bf16x4*)(p + 16);
    return __builtin_shufflevector(a, b, 0, 1, 2, 3, 4, 5, 6, 7);
}
template <int CTRL, int ROWMASK> __device__ __forceinline__ float dpp_f(float v) {
    return __builtin_bit_cast(float, __builtin_amdgcn_update_dpp(0, __builtin_bit_cast(int, v), CTRL, ROWMASK, 0xF, true)); }
__device__ __forceinline__ float wave_incl_scan(float v) {
    v += dpp_f<0x111, 0xF>(v); v += dpp_f<0x112, 0xF>(v); v += dpp_f<0x114, 0xF>(v); v += dpp_f<0x118, 0xF>(v);
    v += dpp_f<0x142, 0xA>(v); v += dpp_f<0x143, 0xC>(v); return v; }
__device__ __forceinline__ float fast_log_sigmoid(float x) { return fminf(x, 0.0f) - __logf(1.0f + __expf(-fabsf(x))); }

constexpr int GP = 144;
constexpr int GL_QD = 0, GL_KI = GL_QD + 64 * GP, GL_KET = GL_KI + 64 * GP, GL_VT = GL_KET + 64 * GP, GL_DEC = GL_VT + 128 * GP, GL_SSP = GL_DEC + 256, GL_OT = GL_SSP + 1024;
constexpr int OTP = 132;
constexpr int GL_END = GL_OT + 64 * OTP * 4;
static_assert(GL_END <= RING_BYTES && (GL_OT % 16) == 0 && (GL_DEC % 16) == 0, "gla lds");

__device__ __forceinline__ void gla_item(const Ptrs& P, LAS unsigned char* lds, int bh) {
    const int tid = threadIdx.x, lane = tid & 63, w = __builtin_amdgcn_readfirstlane(tid >> 6), l31 = lane & 31, hh = lane >> 5;
    const int b = bh >> 2, h = bh & 3, cr = w >> 2, vc = w & 3;
    const bf16* PROJ = (const bf16*)(P.ws + WS_PROJ); bf16* MIX = (bf16*)(P.ws + WS_MIX);
    const size_t tok0 = (size_t)b * SEQ;
    const bf16* pq = PROJ + (tok0 + lane) * NPROJ + PC_Q + h * 64 + 8 * w;
    const bf16* pk = PROJ + (tok0 + lane) * NPROJ + PC_K + h * 64 + 8 * w;
    const bf16* pg = PROJ + (tok0 + lane) * NPROJ + PC_GK + h * 64 + 8 * w;
    const bf16* pv = PROJ + (tok0 + lane) * NPROJ + PC_V + h * 128 + 16 * w;
    const int oc = tid >> 3, ov = (tid & 7) * 16;
    const bf16* pgate = PROJ + (tok0 + oc) * NPROJ + PC_G + h * 128 + ov;
    float bgk[8], nw[16];
#pragma unroll
    for (int j = 0; j < 8; ++j) bgk[j] = P.b_gk[h * 64 + 8 * w + j];
#pragma unroll
    for (int j = 0; j < 16; ++j) nw[j] = P.gla_norm_w[ov + j];
    f32x16 S0, S1;
#pragma unroll
    for (int r = 0; r < 16; ++r) { S0[r] = 0.f; S1[r] = 0.f; }
    v4u nq = *(const v4u*)pq, nk = *(const v4u*)pk, ng = *(const v4u*)pg, nv0 = *(const v4u*)pv, nv1 = *(const v4u*)(pv + 8);
    for (int n = 0; n < SEQ / 64; ++n) {
        const v4u cq = nq, ck = nk, cg = ng, cv0 = nv0, cv1 = nv1;
        const size_t adv = (size_t)(n + 1 < SEQ / 64 ? (n + 1) * 64 : n * 64) * NPROJ;
        nq = *(const v4u*)(pq + adv); nk = *(const v4u*)(pk + adv); ng = *(const v4u*)(pg + adv); nv0 = *(const v4u*)(pv + adv); nv1 = *(const v4u*)(pv + adv + 8);
        const size_t gadv = (size_t)n * 64 * NPROJ;
        const v4u gate0 = *(const v4u*)(pgate + gadv), gate1 = *(const v4u*)(pgate + gadv + 8);
        {
            const unsigned qw[4] = {cq.x, cq.y, cq.z, cq.w}, kw[4] = {ck.x, ck.y, ck.z, ck.w}, gw[4] = {cg.x, cg.y, cg.z, cg.w};
            float bb[8];
#pragma unroll
            for (int j = 0; j < 8; ++j) { const float x = bf2f((gw[j >> 1] >> (16 * (j & 1))) & 0xffffu) + bgk[j]; bb[j] = fast_log_sigmoid(x) * (1.0f / 16.0f); }
#pragma unroll
            for (int j = 0; j < 8; ++j) bb[j] = wave_incl_scan(bb[j]);
            float qd[8], ki[8], ke[8];
#pragma unroll
            for (int j = 0; j < 8; ++j) { const float bl = __builtin_bit_cast(float, __builtin_amdgcn_readlane(__builtin_bit_cast(int, bb[j]), 63));
                const float qv = bf2f((qw[j >> 1] >> (16 * (j & 1))) & 0xffffu), kv = bf2f((kw[j >> 1] >> (16 * (j & 1))) & 0xffffu);
                qd[j] = qv * 0.125f * __expf(bb[j]); ki[j] = kv * __expf(-bb[j]); ke[j] = kv * __expf(bl - bb[j]);
                if (lane == 63) *(LAS float*)(lds + GL_DEC + (8 * w + j) * 4) = __expf(bl); }
            u32x4 t; t.x = cvtpk(qd[0], qd[1]); t.y = cvtpk(qd[2], qd[3]); t.z = cvtpk(qd[4], qd[5]); t.w = cvtpk(qd[6], qd[7]);
            *(LAS u32x4*)(lds + GL_QD + lane * GP + 16 * w) = t;
            t.x = cvtpk(ki[0], ki[1]); t.y = cvtpk(ki[2], ki[3]); t.z = cvtpk(ki[4], ki[5]); t.w = cvtpk(ki[6], ki[7]);
            *(LAS u32x4*)(lds + GL_KI + lane * GP + 16 * w) = t;
#pragma unroll
            for (int j = 0; j < 8; ++j) *(LAS unsigned short*)(lds + GL_KET + (8 * w + j) * GP + lane * 2) = (unsigned short)f2bf(ke[j]);
            const unsigned vw[8] = {cv0.x, cv0.y, cv0.z, cv0.w, cv1.x, cv1.y, cv1.z, cv1.w};
#pragma unroll
            for (int j = 0; j < 16; ++j) *(LAS unsigned short*)(lds + GL_VT + (16 * w + j) * GP + lane * 2) = (unsigned short)((vw[j >> 1] >> (16 * (j & 1))) & 0xffffu);
        }
        __syncthreads();
        f32x16 O;
#pragma unroll
        for (int r = 0; r < 16; ++r) O[r] = 0.f;
        {
            const LAS unsigned char* qrow = lds + GL_QD + (cr * 32 + l31) * GP + 8 * hh;
            O = __builtin_amdgcn_mfma_f32_32x32x16_bf16(pack8<0>(S0), lds_2xb64(qrow + 0), O, 0, 0, 0);
            O = __builtin_amdgcn_mfma_f32_32x32x16_bf16(pack8<1>(S0), lds_2xb64(qrow + 32), O, 0, 0, 0);
            O = __builtin_amdgcn_mfma_f32_32x32x16_bf16(pack8<0>(S1), lds_2xb64(qrow + 64), O, 0, 0, 0);
            O = __builtin_amdgcn_mfma_f32_32x32x16_bf16(pack8<1>(S1), lds_2xb64(qrow + 96), O, 0, 0, 0);
        }
        {
            const LAS unsigned char* qb = lds + GL_QD + (cr * 32 + l31) * GP + 16 * hh;
            const LAS unsigned char* vrow = lds + GL_VT + (vc * 32 + l31) * GP + 8 * hh;
            f32x16 X;
#pragma unroll
            for (int r = 0; r < 16; ++r) X[r] = 0.f;
            if (cr == 1) {
                const LAS unsigned char* ka = lds + GL_KI + l31 * GP + 16 * hh;
#pragma unroll
                for (int kk = 0; kk < 4; ++kk) X = __builtin_amdgcn_mfma_f32_32x32x16_bf16(lds_b128(ka + 32 * kk), lds_b128(qb + 32 * kk), X, 0, 0, 0);
                O = __builtin_amdgcn_mfma_f32_32x32x16_bf16(lds_2xb64(vrow + 0), pack8<0>(X), O, 0, 0, 0);
                O = __builtin_amdgcn_mfma_f32_32x32x16_bf16(lds_2xb64(vrow + 32), pack8<1>(X), O, 0, 0, 0);
#pragma unroll
                for (int r = 0; r < 16; ++r) X[r] = 0.f;
            }
            {
                const LAS unsigned char* ka = lds + GL_KI + (cr * 32 + l31) * GP + 16 * hh;
#pragma unroll
                for (int kk = 0; kk < 4; ++kk) X = __builtin_amdgcn_mfma_f32_32x32x16_bf16(lds_b128(ka + 32 * kk), lds_b128(qb + 32 * kk), X, 0, 0, 0);
#pragma unroll
                for (int r = 0; r < 16; ++r) { const int srow = (r & 3) + 8 * (r >> 2) + 4 * hh; X[r] = (srow <= l31) ? X[r] : 0.f; }
                O = __builtin_amdgcn_mfma_f32_32x32x16_bf16(lds_2xb64(vrow + cr * 64 + 0), pack8<0>(X), O, 0, 0, 0);
                O = __builtin_amdgcn_mfma_f32_32x32x16_bf16(lds_2xb64(vrow + cr * 64 + 32), pack8<1>(X), O, 0, 0, 0);
            }
        }
        {
            const LAS float* dec = (const LAS float*)(lds + GL_DEC);
#pragma unroll
            for (int g4 = 0; g4 < 4; ++g4) { const f32x4 d0 = *(const LAS f32x4*)(dec + 8 * g4 + 4 * hh), d1 = *(const LAS f32x4*)(dec + 32 + 8 * g4 + 4 * hh);
#pragma unroll
                for (int i = 0; i < 4; ++i) { S0[4 * g4 + i] *= d0[i]; S1[4 * g4 + i] *= d1[i]; } }
            const LAS unsigned char* ka0 = lds + GL_KET + l31 * GP + 16 * hh;
            const LAS unsigned char* ka1 = lds + GL_KET + (32 + l31) * GP + 16 * hh;
            const LAS unsigned char* vb = lds + GL_VT + (vc * 32 + l31) * GP + 16 * hh;
#pragma unroll
            for (int ss = 0; ss < 4; ++ss) { const bf16x8 bfr = lds_b128(vb + 32 * ss);
                S0 = __builtin_amdgcn_mfma_f32_32x32x16_bf16(lds_b128(ka0 + 32 * ss), bfr, S0, 0, 0, 0);
                S1 = __builtin_amdgcn_mfma_f32_32x32x16_bf16(lds_b128(ka1 + 32 * ss), bfr, S1, 0, 0, 0); }
        }
        {
            float ssq = 0.f;
#pragma unroll
            for (int r = 0; r < 16; ++r) ssq += O[r] * O[r];
            ssq += __shfl_xor(ssq, 32);
            if (hh == 0) *(LAS float*)(lds + GL_SSP + (vc * 64 + cr * 32 + l31) * 4) = ssq;
            LAS float* ot = (LAS float*)(lds + GL_OT) + (cr * 32 + l31) * OTP + vc * 32 + 4 * hh;
#pragma unroll
            for (int g4 = 0; g4 < 4; ++g4) *(LAS f32x4*)(ot + 8 * g4) = (f32x4){O[4 * g4], O[4 * g4 + 1], O[4 * g4 + 2], O[4 * g4 + 3]};
        }
        __syncthreads();
        {
            const LAS float* ssp = (const LAS float*)(lds + GL_SSP) + oc;
            const float tot = (ssp[0] + ssp[64]) + (ssp[128] + ssp[192]);
            const float rstd = 1.0f / sqrtf(tot * (1.0f / 128.0f) + EPS);
            const LAS float* ot = (const LAS float*)(lds + GL_OT) + oc * OTP + ov;
            const unsigned gw[8] = {gate0.x, gate0.y, gate0.z, gate0.w, gate1.x, gate1.y, gate1.z, gate1.w};
            float y[16];
#pragma unroll
            for (int q4 = 0; q4 < 4; ++q4) { const f32x4 o4 = *(const LAS f32x4*)(ot + 4 * q4);
#pragma unroll
                for (int i = 0; i < 4; ++i) { const int j = 4 * q4 + i; const float gv = bf2f((gw[j >> 1] >> (16 * (j & 1))) & 0xffffu); y[j] = o4[i] * rstd * nw[j] * (gv / (1.0f + __expf(-gv))); } }
            bf16* orow = MIX + (tok0 + (size_t)n * 64 + oc) * D + h * 128 + ov;
            u32x4 t; t.x = cvtpk(y[0], y[1]); t.y = cvtpk(y[2], y[3]); t.z = cvtpk(y[4], y[5]); t.w = cvtpk(y[6], y[7]); *(u32x4*)orow = t;
            t.x = cvtpk(y[8], y[9]); t.y = cvtpk(y[10], y[11]); t.z = cvtpk(y[12], y[13]); t.w = cvtpk(y[14], y[15]); *(u32x4*)(orow + 8) = t;
        }
    }
    __syncthreads();
}

constexpr int SP = 272;
constexpr int SG_W = 0, SG_VN = SG_W + 128 * SP, SG_OT = SG_VN + 128 * SP, SG_ST = SG_OT + 128 * SP, SG_END = SG_ST + 1024;
static_assert(SG_END <= RING_BYTES, "sgu lds");
__device__ __forceinline__ void sgu_item(const Ptrs& P, LAS unsigned char* lds, int bn) {
    const int tid = threadIdx.x, lane = tid & 63, w = __builtin_amdgcn_readfirstlane(tid >> 6), l31 = lane & 31, hh = lane >> 5;
    const bf16* PROJ = (const bf16*)(P.ws + WS_PROJ); bf16* MIX = (bf16*)(P.ws + WS_MIX); const bf16* Wsp = (const bf16*)(P.ws + WS_WSP);
    const size_t tok0 = (size_t)bn * 128;
    LAS float* st = (LAS float*)(lds + SG_ST);
#pragma unroll 4
    for (int rr = 0; rr < 16; ++rr) { const int row = 16 * w + rr;
        const v4u raw = *(const v4u*)(PROJ + (tok0 + row) * NPROJ + PC_VS + lane * 8); const unsigned rw[4] = {raw.x, raw.y, raw.z, raw.w};
        float s = 0.f, q = 0.f;
#pragma unroll
        for (int j = 0; j < 8; ++j) { const float g = gelu_tanh(bf2f((rw[j >> 1] >> (16 * (j & 1))) & 0xffffu)); s += g; q += g * g; }
        s = wave_sum(s); q = wave_sum(q);
        const float mu = s * (1.0f / 512.0f), var = fmaxf(q * (1.0f / 512.0f) - mu * mu, 0.f);
        if (lane == 0) { st[row] = mu; st[128 + row] = 1.0f / sqrtf(var + EPS); } }
    __syncthreads();
    for (int g = 0; g < 4; ++g) {
#pragma unroll
        for (int ps = 0; ps < 4; ++ps) { const int idx = ps * NTHR + tid, row = idx >> 4, c16 = idx & 15;
            *(LAS v4u*)(lds + SG_W + row * SP + c16 * 16) = *(const v4u*)(Wsp + ((size_t)g * 128 + row) * 128 + c16 * 8); }
        { const int s = tid & 127, c0 = (tid >> 7) * 32; const float mu = st[s], rs = st[128 + s];
#pragma unroll
          for (int q4 = 0; q4 < 4; ++q4) { const int cb = c0 + q4 * 8;
              const v4u raw = *(const v4u*)(PROJ + (tok0 + s) * NPROJ + PC_VS + g * 128 + cb); const unsigned rw[4] = {raw.x, raw.y, raw.z, raw.w};
              const f32x4 lw0 = *(const f32x4*)(P.sg_ln_w + g * 128 + cb), lw1 = *(const f32x4*)(P.sg_ln_w + g * 128 + cb + 4), lb0 = *(const f32x4*)(P.sg_ln_b + g * 128 + cb), lb1 = *(const f32x4*)(P.sg_ln_b + g * 128 + cb + 4);
#pragma unroll
              for (int j = 0; j < 8; ++j) { const float gv = gelu_tanh(bf2f((rw[j >> 1] >> (16 * (j & 1))) & 0xffffu));
                  const float vn = (gv - mu) * rs * (j < 4 ? lw0[j & 3] : lw1[j & 3]) + (j < 4 ? lb0[j & 3] : lb1[j & 3]);
                  *(LAS unsigned short*)(lds + SG_VN + (cb + j) * SP + s * 2) = (unsigned short)f2bf(vn); } } }
        __syncthreads();
        { const int ct = w >> 1;
          const LAS unsigned char* arow = lds + SG_VN + (ct * 32 + l31) * SP + 16 * hh;
#pragma unroll
          for (int ti = 0; ti < 2; ++ti) { const int tt = (w & 1) * 2 + ti;
              const LAS unsigned char* brow = lds + SG_W + (tt * 32 + l31) * SP + 16 * hh;
              f32x16 acc;
#pragma unroll
              for (int r = 0; r < 16; ++r) acc[r] = 0.f;
              for (int ks = 0; ks < 2 * (tt + 1); ++ks) acc = __builtin_amdgcn_mfma_f32_32x32x16_bf16(lds_b128(arow + 32 * ks), lds_b128(brow + 32 * ks), acc, 0, 0, 0);
              const float bs = P.b_spatial[g * 128 + tt * 32 + l31];
              LAS unsigned char* orow = lds + SG_OT + (tt * 32 + l31) * SP + (ct * 32 + 4 * hh) * 2;
#pragma unroll
              for (int g4 = 0; g4 < 4; ++g4) { u32x2 pk; pk.x = cvtpk(acc[4 * g4] + bs, acc[4 * g4 + 1] + bs); pk.y = cvtpk(acc[4 * g4 + 2] + bs, acc[4 * g4 + 3] + bs); *(LAS u32x2*)(orow + 16 * g4) = pk; } } }
        __syncthreads();
        { const int t = tid >> 2, cg = (tid & 3) * 32;
#pragma unroll
          for (int q4 = 0; q4 < 4; ++q4) { const v4u mx = *(const LAS v4u*)(lds + SG_OT + t * SP + (cg + q4 * 8) * 2);
              const v4u ur = *(const v4u*)(PROJ + (tok0 + t) * NPROJ + PC_U + g * 128 + cg + q4 * 8);
              const unsigned mw[4] = {mx.x, mx.y, mx.z, mx.w}, uw[4] = {ur.x, ur.y, ur.z, ur.w}; unsigned ow[4];
#pragma unroll
              for (int j = 0; j < 4; ++j) { const float a0 = gelu_tanh(bf2f(uw[j] & 0xffffu)) * bf2f(mw[j] & 0xffffu), a1 = gelu_tanh(bf2f(uw[j] >> 16)) * bf2f(mw[j] >> 16); ow[j] = cvtpk(a0, a1); }
              *(v4u*)(MIX + (tok0 + t) * D + 512 + g * 128 + cg + q4 * 8) = (v4u){ow[0], ow[1], ow[2], ow[3]}; } }
    }
    __syncthreads();
}
__device__ __forceinline__ void moe_weight_items(const Ptrs& P, unsigned char* lds_generic, int gw, int ngw) {
    const int lane = threadIdx.x & 63, wave = __builtin_amdgcn_readfirstlane(threadIdx.x >> 6);
    float* scr = (float*)(lds_generic + wave * 16384);
    for (int it = gw; it < IT_GU + IT_DN; it += ngw) p0_weight_item(P, IT_IN + IT_OUT + it, scr, lane);
}
__device__ __forceinline__ void ph2_mix_fast(const Ptrs& P, LAS unsigned char* lds, unsigned char* lds_generic, int G) {
    const int bid = blockIdx.x, wave = __builtin_amdgcn_readfirstlane(threadIdx.x >> 6);
    if (G >= 128) {
        if (bid < 64) { for (int rep = 0; rep < ((PROBE_REPEAT == 21) ? 2 : 1); ++rep) gla_item(P, lds, bid); }
        else { for (int rep = 0; rep < ((PROBE_REPEAT == 20) ? 2 : 1); ++rep) for (int it = bid - 64; it < NB * 16; it += G - 64) sgu_item(P, lds, it);
               for (int rep = 0; rep < ((PROBE_REPEAT == 22) ? 2 : 1); ++rep) moe_weight_items(P, lds_generic, (bid - 64) * NWAVES + wave, (G - 64) * NWAVES); }
    } else {
        for (int it = bid; it < 64; it += G) gla_item(P, lds, it);
        for (int it = bid; it < NB * 16; it += G) sgu_item(P, lds, it);
        moe_weight_items(P, lds_generic, bid * NWAVES + wave, G * NWAVES);
    }
}

constexpr size_t WS_WR2 = WS_WSP + 256 * 1024;
__device__ __forceinline__ void p0_wr2(const Ptrs& P, int gtid, int gthreads) {
    f32x4* WR2 = (f32x4*)(P.ws + WS_WR2);
    for (int idx = gtid; idx < 64 * 2 * 64; idx += gthreads) { const int j = idx >> 7, tl = (idx >> 6) & 1, q = (idx >> 4) & 3, e = tl * 16 + (idx & 15); f32x4 o;
#pragma unroll
        for (int i = 0; i < 4; ++i) { const int k = 16 * j + 4 * q + i; o[i] = P.w_router[(size_t)k * NE + e] * P.norm_ffn_w[k]; }
        WR2[idx] = o; }
}
__device__ __forceinline__ bool rt_better(float va, int ia, float vb, int ib) { return va > vb || (va == vb && ia < ib); }
__device__ __forceinline__ void ph4_router_fast(const Ptrs& P, LAS unsigned char* lds, int G) {
    const int tid = threadIdx.x, lane = tid & 63, wave = __builtin_amdgcn_readfirstlane(tid >> 6), tk = lane & 15, q = lane >> 4;
    unsigned* ctl = (unsigned*)(P.ws + WS_CTL);
    LAS unsigned* lcnt = (LAS unsigned*)lds; LAS unsigned* lbase = lcnt + 32;
    const f32x4* WR2 = (const f32x4*)(P.ws + WS_WR2);
    const int NGRP = T / 16, rounds = (NGRP + G * NWAVES - 1) / (G * NWAVES);
    for (int rd = 0; rd < rounds; ++rd) {
        if (tid < 32) lcnt[tid] = 0u;
        __syncthreads();
        const int grp = (rd * G + (int)blockIdx.x) * NWAVES + wave; const bool act = grp < NGRP;
        const int m0 = (act ? grp : 0) * 16;
        const float* xrow = (const float*)(P.ws + WS_X1) + (size_t)(m0 + tk) * D + 4 * q;
        f32x4 d0 = {0.f, 0.f, 0.f, 0.f}, d1 = {0.f, 0.f, 0.f, 0.f}; float ssq = 0.f;
#pragma unroll 4
        for (int j = 0; j < 64; ++j) { const f32x4 xv = *(const f32x4*)(xrow + 16 * j); const f32x4 w0 = WR2[(j * 2 + 0) * 64 + lane], w1 = WR2[(j * 2 + 1) * 64 + lane];
            ssq += (xv[0] * xv[0] + xv[1] * xv[1]) + (xv[2] * xv[2] + xv[3] * xv[3]);
#pragma unroll
            for (int i = 0; i < 4; ++i) { d0 = __builtin_amdgcn_mfma_f32_16x16x4f32(w0[i], xv[i], d0, 0, 0, 0); d1 = __builtin_amdgcn_mfma_f32_16x16x4f32(w1[i], xv[i], d1, 0, 0, 0); } }
        ssq += __shfl_xor(ssq, 16); ssq += __shfl_xor(ssq, 32);
        const float rstd = 1.0f / sqrtf(ssq * (1.f / D) + EPS);
        float cv[8]; int ci[8];
#pragma unroll
        for (int r = 0; r < 4; ++r) { cv[r] = d0[r] * rstd + P.b_router[4 * q + r]; ci[r] = 4 * q + r; cv[4 + r] = d1[r] * rstd + P.b_router[16 + 4 * q + r]; ci[4 + r] = 16 + 4 * q + r; }
        float sv[4]; int si[4];
#pragma unroll
        for (int r = 0; r < 4; ++r) { float bv = cv[0]; int bi = ci[0];
#pragma unroll
            for (int c = 1; c < 8; ++c) if (rt_better(cv[c], ci[c], bv, bi)) { bv = cv[c]; bi = ci[c]; }
            sv[r] = bv; si[r] = bi;
#pragma unroll
            for (int c = 0; c < 8; ++c) if (ci[c] == bi) cv[c] = -3.0e38f; }
#pragma unroll
        for (int off = 16; off <= 32; off <<= 1) {
            float ov[4]; int oi[4];
#pragma unroll
            for (int r = 0; r < 4; ++r) { ov[r] = __shfl_xor(sv[r], off); oi[r] = __shfl_xor(si[r], off); }
            float mv[8]; int mi[8];
#pragma unroll
            for (int r = 0; r < 4; ++r) { mv[r] = sv[r]; mi[r] = si[r]; mv[4 + r] = ov[r]; mi[4 + r] = oi[r]; }
#pragma unroll
            for (int r = 0; r < 4; ++r) { float bv = mv[0]; int bi = mi[0];
#pragma unroll
                for (int c = 1; c < 8; ++c) if (rt_better(mv[c], mi[c], bv, bi)) { bv = mv[c]; bi = mi[c]; }
                sv[r] = bv; si[r] = bi;
#pragma unroll
                for (int c = 0; c < 8; ++c) if (mi[c] == bi) mv[c] = -3.0e38f; }
        }
        float pw[4], den = 0.f;
#pragma unroll
        for (int r = 0; r < 4; ++r) { pw[r] = __expf(sv[r] - sv[0]); den += pw[r]; }
        int ee = si[0]; float ww = pw[0];
#pragma unroll
        for (int r = 1; r < 4; ++r) if (q == r) { ee = si[r]; ww = pw[r]; }
        ww /= den;
        unsigned lr = 0u;
        if (act) lr = __hip_atomic_fetch_add(lcnt + ee, 1u, __ATOMIC_RELAXED, __HIP_MEMORY_SCOPE_WORKGROUP);
        __syncthreads();
        if (tid < 32) lbase[tid] = __hip_atomic_fetch_add(ctl + CW_COUNTS + tid, lcnt[tid], RLX_AGENT);
        __syncthreads();
        if (act) { const unsigned rank = lbase[ee] + lr; const int m = m0 + tk;
            ((int*)(P.ws + WS_ROUTE + RT_ROWTOK))[(size_t)ee * T + rank] = m;
            ((float*)(P.ws + WS_ROUTE + RT_ROWW))[(size_t)ee * T + rank] = ww;
            ((int*)(P.ws + WS_ROUTE + RT_TOKSLOT))[(size_t)m * 4 + q] = (ee << 16) | (int)rank;
            bf16* H2 = (bf16*)(P.ws + WS_H);
            for (int tt = 0; tt < 16; ++tt) { const float rs = __shfl(rstd, tt); const f32x4* xr = (const f32x4*)((const float*)(P.ws + WS_X1) + (size_t)(m0 + tt) * D);
#pragma unroll
                for (int j = 0; j < 4; ++j) { const f32x4 v = xr[lane + 64 * j], nwv = ((const f32x4*)P.norm_ffn_w)[lane + 64 * j];
                    if (MOE_FP8) ((unsigned*)((unsigned char*)H2 + (size_t)(m0 + tt) * D))[lane + 64 * j] = pk4_fp8(v[0] * rs * nwv[0] * F8S_H, v[1] * rs * nwv[1] * F8S_H, v[2] * rs * nwv[2] * F8S_H, v[3] * rs * nwv[3] * F8S_H);
                    else ((uint2*)(H2 + (size_t)(m0 + tt) * D))[lane + 64 * j] = make_uint2(cvtpk(v[0] * rs * nwv[0], v[1] * rs * nwv[1]), cvtpk(v[2] * rs * nwv[2], v[3] * rs * nwv[3])); } } }
        __syncthreads();
    }
}

struct Args { Ptrs P; int ph_lo, ph_hi, li, pad; };

__device__ __forceinline__ void ph0_prep(const Ptrs& P, unsigned char* lds_generic, int vcu, int G) {
    const int tid = threadIdx.x, lane = tid & 63, wave = __builtin_amdgcn_readfirstlane(tid >> 6);
    float* scr = (float*)(lds_generic + wave * 16384);
    const int gw = vcu * NWAVES + wave, NGW = G * NWAVES;
    for (int it = gw; it < IT_IN + IT_OUT; it += NGW) p0_weight_item(P, it, scr, lane);
    bf16* Wsp = (bf16*)(P.ws + WS_WSP);
    for (int i = blockIdx.x * NTHR + tid; i < 4 * 128 * 128; i += G * NTHR) { const int t = (i >> 7) & 127, s = i & 127; Wsp[i] = (bf16)f2bf(s <= t ? P.w_spatial[i] : 0.f); }
    p0_wr2(P, blockIdx.x * NTHR + tid, G * NTHR);
    bf16* H = (bf16*)(P.ws + WS_H);
    for (int m = gw; m < T; m += NGW) rms_row_to_bf16(P.x + (size_t)m * D, P.norm_mix_w, H + (size_t)m * D, lane);
}
__device__ __forceinline__ void moe_tables(const Ptrs& P, LAS int* tab) {
    const unsigned* ctl = (const unsigned*)(P.ws + WS_CTL);
    if (threadIdx.x < NE) tab[66 + threadIdx.x] = (int)__hip_atomic_load(ctl + CW_COUNTS + threadIdx.x, RLX_AGENT);
    __syncthreads();
    if (threadIdx.x == 0) { int a = 0; for (int e = 0; e < NE; ++e) { tab[e] = a; tab[33 + e] = a * MT; a += (tab[66 + e] + MT - 1) / MT; } tab[NE] = a; tab[33 + NE] = a * MT; }
    __syncthreads();
}
__device__ __forceinline__ void ph7_final(const Ptrs& P, const LAS int* tab, int G) {
    const int tid = threadIdx.x, lane = tid & 63, wave = tid >> 6;
    const bf16* Y = (const bf16*)(P.ws + WS_YBUF);
    for (int m = blockIdx.x * NWAVES + wave; m < T; m += G * NWAVES) {
        const float* X1 = (const float*)(P.ws + WS_X1) + (size_t)m * D;
        const int* ts = (const int*)(P.ws + WS_ROUTE + RT_TOKSLOT) + (size_t)m * 4;
        f32x4 v[4];
#pragma unroll
        for (int j = 0; j < 4; ++j) v[j] = ((const f32x4*)X1)[lane + 64 * j];
#pragma unroll
        for (int r = 0; r < 4; ++r) { const int pk = ts[r]; const size_t slot = (size_t)tab[33 + (pk >> 16)] + (pk & 0xffff);
#pragma unroll
            for (int j = 0; j < 4; ++j) {
                if (MOE_FP8) { const int y = ((const int*)((const unsigned char*)Y + slot * D))[lane + 64 * j]; const auto lo = __builtin_amdgcn_cvt_pk_f32_fp8(y, false), hi = __builtin_amdgcn_cvt_pk_f32_fp8(y, true);
                    v[j].x += lo[0] * (1.0f / F8S_Y); v[j].y += lo[1] * (1.0f / F8S_Y); v[j].z += hi[0] * (1.0f / F8S_Y); v[j].w += hi[1] * (1.0f / F8S_Y); }
                else { const uint2 y = ((const uint2*)(Y + slot * D))[lane + 64 * j];
                    v[j].x += bf2f(y.x & 0xffffu); v[j].y += bf2f(y.x >> 16); v[j].z += bf2f(y.y & 0xffffu); v[j].w += bf2f(y.y >> 16); } } }
        float s = 0.f;
#pragma unroll
        for (int j = 0; j < 4; ++j) s += (v[j].x * v[j].x + v[j].y * v[j].y) + (v[j].z * v[j].z + v[j].w * v[j].w);
        const float rstd = 1.0f / sqrtf(wave_sum(s) * (1.f / D) + EPS);
#pragma unroll
        for (int j = 0; j < 4; ++j) { const f32x4 ww = ((const f32x4*)P.norm_final_w)[lane + 64 * j];
            ((f32x4*)(P.out + (size_t)m * D))[lane + 64 * j] = (f32x4){v[j].x * rstd * ww.x, v[j].y * rstd * ww.y, v[j].z * rstd * ww.z, v[j].w * rstd * ww.w}; }
    }
}

constexpr int NPHASE = 8;
__global__ void __launch_bounds__(NTHR, 2) mk_fwd(Args args) {
    extern __shared__ __attribute__((aligned(16))) unsigned char lds_raw[];
    LAS unsigned char* lds = (LAS unsigned char*)lds_raw;
    const Ptrs& P = args.P;
    const int tid = threadIdx.x, G = gridDim.x;
    const int vcu = (G % 8 == 0) ? ((int)blockIdx.x % 8) * (G / 8) + (int)blockIdx.x / 8 : (int)blockIdx.x;
    volatile LAS unsigned* MISC = (volatile LAS unsigned*)(lds + MISC_OFF);
    LAS int* tab = (LAS int*)(lds + TAB_OFF);
    if (tid < 64) MISC[tid] = 0u;
    __syncthreads();
    unsigned* ctl = (unsigned*)(P.ws + WS_CTL);
    XcdBarrier bar = xcd_barrier_post(ctl + CW_BAR + args.li * XCD_BAR_WORDS, MISC + 8);
    const int lo = args.ph_lo, hi = args.ph_hi;
#define IN(k) (lo <= (k) && (k) < hi)
#define NREP(k) ((PROBE_REPEAT == (k)) ? 2 : 1)
#define PH(k, ...) if (IN(k)) { for (int rep = 0; rep < NREP(k); ++rep) { __VA_ARGS__; if (rep + 1 < NREP(k) || IN((k) + 1)) xcd_barrier(bar); } }
    PH(0, ph0_prep(P, lds_raw, vcu, G));
    PH(1, { pg8::DenseSched S; S.init(T, NPROJ, D, G, (int)blockIdx.x); pg8::EpiProj E{(bf16*)(P.ws + WS_PROJ)};
            pg8::gemm_phase(lds, lds + AUX_OFF, (const char*)(P.ws + WS_H), (const char*)(P.ws + WS_WIN), D, S, E); });
    PH(2, ph2_mix_fast(P, lds, lds_raw, G));
    PH(3, { pg8::DenseSched S; S.init(T, D, D, G, (int)blockIdx.x); pg8::EpiX1 E{P.x, (float*)(P.ws + WS_X1)};
            pg8::gemm_phase(lds, lds + AUX_OFF, (const char*)(P.ws + WS_MIX), (const char*)(P.ws + WS_WOUT), D, S, E); });
    PH(4, ph4_router_fast(P, lds, G));
    if (IN(5) || IN(6) || IN(7)) moe_tables(P, tab);
    constexpr int KM = MOE_FP8 ? D / 2 : D;
    PH(5, { pg8::MoeSched<true> S{tab, (const int*)(P.ws + WS_ROUTE + RT_ROWTOK), 8, G, (int)blockIdx.x, __builtin_amdgcn_readfirstlane(tab[NE]) * 8, KM, 2048};
            pg8::EpiAct E{(bf16*)(P.ws + WS_ACT), P.b_gate_up};
            pg8::gemm_phase<MOE_FP8 != 0>(lds, lds + AUX_OFF, (const char*)(P.ws + WS_H), (const char*)(P.ws + WS_WGU), KM, S, E); });
    PH(6, { pg8::MoeSched<false> S{tab, nullptr, 4, G, (int)blockIdx.x, __builtin_amdgcn_readfirstlane(tab[NE]) * 4, KM, 1024};
            pg8::EpiDown E{(bf16*)(P.ws + WS_YBUF), P.b_down, (const float*)(P.ws + WS_ROUTE + RT_ROWW)};
            pg8::gemm_phase<MOE_FP8 != 0>(lds, lds + AUX_OFF, (const char*)(P.ws + WS_ACT), (const char*)(P.ws + WS_WD), KM, S, E); });
    PH(7, ph7_final(P, tab, G));
#undef IN
#undef NREP
#undef PH
}

#ifndef MK_SEGMENTS
#define MK_SEGMENTS 1
#endif
extern "C" void kernel_launch(void* const* d_in, const int* in_sizes, int n_in, void* d_out, int out_size, void* d_ws, size_t ws_size, hipStream_t stream) {
    if (n_in != 19 || out_size != T * D || ws_size < WS_END) { fprintf(stderr, "kernel_launch: unexpected shapes n_in %d out %d ws %zu (need %zu)\n", n_in, out_size, ws_size, (size_t)WS_END); return; }
    static int grid = 0;
    if (grid == 0) {
        int dev = 0, cus = 0, per_cu = 0;
        if (hipGetDevice(&dev) != hipSuccess || hipDeviceGetAttribute(&cus, hipDeviceAttributeMultiprocessorCount, dev) != hipSuccess) { fprintf(stderr, "kernel_launch: device query failed\n"); grid = -1; return; }
        if (hipFuncSetAttribute((const void*)mk_fwd, hipFuncAttributeMaxDynamicSharedMemorySize, LDS_BYTES) != hipSuccess) { fprintf(stderr, "kernel_launch: hipFuncSetAttribute failed\n"); grid = -1; return; }
        if (hipOccupancyMaxActiveBlocksPerMultiprocessor(&per_cu, (const void*)mk_fwd, NTHR, LDS_BYTES) != hipSuccess || per_cu < 1) { fprintf(stderr, "kernel_launch: occupancy query says %d\n", per_cu); per_cu = 1; }
        (void)hipGetLastError();
        grid = cus;
        fprintf(stderr, "kernel_launch: cus %d per_cu %d grid %d\n", cus, per_cu, grid);
    }
    if (grid < 0) return;
    Args a{};
    const float** pp = (const float**)&a.P;
    for (int i = 0; i < 19; ++i) pp[i] = (const float*)d_in[i];
    a.P.out = (float*)d_out; a.P.ws = (unsigned char*)d_ws;
    (void)hipMemsetAsync((char*)d_ws + WS_CTL, 0, MiB, stream);
#if MK_SEGMENTS == 1
    a.ph_lo = 0; a.ph_hi = NPHASE; a.li = 0;
    void* kargs[] = {&a};
    hipError_t e = hipLaunchCooperativeKernel((const void*)mk_fwd, dim3(grid), dim3(NTHR), kargs, LDS_BYTES, stream);
    if (e != hipSuccess) fprintf(stderr, "kernel_launch: cooperative launch failed: %s (grid %d)\n", hipGetErrorString(e), grid);
#else
    for (int ph = 0; ph < NPHASE; ++ph) { a.ph_lo = ph; a.ph_hi = ph + 1; a.li = ph; hipLaunchKernelGGL(mk_fwd, dim3(grid), dim3(NTHR), LDS_BYTES, stream, a); }
#endif
}
```

```cpp
#include <hip/hip_runtime.h>
#include <cstdio>
#include <cstdint>

constexpr int T = 32768, D = 1024, SEQ = 2048, NB = 16;
constexpr int NIN_SRC = 2576, NPROJ = 2816;
constexpr int PC_Q = 0, PC_K = 256, PC_V = 512, PC_G = 1024, PC_GK = 1536, PC_U = 1792, PC_VS = 2304;
constexpr int NE = 32, TOPK = 4, DE = 1024;
constexpr int MT = 256;
constexpr int MAXSLOTS = T * TOPK + NE * MT;
constexpr float EPS = 1e-6f;

typedef unsigned short bf16;
typedef unsigned v4u __attribute__((ext_vector_type(4)));
typedef float f32x4 __attribute__((ext_vector_type(4)));

constexpr size_t MiB = 1u << 20;
constexpr size_t WS_CTL   = 0;
constexpr size_t WS_WIN   = 1 * MiB;
constexpr size_t WS_WOUT  = 7 * MiB;
constexpr size_t WS_WSP   = 9 * MiB;
constexpr size_t WS_ROUTE = 10 * MiB;
constexpr size_t WS_WGU   = 20 * MiB;
constexpr size_t WS_WD    = 148 * MiB;
constexpr size_t WS_X1    = 212 * MiB;
constexpr size_t WS_ACT   = 340 * MiB;
constexpr size_t WS_PROJ  = 612 * MiB;
constexpr size_t WS_MIX   = 788 * MiB;
constexpr size_t WS_H     = 852 * MiB;
constexpr size_t WS_YBUF  = WS_PROJ;
constexpr size_t WS_A1    = WS_X1;
constexpr size_t WS_X1B   = WS_X1 + 64 * MiB;
constexpr size_t WS_RRSTD = WS_H + 32 * MiB;
constexpr size_t WS_VN    = WS_ACT;
constexpr size_t WS_END   = 916 * MiB;
static_assert(WS_YBUF + (size_t)MAXSLOTS * 1024 * 2 <= WS_END, "ybuf fits");
static_assert(WS_ACT + (size_t)MAXSLOTS * 1024 * 2 <= WS_PROJ, "act fits");
constexpr size_t RT_ROWTOK = 0;
constexpr size_t RT_ROWW   = 4 * MiB;
constexpr size_t RT_TOKSLOT= 8 * MiB;
constexpr int CW_COUNTS = 64;
constexpr int CW_PSTART = 128;

__device__ __forceinline__ unsigned f2bf(float f) { unsigned u = __builtin_bit_cast(unsigned, f); return (u + 0x7fffu + ((u >> 16) & 1u)) >> 16; }
__device__ __forceinline__ float bf2f(unsigned h) { return __builtin_bit_cast(float, h << 16); }
__device__ __forceinline__ unsigned pk2(float lo, float hi) { return f2bf(lo) | (f2bf(hi) << 16); }
#ifndef MOE_FP8
#define MOE_FP8 1
#endif
constexpr float F8S_H = 8.0f, F8S_W = 32.0f, F8S_ACT = 4.0f, F8S_Y = 64.0f;
__device__ __forceinline__ float f8clamp(float x) { return fminf(fmaxf(x, -448.0f), 448.0f); }
__device__ __forceinline__ unsigned pk4_fp8(float a, float b, float c, float d) {
    int w = 0; w = __builtin_amdgcn_cvt_pk_fp8_f32(f8clamp(a), f8clamp(b), w, false); w = __builtin_amdgcn_cvt_pk_fp8_f32(f8clamp(c), f8clamp(d), w, true); return (unsigned)w; }
__device__ __forceinline__ unsigned pk4_fp8_nc(float a, float b, float c, float d) { int w = 0; w = __builtin_amdgcn_cvt_pk_fp8_f32(a, b, w, false); w = __builtin_amdgcn_cvt_pk_fp8_f32(c, d, w, true); return (unsigned)w; }
__device__ __forceinline__ float gelu_tanh(float x) { const float u = 0.7978845608028654f * (x + 0.044715f * x * x * x); return x / (1.0f + __expf(-2.0f * u)); }
__device__ __forceinline__ float silu(float x) { return x / (1.0f + __expf(-x)); }
__device__ __forceinline__ float log_sigmoid(float x) { return fminf(x, 0.0f) - log1pf(__expf(-fabsf(x))); }
template <int CTRL, int ROWMASK> __device__ __forceinline__ float dpp_f(float v) {
    return __builtin_bit_cast(float, __builtin_amdgcn_update_dpp(0, __builtin_bit_cast(int, v), CTRL, ROWMASK, 0xF, true)); }
__device__ __forceinline__ float wave_incl_scan(float v) {
    v += dpp_f<0x111, 0xF>(v); v += dpp_f<0x112, 0xF>(v); v += dpp_f<0x114, 0xF>(v); v += dpp_f<0x118, 0xF>(v);
    v += dpp_f<0x142, 0xA>(v); v += dpp_f<0x143, 0xC>(v); return v; }
__device__ __forceinline__ float wave_sum(float v) { return __builtin_bit_cast(float, __builtin_amdgcn_readlane(__builtin_bit_cast(int, wave_incl_scan(v)), 63)); }

struct Ptrs {
    const float *x, *norm_mix_w, *w_in, *w_gk_up, *b_gk, *gla_norm_w, *sg_ln_w, *sg_ln_b, *w_spatial, *b_spatial, *w_out, *norm_ffn_w,
                *w_router, *b_router, *w_gate_up, *b_gate_up, *w_down, *b_down, *norm_final_w;
    float* out; unsigned char* ws;
};

__device__ __forceinline__ void p0_tr_write(bf16* WT, int K, int d0, int k0, const float* scr, int lane) {
    const int c = lane & 7;
#pragma unroll
    for (int j = 0; j < 4; ++j) { const int n = (lane >> 3) + 8 * j; const float* s = scr + (8 * c) * 33 + n;
        v4u o; o.x = pk2(s[0 * 33], s[1 * 33]); o.y = pk2(s[2 * 33], s[3 * 33]); o.z = pk2(s[4 * 33], s[5 * 33]); o.w = pk2(s[6 * 33], s[7 * 33]);
        *(v4u*)(WT + (size_t)(d0 + n) * K + k0 + 8 * c) = o; }
}
__device__ __forceinline__ void p0_tr_write_f8(unsigned char* WT, int K, int d0, int k0, const float* scr, int lane, float sc) {
    const int c = lane & 7;
#pragma unroll
    for (int j = 0; j < 4; ++j) { const int n = (lane >> 3) + 8 * j; const float* s = scr + (8 * c) * 33 + n;
        uint2 o; o.x = pk4_fp8(s[0 * 33] * sc, s[1 * 33] * sc, s[2 * 33] * sc, s[3 * 33] * sc); o.y = pk4_fp8(s[4 * 33] * sc, s[5 * 33] * sc, s[6 * 33] * sc, s[7 * 33] * sc);
        *(uint2*)(WT + (size_t)(d0 + n) * K + k0 + 8 * c) = o; }
}
template <bool F8 = false>
__device__ __forceinline__ void p0_transpose_item(const float* W, int ldn, int n0, int k0, bf16* WT, int K, int d0, float* scr, int lane) {
    float v[32];
    const float* src = W + (size_t)(k0 + (lane >> 5)) * ldn + n0 + (lane & 31);
#pragma unroll
    for (int i = 0; i < 32; ++i) v[i] = __builtin_nontemporal_load(src + (size_t)(2 * i) * ldn);
#pragma unroll
    for (int i = 0; i < 32; ++i) scr[(2 * i + (lane >> 5)) * 33 + (lane & 31)] = v[i];
    __builtin_amdgcn_wave_barrier(); asm volatile("s_waitcnt lgkmcnt(0)" ::: "memory");
    if constexpr (F8) p0_tr_write_f8((unsigned char*)WT, K, d0, k0, scr, lane, F8S_W); else p0_tr_write(WT, K, d0, k0, scr, lane);
    asm volatile("s_waitcnt lgkmcnt(0)" ::: "memory"); __builtin_amdgcn_wave_barrier();
}
__device__ __forceinline__ void p0_gk_item(const float* w_in, const float* w_gk_up, int j0, int k0, bf16* WT, float* scr, int lane) {
    for (int i = 0; i < 32; ++i) { const int kk = 2 * i + (lane >> 5), j = j0 + (lane & 31); float s = 0.f;
#pragma unroll
        for (int r = 0; r < 16; ++r) s += w_in[(size_t)(k0 + kk) * NIN_SRC + 1536 + r] * w_gk_up[r * 256 + j];
        scr[kk * 33 + (lane & 31)] = s; }
    __builtin_amdgcn_wave_barrier(); asm volatile("s_waitcnt lgkmcnt(0)" ::: "memory");
    p0_tr_write(WT, D, PC_GK + j0, k0, scr, lane);
    asm volatile("s_waitcnt lgkmcnt(0)" ::: "memory"); __builtin_amdgcn_wave_barrier();
}
constexpr int IT_IN = (NPROJ / 32) * 16, IT_OUT = 32 * 16, IT_GU = NE * 64 * 16, IT_DN = NE * 32 * 16, IT_ALL = IT_IN + IT_OUT + IT_GU + IT_DN;
__device__ __forceinline__ void p0_weight_item(const Ptrs& P, int it, float* scr, int lane) {
    bf16* WinT = (bf16*)(P.ws + WS_WIN); bf16* WoutT = (bf16*)(P.ws + WS_WOUT); bf16* WguT = (bf16*)(P.ws + WS_WGU); bf16* WdT = (bf16*)(P.ws + WS_WD);
    if (it < IT_IN) { const int db = it / 16, kb = it % 16, d0 = db * 32;
        if (d0 >= PC_GK && d0 < PC_U) p0_gk_item(P.w_in, P.w_gk_up, d0 - PC_GK, kb * 64, WinT, scr, lane);
        else p0_transpose_item(P.w_in, NIN_SRC, d0 < PC_GK ? d0 : d0 - 240, kb * 64, WinT, D, d0, scr, lane);
        return; }
    it -= IT_IN;
    if (it < IT_OUT) { const int db = it / 16, kb = it % 16; p0_transpose_item(P.w_out, D, db * 32, kb * 64, WoutT, D, db * 32, scr, lane); return; }
    it -= IT_OUT;
    if (it < IT_GU) { const int e = it / 1024, r = it % 1024, db = r / 16, kb = r % 16, d0 = db * 32, pn = d0 >> 8, bj = (d0 >> 7) & 1, rr = d0 & 127;
        if (MOE_FP8) p0_transpose_item<true>(P.w_gate_up + (size_t)e * D * 2048, 2048, bj * 1024 + 128 * pn + rr, kb * 64, (bf16*)((unsigned char*)WguT + (size_t)e * 2048 * D), D, d0, scr, lane);
        else p0_transpose_item(P.w_gate_up + (size_t)e * D * 2048, 2048, bj * 1024 + 128 * pn + rr, kb * 64, WguT + (size_t)e * 2048 * D, D, d0, scr, lane);
        return; }
    it -= IT_GU;
    { const int e = it / 512, r = it % 512, db = r / 16, kb = r % 16;
      if (MOE_FP8) p0_transpose_item<true>(P.w_down + (size_t)e * DE * D, D, db * 32, kb * 64, (bf16*)((unsigned char*)WdT + (size_t)e * D * DE), DE, db * 32, scr, lane);
      else p0_transpose_item(P.w_down + (size_t)e * DE * D, D, db * 32, kb * 64, WdT + (size_t)e * D * DE, DE, db * 32, scr, lane); }
}
__device__ __forceinline__ void rms_row_to_bf16(const float* xrow, const float* w, bf16* orow, int lane) {
    const f32x4* xr = (const f32x4*)xrow + lane; const f32x4* wr = (const f32x4*)w + lane;
    f32x4 v[4]; float s = 0.f;
#pragma unroll
    for (int j = 0; j < 4; ++j) { v[j] = xr[64 * j]; s += (v[j].x * v[j].x + v[j].y * v[j].y) + (v[j].z * v[j].z + v[j].w * v[j].w); }
    const float rstd = 1.0f / sqrtf(wave_sum(s) * (1.f / D) + EPS);
    unsigned long long* o8 = (unsigned long long*)orow + lane;
#pragma unroll
    for (int j = 0; j < 4; ++j) { const f32x4 ww = wr[64 * j];
        o8[64 * j] = (unsigned long long)pk2(v[j].x * rstd * ww.x, v[j].y * rstd * ww.y) | ((unsigned long long)pk2(v[j].z * rstd * ww.z, v[j].w * rstd * ww.w) << 32); }
}

#ifndef PROBE_STAMP
#define PROBE_STAMP -1
#endif
#ifndef PROBE_REPEAT
#define PROBE_REPEAT -1
#endif
#define LAS __attribute__((address_space(3)))
__device__ __forceinline__ int opaque_tid() { int t = threadIdx.x; asm volatile("" : "+v"(t)); return t; }
typedef short bf16x8 __attribute__((ext_vector_type(8)));
typedef unsigned u32x4 __attribute__((ext_vector_type(4)));
constexpr int NWAVES = 8, NTHR = 512;
constexpr int RING_BYTES = 131072, TAB_OFF = RING_BYTES, MISC_OFF = RING_BYTES + 1024, AUX_OFF = RING_BYTES + 2048, AUX_ROWTAB = 0, AUX_SLOTS = 8192, AUX_SLOT_BYTES = 2048, LDS_BYTES = AUX_OFF + 16384;
constexpr int CW_BAR = 4096;
#define RLX_AGENT __ATOMIC_RELAXED, __HIP_MEMORY_SCOPE_AGENT

#define XB_TMO      128
#define XB_XCNT(j)  (256  + 64 * (j))
#define XB_XSUB(j)  (1280 + 64 * (j))
#define XB_XGEN(j)  (2304 + 64 * (j))
#define XB_TOP      3328
#define XB_TOPGEN   3392
#define XCD_BAR_WORDS 3456
#define XB_SPIN_CAP (1u << 20)
__device__ __forceinline__ unsigned xb_ld(unsigned* p)              { return __hip_atomic_load(p, __ATOMIC_RELAXED, __HIP_MEMORY_SCOPE_AGENT); }
__device__ __forceinline__ unsigned xb_add(unsigned* p, unsigned v) { return __hip_atomic_fetch_add(p, v, __ATOMIC_RELAXED, __HIP_MEMORY_SCOPE_AGENT); }
__device__ __forceinline__ unsigned xb_xcc_id() { return (unsigned)__builtin_amdgcn_s_getreg((3 << 11) | 20) & 0xFu; }
#define XB_SPIN(cond, bar) do { unsigned _sp = 0; while (cond) { __builtin_amdgcn_s_sleep(1); \
    if ((++_sp & 255u) == 0u) { if (xb_ld(&(bar)[XB_TMO])) break; if (_sp > XB_SPIN_CAP) { atomicAdd(&(bar)[XB_TMO], 1u); break; } } } } while (0)
struct XcdBarrier { unsigned* bar; unsigned x; volatile LAS unsigned* st; };
__device__ __forceinline__ XcdBarrier xcd_barrier_post(unsigned* bar, volatile LAS unsigned* st) {
    XcdBarrier b; b.bar = bar; b.x = xb_xcc_id(); b.st = st;
    if (threadIdx.x == 0) (void)xb_add(&bar[XB_XCNT(b.x)], 1u);
    return b;
}
__device__ __forceinline__ void xcd_barrier_complete(unsigned* bar, unsigned x, unsigned& nloc, unsigned& nx) {
    const unsigned G = gridDim.x * gridDim.y * gridDim.z;
    unsigned sum, cnt, mine, sp = 0u;
    for (;;) {
        sum = 0u; cnt = 0u; mine = 0u;
#pragma unroll
        for (unsigned j = 0; j < 16; ++j) { const unsigned c = xb_ld(&bar[XB_XCNT(j)]); sum += c; cnt += (c > 0u) ? 1u : 0u; mine = (j == x) ? c : mine; }
        if (sum == G) break;
        __builtin_amdgcn_s_sleep(1);
        if ((++sp & 255u) == 0u) { if (xb_ld(&bar[XB_TMO])) break; if (sp > XB_SPIN_CAP) { atomicAdd(&bar[XB_TMO], 1u); break; } }
    }
    nloc = mine > 0u ? mine : 1u; nx = cnt > 0u ? cnt : 1u;
}
__device__ __forceinline__ void xcd_barrier(const XcdBarrier& b) {
    asm volatile("s_waitcnt vmcnt(0)" ::: "memory");
    __syncthreads();
    if (threadIdx.x == 0) {
        unsigned* bar = b.bar;
        __builtin_amdgcn_s_waitcnt(0);
        unsigned nloc = b.st[0], nx = b.st[1];
        if (nloc == 0u) { xcd_barrier_complete(bar, b.x, nloc, nx); b.st[0] = nloc; b.st[1] = nx; }
        const unsigned old = xb_add(&bar[XB_XSUB(b.x)], 1u);
        const unsigned gen = old / nloc;
        if (old + 1u == (gen + 1u) * nloc) {
            __builtin_amdgcn_fence(__ATOMIC_RELEASE, "agent");
            asm volatile("s_waitcnt vmcnt(0)" ::: "memory");
            const unsigned og = xb_add(&bar[XB_TOP], 1u);
            const unsigned tg = og / nx;
            if (og + 1u == (tg + 1u) * nx) xb_add(&bar[XB_TOPGEN], 1u);
            else XB_SPIN(xb_ld(&bar[XB_TOPGEN]) == tg, bar);
            __builtin_amdgcn_fence(__ATOMIC_ACQUIRE, "agent");
            xb_add(&bar[XB_XGEN(b.x)], 1u);
            asm volatile("s_waitcnt vmcnt(0)" ::: "memory");
        } else {
            XB_SPIN(xb_ld(&bar[XB_XGEN(b.x)]) == gen, bar);
            __builtin_amdgcn_fence(__ATOMIC_ACQUIRE, "agent");
            asm volatile("s_waitcnt vmcnt(0)" ::: "memory");
        }
    }
    __syncthreads();
}

namespace pg8 {
constexpr int BM = 256, BK = 64, HALF = 128, HTB = HALF * BK * 2, NXCD = 8, WGM = 8;
__device__ __forceinline__ int lds_byte(int r, int c) { const int st = (r >> 4) * 2 + (c >> 5), rr = r & 15, cc = c & 31, ob = rr * 64 + cc * 2; return st * 1024 + (ob ^ (((ob >> 9) & 1) << 5)); }
__device__ __forceinline__ void stage_rc(int b, int& R, int& C) { const int st = b / 1024, sb = b % 1024, swz = sb ^ (((sb >> 9) & 1) << 5); R = (st >> 1) * 16 + swz / 64; C = (st & 1) * 32 + (swz % 64) / 2; }
__device__ __forceinline__ int perm32(int rho) { const int n = rho >> 4, i = rho & 15; return 8 * (i >> 2) + 4 * n + (i & 3); }
typedef float f32x2_t __attribute__((ext_vector_type(2)));
typedef __bf16 bf16x2_t __attribute__((ext_vector_type(2)));
__device__ __forceinline__ unsigned cvt_pk_bf16(float lo, float hi) { const f32x2_t v = {lo, hi}; const bf16x2_t b = __builtin_convertvector(v, bf16x2_t); return __builtin_bit_cast(unsigned, b); }
__device__ __forceinline__ int xcd_remap(int wgid, int nwg) { const int q = nwg / NXCD, r = nwg % NXCD, xcd = wgid % NXCD, off = wgid / NXCD; return (xcd < r ? xcd * (q + 1) : r * (q + 1) + (xcd - r) * q) + off; }

struct Unit { int pm, pn, e, m0, count, slot0; };
typedef f32x4 Acc[2][2][4][2];

struct DenseSched {
    int nM, nN, nwg, G, c, K;
    __device__ __forceinline__ void init(int M, int N, int K_, int G_, int c_) { nM = M / BM; nN = N / BM; nwg = nM * nN; G = G_; c = c_; K = K_; }
    __device__ __forceinline__ bool next(int i, Unit& u) const {
        const long L = (long)i * G + c; if (L >= nwg) return false;
        const int wgid = xcd_remap((int)L, nwg);
        const int nig = WGM * nN, gid = wgid / nig, fm = gid * WGM, gsz = (nM - fm) < WGM ? (nM - fm) : WGM;
        u.pm = fm + ((wgid % nig) % gsz); u.pn = (wgid % nig) / gsz; u.e = 0; u.m0 = 0; u.count = 0; u.slot0 = 0; return true;
    }
    static constexpr bool GATHER = false;
    __device__ __forceinline__ unsigned a_off(const Unit& u, int r) const { return (unsigned)(u.pm * BM + r) * (unsigned)(K * 2); }
    __device__ __forceinline__ const int* row_src(const Unit&, int) const { return nullptr; }
    __device__ __forceinline__ size_t b_off(const Unit& u) const { return (size_t)u.pn * BM * K * 2; }
};
template <bool GATHER_>
struct MoeSched {
    static constexpr bool GATHER = GATHER_;
    const LAS int* tab; const int* rowtok; int NPN, G, c, ntile, K, NB_E  ;
    __device__ __forceinline__ bool next(int i, Unit& u) const {
        const long L = (long)i * G + c; if (L >= ntile) return false;
        const int wgid = xcd_remap((int)L, ntile);
        int lo = 0, hi = NE;
#pragma unroll
        for (int s = 0; s < 5; ++s) { const int mid = (lo + hi) >> 1; if (__builtin_amdgcn_readfirstlane(tab[mid]) * NPN <= wgid) lo = mid; else hi = mid; }
        const int e = lo, t0 = __builtin_amdgcn_readfirstlane(tab[e]), mte = __builtin_amdgcn_readfirstlane(tab[e + 1]) - t0, local = wgid - t0 * NPN;
        u.e = e; u.pn = local / mte; u.pm = 0; u.m0 = (local % mte) * BM; u.count = __builtin_amdgcn_readfirstlane(tab[66 + e]); u.slot0 = __builtin_amdgcn_readfirstlane(tab[33 + e]); return true;
    }
    __device__ __forceinline__ const int* row_src(const Unit& u, int r) const { int m = u.m0 + r; m = m < u.count ? m : u.count - 1; return rowtok + (size_t)u.e * T + m; }
    __device__ __forceinline__ unsigned a_off(const Unit& u, int r) const {
        if (GATHER) return (unsigned)(*row_src(u, r)) * (unsigned)(K * 2);
        return (unsigned)(u.slot0 + u.m0 + r) * (unsigned)(K * 2);
    }
    __device__ __forceinline__ size_t b_off(const Unit& u) const { return ((size_t)u.e * NB_E + (size_t)u.pn * BM) * K * 2; }
};

struct EpiProj {
    static constexpr bool PERM = true, AUX = false;
    bf16* O;
    __device__ __forceinline__ const float* aux_src(const Unit&, int) const { return nullptr; }
    __device__ __forceinline__ void operator()(const Acc& acc, const Unit& u, int wr, int wc, int fr, int fq, const LAS float*) const {
        const int row0 = u.pm * BM + wr * 64 + fr, col0 = u.pn * BM + wc * 32 + 8 * fq;
#pragma unroll
        for (int ai = 0; ai < 2; ++ai)
#pragma unroll
            for (int m = 0; m < 4; ++m) { bf16* rowp = O + (size_t)(row0 + ai * HALF + m * 16) * NPROJ + col0;
#pragma unroll
                for (int bj = 0; bj < 2; ++bj) { const f32x4 v0 = acc[ai][bj][m][0], v1 = acc[ai][bj][m][1];
                    u32x4 w; w.x = cvt_pk_bf16(v0[0], v0[1]); w.y = cvt_pk_bf16(v0[2], v0[3]); w.z = cvt_pk_bf16(v1[0], v1[1]); w.w = cvt_pk_bf16(v1[2], v1[3]);
                    *(u32x4*)(rowp + bj * HALF) = w; } }
    }
};
struct EpiA1 {
    static constexpr bool PERM = true, AUX = false;
    bf16* O;
    __device__ __forceinline__ const float* aux_src(const Unit&, int) const { return nullptr; }
    __device__ __forceinline__ void operator()(const Acc& acc, const Unit& u, int wr, int wc, int fr, int fq, const LAS float*) const {
        const int row0 = u.pm * BM + wr * 64 + fr, col0 = u.pn * BM + wc * 32 + 8 * fq;
#pragma unroll
        for (int ai = 0; ai < 2; ++ai)
#pragma unroll
            for (int m = 0; m < 4; ++m) { bf16* rowp = O + (size_t)(row0 + ai * HALF + m * 16) * D + col0;
#pragma unroll
                for (int bj = 0; bj < 2; ++bj) { const f32x4 v0 = acc[ai][bj][m][0], v1 = acc[ai][bj][m][1];
                    u32x4 w; w.x = cvt_pk_bf16(v0[0], v0[1]); w.y = cvt_pk_bf16(v0[2], v0[3]); w.z = cvt_pk_bf16(v1[0], v1[1]); w.w = cvt_pk_bf16(v1[2], v1[3]);
                    *(u32x4*)(rowp + bj * HALF) = w; } }
    }
};
struct EpiAct {
    static constexpr bool PERM = true, AUX = true;
    bf16* O; const float* bgu; const float* rrstd;
    __device__ __forceinline__ const float* aux_src(const Unit& u, int idx) const {
        if (idx < 256) return bgu + (size_t)u.e * 2048 + (idx < 128 ? u.pn * 128 + idx : 1024 + u.pn * 128 + (idx - 128));
        int m = u.m0 + (idx - 256); m = m < u.count ? m : u.count - 1; return rrstd + (size_t)u.e * T + m; }
    __device__ __forceinline__ void operator()(const Acc& acc, const Unit& u, int wr, int wc, int fr, int fq, const LAS float* aux) const {
        const int colj = u.pn * 128 + wc * 32 + 8 * fq;
        const LAS float* bg = aux + wc * 32 + 8 * fq;
        const f32x4 g0 = *(const LAS f32x4*)bg, g1 = *(const LAS f32x4*)(bg + 4), u0 = *(const LAS f32x4*)(bg + 128), u1 = *(const LAS f32x4*)(bg + 132);
#pragma unroll
        for (int ai = 0; ai < 2; ++ai)
#pragma unroll
            for (int m = 0; m < 4; ++m) { const int r = ai * HALF + wr * 64 + m * 16 + fr;
                { float y[8]; const float rs = aux[256 + r] * (MOE_FP8 ? 1.0f / (F8S_H * F8S_W) : 1.0f);
#pragma unroll
                    for (int n = 0; n < 2; ++n)
#pragma unroll
                        for (int i = 0; i < 4; ++i) {
                            float g = acc[ai][0][m][n][i] * rs + (n ? g1[i] : g0[i]), up = acc[ai][1][m][n][i] * rs + (n ? u1[i] : u0[i]);
                            g = fminf(g, 7.0f); up = fminf(fmaxf(up, -7.0f), 7.0f); y[n * 4 + i] = (up + 1.0f) * g * __builtin_amdgcn_rcpf(1.0f + __expf(-1.702f * g)); }
                    if (MOE_FP8) { uint2 w; w.x = pk4_fp8_nc(y[0] * F8S_ACT, y[1] * F8S_ACT, y[2] * F8S_ACT, y[3] * F8S_ACT); w.y = pk4_fp8_nc(y[4] * F8S_ACT, y[5] * F8S_ACT, y[6] * F8S_ACT, y[7] * F8S_ACT);
                        *(uint2*)((unsigned char*)O + (size_t)(u.slot0 + u.m0 + r) * DE + colj) = w; }
                    else { u32x4 w; w.x = cvt_pk_bf16(y[0], y[1]); w.y = cvt_pk_bf16(y[2], y[3]); w.z = cvt_pk_bf16(y[4], y[5]); w.w = cvt_pk_bf16(y[6], y[7]);
                        *(u32x4*)(O + (size_t)(u.slot0 + u.m0 + r) * DE + colj) = w; } } }
    }
};
struct EpiDown {
    static constexpr bool PERM = true, AUX = true;
    bf16* O; const float* bd; const float* roww;
    __device__ __forceinline__ const float* aux_src(const Unit& u, int idx) const {
        if (idx < 256) return bd + (size_t)u.e * D + u.pn * BM + idx;
        int m = u.m0 + (idx - 256); m = m < u.count ? m : u.count - 1; return roww + (size_t)u.e * T + m; }
    __device__ __forceinline__ void operator()(const Acc& acc, const Unit& u, int wr, int wc, int fr, int fq, const LAS float* aux) const {
        const int col0 = u.pn * BM + wc * 32 + 8 * fq;
        const LAS float* bp = aux + wc * 32 + 8 * fq;
        f32x4 bv[2][2];
#pragma unroll
        for (int bj = 0; bj < 2; ++bj)
#pragma unroll
            for (int n = 0; n < 2; ++n) bv[bj][n] = *(const LAS f32x4*)(bp + bj * HALF + 4 * n);
#pragma unroll
        for (int ai = 0; ai < 2; ++ai)
#pragma unroll
            for (int m = 0; m < 4; ++m) { const int r = ai * HALF + wr * 64 + m * 16 + fr;
                { const float w8 = aux[256 + r]; bf16* rowp = O + (size_t)(u.slot0 + u.m0 + r) * D + col0;
#pragma unroll
                    for (int bj = 0; bj < 2; ++bj) { constexpr float isc = MOE_FP8 ? 1.0f / (F8S_ACT * F8S_W) : 1.0f;
                        const f32x4 v0 = (acc[ai][bj][m][0] * isc + bv[bj][0]) * w8, v1 = (acc[ai][bj][m][1] * isc + bv[bj][1]) * w8;
                        if (MOE_FP8) { uint2 w; w.x = pk4_fp8(v0[0] * F8S_Y, v0[1] * F8S_Y, v0[2] * F8S_Y, v0[3] * F8S_Y); w.y = pk4_fp8(v1[0] * F8S_Y, v1[1] * F8S_Y, v1[2] * F8S_Y, v1[3] * F8S_Y);
                            *(uint2*)((unsigned char*)O + (size_t)(u.slot0 + u.m0 + r) * D + col0 + bj * HALF) = w; }
                        else { u32x4 w; w.x = cvt_pk_bf16(v0[0], v0[1]); w.y = cvt_pk_bf16(v0[2], v0[3]); w.z = cvt_pk_bf16(v1[0], v1[1]); w.w = cvt_pk_bf16(v1[2], v1[3]);
                            *(u32x4*)(rowp + bj * HALF) = w; } } } }
    }
};

typedef int i32x4 __attribute__((ext_vector_type(4)));
typedef int i32x8 __attribute__((ext_vector_type(8)));
template <bool F8 = false, class Epi, class Sched>
__device__ __forceinline__ void gemm_phase(LAS unsigned char* lds, LAS unsigned char* aux, const char* gA, const char* gB, int K, const Sched& S, const Epi& E) {
    const int tid = opaque_tid(), wid = __builtin_amdgcn_readfirstlane(tid >> 6), lane = tid & 63, wr = wid >> 2, wc = wid & 3, fr = lane & 15, fq = lane >> 4;
    const int nt = K / BK;
    unsigned voffB[2];
#pragma unroll
    for (int i = 0; i < 2; ++i) { int R, C; stage_rc(tid * 16 + i * 8192, R, C); const int Rb = Epi::PERM ? ((R & ~31) + perm32(R & 31)) : R; voffB[i] = (unsigned)(Rb * K + C) * 2u; }
#define PG8_AOFFS(U, o0, o1) do { int t_ = tid; asm volatile("" : "+v"(t_)); _Pragma("unroll") for (int i = 0; i < 2; ++i) { int R, C; stage_rc(t_ * 16 + i * 8192, R, C); \
        o0[i] = S.a_off(U, R) + (unsigned)C * 2u; o1[i] = S.a_off(U, HALF + R) + (unsigned)C * 2u; } } while (0)
    const size_t hstep = (size_t)HALF * K * 2;
    const unsigned ldsw = (unsigned)wid * 1024u;
    const int aoff = lds_byte(wr * 64 + fr, fq * 8), boff = lds_byte(wc * 32 + fr, fq * 8);
#define PG8_SA(b, h) (((b) * 2 + (h)) * HTB)
#define PG8_SB(b, h) ((4 + (b) * 2 + (h)) * HTB)
#define PG8_STAGEB(bufoff, gbase) do { _Pragma("unroll") for (int _i = 0; _i < 2; ++_i) { unsigned _o = voffB[_i]; asm volatile("" : "+v"(_o)); \
        __builtin_amdgcn_global_load_lds((const unsigned*)((const char*)(gbase) + _o), (LAS unsigned*)(lds + (bufoff) + ldsw + _i * 8192), 16, 0, 0); } } while (0)
#define PG8_STAGEA(bufoff, voff2, kb) do { _Pragma("unroll") for (int _i = 0; _i < 2; ++_i) { unsigned _o = (voff2)[_i]; asm volatile("" : "+v"(_o)); \
        __builtin_amdgcn_global_load_lds((const unsigned*)((gA + (size_t)(kb)) + _o), (LAS unsigned*)(lds + (bufoff) + ldsw + _i * 8192), 16, 0, 0); } } while (0)
#define PG8_LD8(p) __builtin_shufflevector(*(const LAS i32x4*)(p), *(const LAS i32x4*)((p) + 1024), 0, 1, 2, 3, 4, 5, 6, 7)
#define PG8_LDA(dst, b, h) do { _Pragma("unroll") for (int m = 0; m < 4; ++m) dst[m] = PG8_LD8(lds + PG8_SA(b, h) + aoff + m * 2048); } while (0)
#define PG8_LDB(dst, b, h) do { _Pragma("unroll") for (int n = 0; n < 2; ++n) dst[n] = PG8_LD8(lds + PG8_SB(b, h) + boff + n * 2048); } while (0)
#define PG8_LO(x) __builtin_bit_cast(bf16x8, __builtin_shufflevector(x, x, 0, 1, 2, 3))
#define PG8_HI(x) __builtin_bit_cast(bf16x8, __builtin_shufflevector(x, x, 4, 5, 6, 7))
#define PG8_MMA(ai, bj, At, Bt) do { if constexpr (F8) __builtin_amdgcn_sched_barrier(0); __builtin_amdgcn_s_setprio(1); _Pragma("unroll") for (int m = 0; m < 4; ++m) _Pragma("unroll") for (int n = 0; n < 2; ++n) { \
        if constexpr (F8) asm volatile("v_mfma_scale_f32_16x16x128_f8f6f4 %0, %1, %2, %0, %3, %3 op_sel_hi:[0,0,0]" : "+v"(acc[ai][bj][m][n]) : "v"(Bt[n]), "v"(At[m]), "v"(f8scale)); \
        else { acc[ai][bj][m][n] = __builtin_amdgcn_mfma_f32_16x16x32_bf16(PG8_LO(Bt[n]), PG8_LO(At[m]), acc[ai][bj][m][n], 0, 0, 0); \
               acc[ai][bj][m][n] = __builtin_amdgcn_mfma_f32_16x16x32_bf16(PG8_HI(Bt[n]), PG8_HI(At[m]), acc[ai][bj][m][n], 0, 0, 0); } } \
        __builtin_amdgcn_s_setprio(0); if constexpr (F8) __builtin_amdgcn_sched_barrier(0); } while (0)
#define PG8_WAIT_V(n) asm volatile("s_waitcnt vmcnt(" #n ")" ::: "memory")
#define PG8_WAIT_L(n) asm volatile("s_waitcnt lgkmcnt(" #n ")" ::: "memory")
#define PG8_BAR __builtin_amdgcn_s_barrier()
#define PG8_SCHED __builtin_amdgcn_sched_barrier(0)
    Unit cur, nxt; int ui = 0;
    if (!S.next(0, cur)) return;
    Acc acc;
#pragma unroll
    for (int a = 0; a < 2; ++a)
#pragma unroll
        for (int b = 0; b < 2; ++b)
#pragma unroll
            for (int m = 0; m < 4; ++m)
#pragma unroll
                for (int n = 0; n < 2; ++n) acc[a][b][m][n] = (f32x4){0.f, 0.f, 0.f, 0.f};
    i32x8 At[4], B0[2], B1[2];
    int f8scale = 0x7F7F7F7F; asm volatile("" : "+v"(f8scale));
    unsigned cA0[2], cA1[2];
#define PG8_DMA4(src, dstoff) __builtin_amdgcn_global_load_lds((const unsigned*)(src), (LAS unsigned*)(aux + (dstoff) + wid * 256), 4, 0, 0)
#define PG8_SIDE_DMA(U, UI) do { if constexpr (Sched::GATHER) { int t_ = tid; asm volatile("" : "+v"(t_)); _Pragma("unroll") for (int p = 0; p < 4; ++p) { int R, C; stage_rc(t_ * 16 + (p & 1) * 8192, R, C); \
            PG8_DMA4(S.row_src(U, (p >> 1) * HALF + R), AUX_ROWTAB + p * 2048); } } \
        if constexpr (Epi::AUX) PG8_DMA4(E.aux_src(U, wid * 64 + lane), AUX_SLOTS + ((UI) & 3) * AUX_SLOT_BYTES); } while (0)
    if constexpr (Epi::AUX) PG8_DMA4(E.aux_src(cur, wid * 64 + lane), AUX_SLOTS);
    PG8_AOFFS(cur, cA0, cA1);
    const char* cB = gB + S.b_off(cur);
    PG8_STAGEB(PG8_SB(0, 0), cB); PG8_STAGEB(PG8_SB(0, 1), cB + hstep); PG8_STAGEA(PG8_SA(0, 0), cA0, 0); PG8_STAGEA(PG8_SA(0, 1), cA1, 0);
    if (wr == 1) PG8_BAR;
    PG8_WAIT_V(2); PG8_BAR;
    PG8_STAGEB(PG8_SB(1, 0), cB + BK * 2); PG8_STAGEA(PG8_SA(1, 0), cA0, BK * 2); PG8_STAGEB(PG8_SB(1, 1), cB + hstep + BK * 2);
    PG8_WAIT_V(6); PG8_BAR;
    for (;;) {
        const bool has_next = S.next(ui + 1, nxt);
        const char* nB = cB;
        if (has_next) { PG8_SIDE_DMA(nxt, ui + 1); nB = gB + S.b_off(nxt); }
        unsigned a20[2], a21[2];
#pragma nounroll
        for (int t = 0; t < nt; t += 2) {
            const bool last = (t == nt - 2);
            const unsigned k1 = (unsigned)(t + 1) * (BK * 2), k2 = last ? 0u : (unsigned)(t + 2) * (BK * 2), k3 = k2 + BK * 2;
            if (last && has_next) {
                if constexpr (Sched::GATHER) { int t_ = tid; asm volatile("" : "+v"(t_));
#pragma unroll
                    for (int i = 0; i < 2; ++i) { int R, C; stage_rc(t_ * 16 + i * 8192, R, C);
                        a20[i] = *(volatile LAS unsigned*)(aux + AUX_ROWTAB + i * 2048 + t_ * 4) * (unsigned)(K * 2) + (unsigned)C * 2u;
                        a21[i] = *(volatile LAS unsigned*)(aux + AUX_ROWTAB + (2 + i) * 2048 + t_ * 4) * (unsigned)(K * 2) + (unsigned)C * 2u; } }
                else PG8_AOFFS(nxt, a20, a21);
            } else {
#pragma unroll
                for (int i = 0; i < 2; ++i) { a20[i] = cA0[i]; a21[i] = cA1[i]; }
            }
            const char* b2 = (last ? nB : cB) + k2; const char* b3 = b2 + BK * 2;
            PG8_LDB(B0, 0, 0); PG8_LDB(B1, 0, 1); PG8_SCHED; PG8_LDA(At, 0, 0); PG8_STAGEA(PG8_SA(1, 1), cA1, k1);
            PG8_WAIT_V(8); PG8_WAIT_L(0); PG8_BAR; PG8_MMA(0, 0, At, B0); PG8_MMA(0, 1, At, B1); PG8_BAR; PG8_SCHED;
            PG8_LDA(At, 0, 1); PG8_STAGEB(PG8_SB(0, 0), b2); PG8_STAGEB(PG8_SB(0, 1), b2 + hstep); PG8_STAGEA(PG8_SA(0, 0), a20, k2);
            PG8_WAIT_V(8); PG8_WAIT_L(0); PG8_BAR; PG8_MMA(1, 0, At, B0); PG8_MMA(1, 1, At, B1); PG8_BAR; PG8_SCHED;
            PG8_LDB(B0, 1, 0); PG8_LDB(B1, 1, 1); PG8_SCHED; PG8_LDA(At, 1, 0); PG8_STAGEA(PG8_SA(0, 1), a21, k2);
            PG8_WAIT_V(8); PG8_WAIT_L(0); PG8_BAR; PG8_MMA(0, 0, At, B0); PG8_MMA(0, 1, At, B1); PG8_BAR; PG8_SCHED;
            PG8_LDA(At, 1, 1); PG8_STAGEB(PG8_SB(1, 0), b3); PG8_STAGEB(PG8_SB(1, 1), b3 + hstep); PG8_STAGEA(PG8_SA(1, 0), a20, k3);
            PG8_WAIT_V(8); PG8_WAIT_L(0); PG8_BAR; PG8_MMA(1, 0, At, B0); PG8_MMA(1, 1, At, B1); PG8_BAR; PG8_SCHED;
        }
        if constexpr (F8) asm volatile("s_nop 15\n\ts_nop 15" ::: "memory");
        if (wr == 0) PG8_BAR;
        int t_e = threadIdx.x; asm volatile("" : "+v"(t_e));
        int fr_e = t_e & 15, fq_e = (t_e >> 4) & 3;
#pragma unroll
        for (int a = 0; a < 2; ++a)
#pragma unroll
            for (int b = 0; b < 2; ++b)
#pragma unroll
                for (int m = 0; m < 4; ++m)
#pragma unroll
                    for (int n = 0; n < 2; ++n) asm volatile("" : "+v"(acc[a][b][m][n]));
        E(acc, cur, wr, wc, fr_e, fq_e, (const LAS float*)(aux + AUX_SLOTS + (ui & 3) * AUX_SLOT_BYTES));
        if (PROBE_REPEAT == 30) { asm volatile("" : "+v"(t_e)); E(acc, cur, wr, wc, t_e & 15, (t_e >> 4) & 3, (const LAS float*)(aux + AUX_SLOTS + (ui & 3) * AUX_SLOT_BYTES)); }
        if (!has_next) break;
#pragma unroll
        for (int a = 0; a < 2; ++a)
#pragma unroll
            for (int b = 0; b < 2; ++b)
#pragma unroll
                for (int m = 0; m < 4; ++m)
#pragma unroll
                    for (int n = 0; n < 2; ++n) acc[a][b][m][n] = (f32x4){0.f, 0.f, 0.f, 0.f};
        cur = nxt; cB = nB; ++ui;
#pragma unroll
        for (int i = 0; i < 2; ++i) { cA0[i] = a20[i]; cA1[i] = a21[i]; }
        if (wr == 1) PG8_BAR;
    }
    PG8_WAIT_V(0);
    PG8_BAR;
#undef PG8_SA
#undef PG8_SB
#undef PG8_STAGEA
#undef PG8_AOFFS
#undef PG8_DMA4
#undef PG8_SIDE_DMA
#undef PG8_STAGEB
#undef PG8_LDA
#undef PG8_LDB
#undef PG8_MMA
#undef PG8_LD8
#undef PG8_LO
#undef PG8_HI
#undef PG8_WAIT_V
#undef PG8_WAIT_L
#undef PG8_BAR
#undef PG8_SCHED
}
}


typedef float f32x16 __attribute__((ext_vector_type(16)));
typedef short bf16x4 __attribute__((ext_vector_type(4)));
typedef unsigned u32x2 __attribute__((ext_vector_type(2)));
typedef float f32x2_t __attribute__((ext_vector_type(2)));
typedef __bf16 bf16x2_t __attribute__((ext_vector_type(2)));
__device__ __forceinline__ unsigned cvtpk(float lo, float hi) { const f32x2_t v = {lo, hi}; const bf16x2_t b = __builtin_convertvector(v, bf16x2_t); return __builtin_bit_cast(unsigned, b); }
template <int S8> __device__ __forceinline__ bf16x8 pack8(const f32x16& X) {
    u32x4 w; w.x = cvtpk(X[8 * S8 + 0], X[8 * S8 + 1]); w.y = cvtpk(X[8 * S8 + 2], X[8 * S8 + 3]); w.z = cvtpk(X[8 * S8 + 4], X[8 * S8 + 5]); w.w = cvtpk(X[8 * S8 + 6], X[8 * S8 + 7]);
    return __builtin_bit_cast(bf16x8, w);
}
__device__ __forceinline__ bf16x8 lds_b128(const LAS unsigned char* p) { return *(const LAS bf16x8*)p; }
__device__ __forceinline__ bf16x8 lds_2xb64(const LAS unsigned char* p) {
    const bf16x4 a = *(const LAS bf16x4*)p, b = *(const LAS bf16x4*)(p + 16);
    return __builtin_shufflevector(a, b, 0, 1, 2, 3, 4, 5, 6, 7);
}
__device__ __forceinline__ float fast_log_sigmoid(float x) { return fminf(x, 0.0f) - __logf(1.0f + __expf(-fabsf(x))); }

constexpr int GP = 144;
constexpr int GS_QD = 0, GS_KI = GS_QD + 64 * GP, GS_KET = GS_KI + 64 * GP, GS_VT = GS_KET + 64 * GP, GS_DEC = GS_VT + 128 * GP, GS_SIZE = GS_DEC + 256;
constexpr int GL_SSP = 2 * GS_SIZE, GL_CONST = GL_SSP + 1024, GL_OT = GL_CONST + 1024;
constexpr int OTP = 132;
constexpr int GL_END = GL_OT + 64 * OTP * 4;
static_assert(GL_END <= RING_BYTES && (GL_OT % 16) == 0 && (GS_SIZE % 16) == 0 && (GS_DEC % 16) == 0, "gla lds");

__device__ __forceinline__ void gla_item(const Ptrs& P, LAS unsigned char* lds, int bh) {
    const int tid = opaque_tid(), lane = tid & 63, w = __builtin_amdgcn_readfirstlane(tid >> 6), l31 = lane & 31, hh = lane >> 5;
    const int b = bh >> 2, h = bh & 3;
    const bool grpA = w < 4; const int wa = w & 3;
    const bf16* PROJ = (const bf16*)(P.ws + WS_PROJ); bf16* MIX = (bf16*)(P.ws + WS_MIX);
    const size_t tok0 = (size_t)b * SEQ;
    const char* ub = (const char*)(PROJ + tok0 * NPROJ);
    const unsigned laneoff = (unsigned)lane * (NPROJ * 2);
    const int cq0 = PC_Q + h * 64 + 16 * wa, ck0 = PC_K + h * 64 + 16 * wa, cg0 = PC_GK + h * 64 + 16 * wa, cv0 = PC_V + h * 128 + 32 * wa;
    const int oc = tid >> 3, ov = (tid & 7) * 16;
    const unsigned gateoff = (unsigned)oc * (NPROJ * 2) + (unsigned)ov * 2;
#define GLA_LD(colel, chunk, lo) (*(const v4u*)(ub + ((size_t)(chunk) * 64 * NPROJ + (colel)) * 2 + (lo)))
    LAS float* cst = (LAS float*)(lds + GL_CONST);
    if (tid < 64) cst[tid] = P.b_gk[h * 64 + tid]; else if (tid < 192) cst[tid] = P.gla_norm_w[tid - 64];
    f32x16 S0, S1;
#pragma unroll
    for (int r = 0; r < 16; ++r) { S0[r] = 0.f; S1[r] = 0.f; }
    v4u nq[2], nk[2], ng[2];
    if (grpA) {
#pragma unroll
        for (int s = 0; s < 2; ++s) { nq[s] = GLA_LD(cq0 + 8 * s, 0, laneoff); nk[s] = GLA_LD(ck0 + 8 * s, 0, laneoff); ng[s] = GLA_LD(cg0 + 8 * s, 0, laneoff); }
    }
    __syncthreads();
#define GLA_STAGE_A(c) do { \
        LAS unsigned char* set_ = lds + ((c) & 1) * GS_SIZE; \
        v4u cq_[2], ck_[2], cg_[2], cv_[4]; \
        _Pragma("unroll") for (int s = 0; s < 2; ++s) { cq_[s] = nq[s]; ck_[s] = nk[s]; cg_[s] = ng[s]; } \
        _Pragma("unroll") for (int s = 0; s < 4; ++s) cv_[s] = GLA_LD(cv0 + 8 * s, (c), laneoff);     \
        { const int nc_ = (c) + 1 < SEQ / 64 ? (c) + 1 : (c); \
          _Pragma("unroll") for (int s = 0; s < 2; ++s) { nq[s] = GLA_LD(cq0 + 8 * s, nc_, laneoff); nk[s] = GLA_LD(ck0 + 8 * s, nc_, laneoff); ng[s] = GLA_LD(cg0 + 8 * s, nc_, laneoff); } } \
        _Pragma("unroll") for (int s = 0; s < 2; ++s) { \
            const int kc_ = 16 * wa + 8 * s; \
            const unsigned qw_[4] = {cq_[s].x, cq_[s].y, cq_[s].z, cq_[s].w}, kw_[4] = {ck_[s].x, ck_[s].y, ck_[s].z, ck_[s].w}, gw_[4] = {cg_[s].x, cg_[s].y, cg_[s].z, cg_[s].w}; \
            const f32x4 bg0_ = *(const LAS f32x4*)(cst + kc_), bg1_ = *(const LAS f32x4*)(cst + kc_ + 4); \
            float bb_[8]; \
            _Pragma("unroll") for (int j = 0; j < 8; ++j) { const float x_ = bf2f((gw_[j >> 1] >> (16 * (j & 1))) & 0xffffu) + (j < 4 ? bg0_[j & 3] : bg1_[j & 3]); bb_[j] = wave_incl_scan(fast_log_sigmoid(x_) * (1.0f / 16.0f)); } \
            float qd_[8], ki_[8], ke_[8]; \
            _Pragma("unroll") for (int j = 0; j < 8; ++j) { const float bl_ = __builtin_bit_cast(float, __builtin_amdgcn_readlane(__builtin_bit_cast(int, bb_[j]), 63)); \
                const float qv_ = bf2f((qw_[j >> 1] >> (16 * (j & 1))) & 0xffffu), kv_ = bf2f((kw_[j >> 1] >> (16 * (j & 1))) & 0xffffu); \
                qd_[j] = qv_ * 0.125f * __expf(bb_[j]); ki_[j] = kv_ * __expf(-bb_[j]); ke_[j] = kv_ * __expf(bl_ - bb_[j]); \
                if (lane == 63) *(LAS float*)(set_ + GS_DEC + (kc_ + j) * 4) = __expf(bl_); } \
            u32x4 t_; t_.x = cvtpk(qd_[0], qd_[1]); t_.y = cvtpk(qd_[2], qd_[3]); t_.z = cvtpk(qd_[4], qd_[5]); t_.w = cvtpk(qd_[6], qd_[7]); \
            *(LAS u32x4*)(set_ + GS_QD + lane * GP + kc_ * 2) = t_; \
            t_.x = cvtpk(ki_[0], ki_[1]); t_.y = cvtpk(ki_[2], ki_[3]); t_.z = cvtpk(ki_[4], ki_[5]); t_.w = cvtpk(ki_[6], ki_[7]); \
            *(LAS u32x4*)(set_ + GS_KI + lane * GP + kc_ * 2) = t_; \
            _Pragma("unroll") for (int j = 0; j < 8; ++j) *(LAS unsigned short*)(set_ + GS_KET + (kc_ + j) * GP + lane * 2) = (unsigned short)f2bf(ke_[j]); } \
        _Pragma("unroll") for (int s = 0; s < 4; ++s) { const unsigned vw_[4] = {cv_[s].x, cv_[s].y, cv_[s].z, cv_[s].w}; \
            _Pragma("unroll") for (int j = 0; j < 8; ++j) *(LAS unsigned short*)(set_ + GS_VT + (32 * wa + 8 * s + j) * GP + lane * 2) = (unsigned short)((vw_[j >> 1] >> (16 * (j & 1))) & 0xffffu); } \
    } while (0)
    if (grpA) GLA_STAGE_A(0);
    __syncthreads();
    for (int n = 0; n < SEQ / 64; ++n) {
        const v4u gate0 = GLA_LD(PC_G + h * 128, n, gateoff), gate1 = GLA_LD(PC_G + h * 128 + 8, n, gateoff);
        if (grpA) {
            if (n + 1 < SEQ / 64) GLA_STAGE_A(n + 1);
        } else {
            const LAS unsigned char* set = lds + (n & 1) * GS_SIZE;
            const int vc = wa;
            f32x16 O0, O1;
#pragma unroll
            for (int r = 0; r < 16; ++r) { O0[r] = 0.f; O1[r] = 0.f; }
            {
                const bf16x8 s00 = pack8<0>(S0), s01 = pack8<1>(S0), s10 = pack8<0>(S1), s11 = pack8<1>(S1);
                const LAS unsigned char* q0 = set + GS_QD + l31 * GP + 8 * hh; const LAS unsigned char* q1 = q0 + 32 * GP;
                const bf16x8 a0 = lds_2xb64(q0), a1 = lds_2xb64(q0 + 32), a2 = lds_2xb64(q0 + 64), a3 = lds_2xb64(q0 + 96);
                const bf16x8 b0 = lds_2xb64(q1), b1 = lds_2xb64(q1 + 32), b2 = lds_2xb64(q1 + 64), b3 = lds_2xb64(q1 + 96);
                O0 = __builtin_amdgcn_mfma_f32_32x32x16_bf16(s00, a0, O0, 0, 0, 0); O1 = __builtin_amdgcn_mfma_f32_32x32x16_bf16(s00, b0, O1, 0, 0, 0);
                O0 = __builtin_amdgcn_mfma_f32_32x32x16_bf16(s01, a1, O0, 0, 0, 0); O1 = __builtin_amdgcn_mfma_f32_32x32x16_bf16(s01, b1, O1, 0, 0, 0);
                O0 = __builtin_amdgcn_mfma_f32_32x32x16_bf16(s10, a2, O0, 0, 0, 0); O1 = __builtin_amdgcn_mfma_f32_32x32x16_bf16(s10, b2, O1, 0, 0, 0);
                O0 = __builtin_amdgcn_mfma_f32_32x32x16_bf16(s11, a3, O0, 0, 0, 0); O1 = __builtin_amdgcn_mfma_f32_32x32x16_bf16(s11, b3, O1, 0, 0, 0);
            }
            {
                const LAS unsigned char* kA0 = set + GS_KI + l31 * GP + 16 * hh; const LAS unsigned char* kA1 = kA0 + 32 * GP;
                const LAS unsigned char* qB0 = set + GS_QD + l31 * GP + 16 * hh; const LAS unsigned char* qB1 = qB0 + 32 * GP;
                const LAS unsigned char* vrow = set + GS_VT + (vc * 32 + l31) * GP + 8 * hh;
                bf16x8 fa[4], fb[4];
                f32x16 X;
#pragma unroll
                for (int kk = 0; kk < 4; ++kk) { fa[kk] = lds_b128(kA0 + 32 * kk); fb[kk] = lds_b128(qB0 + 32 * kk); }
                const bf16x8 v0 = lds_2xb64(vrow), v1 = lds_2xb64(vrow + 32);
#pragma unroll
                for (int r = 0; r < 16; ++r) X[r] = 0.f;
#pragma unroll
                for (int kk = 0; kk < 4; ++kk) X = __builtin_amdgcn_mfma_f32_32x32x16_bf16(fa[kk], fb[kk], X, 0, 0, 0);
#pragma unroll
                for (int kk = 0; kk < 4; ++kk) fb[kk] = lds_b128(qB1 + 32 * kk);
#pragma unroll
                for (int r = 0; r < 16; ++r) { const int srow = (r & 3) + 8 * (r >> 2) + 4 * hh; X[r] = (srow <= l31) ? X[r] : 0.f; }
                O0 = __builtin_amdgcn_mfma_f32_32x32x16_bf16(v0, pack8<0>(X), O0, 0, 0, 0); O0 = __builtin_amdgcn_mfma_f32_32x32x16_bf16(v1, pack8<1>(X), O0, 0, 0, 0);
#pragma unroll
                for (int r = 0; r < 16; ++r) X[r] = 0.f;
#pragma unroll
                for (int kk = 0; kk < 4; ++kk) X = __builtin_amdgcn_mfma_f32_32x32x16_bf16(fa[kk], fb[kk], X, 0, 0, 0);
#pragma unroll
                for (int kk = 0; kk < 4; ++kk) fa[kk] = lds_b128(kA1 + 32 * kk);
                O1 = __builtin_amdgcn_mfma_f32_32x32x16_bf16(v0, pack8<0>(X), O1, 0, 0, 0); O1 = __builtin_amdgcn_mfma_f32_32x32x16_bf16(v1, pack8<1>(X), O1, 0, 0, 0);
                const bf16x8 v2 = lds_2xb64(vrow + 64), v3 = lds_2xb64(vrow + 96);
#pragma unroll
                for (int r = 0; r < 16; ++r) X[r] = 0.f;
#pragma unroll
                for (int kk = 0; kk < 4; ++kk) X = __builtin_amdgcn_mfma_f32_32x32x16_bf16(fa[kk], fb[kk], X, 0, 0, 0);
#pragma unroll
                for (int r = 0; r < 16; ++r) { const int srow = (r & 3) + 8 * (r >> 2) + 4 * hh; X[r] = (srow <= l31) ? X[r] : 0.f; }
                O1 = __builtin_amdgcn_mfma_f32_32x32x16_bf16(v2, pack8<0>(X), O1, 0, 0, 0); O1 = __builtin_amdgcn_mfma_f32_32x32x16_bf16(v3, pack8<1>(X), O1, 0, 0, 0);
            }
            {
                const LAS float* dec = (const LAS float*)(set + GS_DEC);
                const LAS unsigned char* ka0 = set + GS_KET + l31 * GP + 16 * hh; const LAS unsigned char* ka1 = ka0 + 32 * GP;
                const LAS unsigned char* vb = set + GS_VT + (vc * 32 + l31) * GP + 16 * hh;
                bf16x8 e0[4], e1[4], vv[4];
#pragma unroll
                for (int ss = 0; ss < 4; ++ss) { e0[ss] = lds_b128(ka0 + 32 * ss); e1[ss] = lds_b128(ka1 + 32 * ss); vv[ss] = lds_b128(vb + 32 * ss); }
#pragma unroll
                for (int g4 = 0; g4 < 4; ++g4) { const f32x4 d0 = *(const LAS f32x4*)(dec + 8 * g4 + 4 * hh), d1 = *(const LAS f32x4*)(dec + 32 + 8 * g4 + 4 * hh);
#pragma unroll
                    for (int i = 0; i < 4; ++i) { S0[4 * g4 + i] *= d0[i]; S1[4 * g4 + i] *= d1[i]; } }
#pragma unroll
                for (int ss = 0; ss < 4; ++ss) { S0 = __builtin_amdgcn_mfma_f32_32x32x16_bf16(e0[ss], vv[ss], S0, 0, 0, 0); S1 = __builtin_amdgcn_mfma_f32_32x32x16_bf16(e1[ss], vv[ss], S1, 0, 0, 0); }
            }
            {
                float q0 = 0.f, q1 = 0.f;
#pragma unroll
                for (int r = 0; r < 16; ++r) { q0 += O0[r] * O0[r]; q1 += O1[r] * O1[r]; }
                q0 += __shfl_xor(q0, 32); q1 += __shfl_xor(q1, 32);
                if (hh == 0) { *(LAS float*)(lds + GL_SSP + (vc * 64 + l31) * 4) = q0; *(LAS float*)(lds + GL_SSP + (vc * 64 + 32 + l31) * 4) = q1; }
                LAS float* ot0 = (LAS float*)(lds + GL_OT) + l31 * OTP + vc * 32 + 4 * hh; LAS float* ot1 = ot0 + 32 * OTP;
#pragma unroll
                for (int g4 = 0; g4 < 4; ++g4) { *(LAS f32x4*)(ot0 + 8 * g4) = (f32x4){O0[4 * g4], O0[4 * g4 + 1], O0[4 * g4 + 2], O0[4 * g4 + 3]};
                    *(LAS f32x4*)(ot1 + 8 * g4) = (f32x4){O1[4 * g4], O1[4 * g4 + 1], O1[4 * g4 + 2], O1[4 * g4 + 3]}; }
            }
        }
        __syncthreads();
        {
            const LAS float* ssp = (const LAS float*)(lds + GL_SSP) + oc;
            const float tot = (ssp[0] + ssp[64]) + (ssp[128] + ssp[192]);
            const float rstd = 1.0f / sqrtf(tot * (1.0f / 128.0f) + EPS);
            const LAS float* ot = (const LAS float*)(lds + GL_OT) + oc * OTP + ov;
            const LAS float* nwp = cst + 64 + ov;
            const unsigned gw[8] = {gate0.x, gate0.y, gate0.z, gate0.w, gate1.x, gate1.y, gate1.z, gate1.w};
            float y[16];
#pragma unroll
            for (int q4 = 0; q4 < 4; ++q4) { const f32x4 o4 = *(const LAS f32x4*)(ot + 4 * q4), n4 = *(const LAS f32x4*)(nwp + 4 * q4);
#pragma unroll
                for (int i = 0; i < 4; ++i) { const int j = 4 * q4 + i; const float gv = bf2f((gw[j >> 1] >> (16 * (j & 1))) & 0xffffu); y[j] = o4[i] * rstd * n4[i] * gv * __builtin_amdgcn_rcpf(1.0f + __expf(-gv)); } }
            bf16* orow = MIX + (tok0 + (size_t)n * 64 + oc) * D + h * 128 + ov;
            u32x4 t; t.x = cvtpk(y[0], y[1]); t.y = cvtpk(y[2], y[3]); t.z = cvtpk(y[4], y[5]); t.w = cvtpk(y[6], y[7]); *(u32x4*)orow = t;
            t.x = cvtpk(y[8], y[9]); t.y = cvtpk(y[10], y[11]); t.z = cvtpk(y[12], y[13]); t.w = cvtpk(y[14], y[15]); *(u32x4*)(orow + 8) = t;
        }
        __syncthreads();
    }
#undef GLA_STAGE_A
#undef GLA_LD
}

constexpr int SP = 272;
constexpr int SG_W = 0, SG_VN = SG_W + 128 * SP, SG_OT = SG_VN + 128 * SP, SG_ST = SG_OT + 128 * SP, SG_END = SG_ST + 1024;
static_assert(SG_END <= RING_BYTES, "sgu lds");
__device__ __forceinline__ void sgu_item(const Ptrs& P, LAS unsigned char* lds, int bn) {
    const int tid = opaque_tid(), lane = tid & 63, w = __builtin_amdgcn_readfirstlane(tid >> 6), l31 = lane & 31, hh = lane >> 5;
    const bf16* PROJ = (const bf16*)(P.ws + WS_PROJ); bf16* MIX = (bf16*)(P.ws + WS_MIX); const bf16* Wsp = (const bf16*)(P.ws + WS_WSP);
    const size_t tok0 = (size_t)bn * 128;
    LAS float* st = (LAS float*)(lds + SG_ST);
#pragma unroll 4
    for (int rr = 0; rr < 16; ++rr) { const int row = 16 * w + rr;
        const v4u raw = *(const v4u*)(PROJ + (tok0 + row) * NPROJ + PC_VS + lane * 8); const unsigned rw[4] = {raw.x, raw.y, raw.z, raw.w};
        float s = 0.f, q = 0.f;
#pragma unroll
        for (int j = 0; j < 8; ++j) { const float g = gelu_tanh(bf2f((rw[j >> 1] >> (16 * (j & 1))) & 0xffffu)); s += g; q += g * g; }
        s = wave_sum(s); q = wave_sum(q);
        const float mu = s * (1.0f / 512.0f), var = fmaxf(q * (1.0f / 512.0f) - mu * mu, 0.f);
        if (lane == 0) { st[row] = mu; st[128 + row] = 1.0f / sqrtf(var + EPS); } }
    __syncthreads();
    for (int g = 0; g < 4; ++g) {
#pragma unroll
        for (int ps = 0; ps < 4; ++ps) { const int idx = ps * NTHR + tid, row = idx >> 4, c16 = idx & 15;
            *(LAS v4u*)(lds + SG_W + row * SP + c16 * 16) = *(const v4u*)(Wsp + ((size_t)g * 128 + row) * 128 + c16 * 8); }
        { const int s = tid & 127, c0 = (tid >> 7) * 32; const float mu = st[s], rs = st[128 + s];
#pragma unroll
          for (int q4 = 0; q4 < 4; ++q4) { const int cb = c0 + q4 * 8;
              const v4u raw = *(const v4u*)(PROJ + (tok0 + s) * NPROJ + PC_VS + g * 128 + cb); const unsigned rw[4] = {raw.x, raw.y, raw.z, raw.w};
              const f32x4 lw0 = *(const f32x4*)(P.sg_ln_w + g * 128 + cb), lw1 = *(const f32x4*)(P.sg_ln_w + g * 128 + cb + 4), lb0 = *(const f32x4*)(P.sg_ln_b + g * 128 + cb), lb1 = *(const f32x4*)(P.sg_ln_b + g * 128 + cb + 4);
#pragma unroll
              for (int j = 0; j < 8; ++j) { const float gv = gelu_tanh(bf2f((rw[j >> 1] >> (16 * (j & 1))) & 0xffffu));
                  const float vn = (gv - mu) * rs * (j < 4 ? lw0[j & 3] : lw1[j & 3]) + (j < 4 ? lb0[j & 3] : lb1[j & 3]);
                  *(LAS unsigned short*)(lds + SG_VN + (cb + j) * SP + s * 2) = (unsigned short)f2bf(vn); } } }
        __syncthreads();
        { const int ct = w >> 1;
          const LAS unsigned char* arow = lds + SG_VN + (ct * 32 + l31) * SP + 16 * hh;
#pragma unroll
          for (int ti = 0; ti < 2; ++ti) { const int tt = (w & 1) * 2 + ti;
              const LAS unsigned char* brow = lds + SG_W + (tt * 32 + l31) * SP + 16 * hh;
              f32x16 acc;
#pragma unroll
              for (int r = 0; r < 16; ++r) acc[r] = 0.f;
              for (int ks = 0; ks < 2 * (tt + 1); ++ks) acc = __builtin_amdgcn_mfma_f32_32x32x16_bf16(lds_b128(arow + 32 * ks), lds_b128(brow + 32 * ks), acc, 0, 0, 0);
              const float bs = P.b_spatial[g * 128 + tt * 32 + l31];
              LAS unsigned char* orow = lds + SG_OT + (tt * 32 + l31) * SP + (ct * 32 + 4 * hh) * 2;
#pragma unroll
              for (int g4 = 0; g4 < 4; ++g4) { u32x2 pk; pk.x = cvtpk(acc[4 * g4] + bs, acc[4 * g4 + 1] + bs); pk.y = cvtpk(acc[4 * g4 + 2] + bs, acc[4 * g4 + 3] + bs); *(LAS u32x2*)(orow + 16 * g4) = pk; } } }
        __syncthreads();
        { const int t = tid >> 2, cg = (tid & 3) * 32;
#pragma unroll
          for (int q4 = 0; q4 < 4; ++q4) { const v4u mx = *(const LAS v4u*)(lds + SG_OT + t * SP + (cg + q4 * 8) * 2);
              const v4u ur = *(const v4u*)(PROJ + (tok0 + t) * NPROJ + PC_U + g * 128 + cg + q4 * 8);
              const unsigned mw[4] = {mx.x, mx.y, mx.z, mx.w}, uw[4] = {ur.x, ur.y, ur.z, ur.w}; unsigned ow[4];
#pragma unroll
              for (int j = 0; j < 4; ++j) { const float a0 = gelu_tanh(bf2f(uw[j] & 0xffffu)) * bf2f(mw[j] & 0xffffu), a1 = gelu_tanh(bf2f(uw[j] >> 16)) * bf2f(mw[j] >> 16); ow[j] = cvtpk(a0, a1); }
              *(v4u*)(MIX + (tok0 + t) * D + 512 + g * 128 + cg + q4 * 8) = (v4u){ow[0], ow[1], ow[2], ow[3]}; } }
    }
    __syncthreads();
}
constexpr int CW_CONVQ = 192;
constexpr int CONV_CHUNK = 16;
__device__ __forceinline__ void moe_weight_items(const Ptrs& P, unsigned char* lds_generic) {
    const int tid_ = opaque_tid(), lane = tid_ & 63, wave = __builtin_amdgcn_readfirstlane(tid_ >> 6);
    float* scr = (float*)(lds_generic + wave * 16384);
    unsigned* q = (unsigned*)(P.ws + WS_CTL) + CW_CONVQ;
    for (;;) {
        unsigned c0 = 0; if (lane == 0) c0 = __hip_atomic_fetch_add(q, 1u, RLX_AGENT);
        c0 = __builtin_amdgcn_readfirstlane(c0) * CONV_CHUNK;
        if (c0 >= (unsigned)(IT_GU + IT_DN)) break;
#pragma nounroll
        for (int it = (int)c0; it < (int)c0 + CONV_CHUNK; ++it) p0_weight_item(P, IT_IN + IT_OUT + it, scr, lane);
    }
}
__device__ __forceinline__ void ph2_mix_fast(const Ptrs& P, LAS unsigned char* lds, unsigned char* lds_generic, int G) {
    const int bid = blockIdx.x;
    if (G >= 128) {
        if (bid < 64) { for (int rep = 0; rep < ((PROBE_REPEAT == 21) ? 2 : 1); ++rep) gla_item(P, lds, bid); }
        else { for (int rep = 0; rep < ((PROBE_REPEAT == 20) ? 2 : 1); ++rep) for (int it = bid - 64; it < NB * 16; it += G - 64) sgu_item(P, lds, it); }
    } else {
        for (int it = bid; it < 64; it += G) gla_item(P, lds, it);
        for (int it = bid; it < NB * 16; it += G) sgu_item(P, lds, it);
    }
    __syncthreads();
    moe_weight_items(P, lds_generic);
}

constexpr size_t WS_WR2 = WS_WSP + 256 * 1024;
__device__ __forceinline__ void p0_wr2(const Ptrs& P, int gtid, int gthreads) {
    f32x4* WR2 = (f32x4*)(P.ws + WS_WR2);
    for (int idx = gtid; idx < 32 * 2 * 2 * 64; idx += gthreads) { const int jj = idx >> 8, i4 = (idx >> 7) & 1, tl = (idx >> 6) & 1, q = (idx >> 4) & 3, e = tl * 16 + (idx & 15); f32x4 o;
#pragma unroll
        for (int i = 0; i < 4; ++i) { const int k = 32 * jj + 8 * q + 4 * i4 + i; o[i] = P.w_router[(size_t)k * NE + e] * P.norm_ffn_w[k]; }
        WR2[idx] = o; }
}
__device__ __forceinline__ bool rt_better(float va, int ia, float vb, int ib) { return va > vb || (va == vb && ia < ib); }
__device__ __forceinline__ void ph4_router_fast(const Ptrs& P, LAS unsigned char* lds, int G) {
    const int tid = opaque_tid(), lane = tid & 63, wave = __builtin_amdgcn_readfirstlane(tid >> 6), tk = lane & 15, q = lane >> 4;
    unsigned* ctl = (unsigned*)(P.ws + WS_CTL);
    LAS unsigned* lcnt = (LAS unsigned*)lds; LAS unsigned* lbase = lcnt + 32;
    const f32x4* WR2 = (const f32x4*)(P.ws + WS_WR2);
    const int NGRP = T / 16, rounds = (NGRP + G * NWAVES - 1) / (G * NWAVES);
    for (int rd = 0; rd < rounds; ++rd) {
        if (tid < 32) lcnt[tid] = 0u;
        __syncthreads();
        const int grp = (rd * G + (int)blockIdx.x) * NWAVES + wave; const bool act = grp < NGRP;
        const int m0 = (act ? grp : 0) * 16;
        LAS float* xt = (LAS float*)(lds + 1024 + wave * (16 * 132 * 4));
        const int ldr = lane >> 5, lc = (lane & 31) * 4;
        f32x4 d0 = {0.f, 0.f, 0.f, 0.f}, d1 = {0.f, 0.f, 0.f, 0.f}; float psq[8];
#pragma unroll
        for (int i = 0; i < 8; ++i) psq[i] = 0.f;
        f32x4 nxv[8]; uint2 nav[8];
#pragma unroll
        for (int i = 0; i < 8; ++i) { const size_t ro = (size_t)(m0 + 2 * i + ldr) * D + lc; nxv[i] = *(const f32x4*)(P.x + ro); nav[i] = *(const uint2*)((const bf16*)(P.ws + WS_A1) + ro); }
#pragma nounroll
        for (int ch = 0; ch < 8; ++ch) {
            const int c0 = ch * 128 + lc, c1 = (ch < 7 ? ch + 1 : ch) * 128 + lc;
            const f32x4 nwv = *(const f32x4*)(P.norm_ffn_w + c0);
            f32x4 xv[8]; uint2 av[8];
#pragma unroll
            for (int i = 0; i < 8; ++i) { xv[i] = nxv[i]; av[i] = nav[i]; }
#pragma unroll
            for (int i = 0; i < 8; ++i) { const size_t ro = (size_t)(m0 + 2 * i + ldr) * D + c1; nxv[i] = *(const f32x4*)(P.x + ro); nav[i] = *(const uint2*)((const bf16*)(P.ws + WS_A1) + ro); }
#pragma unroll
            for (int i = 0; i < 8; ++i) { const size_t ro = (size_t)(m0 + 2 * i + ldr) * D + c0;
                const f32x4 x1 = {xv[i][0] + bf2f(av[i].x & 0xffffu), xv[i][1] + bf2f(av[i].x >> 16), xv[i][2] + bf2f(av[i].y & 0xffffu), xv[i][3] + bf2f(av[i].y >> 16)};
                psq[i] += (x1[0] * x1[0] + x1[1] * x1[1]) + (x1[2] * x1[2] + x1[3] * x1[3]);
                *(LAS f32x4*)(xt + (2 * i + ldr) * 132 + lc) = x1;
                *(uint2*)((bf16*)(P.ws + WS_X1B) + ro) = make_uint2(cvtpk(x1[0], x1[1]), cvtpk(x1[2], x1[3]));
                *(unsigned*)((unsigned char*)(P.ws + WS_H) + ro) = pk4_fp8(x1[0] * nwv[0] * F8S_H, x1[1] * nwv[1] * F8S_H, x1[2] * nwv[2] * F8S_H, x1[3] * nwv[3] * F8S_H); }
#pragma unroll
            for (int j4 = 0; j4 < 4; ++j4) { const int jj = ch * 4 + j4;
                const f32x4 xa = *(const LAS f32x4*)(xt + tk * 132 + 32 * j4 + 8 * q), xb = *(const LAS f32x4*)(xt + tk * 132 + 32 * j4 + 8 * q + 4);
                const f32x4 w0a = WR2[((jj * 2 + 0) * 2 + 0) * 64 + lane], w1a = WR2[((jj * 2 + 0) * 2 + 1) * 64 + lane], w0b = WR2[((jj * 2 + 1) * 2 + 0) * 64 + lane], w1b = WR2[((jj * 2 + 1) * 2 + 1) * 64 + lane];
#pragma unroll
                for (int i = 0; i < 4; ++i) { d0 = __builtin_amdgcn_mfma_f32_16x16x4f32(w0a[i], xa[i], d0, 0, 0, 0); d1 = __builtin_amdgcn_mfma_f32_16x16x4f32(w1a[i], xa[i], d1, 0, 0, 0); }
#pragma unroll
                for (int i = 0; i < 4; ++i) { d0 = __builtin_amdgcn_mfma_f32_16x16x4f32(w0b[i], xb[i], d0, 0, 0, 0); d1 = __builtin_amdgcn_mfma_f32_16x16x4f32(w1b[i], xb[i], d1, 0, 0, 0); } }
        }
#pragma unroll
        for (int i = 0; i < 8; ++i) { float v = psq[i]; v += dpp_f<0x111, 0xF>(v); v += dpp_f<0x112, 0xF>(v); v += dpp_f<0x114, 0xF>(v); v += dpp_f<0x118, 0xF>(v); v += dpp_f<0x142, 0xA>(v);
            if ((lane & 31) == 31) xt[2 * i + ldr] = v; }
        float ssq = xt[tk];

        const float rstd = 1.0f / sqrtf(ssq * (1.f / D) + EPS);
        float cv[8]; int ci[8];
#pragma unroll
        for (int r = 0; r < 4; ++r) { cv[r] = d0[r] * rstd + P.b_router[4 * q + r]; ci[r] = 4 * q + r; cv[4 + r] = d1[r] * rstd + P.b_router[16 + 4 * q + r]; ci[4 + r] = 16 + 4 * q + r; }
        float sv[4]; int si[4];
#pragma unroll
        for (int r = 0; r < 4; ++r) { float bv = cv[0]; int bi = ci[0];
#pragma unroll
            for (int c = 1; c < 8; ++c) if (rt_better(cv[c], ci[c], bv, bi)) { bv = cv[c]; bi = ci[c]; }
            sv[r] = bv; si[r] = bi;
#pragma unroll
            for (int c = 0; c < 8; ++c) if (ci[c] == bi) cv[c] = -3.0e38f; }
#pragma unroll
        for (int off = 16; off <= 32; off <<= 1) {
            float ov[4]; int oi[4];
#pragma unroll
            for (int r = 0; r < 4; ++r) { ov[r] = __shfl_xor(sv[r], off); oi[r] = __shfl_xor(si[r], off); }
            float mv[8]; int mi[8];
#pragma unroll
            for (int r = 0; r < 4; ++r) { mv[r] = sv[r]; mi[r] = si[r]; mv[4 + r] = ov[r]; mi[4 + r] = oi[r]; }
#pragma unroll
            for (int r = 0; r < 4; ++r) { float bv = mv[0]; int bi = mi[0];
#pragma unroll
                for (int c = 1; c < 8; ++c) if (rt_better(mv[c], mi[c], bv, bi)) { bv = mv[c]; bi = mi[c]; }
                sv[r] = bv; si[r] = bi;
#pragma unroll
                for (int c = 0; c < 8; ++c) if (mi[c] == bi) mv[c] = -3.0e38f; }
        }
        float pw[4], den = 0.f;
#pragma unroll
        for (int r = 0; r < 4; ++r) { pw[r] = __expf(sv[r] - sv[0]); den += pw[r]; }
        int ee = si[0]; float ww = pw[0];
#pragma unroll
        for (int r = 1; r < 4; ++r) if (q == r) { ee = si[r]; ww = pw[r]; }
        ww /= den;
        unsigned lr = 0u;
        if (act) lr = __hip_atomic_fetch_add(lcnt + ee, 1u, __ATOMIC_RELAXED, __HIP_MEMORY_SCOPE_WORKGROUP);
        __syncthreads();
        if (tid < 32) lbase[tid] = __hip_atomic_fetch_add(ctl + CW_COUNTS + tid, lcnt[tid], RLX_AGENT);
        __syncthreads();
        if (act) { const unsigned rank = lbase[ee] + lr; const int m = m0 + tk;
            ((int*)(P.ws + WS_ROUTE + RT_ROWTOK))[(size_t)ee * T + rank] = m;
            ((float*)(P.ws + WS_ROUTE + RT_ROWW))[(size_t)ee * T + rank] = ww;
            ((int*)(P.ws + WS_ROUTE + RT_TOKSLOT))[(size_t)m * 4 + q] = (ee << 16) | (int)rank;
            ((float*)(P.ws + WS_RRSTD))[(size_t)ee * T + rank] = rstd; }
        __syncthreads();
    }
}

struct Args { Ptrs P; int ph_lo, ph_hi, li, pad; };

__device__ __forceinline__ void ph0_prep(const Ptrs& P, unsigned char* lds_generic, int vcu, int G) {
    const int tid = opaque_tid(), lane = tid & 63, wave = __builtin_amdgcn_readfirstlane(tid >> 6);
    float* scr = (float*)(lds_generic + wave * 16384);
    const int gw = vcu * NWAVES + wave, NGW = G * NWAVES;
    for (int it = gw; it < IT_IN + IT_OUT; it += NGW) p0_weight_item(P, it, scr, lane);
    bf16* Wsp = (bf16*)(P.ws + WS_WSP);
    for (int i = blockIdx.x * NTHR + tid; i < 4 * 128 * 128; i += G * NTHR) { const int t = (i >> 7) & 127, s = i & 127; Wsp[i] = (bf16)f2bf(s <= t ? P.w_spatial[i] : 0.f); }
    p0_wr2(P, blockIdx.x * NTHR + tid, G * NTHR);
    bf16* H = (bf16*)(P.ws + WS_H);
    for (int mb = gw; mb < T; mb += 4 * NGW) {
        f32x4 v[4][4];
#pragma unroll
        for (int t = 0; t < 4; ++t) { const int m = (mb + t * NGW < T) ? mb + t * NGW : mb;
#pragma unroll
            for (int j = 0; j < 4; ++j) v[t][j] = ((const f32x4*)(P.x + (size_t)m * D))[lane + 64 * j]; }
#pragma unroll
        for (int t = 0; t < 4; ++t) { const int m = mb + t * NGW;
            if (m < T) { float sq = 0.f;
#pragma unroll
                for (int j = 0; j < 4; ++j) sq += (v[t][j].x * v[t][j].x + v[t][j].y * v[t][j].y) + (v[t][j].z * v[t][j].z + v[t][j].w * v[t][j].w);
                const float rstd = 1.0f / sqrtf(wave_sum(sq) * (1.f / D) + EPS);
                unsigned long long* o8 = (unsigned long long*)(H + (size_t)m * D) + lane;
#pragma unroll
                for (int j = 0; j < 4; ++j) { const f32x4 ww = ((const f32x4*)P.norm_mix_w)[lane + 64 * j];
                    o8[64 * j] = (unsigned long long)pk2(v[t][j].x * rstd * ww.x, v[t][j].y * rstd * ww.y) | ((unsigned long long)pk2(v[t][j].z * rstd * ww.z, v[t][j].w * rstd * ww.w) << 32); } } }
    }
}
__device__ __forceinline__ void moe_tables(const Ptrs& P, LAS int* tab) {
    const unsigned* ctl = (const unsigned*)(P.ws + WS_CTL);
    if (threadIdx.x < NE) tab[66 + threadIdx.x] = (int)__hip_atomic_load(ctl + CW_COUNTS + threadIdx.x, RLX_AGENT);
    __syncthreads();
    if (threadIdx.x == 0) { int a = 0; for (int e = 0; e < NE; ++e) { tab[e] = a; tab[33 + e] = a * MT; a += (tab[66 + e] + MT - 1) / MT; } tab[NE] = a; tab[33 + NE] = a * MT; }
    __syncthreads();
}
__device__ __forceinline__ void ph7_final(const Ptrs& P, const LAS int* tab, int G, volatile LAS unsigned* MISC) {
    const int tid = opaque_tid(), lane = tid & 63, wave = tid >> 6;
    const unsigned char* Y = (const unsigned char*)(P.ws + WS_YBUF);
    constexpr int TB = 4;
    const int stride = G * NWAVES;
    for (int mb = blockIdx.x * NWAVES + wave; mb < T; mb += TB * stride) {
        uint2 xb[TB][4]; int yv[TB][4][4];
#pragma unroll
        for (int t = 0; t < TB; ++t) { const int m = (mb + t * stride < T) ? mb + t * stride : mb;
            const int4 ts = *(const int4*)((const int*)(P.ws + WS_ROUTE + RT_TOKSLOT) + (size_t)m * 4); const int pk[4] = {ts.x, ts.y, ts.z, ts.w};
            const bf16* X1 = (const bf16*)(P.ws + WS_X1B) + (size_t)m * D;
#pragma unroll
            for (int j = 0; j < 4; ++j) xb[t][j] = ((const uint2*)X1)[lane + 64 * j];
#pragma unroll
            for (int r = 0; r < 4; ++r) { const size_t slot = (size_t)tab[33 + (pk[r] >> 16)] + (pk[r] & 0xffff);
#pragma unroll
                for (int j = 0; j < 4; ++j) yv[t][r][j] = ((const int*)(Y + slot * D))[lane + 64 * j]; } }
#pragma unroll
        for (int t = 0; t < TB; ++t) { const int m = mb + t * stride;
            if (m < T) {
                f32x4 v[4];
#pragma unroll
                for (int j = 0; j < 4; ++j) { v[j] = (f32x4){bf2f(xb[t][j].x & 0xffffu), bf2f(xb[t][j].x >> 16), bf2f(xb[t][j].y & 0xffffu), bf2f(xb[t][j].y >> 16)};
#pragma unroll
                    for (int r = 0; r < 4; ++r) { const auto lo = __builtin_amdgcn_cvt_pk_f32_fp8(yv[t][r][j], false), hi = __builtin_amdgcn_cvt_pk_f32_fp8(yv[t][r][j], true);
                        v[j].x += lo[0] * (1.0f / F8S_Y); v[j].y += lo[1] * (1.0f / F8S_Y); v[j].z += hi[0] * (1.0f / F8S_Y); v[j].w += hi[1] * (1.0f / F8S_Y); } }
                float s = 0.f;
#pragma unroll
                for (int j = 0; j < 4; ++j) s += (v[j].x * v[j].x + v[j].y * v[j].y) + (v[j].z * v[j].z + v[j].w * v[j].w);
                const float rstd = 1.0f / sqrtf(wave_sum(s) * (1.f / D) + EPS);
#pragma unroll
                for (int j = 0; j < 4; ++j) { const f32x4 ww = ((const f32x4*)P.norm_final_w)[lane + 64 * j];
                    ((f32x4*)(P.out + (size_t)m * D))[lane + 64 * j] = (f32x4){v[j].x * rstd * ww.x, v[j].y * rstd * ww.y, v[j].z * rstd * ww.z, v[j].w * rstd * ww.w}; }
                if (PROBE_STAMP >= 0 && m == 0 && lane == 0) { asm volatile("s_waitcnt vmcnt(0)" ::: "memory"); P.out[0] += (float)(MISC[17] - MISC[16]) * (0.01f / 4.0f); }
            } }
    }
}

constexpr int NPHASE = 8;
__global__ void __launch_bounds__(NTHR, 2) mk_fwd(Args args) {
    extern __shared__ __attribute__((aligned(16))) unsigned char lds_raw[];
    LAS unsigned char* lds = (LAS unsigned char*)lds_raw;
    const Ptrs& P = args.P;
    const int tid = threadIdx.x, G = gridDim.x;
    const int vcu = (G % 8 == 0) ? ((int)blockIdx.x % 8) * (G / 8) + (int)blockIdx.x / 8 : (int)blockIdx.x;
    volatile LAS unsigned* MISC = (volatile LAS unsigned*)(lds + MISC_OFF);
    LAS int* tab = (LAS int*)(lds + TAB_OFF);
    if (tid < 64) MISC[tid] = 0u;
    __syncthreads();
    unsigned* ctl = (unsigned*)(P.ws + WS_CTL);
    XcdBarrier bar = xcd_barrier_post(ctl + CW_BAR + args.li * XCD_BAR_WORDS, MISC + 8);
    const int lo = args.ph_lo, hi = args.ph_hi;
#define IN(k) (lo <= (k) && (k) < hi)
#define NREP(k) ((PROBE_REPEAT == (k)) ? 2 : 1)
#define PH(k, ...) if (IN(k)) { if (PROBE_STAMP == (k) && tid == 0) MISC[16] = (unsigned)__builtin_amdgcn_s_memrealtime(); \
        for (int rep = 0; rep < NREP(k); ++rep) { __VA_ARGS__; if (rep + 1 < NREP(k) || IN((k) + 1)) xcd_barrier(bar); } \
        if (PROBE_STAMP == (k) && tid == 0) MISC[17] = (unsigned)__builtin_amdgcn_s_memrealtime(); }
    PH(0, ph0_prep(P, lds_raw, vcu, G));
    PH(1, { pg8::DenseSched S; S.init(T, NPROJ, D, G, (int)blockIdx.x); pg8::EpiProj E{(bf16*)(P.ws + WS_PROJ)};
            pg8::gemm_phase(lds, lds + AUX_OFF, (const char*)(P.ws + WS_H), (const char*)(P.ws + WS_WIN), D, S, E); });
    PH(2, ph2_mix_fast(P, lds, lds_raw, G));
    PH(3, { pg8::DenseSched S; S.init(T, D, D, G, (int)blockIdx.x); pg8::EpiA1 E{(bf16*)(P.ws + WS_A1)};
            pg8::gemm_phase(lds, lds + AUX_OFF, (const char*)(P.ws + WS_MIX), (const char*)(P.ws + WS_WOUT), D, S, E); });
    PH(4, ph4_router_fast(P, lds, G));
    if (IN(5) || IN(6) || IN(7)) moe_tables(P, tab);
    constexpr int KM = MOE_FP8 ? D / 2 : D;
    PH(5, { pg8::MoeSched<true> S{tab, (const int*)(P.ws + WS_ROUTE + RT_ROWTOK), 8, G, (int)blockIdx.x, __builtin_amdgcn_readfirstlane(tab[NE]) * 8, KM, 2048};
            pg8::EpiAct E{(bf16*)(P.ws + WS_ACT), P.b_gate_up, (const float*)(P.ws + WS_RRSTD)};
            pg8::gemm_phase<MOE_FP8 != 0>(lds, lds + AUX_OFF, (const char*)(P.ws + WS_H), (const char*)(P.ws + WS_WGU), KM, S, E); });
    PH(6, { pg8::MoeSched<false> S{tab, nullptr, 4, G, (int)blockIdx.x, __builtin_amdgcn_readfirstlane(tab[NE]) * 4, KM, 1024};
            pg8::EpiDown E{(bf16*)(P.ws + WS_YBUF), P.b_down, (const float*)(P.ws + WS_ROUTE + RT_ROWW)};
            pg8::gemm_phase<MOE_FP8 != 0>(lds, lds + AUX_OFF, (const char*)(P.ws + WS_ACT), (const char*)(P.ws + WS_WD), KM, S, E); });
    PH(7, ph7_final(P, tab, G, MISC));
#undef IN
#undef NREP
#undef PH
}

#ifndef MK_SEGMENTS
#define MK_SEGMENTS 1
#endif
extern "C" void kernel_launch(void* const* d_in, const int* in_sizes, int n_in, void* d_out, int out_size, void* d_ws, size_t ws_size, hipStream_t stream) {
    if (n_in != 19 || out_size != T * D || ws_size < WS_END) { fprintf(stderr, "kernel_launch: unexpected shapes n_in %d out %d ws %zu (need %zu)\n", n_in, out_size, ws_size, (size_t)WS_END); return; }
    static int grid = 0;
    if (grid == 0) {
        int dev = 0, cus = 0, per_cu = 0;
        if (hipGetDevice(&dev) != hipSuccess || hipDeviceGetAttribute(&cus, hipDeviceAttributeMultiprocessorCount, dev) != hipSuccess) { fprintf(stderr, "kernel_launch: device query failed\n"); grid = -1; return; }
        if (hipFuncSetAttribute((const void*)mk_fwd, hipFuncAttributeMaxDynamicSharedMemorySize, LDS_BYTES) != hipSuccess) { fprintf(stderr, "kernel_launch: hipFuncSetAttribute failed\n"); grid = -1; return; }
        if (hipOccupancyMaxActiveBlocksPerMultiprocessor(&per_cu, (const void*)mk_fwd, NTHR, LDS_BYTES) != hipSuccess || per_cu < 1) { fprintf(stderr, "kernel_launch: occupancy query says %d\n", per_cu); per_cu = 1; }
        (void)hipGetLastError();
        grid = cus;
        fprintf(stderr, "kernel_launch: cus %d per_cu %d grid %d\n", cus, per_cu, grid);
    }
    if (grid < 0) return;
    Args a{};
    const float** pp = (const float**)&a.P;
    for (int i = 0; i < 19; ++i) pp[i] = (const float*)d_in[i];
    a.P.out = (float*)d_out; a.P.ws = (unsigned char*)d_ws;
    (void)hipMemsetAsync((char*)d_ws + WS_CTL, 0, MiB, stream);
#if MK_SEGMENTS == 1
    a.ph_lo = 0; a.ph_hi = NPHASE; a.li = 0;
    void* kargs[] = {&a};
    hipError_t e = hipLaunchCooperativeKernel((const void*)mk_fwd, dim3(grid), dim3(NTHR), kargs, LDS_BYTES, stream);
    if (e != hipSuccess) fprintf(stderr, "kernel_launch: cooperative launch failed: %s (grid %d)\n", hipGetErrorString(e), grid);
#else
    for (int ph = 0; ph < NPHASE; ++ph) { a.ph_lo = ph; a.ph_hi = ph + 1; a.li = ph; hipLaunchKernelGGL(mk_fwd, dim3(grid), dim3(NTHR), LDS_BYTES, stream, a); }
#endif
}
```

```cpp
#include <hip/hip_runtime.h>
#include <cstdio>
#include <cstdint>

constexpr int T = 32768, D = 1024, SEQ = 2048, NB = 16;
constexpr int NIN_SRC = 2576, NPROJ = 2816;
constexpr int PC_Q = 0, PC_K = 256, PC_V = 512, PC_G = 1024, PC_GK = 1536, PC_U = 1792, PC_VS = 2304;
constexpr int NE = 32, TOPK = 4, DE = 1024;
constexpr int MT = 256;
constexpr int MAXSLOTS = T * TOPK + NE * MT;
constexpr float EPS = 1e-6f;

typedef unsigned short bf16;
typedef unsigned v4u __attribute__((ext_vector_type(4)));
typedef float f32x4 __attribute__((ext_vector_type(4)));

constexpr size_t MiB = 1u << 20;
constexpr size_t WS_CTL   = 0;
constexpr size_t WS_WIN   = 1 * MiB;
constexpr size_t WS_WOUT  = 7 * MiB;
constexpr size_t WS_WSP   = 9 * MiB;
constexpr size_t WS_ROUTE = 10 * MiB;
constexpr size_t WS_WGU   = 20 * MiB;
constexpr size_t WS_WD    = 148 * MiB;
constexpr size_t WS_X1    = 212 * MiB;
constexpr size_t WS_ACT   = 340 * MiB;
constexpr size_t WS_PROJ  = 612 * MiB;
constexpr size_t WS_MIX   = 788 * MiB;
constexpr size_t WS_H     = 852 * MiB;
constexpr size_t WS_YBUF  = WS_PROJ;
constexpr size_t WS_A1    = WS_X1;
constexpr size_t WS_X1B   = WS_X1 + 64 * MiB;
constexpr size_t WS_RRSTD = WS_H + 32 * MiB;
constexpr size_t WS_VN    = WS_ACT;
constexpr size_t WS_END   = 916 * MiB;
static_assert(WS_YBUF + (size_t)MAXSLOTS * 1024 * 2 <= WS_END, "ybuf fits");
static_assert(WS_ACT + (size_t)MAXSLOTS * 1024 * 2 <= WS_PROJ, "act fits");
constexpr size_t RT_ROWTOK = 0;
constexpr size_t RT_ROWW   = 4 * MiB;
constexpr size_t RT_TOKSLOT= 8 * MiB;
constexpr int CW_COUNTS = 64;
constexpr int CW_PSTART = 128;

__device__ __forceinline__ unsigned f2bf(float f) { unsigned u = __builtin_bit_cast(unsigned, f); return (u + 0x7fffu + ((u >> 16) & 1u)) >> 16; }
__device__ __forceinline__ float bf2f(unsigned h) { return __builtin_bit_cast(float, h << 16); }
__device__ __forceinline__ unsigned pk2(float lo, float hi) { return f2bf(lo) | (f2bf(hi) << 16); }
#ifndef MOE_FP8
#define MOE_FP8 1
#endif
constexpr float F8S_H = 8.0f, F8S_W = 32.0f, F8S_ACT = 4.0f, F8S_Y = 64.0f;
__device__ __forceinline__ float f8clamp(float x) { return fminf(fmaxf(x, -448.0f), 448.0f); }
__device__ __forceinline__ unsigned pk4_fp8(float a, float b, float c, float d) {
    int w = 0; w = __builtin_amdgcn_cvt_pk_fp8_f32(f8clamp(a), f8clamp(b), w, false); w = __builtin_amdgcn_cvt_pk_fp8_f32(f8clamp(c), f8clamp(d), w, true); return (unsigned)w; }
__device__ __forceinline__ unsigned pk4_fp8_nc(float a, float b, float c, float d) { int w = 0; w = __builtin_amdgcn_cvt_pk_fp8_f32(a, b, w, false); w = __builtin_amdgcn_cvt_pk_fp8_f32(c, d, w, true); return (unsigned)w; }
__device__ __forceinline__ float gelu_tanh(float x) { const float u = 0.7978845608028654f * (x + 0.044715f * x * x * x); return x / (1.0f + __expf(-2.0f * u)); }
__device__ __forceinline__ float silu(float x) { return x / (1.0f + __expf(-x)); }
__device__ __forceinline__ float log_sigmoid(float x) { return fminf(x, 0.0f) - log1pf(__expf(-fabsf(x))); }
template <int CTRL, int ROWMASK> __device__ __forceinline__ float dpp_f(float v) {
    return __builtin_bit_cast(float, __builtin_amdgcn_update_dpp(0, __builtin_bit_cast(int, v), CTRL, ROWMASK, 0xF, true)); }
__device__ __forceinline__ float wave_incl_scan(float v) {
    v += dpp_f<0x111, 0xF>(v); v += dpp_f<0x112, 0xF>(v); v += dpp_f<0x114, 0xF>(v); v += dpp_f<0x118, 0xF>(v);
    v += dpp_f<0x142, 0xA>(v); v += dpp_f<0x143, 0xC>(v); return v; }
__device__ __forceinline__ float wave_sum(float v) { return __builtin_bit_cast(float, __builtin_amdgcn_readlane(__builtin_bit_cast(int, wave_incl_scan(v)), 63)); }

struct Ptrs {
    const float *x, *norm_mix_w, *w_in, *w_gk_up, *b_gk, *gla_norm_w, *sg_ln_w, *sg_ln_b, *w_spatial, *b_spatial, *w_out, *norm_ffn_w,
                *w_router, *b_router, *w_gate_up, *b_gate_up, *w_down, *b_down, *norm_final_w;
    float* out; unsigned char* ws;
};

__device__ __forceinline__ void p0_tr_write(bf16* WT, int K, int d0, int k0, const float* scr, int lane) {
    const int c = lane & 7;
#pragma unroll
    for (int j = 0; j < 4; ++j) { const int n = (lane >> 3) + 8 * j; const float* s = scr + (8 * c) * 33 + n;
        v4u o; o.x = pk2(s[0 * 33], s[1 * 33]); o.y = pk2(s[2 * 33], s[3 * 33]); o.z = pk2(s[4 * 33], s[5 * 33]); o.w = pk2(s[6 * 33], s[7 * 33]);
        *(v4u*)(WT + (size_t)(d0 + n) * K + k0 + 8 * c) = o; }
}
__device__ __forceinline__ void p0_tr_write_f8(unsigned char* WT, int K, int d0, int k0, const float* scr, int lane, float sc) {
    const int c = lane & 7;
#pragma unroll
    for (int j = 0; j < 4; ++j) { const int n = (lane >> 3) + 8 * j; const float* s = scr + (8 * c) * 33 + n;
        uint2 o; o.x = pk4_fp8(s[0 * 33] * sc, s[1 * 33] * sc, s[2 * 33] * sc, s[3 * 33] * sc); o.y = pk4_fp8(s[4 * 33] * sc, s[5 * 33] * sc, s[6 * 33] * sc, s[7 * 33] * sc);
        *(uint2*)(WT + (size_t)(d0 + n) * K + k0 + 8 * c) = o; }
}
template <bool F8 = false>
__device__ __forceinline__ void p0_transpose_item(const float* W, int ldn, int n0, int k0, bf16* WT, int K, int d0, float* scr, int lane) {
    float v[32];
    const float* src = W + (size_t)(k0 + (lane >> 5)) * ldn + n0 + (lane & 31);
#pragma unroll
    for (int i = 0; i < 32; ++i) v[i] = __builtin_nontemporal_load(src + (size_t)(2 * i) * ldn);
#pragma unroll
    for (int i = 0; i < 32; ++i) scr[(2 * i + (lane >> 5)) * 33 + (lane & 31)] = v[i];
    __builtin_amdgcn_wave_barrier(); asm volatile("s_waitcnt lgkmcnt(0)" ::: "memory");
    if constexpr (F8) p0_tr_write_f8((unsigned char*)WT, K, d0, k0, scr, lane, F8S_W); else p0_tr_write(WT, K, d0, k0, scr, lane);
    asm volatile("s_waitcnt lgkmcnt(0)" ::: "memory"); __builtin_amdgcn_wave_barrier();
}
__device__ __forceinline__ void p0_gk_item(const float* w_in, const float* w_gk_up, int j0, int k0, bf16* WT, float* scr, int lane) {
    for (int i = 0; i < 32; ++i) { const int kk = 2 * i + (lane >> 5), j = j0 + (lane & 31); float s = 0.f;
#pragma unroll
        for (int r = 0; r < 16; ++r) s += w_in[(size_t)(k0 + kk) * NIN_SRC + 1536 + r] * w_gk_up[r * 256 + j];
        scr[kk * 33 + (lane & 31)] = s; }
    __builtin_amdgcn_wave_barrier(); asm volatile("s_waitcnt lgkmcnt(0)" ::: "memory");
    p0_tr_write(WT, D, PC_GK + j0, k0, scr, lane);
    asm volatile("s_waitcnt lgkmcnt(0)" ::: "memory"); __builtin_amdgcn_wave_barrier();
}
constexpr int IT_IN = (NPROJ / 32) * 16, IT_OUT = 32 * 16, IT_GU = NE * 64 * 16, IT_DN = NE * 32 * 16, IT_ALL = IT_IN + IT_OUT + IT_GU + IT_DN;
__device__ __forceinline__ void p0_weight_item(const Ptrs& P, int it, float* scr, int lane) {
    bf16* WinT = (bf16*)(P.ws + WS_WIN); bf16* WoutT = (bf16*)(P.ws + WS_WOUT); bf16* WguT = (bf16*)(P.ws + WS_WGU); bf16* WdT = (bf16*)(P.ws + WS_WD);
    if (it < IT_IN) { const int db = it / 16, kb = it % 16, d0 = db * 32;
        if (d0 >= PC_GK && d0 < PC_U) p0_gk_item(P.w_in, P.w_gk_up, d0 - PC_GK, kb * 64, WinT, scr, lane);
        else p0_transpose_item(P.w_in, NIN_SRC, d0 < PC_GK ? d0 : d0 - 240, kb * 64, WinT, D, d0, scr, lane);
        return; }
    it -= IT_IN;
    if (it < IT_OUT) { const int db = it / 16, kb = it % 16; p0_transpose_item(P.w_out, D, db * 32, kb * 64, WoutT, D, db * 32, scr, lane); return; }
    it -= IT_OUT;
    if (it < IT_GU) { const int e = it / 1024, r = it % 1024, db = r / 16, kb = r % 16, d0 = db * 32, pn = d0 >> 8, bj = (d0 >> 7) & 1, rr = d0 & 127;
        if (MOE_FP8) p0_transpose_item<true>(P.w_gate_up + (size_t)e * D * 2048, 2048, bj * 1024 + 128 * pn + rr, kb * 64, (bf16*)((unsigned char*)WguT + (size_t)e * 2048 * D), D, d0, scr, lane);
        else p0_transpose_item(P.w_gate_up + (size_t)e * D * 2048, 2048, bj * 1024 + 128 * pn + rr, kb * 64, WguT + (size_t)e * 2048 * D, D, d0, scr, lane);
        return; }
    it -= IT_GU;
    { const int e = it / 512, r = it % 512, db = r / 16, kb = r % 16;
      if (MOE_FP8) p0_transpose_item<true>(P.w_down + (size_t)e * DE * D, D, db * 32, kb * 64, (bf16*)((unsigned char*)WdT + (size_t)e * D * DE), DE, db * 32, scr, lane);
      else p0_transpose_item(P.w_down + (size_t)e * DE * D, D, db * 32, kb * 64, WdT + (size_t)e * D * DE, DE, db * 32, scr, lane); }
}
__device__ __forceinline__ void rms_row_to_bf16(const float* xrow, const float* w, bf16* orow, int lane) {
    const f32x4* xr = (const f32x4*)xrow + lane; const f32x4* wr = (const f32x4*)w + lane;
    f32x4 v[4]; float s = 0.f;
#pragma unroll
    for (int j = 0; j < 4; ++j) { v[j] = xr[64 * j]; s += (v[j].x * v[j].x + v[j].y * v[j].y) + (v[j].z * v[j].z + v[j].w * v[j].w); }
    const float rstd = 1.0f / sqrtf(wave_sum(s) * (1.f / D) + EPS);
    unsigned long long* o8 = (unsigned long long*)orow + lane;
#pragma unroll
    for (int j = 0; j < 4; ++j) { const f32x4 ww = wr[64 * j];
        o8[64 * j] = (unsigned long long)pk2(v[j].x * rstd * ww.x, v[j].y * rstd * ww.y) | ((unsigned long long)pk2(v[j].z * rstd * ww.z, v[j].w * rstd * ww.w) << 32); }
}

#ifndef PROBE_P2
#define PROBE_P2 -1
#endif
#ifndef PROBE_STAMP
#define PROBE_STAMP -1
#endif
#ifndef PROBE_REPEAT
#define PROBE_REPEAT -1
#endif
#define LAS __attribute__((address_space(3)))
__device__ __forceinline__ int opaque_tid() { int t = threadIdx.x; asm volatile("" : "+v"(t)); return t; }
typedef short bf16x8 __attribute__((ext_vector_type(8)));
typedef unsigned u32x4 __attribute__((ext_vector_type(4)));
constexpr int NWAVES = 8, NTHR = 512;
constexpr int RING_BYTES = 131072, TAB_OFF = RING_BYTES, MISC_OFF = RING_BYTES + 1024, AUX_OFF = RING_BYTES + 2048, AUX_ROWTAB = 0, AUX_SLOTS = 8192, AUX_SLOT_BYTES = 2048, LDS_BYTES = AUX_OFF + 16384;
constexpr int CW_BAR = 4096;
#define RLX_AGENT __ATOMIC_RELAXED, __HIP_MEMORY_SCOPE_AGENT

#define XB_TMO      128
#define XB_XCNT(j)  (256  + 64 * (j))
#define XB_XSUB(j)  (1280 + 64 * (j))
#define XB_XGEN(j)  (2304 + 64 * (j))
#define XB_TOP      3328
#define XB_TOPGEN   3392
#define XCD_BAR_WORDS 3456
#define XB_SPIN_CAP (1u << 20)
__device__ __forceinline__ unsigned xb_ld(unsigned* p)              { return __hip_atomic_load(p, __ATOMIC_RELAXED, __HIP_MEMORY_SCOPE_AGENT); }
__device__ __forceinline__ unsigned xb_add(unsigned* p, unsigned v) { return __hip_atomic_fetch_add(p, v, __ATOMIC_RELAXED, __HIP_MEMORY_SCOPE_AGENT); }
__device__ __forceinline__ unsigned xb_xcc_id() { return (unsigned)__builtin_amdgcn_s_getreg((3 << 11) | 20) & 0xFu; }
#define XB_SPIN(cond, bar) do { unsigned _sp = 0; while (cond) { __builtin_amdgcn_s_sleep(1); \
    if ((++_sp & 255u) == 0u) { if (xb_ld(&(bar)[XB_TMO])) break; if (_sp > XB_SPIN_CAP) { atomicAdd(&(bar)[XB_TMO], 1u); break; } } } } while (0)
struct XcdBarrier { unsigned* bar; unsigned x; volatile LAS unsigned* st; };
__device__ __forceinline__ XcdBarrier xcd_barrier_post(unsigned* bar, volatile LAS unsigned* st) {
    XcdBarrier b; b.bar = bar; b.x = xb_xcc_id(); b.st = st;
    if (threadIdx.x == 0) (void)xb_add(&bar[XB_XCNT(b.x)], 1u);
    return b;
}
__device__ __forceinline__ void xcd_barrier_complete(unsigned* bar, unsigned x, unsigned& nloc, unsigned& nx) {
    const unsigned G = gridDim.x * gridDim.y * gridDim.z;
    unsigned sum, cnt, mine, sp = 0u;
    for (;;) {
        sum = 0u; cnt = 0u; mine = 0u;
#pragma unroll
        for (unsigned j = 0; j < 16; ++j) { const unsigned c = xb_ld(&bar[XB_XCNT(j)]); sum += c; cnt += (c > 0u) ? 1u : 0u; mine = (j == x) ? c : mine; }
        if (sum == G) break;
        __builtin_amdgcn_s_sleep(1);
        if ((++sp & 255u) == 0u) { if (xb_ld(&bar[XB_TMO])) break; if (sp > XB_SPIN_CAP) { atomicAdd(&bar[XB_TMO], 1u); break; } }
    }
    nloc = mine > 0u ? mine : 1u; nx = cnt > 0u ? cnt : 1u;
}
__device__ __forceinline__ void xcd_barrier(const XcdBarrier& b) {
    asm volatile("s_waitcnt vmcnt(0)" ::: "memory");
    __syncthreads();
    if (threadIdx.x == 0) {
        unsigned* bar = b.bar;
        __builtin_amdgcn_s_waitcnt(0);
        unsigned nloc = b.st[0], nx = b.st[1];
        if (nloc == 0u) { xcd_barrier_complete(bar, b.x, nloc, nx); b.st[0] = nloc; b.st[1] = nx; }
        const unsigned old = xb_add(&bar[XB_XSUB(b.x)], 1u);
        const unsigned gen = old / nloc;
        if (old + 1u == (gen + 1u) * nloc) {
            __builtin_amdgcn_fence(__ATOMIC_RELEASE, "agent");
            asm volatile("s_waitcnt vmcnt(0)" ::: "memory");
            const unsigned og = xb_add(&bar[XB_TOP], 1u);
            const unsigned tg = og / nx;
            if (og + 1u == (tg + 1u) * nx) xb_add(&bar[XB_TOPGEN], 1u);
            else XB_SPIN(xb_ld(&bar[XB_TOPGEN]) == tg, bar);
            __builtin_amdgcn_fence(__ATOMIC_ACQUIRE, "agent");
            xb_add(&bar[XB_XGEN(b.x)], 1u);
            asm volatile("s_waitcnt vmcnt(0)" ::: "memory");
        } else {
            XB_SPIN(xb_ld(&bar[XB_XGEN(b.x)]) == gen, bar);
            __builtin_amdgcn_fence(__ATOMIC_ACQUIRE, "agent");
            asm volatile("s_waitcnt vmcnt(0)" ::: "memory");
        }
    }
    __syncthreads();
}

namespace pg8 {
constexpr int BM = 256, BK = 64, HALF = 128, HTB = HALF * BK * 2, NXCD = 8, WGM = 8;
__device__ __forceinline__ int lds_byte(int r, int c) { const int st = (r >> 4) * 2 + (c >> 5), rr = r & 15, cc = c & 31, ob = rr * 64 + cc * 2; return st * 1024 + (ob ^ (((ob >> 9) & 1) << 5)); }
__device__ __forceinline__ void stage_rc(int b, int& R, int& C) { const int st = b / 1024, sb = b % 1024, swz = sb ^ (((sb >> 9) & 1) << 5); R = (st >> 1) * 16 + swz / 64; C = (st & 1) * 32 + (swz % 64) / 2; }
__device__ __forceinline__ int perm32(int rho) { const int n = rho >> 4, i = rho & 15; return 8 * (i >> 2) + 4 * n + (i & 3); }
typedef float f32x2_t __attribute__((ext_vector_type(2)));
typedef __bf16 bf16x2_t __attribute__((ext_vector_type(2)));
__device__ __forceinline__ unsigned cvt_pk_bf16(float lo, float hi) { const f32x2_t v = {lo, hi}; const bf16x2_t b = __builtin_convertvector(v, bf16x2_t); return __builtin_bit_cast(unsigned, b); }
__device__ __forceinline__ int xcd_remap(int wgid, int nwg) { const int q = nwg / NXCD, r = nwg % NXCD, xcd = wgid % NXCD, off = wgid / NXCD; return (xcd < r ? xcd * (q + 1) : r * (q + 1) + (xcd - r) * q) + off; }

struct Unit { int pm, pn, e, m0, count, slot0; };
typedef f32x4 Acc[2][2][4][2];

struct DenseSched {
    int nM, nN, nwg, G, c, K;
    __device__ __forceinline__ void init(int M, int N, int K_, int G_, int c_) { nM = M / BM; nN = N / BM; nwg = nM * nN; G = G_; c = c_; K = K_; }
    __device__ __forceinline__ bool next(int i, Unit& u) const {
        const long L = (long)i * G + c; if (L >= nwg) return false;
        const int wgid = xcd_remap((int)L, nwg);
        const int nig = WGM * nN, gid = wgid / nig, fm = gid * WGM, gsz = (nM - fm) < WGM ? (nM - fm) : WGM;
        u.pm = fm + ((wgid % nig) % gsz); u.pn = (wgid % nig) / gsz; u.e = 0; u.m0 = 0; u.count = 0; u.slot0 = 0; return true;
    }
    static constexpr bool GATHER = false;
    __device__ __forceinline__ unsigned a_off(const Unit& u, int r) const { return (unsigned)(u.pm * BM + r) * (unsigned)(K * 2); }
    __device__ __forceinline__ const int* row_src(const Unit&, int) const { return nullptr; }
    __device__ __forceinline__ size_t b_off(const Unit& u) const { return (size_t)u.pn * BM * K * 2; }
};
template <bool GATHER_>
struct MoeSched {
    static constexpr bool GATHER = GATHER_;
    const LAS int* tab; const int* rowtok; int NPN, G, c, ntile, K, NB_E  ;
    __device__ __forceinline__ bool next(int i, Unit& u) const {
        const long L = (long)i * G + c; if (L >= ntile) return false;
        const int wgid = xcd_remap((int)L, ntile);
        int lo = 0, hi = NE;
#pragma unroll
        for (int s = 0; s < 5; ++s) { const int mid = (lo + hi) >> 1; if (__builtin_amdgcn_readfirstlane(tab[mid]) * NPN <= wgid) lo = mid; else hi = mid; }
        const int e = lo, t0 = __builtin_amdgcn_readfirstlane(tab[e]), mte = __builtin_amdgcn_readfirstlane(tab[e + 1]) - t0, local = wgid - t0 * NPN;
        u.e = e; u.pn = local / mte; u.pm = 0; u.m0 = (local % mte) * BM; u.count = __builtin_amdgcn_readfirstlane(tab[66 + e]); u.slot0 = __builtin_amdgcn_readfirstlane(tab[33 + e]); return true;
    }
    __device__ __forceinline__ const int* row_src(const Unit& u, int r) const { int m = u.m0 + r; m = m < u.count ? m : u.count - 1; return rowtok + (size_t)u.e * T + m; }
    __device__ __forceinline__ unsigned a_off(const Unit& u, int r) const {
        if (GATHER) return (unsigned)(*row_src(u, r)) * (unsigned)(K * 2);
        return (unsigned)(u.slot0 + u.m0 + r) * (unsigned)(K * 2);
    }
    __device__ __forceinline__ size_t b_off(const Unit& u) const { return ((size_t)u.e * NB_E + (size_t)u.pn * BM) * K * 2; }
};

struct EpiProj {
    static constexpr bool PERM = true, AUX = false;
    bf16* O;
    __device__ __forceinline__ const float* aux_src(const Unit&, int) const { return nullptr; }
    __device__ __forceinline__ void operator()(const Acc& acc, const Unit& u, int wr, int wc, int fr, int fq, const LAS float*) const {
        const int row0 = u.pm * BM + wr * 64 + fr, col0 = u.pn * BM + wc * 32 + 8 * fq;
#pragma unroll
        for (int ai = 0; ai < 2; ++ai)
#pragma unroll
            for (int m = 0; m < 4; ++m) { bf16* rowp = O + (size_t)(row0 + ai * HALF + m * 16) * NPROJ + col0;
#pragma unroll
                for (int bj = 0; bj < 2; ++bj) { const f32x4 v0 = acc[ai][bj][m][0], v1 = acc[ai][bj][m][1];
                    u32x4 w; w.x = cvt_pk_bf16(v0[0], v0[1]); w.y = cvt_pk_bf16(v0[2], v0[3]); w.z = cvt_pk_bf16(v1[0], v1[1]); w.w = cvt_pk_bf16(v1[2], v1[3]);
                    *(u32x4*)(rowp + bj * HALF) = w; } }
    }
};
struct EpiA1 {
    static constexpr bool PERM = true, AUX = false;
    bf16* O;
    __device__ __forceinline__ const float* aux_src(const Unit&, int) const { return nullptr; }
    __device__ __forceinline__ void operator()(const Acc& acc, const Unit& u, int wr, int wc, int fr, int fq, const LAS float*) const {
        const int row0 = u.pm * BM + wr * 64 + fr, col0 = u.pn * BM + wc * 32 + 8 * fq;
#pragma unroll
        for (int ai = 0; ai < 2; ++ai)
#pragma unroll
            for (int m = 0; m < 4; ++m) { bf16* rowp = O + (size_t)(row0 + ai * HALF + m * 16) * D + col0;
#pragma unroll
                for (int bj = 0; bj < 2; ++bj) { const f32x4 v0 = acc[ai][bj][m][0], v1 = acc[ai][bj][m][1];
                    u32x4 w; w.x = cvt_pk_bf16(v0[0], v0[1]); w.y = cvt_pk_bf16(v0[2], v0[3]); w.z = cvt_pk_bf16(v1[0], v1[1]); w.w = cvt_pk_bf16(v1[2], v1[3]);
                    *(u32x4*)(rowp + bj * HALF) = w; } }
    }
};
struct EpiAct {
    static constexpr bool PERM = true, AUX = true;
    bf16* O; const float* bgu; const float* rrstd;
    __device__ __forceinline__ const float* aux_src(const Unit& u, int idx) const {
        if (idx < 256) return bgu + (size_t)u.e * 2048 + (idx < 128 ? u.pn * 128 + idx : 1024 + u.pn * 128 + (idx - 128));
        int m = u.m0 + (idx - 256); m = m < u.count ? m : u.count - 1; return rrstd + (size_t)u.e * T + m; }
    __device__ __forceinline__ void operator()(const Acc& acc, const Unit& u, int wr, int wc, int fr, int fq, const LAS float* aux) const {
        const int colj = u.pn * 128 + wc * 32 + 8 * fq;
        const LAS float* bg = aux + wc * 32 + 8 * fq;
        const f32x4 g0 = *(const LAS f32x4*)bg, g1 = *(const LAS f32x4*)(bg + 4), u0 = *(const LAS f32x4*)(bg + 128), u1 = *(const LAS f32x4*)(bg + 132);
#pragma unroll
        for (int ai = 0; ai < 2; ++ai)
#pragma unroll
            for (int m = 0; m < 4; ++m) { const int r = ai * HALF + wr * 64 + m * 16 + fr;
                { float y[8]; const float rs = aux[256 + r] * (MOE_FP8 ? 1.0f / (F8S_H * F8S_W) : 1.0f);
#pragma unroll
                    for (int n = 0; n < 2; ++n)
#pragma unroll
                        for (int i = 0; i < 4; ++i) {
                            float g = acc[ai][0][m][n][i] * rs + (n ? g1[i] : g0[i]), up = acc[ai][1][m][n][i] * rs + (n ? u1[i] : u0[i]);
                            g = fminf(g, 7.0f); up = fminf(fmaxf(up, -7.0f), 7.0f); y[n * 4 + i] = (up + 1.0f) * g * __builtin_amdgcn_rcpf(1.0f + __expf(-1.702f * g)); }
                    if (MOE_FP8) { uint2 w; w.x = pk4_fp8_nc(y[0] * F8S_ACT, y[1] * F8S_ACT, y[2] * F8S_ACT, y[3] * F8S_ACT); w.y = pk4_fp8_nc(y[4] * F8S_ACT, y[5] * F8S_ACT, y[6] * F8S_ACT, y[7] * F8S_ACT);
                        *(uint2*)((unsigned char*)O + (size_t)(u.slot0 + u.m0 + r) * DE + colj) = w; }
                    else { u32x4 w; w.x = cvt_pk_bf16(y[0], y[1]); w.y = cvt_pk_bf16(y[2], y[3]); w.z = cvt_pk_bf16(y[4], y[5]); w.w = cvt_pk_bf16(y[6], y[7]);
                        *(u32x4*)(O + (size_t)(u.slot0 + u.m0 + r) * DE + colj) = w; } } }
    }
};
struct EpiDown {
    static constexpr bool PERM = true, AUX = true;
    bf16* O; const float* bd; const float* roww;
    __device__ __forceinline__ const float* aux_src(const Unit& u, int idx) const {
        if (idx < 256) return bd + (size_t)u.e * D + u.pn * BM + idx;
        int m = u.m0 + (idx - 256); m = m < u.count ? m : u.count - 1; return roww + (size_t)u.e * T + m; }
    __device__ __forceinline__ void operator()(const Acc& acc, const Unit& u, int wr, int wc, int fr, int fq, const LAS float* aux) const {
        const int col0 = u.pn * BM + wc * 32 + 8 * fq;
        const LAS float* bp = aux + wc * 32 + 8 * fq;
        f32x4 bv[2][2];
#pragma unroll
        for (int bj = 0; bj < 2; ++bj)
#pragma unroll
            for (int n = 0; n < 2; ++n) bv[bj][n] = *(const LAS f32x4*)(bp + bj * HALF + 4 * n);
#pragma unroll
        for (int ai = 0; ai < 2; ++ai)
#pragma unroll
            for (int m = 0; m < 4; ++m) { const int r = ai * HALF + wr * 64 + m * 16 + fr;
                { const float w8 = aux[256 + r]; bf16* rowp = O + (size_t)(u.slot0 + u.m0 + r) * D + col0;
#pragma unroll
                    for (int bj = 0; bj < 2; ++bj) { constexpr float isc = MOE_FP8 ? 1.0f / (F8S_ACT * F8S_W) : 1.0f;
                        const f32x4 v0 = (acc[ai][bj][m][0] * isc + bv[bj][0]) * w8, v1 = (acc[ai][bj][m][1] * isc + bv[bj][1]) * w8;
                        if (MOE_FP8) { uint2 w; w.x = pk4_fp8(v0[0] * F8S_Y, v0[1] * F8S_Y, v0[2] * F8S_Y, v0[3] * F8S_Y); w.y = pk4_fp8(v1[0] * F8S_Y, v1[1] * F8S_Y, v1[2] * F8S_Y, v1[3] * F8S_Y);
                            *(uint2*)((unsigned char*)O + (size_t)(u.slot0 + u.m0 + r) * D + col0 + bj * HALF) = w; }
                        else { u32x4 w; w.x = cvt_pk_bf16(v0[0], v0[1]); w.y = cvt_pk_bf16(v0[2], v0[3]); w.z = cvt_pk_bf16(v1[0], v1[1]); w.w = cvt_pk_bf16(v1[2], v1[3]);
                            *(u32x4*)(rowp + bj * HALF) = w; } } } }
    }
};

typedef int i32x4 __attribute__((ext_vector_type(4)));
typedef int i32x8 __attribute__((ext_vector_type(8)));
template <bool F8 = false, class Epi, class Sched>
__device__ __forceinline__ void gemm_phase(LAS unsigned char* lds, LAS unsigned char* aux, const char* gA, const char* gB, int K, const Sched& S, const Epi& E) {
    const int tid = opaque_tid(), wid = __builtin_amdgcn_readfirstlane(tid >> 6), lane = tid & 63, wr = wid >> 2, wc = wid & 3, fr = lane & 15, fq = lane >> 4;
    const int nt = K / BK;
    unsigned voffB[2];
#pragma unroll
    for (int i = 0; i < 2; ++i) { int R, C; stage_rc(tid * 16 + i * 8192, R, C); const int Rb = Epi::PERM ? ((R & ~31) + perm32(R & 31)) : R; voffB[i] = (unsigned)(Rb * K + C) * 2u; }
#define PG8_AOFFS(U, o0, o1) do { int t_ = tid; asm volatile("" : "+v"(t_)); _Pragma("unroll") for (int i = 0; i < 2; ++i) { int R, C; stage_rc(t_ * 16 + i * 8192, R, C); \
        o0[i] = S.a_off(U, R) + (unsigned)C * 2u; o1[i] = S.a_off(U, HALF + R) + (unsigned)C * 2u; } } while (0)
    const size_t hstep = (size_t)HALF * K * 2;
    const unsigned ldsw = (unsigned)wid * 1024u;
    const int aoff = lds_byte(wr * 64 + fr, fq * 8), boff = lds_byte(wc * 32 + fr, fq * 8);
#define PG8_SA(b, h) (((b) * 2 + (h)) * HTB)
#define PG8_SB(b, h) ((4 + (b) * 2 + (h)) * HTB)
#define PG8_STAGEB(bufoff, gbase) do { _Pragma("unroll") for (int _i = 0; _i < 2; ++_i) { unsigned _o = voffB[_i]; asm volatile("" : "+v"(_o)); \
        __builtin_amdgcn_global_load_lds((const unsigned*)((const char*)(gbase) + _o), (LAS unsigned*)(lds + (bufoff) + ldsw + _i * 8192), 16, 0, 0); } } while (0)
#define PG8_STAGEA(bufoff, voff2, kb) do { _Pragma("unroll") for (int _i = 0; _i < 2; ++_i) { unsigned _o = (voff2)[_i]; asm volatile("" : "+v"(_o)); \
        __builtin_amdgcn_global_load_lds((const unsigned*)((gA + (size_t)(kb)) + _o), (LAS unsigned*)(lds + (bufoff) + ldsw + _i * 8192), 16, 0, 0); } } while (0)
#define PG8_LD8(p) __builtin_shufflevector(*(const LAS i32x4*)(p), *(const LAS i32x4*)((p) + 1024), 0, 1, 2, 3, 4, 5, 6, 7)
#define PG8_LDA(dst, b, h) do { _Pragma("unroll") for (int m = 0; m < 4; ++m) dst[m] = PG8_LD8(lds + PG8_SA(b, h) + aoff + m * 2048); } while (0)
#define PG8_LDB(dst, b, h) do { _Pragma("unroll") for (int n = 0; n < 2; ++n) dst[n] = PG8_LD8(lds + PG8_SB(b, h) + boff + n * 2048); } while (0)
#define PG8_LO(x) __builtin_bit_cast(bf16x8, __builtin_shufflevector(x, x, 0, 1, 2, 3))
#define PG8_HI(x) __builtin_bit_cast(bf16x8, __builtin_shufflevector(x, x, 4, 5, 6, 7))
#define PG8_MMA(ai, bj, At, Bt) do { if constexpr (F8) __builtin_amdgcn_sched_barrier(0); __builtin_amdgcn_s_setprio(1); _Pragma("unroll") for (int m = 0; m < 4; ++m) _Pragma("unroll") for (int n = 0; n < 2; ++n) { \
        if constexpr (F8) asm volatile("v_mfma_scale_f32_16x16x128_f8f6f4 %0, %1, %2, %0, %3, %3 op_sel_hi:[0,0,0]" : "+v"(acc[ai][bj][m][n]) : "v"(Bt[n]), "v"(At[m]), "v"(f8scale)); \
        else { acc[ai][bj][m][n] = __builtin_amdgcn_mfma_f32_16x16x32_bf16(PG8_LO(Bt[n]), PG8_LO(At[m]), acc[ai][bj][m][n], 0, 0, 0); \
               acc[ai][bj][m][n] = __builtin_amdgcn_mfma_f32_16x16x32_bf16(PG8_HI(Bt[n]), PG8_HI(At[m]), acc[ai][bj][m][n], 0, 0, 0); } } \
        __builtin_amdgcn_s_setprio(0); if constexpr (F8) __builtin_amdgcn_sched_barrier(0); } while (0)
#define PG8_WAIT_V(n) asm volatile("s_waitcnt vmcnt(" #n ")" ::: "memory")
#define PG8_WAIT_L(n) asm volatile("s_waitcnt lgkmcnt(" #n ")" ::: "memory")
#define PG8_BAR __builtin_amdgcn_s_barrier()
#define PG8_SCHED __builtin_amdgcn_sched_barrier(0)
    Unit cur, nxt; int ui = 0;
    if (!S.next(0, cur)) return;
    Acc acc;
#pragma unroll
    for (int a = 0; a < 2; ++a)
#pragma unroll
        for (int b = 0; b < 2; ++b)
#pragma unroll
            for (int m = 0; m < 4; ++m)
#pragma unroll
                for (int n = 0; n < 2; ++n) acc[a][b][m][n] = (f32x4){0.f, 0.f, 0.f, 0.f};
    i32x8 At[4], B0[2], B1[2];
    int f8scale = 0x7F7F7F7F; asm volatile("" : "+v"(f8scale));
    unsigned cA0[2], cA1[2];
#define PG8_DMA4(src, dstoff) __builtin_amdgcn_global_load_lds((const unsigned*)(src), (LAS unsigned*)(aux + (dstoff) + wid * 256), 4, 0, 0)
#define PG8_SIDE_DMA(U, UI) do { if constexpr (Sched::GATHER) { int t_ = tid; asm volatile("" : "+v"(t_)); _Pragma("unroll") for (int p = 0; p < 4; ++p) { int R, C; stage_rc(t_ * 16 + (p & 1) * 8192, R, C); \
            PG8_DMA4(S.row_src(U, (p >> 1) * HALF + R), AUX_ROWTAB + p * 2048); } } \
        if constexpr (Epi::AUX) PG8_DMA4(E.aux_src(U, wid * 64 + lane), AUX_SLOTS + ((UI) & 3) * AUX_SLOT_BYTES); } while (0)
    if constexpr (Epi::AUX) PG8_DMA4(E.aux_src(cur, wid * 64 + lane), AUX_SLOTS);
    PG8_AOFFS(cur, cA0, cA1);
    const char* cB = gB + S.b_off(cur);
    PG8_STAGEB(PG8_SB(0, 0), cB); PG8_STAGEB(PG8_SB(0, 1), cB + hstep); PG8_STAGEA(PG8_SA(0, 0), cA0, 0); PG8_STAGEA(PG8_SA(0, 1), cA1, 0);
    if (wr == 1) PG8_BAR;
    PG8_WAIT_V(2); PG8_BAR;
    PG8_STAGEB(PG8_SB(1, 0), cB + BK * 2); PG8_STAGEA(PG8_SA(1, 0), cA0, BK * 2); PG8_STAGEB(PG8_SB(1, 1), cB + hstep + BK * 2);
    PG8_WAIT_V(6); PG8_BAR;
    for (;;) {
        const bool has_next = S.next(ui + 1, nxt);
        const char* nB = cB;
        if (has_next) { PG8_SIDE_DMA(nxt, ui + 1); nB = gB + S.b_off(nxt); }
        unsigned a20[2], a21[2];
#pragma nounroll
        for (int t = 0; t < nt; t += 2) {
            const bool last = (t == nt - 2);
            const unsigned k1 = (unsigned)(t + 1) * (BK * 2), k2 = last ? 0u : (unsigned)(t + 2) * (BK * 2), k3 = k2 + BK * 2;
            if (last && has_next) {
                if constexpr (Sched::GATHER) { int t_ = tid; asm volatile("" : "+v"(t_));
#pragma unroll
                    for (int i = 0; i < 2; ++i) { int R, C; stage_rc(t_ * 16 + i * 8192, R, C);
                        a20[i] = *(volatile LAS unsigned*)(aux + AUX_ROWTAB + i * 2048 + t_ * 4) * (unsigned)(K * 2) + (unsigned)C * 2u;
                        a21[i] = *(volatile LAS unsigned*)(aux + AUX_ROWTAB + (2 + i) * 2048 + t_ * 4) * (unsigned)(K * 2) + (unsigned)C * 2u; } }
                else PG8_AOFFS(nxt, a20, a21);
            } else {
#pragma unroll
                for (int i = 0; i < 2; ++i) { a20[i] = cA0[i]; a21[i] = cA1[i]; }
            }
            const char* b2 = (last ? nB : cB) + k2; const char* b3 = b2 + BK * 2;
            PG8_LDB(B0, 0, 0); PG8_LDB(B1, 0, 1); PG8_SCHED; PG8_LDA(At, 0, 0); PG8_STAGEA(PG8_SA(1, 1), cA1, k1);
            PG8_WAIT_V(8); PG8_WAIT_L(0); PG8_BAR; PG8_MMA(0, 0, At, B0); PG8_MMA(0, 1, At, B1); PG8_BAR; PG8_SCHED;
            PG8_LDA(At, 0, 1); PG8_STAGEB(PG8_SB(0, 0), b2); PG8_STAGEB(PG8_SB(0, 1), b2 + hstep); PG8_STAGEA(PG8_SA(0, 0), a20, k2);
            PG8_WAIT_V(8); PG8_WAIT_L(0); PG8_BAR; PG8_MMA(1, 0, At, B0); PG8_MMA(1, 1, At, B1); PG8_BAR; PG8_SCHED;
            PG8_LDB(B0, 1, 0); PG8_LDB(B1, 1, 1); PG8_SCHED; PG8_LDA(At, 1, 0); PG8_STAGEA(PG8_SA(0, 1), a21, k2);
            PG8_WAIT_V(8); PG8_WAIT_L(0); PG8_BAR; PG8_MMA(0, 0, At, B0); PG8_MMA(0, 1, At, B1); PG8_BAR; PG8_SCHED;
            PG8_LDA(At, 1, 1); PG8_STAGEB(PG8_SB(1, 0), b3); PG8_STAGEB(PG8_SB(1, 1), b3 + hstep); PG8_STAGEA(PG8_SA(1, 0), a20, k3);
            PG8_WAIT_V(8); PG8_WAIT_L(0); PG8_BAR; PG8_MMA(1, 0, At, B0); PG8_MMA(1, 1, At, B1); PG8_BAR; PG8_SCHED;
        }
        if constexpr (F8) asm volatile("s_nop 15\n\ts_nop 15" ::: "memory");
        if (wr == 0) PG8_BAR;
        int t_e = threadIdx.x; asm volatile("" : "+v"(t_e));
        int fr_e = t_e & 15, fq_e = (t_e >> 4) & 3;
#pragma unroll
        for (int a = 0; a < 2; ++a)
#pragma unroll
            for (int b = 0; b < 2; ++b)
#pragma unroll
                for (int m = 0; m < 4; ++m)
#pragma unroll
                    for (int n = 0; n < 2; ++n) asm volatile("" : "+v"(acc[a][b][m][n]));
        E(acc, cur, wr, wc, fr_e, fq_e, (const LAS float*)(aux + AUX_SLOTS + (ui & 3) * AUX_SLOT_BYTES));
        if (PROBE_REPEAT == 30) { asm volatile("" : "+v"(t_e)); E(acc, cur, wr, wc, t_e & 15, (t_e >> 4) & 3, (const LAS float*)(aux + AUX_SLOTS + (ui & 3) * AUX_SLOT_BYTES)); }
        if (!has_next) break;
#pragma unroll
        for (int a = 0; a < 2; ++a)
#pragma unroll
            for (int b = 0; b < 2; ++b)
#pragma unroll
                for (int m = 0; m < 4; ++m)
#pragma unroll
                    for (int n = 0; n < 2; ++n) acc[a][b][m][n] = (f32x4){0.f, 0.f, 0.f, 0.f};
        cur = nxt; cB = nB; ++ui;
#pragma unroll
        for (int i = 0; i < 2; ++i) { cA0[i] = a20[i]; cA1[i] = a21[i]; }
        if (wr == 1) PG8_BAR;
    }
    PG8_WAIT_V(0);
    PG8_BAR;
#undef PG8_SA
#undef PG8_SB
#undef PG8_STAGEA
#undef PG8_AOFFS
#undef PG8_DMA4
#undef PG8_SIDE_DMA
#undef PG8_STAGEB
#undef PG8_LDA
#undef PG8_LDB
#undef PG8_MMA
#undef PG8_LD8
#undef PG8_LO
#undef PG8_HI
#undef PG8_WAIT_V
#undef PG8_WAIT_L
#undef PG8_BAR
#undef PG8_SCHED
}
}


typedef float f32x16 __attribute__((ext_vector_type(16)));
typedef short bf16x4 __attribute__((ext_vector_type(4)));
typedef unsigned u32x2 __attribute__((ext_vector_type(2)));
typedef float f32x2_t __attribute__((ext_vector_type(2)));
typedef __bf16 bf16x2_t __attribute__((ext_vector_type(2)));
__device__ __forceinline__ unsigned cvtpk(float lo, float hi) { const f32x2_t v = {lo, hi}; const bf16x2_t b = __builtin_convertvector(v, bf16x2_t); return __builtin_bit_cast(unsigned, b); }
template <int S8> __device__ __forceinline__ bf16x8 pack8(const f32x16& X) {
    u32x4 w; w.x = cvtpk(X[8 * S8 + 0], X[8 * S8 + 1]); w.y = cvtpk(X[8 * S8 + 2], X[8 * S8 + 3]); w.z = cvtpk(X[8 * S8 + 4], X[8 * S8 + 5]); w.w = cvtpk(X[8 * S8 + 6], X[8 * S8 + 7]);
    return __builtin_bit_cast(bf16x8, w);
}
__device__ __forceinline__ bf16x8 lds_b128(const LAS unsigned char* p) { return *(const LAS bf16x8*)p; }
__device__ __forceinline__ bf16x8 lds_2xb64(const LAS unsigned char* p) {
    const bf16x4 a = *(const LAS bf16x4*)p, b = *(const LAS bf16x4*)(p + 16);
    return __builtin_shufflevector(a, b, 0, 1, 2, 3, 4, 5, 6, 7);
}
__device__ __forceinline__ float fast_log_sigmoid(float x) { return fminf(x, 0.0f) - __logf(1.0f + __expf(-fabsf(x))); }

constexpr int GP = 144;
constexpr int GS_QD = 0, GS_KI = GS_QD + 64 * GP, GS_KET = GS_KI + 64 * GP, GS_VT = GS_KET + 64 * GP, GS_DEC = GS_VT + 128 * GP, GS_SIZE = GS_DEC + 256;
constexpr int GL_SSP = 2 * GS_SIZE, GL_CONST = GL_SSP + 1024, GL_OT = GL_CONST + 1024;
constexpr int OTP = 132;
constexpr int GL_END = GL_OT + 64 * OTP * 4;
static_assert(GL_END <= RING_BYTES && (GL_OT % 16) == 0 && (GS_SIZE % 16) == 0 && (GS_DEC % 16) == 0, "gla lds");

__device__ __forceinline__ void gla_item(const Ptrs& P, LAS unsigned char* lds, int bh) {
    const int tid = opaque_tid(), lane = tid & 63, w = __builtin_amdgcn_readfirstlane(tid >> 6), l31 = lane & 31, hh = lane >> 5;
    const int b = bh >> 2, h = bh & 3;
    const bool grpA = w < 4; const int wa = w & 3;
    const bf16* PROJ = (const bf16*)(P.ws + WS_PROJ); bf16* MIX = (bf16*)(P.ws + WS_MIX);
    const size_t tok0 = (size_t)b * SEQ;
    const char* ub = (const char*)(PROJ + tok0 * NPROJ);
    const unsigned laneoff = (unsigned)lane * (NPROJ * 2);
    const int cq0 = PC_Q + h * 64 + 16 * wa, ck0 = PC_K + h * 64 + 16 * wa, cg0 = PC_GK + h * 64 + 16 * wa, cv0 = PC_V + h * 128 + 32 * wa;
    const int oc = tid >> 3, ov = (tid & 7) * 16;
    const unsigned gateoff = (unsigned)oc * (NPROJ * 2) + (unsigned)ov * 2;
#define GLA_LD(colel, chunk, lo) (*(const v4u*)(ub + ((size_t)(chunk) * 64 * NPROJ + (colel)) * 2 + (lo)))
    LAS float* cst = (LAS float*)(lds + GL_CONST);
    if (tid < 64) cst[tid] = P.b_gk[h * 64 + tid]; else if (tid < 192) cst[tid] = P.gla_norm_w[tid - 64];
    f32x16 S0, S1;
#pragma unroll
    for (int r = 0; r < 16; ++r) { S0[r] = 0.f; S1[r] = 0.f; }
    v4u nq[2], nk[2], ng[2];
    if (grpA) {
#pragma unroll
        for (int s = 0; s < 2; ++s) { nq[s] = GLA_LD(cq0 + 8 * s, 0, laneoff); nk[s] = GLA_LD(ck0 + 8 * s, 0, laneoff); ng[s] = GLA_LD(cg0 + 8 * s, 0, laneoff); }
    }
    __syncthreads();
#define GLA_STAGE_A(c) do { \
        LAS unsigned char* set_ = lds + ((c) & 1) * GS_SIZE; \
        v4u cq_[2], ck_[2], cg_[2], cv_[4]; \
        _Pragma("unroll") for (int s = 0; s < 2; ++s) { cq_[s] = nq[s]; ck_[s] = nk[s]; cg_[s] = ng[s]; } \
        _Pragma("unroll") for (int s = 0; s < 4; ++s) cv_[s] = GLA_LD(cv0 + 8 * s, (c), laneoff);     \
        { const int nc_ = (c) + 1 < SEQ / 64 ? (c) + 1 : (c); \
          _Pragma("unroll") for (int s = 0; s < 2; ++s) { nq[s] = GLA_LD(cq0 + 8 * s, nc_, laneoff); nk[s] = GLA_LD(ck0 + 8 * s, nc_, laneoff); ng[s] = GLA_LD(cg0 + 8 * s, nc_, laneoff); } } \
        _Pragma("unroll") for (int s = 0; s < 2; ++s) { \
            const int kc_ = 16 * wa + 8 * s; \
            const unsigned qw_[4] = {cq_[s].x, cq_[s].y, cq_[s].z, cq_[s].w}, kw_[4] = {ck_[s].x, ck_[s].y, ck_[s].z, ck_[s].w}, gw_[4] = {cg_[s].x, cg_[s].y, cg_[s].z, cg_[s].w}; \
            const f32x4 bg0_ = *(const LAS f32x4*)(cst + kc_), bg1_ = *(const LAS f32x4*)(cst + kc_ + 4); \
            float bb_[8];                                   \
            _Pragma("unroll") for (int j = 0; j < 8; ++j) { const float x_ = bf2f((gw_[j >> 1] >> (16 * (j & 1))) & 0xffffu) + (j < 4 ? bg0_[j & 3] : bg1_[j & 3]); \
                const float l2_ = __builtin_amdgcn_logf(1.0f + __builtin_amdgcn_exp2f(fabsf(x_) * -1.4426950408889634f));     \
                bb_[j] = wave_incl_scan(fminf(x_, 0.0f) * (1.4426950408889634f / 16.0f) - l2_ * (1.0f / 16.0f)); } \
            float qd_[8], ki_[8], ke_[8]; \
            _Pragma("unroll") for (int j = 0; j < 8; ++j) { \
                const float e_ = __builtin_amdgcn_exp2f(bb_[j]), ie_ = __builtin_amdgcn_exp2f(-bb_[j]); \
                const float dec_ = __builtin_bit_cast(float, __builtin_amdgcn_readlane(__builtin_bit_cast(int, e_), 63));     \
                const float qv_ = bf2f((qw_[j >> 1] >> (16 * (j & 1))) & 0xffffu), kv_ = bf2f((kw_[j >> 1] >> (16 * (j & 1))) & 0xffffu); \
                qd_[j] = qv_ * (e_ * 0.125f); ki_[j] = kv_ * ie_; ke_[j] = ki_[j] * dec_; \
                if (lane == 63) *(LAS float*)(set_ + GS_DEC + (kc_ + j) * 4) = e_; } \
            u32x4 t_; t_.x = cvtpk(qd_[0], qd_[1]); t_.y = cvtpk(qd_[2], qd_[3]); t_.z = cvtpk(qd_[4], qd_[5]); t_.w = cvtpk(qd_[6], qd_[7]); \
            *(LAS u32x4*)(set_ + GS_QD + lane * GP + kc_ * 2) = t_; \
            t_.x = cvtpk(ki_[0], ki_[1]); t_.y = cvtpk(ki_[2], ki_[3]); t_.z = cvtpk(ki_[4], ki_[5]); t_.w = cvtpk(ki_[6], ki_[7]); \
            *(LAS u32x4*)(set_ + GS_KI + lane * GP + kc_ * 2) = t_; \
            _Pragma("unroll") for (int j = 0; j < 4; ++j) { const unsigned pk_ = cvtpk(ke_[2 * j], ke_[2 * j + 1]); \
                *(LAS unsigned short*)(set_ + GS_KET + (kc_ + 2 * j) * GP + lane * 2) = (unsigned short)(pk_ & 0xffffu); *(LAS unsigned short*)(set_ + GS_KET + (kc_ + 2 * j + 1) * GP + lane * 2) = (unsigned short)(pk_ >> 16); } } \
        _Pragma("unroll") for (int s = 0; s < 4; ++s) { const unsigned vw_[4] = {cv_[s].x, cv_[s].y, cv_[s].z, cv_[s].w}; \
            _Pragma("unroll") for (int j = 0; j < 8; ++j) *(LAS unsigned short*)(set_ + GS_VT + (32 * wa + 8 * s + j) * GP + lane * 2) = (unsigned short)((vw_[j >> 1] >> (16 * (j & 1))) & 0xffffu); } \
    } while (0)
    if (grpA) GLA_STAGE_A(0);
    __syncthreads();
    for (int n = 0; n < SEQ / 64; ++n) {
        const v4u gate0 = GLA_LD(PC_G + h * 128, n, gateoff), gate1 = GLA_LD(PC_G + h * 128 + 8, n, gateoff);
        if (grpA) {
            if (n + 1 < SEQ / 64) GLA_STAGE_A(n + 1);
        } else {
            const LAS unsigned char* set = lds + (n & 1) * GS_SIZE;
            const int vc = wa;
            f32x16 O0, O1;
#pragma unroll
            for (int r = 0; r < 16; ++r) { O0[r] = 0.f; O1[r] = 0.f; }
            {
                const bf16x8 s00 = pack8<0>(S0), s01 = pack8<1>(S0), s10 = pack8<0>(S1), s11 = pack8<1>(S1);
                const LAS unsigned char* q0 = set + GS_QD + l31 * GP + 8 * hh; const LAS unsigned char* q1 = q0 + 32 * GP;
                const bf16x8 a0 = lds_2xb64(q0), a1 = lds_2xb64(q0 + 32), a2 = lds_2xb64(q0 + 64), a3 = lds_2xb64(q0 + 96);
                const bf16x8 b0 = lds_2xb64(q1), b1 = lds_2xb64(q1 + 32), b2 = lds_2xb64(q1 + 64), b3 = lds_2xb64(q1 + 96);
                O0 = __builtin_amdgcn_mfma_f32_32x32x16_bf16(s00, a0, O0, 0, 0, 0); O1 = __builtin_amdgcn_mfma_f32_32x32x16_bf16(s00, b0, O1, 0, 0, 0);
                O0 = __builtin_amdgcn_mfma_f32_32x32x16_bf16(s01, a1, O0, 0, 0, 0); O1 = __builtin_amdgcn_mfma_f32_32x32x16_bf16(s01, b1, O1, 0, 0, 0);
                O0 = __builtin_amdgcn_mfma_f32_32x32x16_bf16(s10, a2, O0, 0, 0, 0); O1 = __builtin_amdgcn_mfma_f32_32x32x16_bf16(s10, b2, O1, 0, 0, 0);
                O0 = __builtin_amdgcn_mfma_f32_32x32x16_bf16(s11, a3, O0, 0, 0, 0); O1 = __builtin_amdgcn_mfma_f32_32x32x16_bf16(s11, b3, O1, 0, 0, 0);
            }
            {
                const LAS unsigned char* kA0 = set + GS_KI + l31 * GP + 16 * hh; const LAS unsigned char* kA1 = kA0 + 32 * GP;
                const LAS unsigned char* qB0 = set + GS_QD + l31 * GP + 16 * hh; const LAS unsigned char* qB1 = qB0 + 32 * GP;
                const LAS unsigned char* vrow = set + GS_VT + (vc * 32 + l31) * GP + 8 * hh;
                bf16x8 fa[4], fb[4];
                f32x16 X;
#pragma unroll
                for (int kk = 0; kk < 4; ++kk) { fa[kk] = lds_b128(kA0 + 32 * kk); fb[kk] = lds_b128(qB0 + 32 * kk); }
                const bf16x8 v0 = lds_2xb64(vrow), v1 = lds_2xb64(vrow + 32);
#pragma unroll
                for (int r = 0; r < 16; ++r) X[r] = 0.f;
#pragma unroll
                for (int kk = 0; kk < 4; ++kk) X = __builtin_amdgcn_mfma_f32_32x32x16_bf16(fa[kk], fb[kk], X, 0, 0, 0);
#pragma unroll
                for (int kk = 0; kk < 4; ++kk) fb[kk] = lds_b128(qB1 + 32 * kk);
#pragma unroll
                for (int r = 0; r < 16; ++r) { const int srow = (r & 3) + 8 * (r >> 2) + 4 * hh; X[r] = (srow <= l31) ? X[r] : 0.f; }
                O0 = __builtin_amdgcn_mfma_f32_32x32x16_bf16(v0, pack8<0>(X), O0, 0, 0, 0); O0 = __builtin_amdgcn_mfma_f32_32x32x16_bf16(v1, pack8<1>(X), O0, 0, 0, 0);
#pragma unroll
                for (int r = 0; r < 16; ++r) X[r] = 0.f;
#pragma unroll
                for (int kk = 0; kk < 4; ++kk) X = __builtin_amdgcn_mfma_f32_32x32x16_bf16(fa[kk], fb[kk], X, 0, 0, 0);
#pragma unroll
                for (int kk = 0; kk < 4; ++kk) fa[kk] = lds_b128(kA1 + 32 * kk);
                O1 = __builtin_amdgcn_mfma_f32_32x32x16_bf16(v0, pack8<0>(X), O1, 0, 0, 0); O1 = __builtin_amdgcn_mfma_f32_32x32x16_bf16(v1, pack8<1>(X), O1, 0, 0, 0);
                const bf16x8 v2 = lds_2xb64(vrow + 64), v3 = lds_2xb64(vrow + 96);
#pragma unroll
                for (int r = 0; r < 16; ++r) X[r] = 0.f;
#pragma unroll
                for (int kk = 0; kk < 4; ++kk) X = __builtin_amdgcn_mfma_f32_32x32x16_bf16(fa[kk], fb[kk], X, 0, 0, 0);
#pragma unroll
                for (int r = 0; r < 16; ++r) { const int srow = (r & 3) + 8 * (r >> 2) + 4 * hh; X[r] = (srow <= l31) ? X[r] : 0.f; }
                O1 = __builtin_amdgcn_mfma_f32_32x32x16_bf16(v2, pack8<0>(X), O1, 0, 0, 0); O1 = __builtin_amdgcn_mfma_f32_32x32x16_bf16(v3, pack8<1>(X), O1, 0, 0, 0);
            }
            {
                const LAS float* dec = (const LAS float*)(set + GS_DEC);
                const LAS unsigned char* ka0 = set + GS_KET + l31 * GP + 16 * hh; const LAS unsigned char* ka1 = ka0 + 32 * GP;
                const LAS unsigned char* vb = set + GS_VT + (vc * 32 + l31) * GP + 16 * hh;
                bf16x8 e0[4], e1[4], vv[4];
#pragma unroll
                for (int ss = 0; ss < 4; ++ss) { e0[ss] = lds_b128(ka0 + 32 * ss); e1[ss] = lds_b128(ka1 + 32 * ss); vv[ss] = lds_b128(vb + 32 * ss); }
#pragma unroll
                for (int g4 = 0; g4 < 4; ++g4) { const f32x4 d0 = *(const LAS f32x4*)(dec + 8 * g4 + 4 * hh), d1 = *(const LAS f32x4*)(dec + 32 + 8 * g4 + 4 * hh);
#pragma unroll
                    for (int i = 0; i < 4; ++i) { S0[4 * g4 + i] *= d0[i]; S1[4 * g4 + i] *= d1[i]; } }
#pragma unroll
                for (int ss = 0; ss < 4; ++ss) { S0 = __builtin_amdgcn_mfma_f32_32x32x16_bf16(e0[ss], vv[ss], S0, 0, 0, 0); S1 = __builtin_amdgcn_mfma_f32_32x32x16_bf16(e1[ss], vv[ss], S1, 0, 0, 0); }
            }
            {
                float q0 = 0.f, q1 = 0.f;
#pragma unroll
                for (int r = 0; r < 16; ++r) { q0 += O0[r] * O0[r]; q1 += O1[r] * O1[r]; }
                q0 += __shfl_xor(q0, 32); q1 += __shfl_xor(q1, 32);
                if (hh == 0) { *(LAS float*)(lds + GL_SSP + (vc * 64 + l31) * 4) = q0; *(LAS float*)(lds + GL_SSP + (vc * 64 + 32 + l31) * 4) = q1; }
                LAS float* ot0 = (LAS float*)(lds + GL_OT) + l31 * OTP + vc * 32 + 4 * hh; LAS float* ot1 = ot0 + 32 * OTP;
#pragma unroll
                for (int g4 = 0; g4 < 4; ++g4) { *(LAS f32x4*)(ot0 + 8 * g4) = (f32x4){O0[4 * g4], O0[4 * g4 + 1], O0[4 * g4 + 2], O0[4 * g4 + 3]};
                    *(LAS f32x4*)(ot1 + 8 * g4) = (f32x4){O1[4 * g4], O1[4 * g4 + 1], O1[4 * g4 + 2], O1[4 * g4 + 3]}; }
            }
        }
        __syncthreads();
        {
            const LAS float* ssp = (const LAS float*)(lds + GL_SSP) + oc;
            const float tot = (ssp[0] + ssp[64]) + (ssp[128] + ssp[192]);
            const float rstd = 1.0f / sqrtf(tot * (1.0f / 128.0f) + EPS);
            const LAS float* ot = (const LAS float*)(lds + GL_OT) + oc * OTP + ov;
            const LAS float* nwp = cst + 64 + ov;
            const unsigned gw[8] = {gate0.x, gate0.y, gate0.z, gate0.w, gate1.x, gate1.y, gate1.z, gate1.w};
            float y[16];
#pragma unroll
            for (int q4 = 0; q4 < 4; ++q4) { const f32x4 o4 = *(const LAS f32x4*)(ot + 4 * q4), n4 = *(const LAS f32x4*)(nwp + 4 * q4);
#pragma unroll
                for (int i = 0; i < 4; ++i) { const int j = 4 * q4 + i; const float gv = bf2f((gw[j >> 1] >> (16 * (j & 1))) & 0xffffu); y[j] = o4[i] * rstd * n4[i] * gv * __builtin_amdgcn_rcpf(1.0f + __expf(-gv)); } }
            bf16* orow = MIX + (tok0 + (size_t)n * 64 + oc) * D + h * 128 + ov;
            u32x4 t; t.x = cvtpk(y[0], y[1]); t.y = cvtpk(y[2], y[3]); t.z = cvtpk(y[4], y[5]); t.w = cvtpk(y[6], y[7]); *(u32x4*)orow = t;
            t.x = cvtpk(y[8], y[9]); t.y = cvtpk(y[10], y[11]); t.z = cvtpk(y[12], y[13]); t.w = cvtpk(y[14], y[15]); *(u32x4*)(orow + 8) = t;
        }
        __syncthreads();
    }
#undef GLA_STAGE_A
#undef GLA_LD
}

constexpr int SP = 272;
constexpr int SG_W = 0, SG_VN = SG_W + 128 * SP, SG_OT = SG_VN + 128 * SP, SG_ST = SG_OT + 128 * SP, SG_END = SG_ST + 1024;
static_assert(SG_END <= RING_BYTES, "sgu lds");
__device__ __forceinline__ void sgu_item(const Ptrs& P, LAS unsigned char* lds, int bn) {
    const int tid = opaque_tid(), lane = tid & 63, w = __builtin_amdgcn_readfirstlane(tid >> 6), l31 = lane & 31, hh = lane >> 5;
    const bf16* PROJ = (const bf16*)(P.ws + WS_PROJ); bf16* MIX = (bf16*)(P.ws + WS_MIX); const bf16* Wsp = (const bf16*)(P.ws + WS_WSP);
    const size_t tok0 = (size_t)bn * 128;
    LAS float* st = (LAS float*)(lds + SG_ST);
    {
        v4u raws[16];
#pragma unroll
        for (int rr = 0; rr < 16; ++rr) raws[rr] = *(const v4u*)(PROJ + (tok0 + 16 * w + rr) * NPROJ + PC_VS + lane * 8);
#pragma unroll
        for (int rr = 0; rr < 16; ++rr) { const int row = 16 * w + rr; const unsigned rw[4] = {raws[rr].x, raws[rr].y, raws[rr].z, raws[rr].w};
            float s = 0.f, q = 0.f;
#pragma unroll
            for (int j = 0; j < 8; ++j) { const float g = gelu_tanh(bf2f((rw[j >> 1] >> (16 * (j & 1))) & 0xffffu)); s += g; q += g * g; }
            s = wave_sum(s); q = wave_sum(q);
            const float mu = s * (1.0f / 512.0f), var = fmaxf(q * (1.0f / 512.0f) - mu * mu, 0.f);
            if (lane == 0) { st[row] = mu; st[128 + row] = 1.0f / sqrtf(var + EPS); } }
    }
    const int s_ = tid & 127, c0_ = (tid >> 7) * 32;
    const int t_ = tid >> 2, cg_ = (tid & 3) * 32;
    v4u vsr[4];
#pragma unroll
    for (int q4 = 0; q4 < 4; ++q4) vsr[q4] = *(const v4u*)(PROJ + (tok0 + s_) * NPROJ + PC_VS + c0_ + q4 * 8);
    __syncthreads();
    for (int g = 0; g < 4; ++g) {
#pragma unroll
        for (int ps = 0; ps < 4; ++ps) { const int idx = ps * NTHR + tid, row = idx >> 4, c16 = idx & 15;
            *(LAS v4u*)(lds + SG_W + row * SP + c16 * 16) = *(const v4u*)(Wsp + ((size_t)g * 128 + row) * 128 + c16 * 8); }
        { const float mu = st[s_], rs = st[128 + s_];
#pragma unroll
          for (int q4 = 0; q4 < 4; ++q4) { const int cb = c0_ + q4 * 8;
              const unsigned rw[4] = {vsr[q4].x, vsr[q4].y, vsr[q4].z, vsr[q4].w};
              const f32x4 lw0 = *(const f32x4*)(P.sg_ln_w + g * 128 + cb), lw1 = *(const f32x4*)(P.sg_ln_w + g * 128 + cb + 4), lb0 = *(const f32x4*)(P.sg_ln_b + g * 128 + cb), lb1 = *(const f32x4*)(P.sg_ln_b + g * 128 + cb + 4);
#pragma unroll
              for (int j = 0; j < 8; ++j) { const float gv = gelu_tanh(bf2f((rw[j >> 1] >> (16 * (j & 1))) & 0xffffu));
                  const float vn = (gv - mu) * rs * (j < 4 ? lw0[j & 3] : lw1[j & 3]) + (j < 4 ? lb0[j & 3] : lb1[j & 3]);
                  *(LAS unsigned short*)(lds + SG_VN + (cb + j) * SP + s_ * 2) = (unsigned short)f2bf(vn); } } }
        v4u ur[4];
#pragma unroll
        for (int q4 = 0; q4 < 4; ++q4) ur[q4] = *(const v4u*)(PROJ + (tok0 + t_) * NPROJ + PC_U + g * 128 + cg_ + q4 * 8);
        { const int gn = g < 3 ? g + 1 : g;
#pragma unroll
          for (int q4 = 0; q4 < 4; ++q4) vsr[q4] = *(const v4u*)(PROJ + (tok0 + s_) * NPROJ + PC_VS + gn * 128 + c0_ + q4 * 8); }
        __syncthreads();
        { const int ct = w >> 1;
          const LAS unsigned char* arow = lds + SG_VN + (ct * 32 + l31) * SP + 16 * hh;
#pragma unroll
          for (int ti = 0; ti < 2; ++ti) { const int tt = (w & 1) * 2 + ti;
              const LAS unsigned char* brow = lds + SG_W + (tt * 32 + l31) * SP + 16 * hh;
              f32x16 acc;
#pragma unroll
              for (int r = 0; r < 16; ++r) acc[r] = 0.f;
              for (int ks = 0; ks < 2 * (tt + 1); ++ks) acc = __builtin_amdgcn_mfma_f32_32x32x16_bf16(lds_b128(arow + 32 * ks), lds_b128(brow + 32 * ks), acc, 0, 0, 0);
              const float bs = P.b_spatial[g * 128 + tt * 32 + l31];
              LAS unsigned char* orow = lds + SG_OT + (tt * 32 + l31) * SP + (ct * 32 + 4 * hh) * 2;
#pragma unroll
              for (int g4 = 0; g4 < 4; ++g4) { u32x2 pk; pk.x = cvtpk(acc[4 * g4] + bs, acc[4 * g4 + 1] + bs); pk.y = cvtpk(acc[4 * g4 + 2] + bs, acc[4 * g4 + 3] + bs); *(LAS u32x2*)(orow + 16 * g4) = pk; } } }
        __syncthreads();
        {
#pragma unroll
          for (int q4 = 0; q4 < 4; ++q4) { const v4u mx = *(const LAS v4u*)(lds + SG_OT + t_ * SP + (cg_ + q4 * 8) * 2);
              const unsigned mw[4] = {mx.x, mx.y, mx.z, mx.w}, uw[4] = {ur[q4].x, ur[q4].y, ur[q4].z, ur[q4].w}; unsigned ow[4];
#pragma unroll
              for (int j = 0; j < 4; ++j) { const float a0 = gelu_tanh(bf2f(uw[j] & 0xffffu)) * bf2f(mw[j] & 0xffffu), a1 = gelu_tanh(bf2f(uw[j] >> 16)) * bf2f(mw[j] >> 16); ow[j] = cvtpk(a0, a1); }
              *(v4u*)(MIX + (tok0 + t_) * D + 512 + g * 128 + cg_ + q4 * 8) = (v4u){ow[0], ow[1], ow[2], ow[3]}; } }
    }
    __syncthreads();
}
constexpr int CW_CONVQ = 192;
constexpr int CONV_UNIT = 4;
struct WItem { const float* src; int ldn; unsigned char* wt; int d0, k0; };
__device__ __forceinline__ WItem moe_witem(const Ptrs& P, int it, int lane) {
    WItem w; const int sub = lane >> 5, col = lane & 31;
    if (it < IT_GU) { const int e = it / 1024, r = it % 1024, db = r / 16, kb = r % 16, d0 = db * 32, pn = d0 >> 8, bj = (d0 >> 7) & 1, rr = d0 & 127;
        w.ldn = 2048; w.src = P.w_gate_up + (size_t)e * D * 2048 + (size_t)(kb * 64 + sub) * 2048 + bj * 1024 + 128 * pn + rr + col; w.wt = (unsigned char*)(P.ws + WS_WGU) + (size_t)e * 2048 * D; w.d0 = d0; w.k0 = kb * 64; }
    else { it -= IT_GU; const int e = it / 512, r = it % 512, db = r / 16, kb = r % 16;
        w.ldn = D; w.src = P.w_down + (size_t)e * DE * D + (size_t)(kb * 64 + sub) * D + db * 32 + col; w.wt = (unsigned char*)(P.ws + WS_WD) + (size_t)e * D * DE; w.d0 = db * 32; w.k0 = kb * 64; }
    return w;
}
__device__ __forceinline__ void moe_weight_items(const Ptrs& P, unsigned char* lds_generic, int units_per_grab, int max_grabs) {
    const int tid_ = opaque_tid(), lane = tid_ & 63, wave = __builtin_amdgcn_readfirstlane(tid_ >> 6);
    float* scr = (float*)(lds_generic + wave * 16384);
    unsigned* q = (unsigned*)(P.ws + WS_CTL) + CW_CONVQ;
    constexpr unsigned NUNITS = (IT_GU + IT_DN) / CONV_UNIT;
    int grab = units_per_grab;
    for (int ng = 0; ng < max_grabs; ++ng) {
        unsigned c0 = 0; if (lane == 0) c0 = __hip_atomic_fetch_add(q, (unsigned)grab, RLX_AGENT);
        c0 = __builtin_amdgcn_readfirstlane(c0);
        if (c0 >= NUNITS) break;
        const unsigned c1 = (c0 + (unsigned)grab < NUNITS) ? c0 + (unsigned)grab : NUNITS;
        if (c1 >= NUNITS * 3 / 4) grab = 1;
        const int it0 = (int)(c0 * CONV_UNIT), it1 = (int)(c1 * CONV_UNIT);
        float v[32]; WItem cur = moe_witem(P, it0, lane);
#pragma unroll
        for (int i = 0; i < 32; ++i) v[i] = __builtin_nontemporal_load(cur.src + (size_t)(2 * i) * cur.ldn);
#pragma nounroll
        for (int it = it0; it < it1; ++it) {
            float vn[32]; WItem nxt = cur;
            if (it + 1 < it1) { nxt = moe_witem(P, it + 1, lane);
#pragma unroll
                for (int i = 0; i < 32; ++i) vn[i] = __builtin_nontemporal_load(nxt.src + (size_t)(2 * i) * nxt.ldn); }
#pragma unroll
            for (int i = 0; i < 32; ++i) scr[(2 * i + (lane >> 5)) * 33 + (lane & 31)] = v[i];
            __builtin_amdgcn_wave_barrier(); asm volatile("s_waitcnt lgkmcnt(0)" ::: "memory");
            p0_tr_write_f8(cur.wt, D, cur.d0, cur.k0, scr, lane, F8S_W);
            asm volatile("s_waitcnt lgkmcnt(0)" ::: "memory"); __builtin_amdgcn_wave_barrier();
            cur = nxt;
#pragma unroll
            for (int i = 0; i < 32; ++i) v[i] = vn[i];
        }
    }
}
#define P2_MARK(id, wg) do { if (PROBE_P2 == (id) && (int)blockIdx.x == (wg) && threadIdx.x == 0) __hip_atomic_store((unsigned*)(P.ws + WS_CTL) + 201, (unsigned)__builtin_amdgcn_s_memrealtime(), RLX_AGENT); } while (0)
__device__ __forceinline__ void ph2_mix_fast(const Ptrs& P, LAS unsigned char* lds, unsigned char* lds_generic, int G) {
    const int bid = blockIdx.x;
    if (PROBE_P2 >= 0 && bid == 0 && threadIdx.x == 0) __hip_atomic_store((unsigned*)(P.ws + WS_CTL) + 200, (unsigned)__builtin_amdgcn_s_memrealtime(), RLX_AGENT);
    if (G >= 128) {
        if (bid < 64) { for (int rep = 0; rep < ((PROBE_REPEAT == 21) ? 2 : 1); ++rep) gla_item(P, lds, bid); }
        else { for (int rep = 0; rep < ((PROBE_REPEAT == 20) ? 2 : 1); ++rep) for (int it = bid - 64; it < NB * 16; it += G - 64) sgu_item(P, lds, it); }
    } else {
        for (int it = bid; it < 64; it += G) gla_item(P, lds, it);
        for (int it = bid; it < NB * 16; it += G) sgu_item(P, lds, it);
    }
    __syncthreads();
    P2_MARK(0, 0); P2_MARK(1, 64); P2_MARK(5, 255);
    moe_weight_items(P, lds_generic, 4, 1 << 30);
    __syncthreads();
    P2_MARK(2, 64); P2_MARK(3, 255); P2_MARK(4, 0);
}

constexpr size_t WS_WR2 = WS_WSP + 256 * 1024;
__device__ __forceinline__ void p0_wr2(const Ptrs& P, int gtid, int gthreads) {
    f32x4* WR2 = (f32x4*)(P.ws + WS_WR2);
    for (int idx = gtid; idx < 32 * 2 * 2 * 64; idx += gthreads) { const int jj = idx >> 8, i4 = (idx >> 7) & 1, tl = (idx >> 6) & 1, q = (idx >> 4) & 3, e = tl * 16 + (idx & 15); f32x4 o;
#pragma unroll
        for (int i = 0; i < 4; ++i) { const int k = 32 * jj + 8 * q + 4 * i4 + i; o[i] = P.w_router[(size_t)k * NE + e] * P.norm_ffn_w[k]; }
        WR2[idx] = o; }
}
__device__ __forceinline__ bool rt_better(float va, int ia, float vb, int ib) { return va > vb || (va == vb && ia < ib); }
__device__ __forceinline__ void ph4_router_fast(const Ptrs& P, LAS unsigned char* lds, int G) {
    const int tid = opaque_tid(), lane = tid & 63, wave = __builtin_amdgcn_readfirstlane(tid >> 6), tk = lane & 15, q = lane >> 4;
    unsigned* ctl = (unsigned*)(P.ws + WS_CTL);
    LAS unsigned* lcnt = (LAS unsigned*)lds; LAS unsigned* lbase = lcnt + 32;
    const f32x4* WR2 = (const f32x4*)(P.ws + WS_WR2);
    const int NGRP = T / 16, rounds = (NGRP + G * NWAVES - 1) / (G * NWAVES);
    for (int rd = 0; rd < rounds; ++rd) {
        if (tid < 32) lcnt[tid] = 0u;
        __syncthreads();
        const int grp = (rd * G + (int)blockIdx.x) * NWAVES + wave; const bool act = grp < NGRP;
        const int m0 = (act ? grp : 0) * 16;
        LAS float* xt = (LAS float*)(lds + 1024 + wave * (16 * 132 * 4));
        const int ldr = lane >> 5, lc = (lane & 31) * 4;
        f32x4 d0 = {0.f, 0.f, 0.f, 0.f}, d1 = {0.f, 0.f, 0.f, 0.f}; float psq[8];
#pragma unroll
        for (int i = 0; i < 8; ++i) psq[i] = 0.f;
        f32x4 nxv[8]; uint2 nav[8];
#pragma unroll
        for (int i = 0; i < 8; ++i) { const size_t ro = (size_t)(m0 + 2 * i + ldr) * D + lc; nxv[i] = *(const f32x4*)(P.x + ro); nav[i] = *(const uint2*)((const bf16*)(P.ws + WS_A1) + ro); }
#pragma nounroll
        for (int ch = 0; ch < 8; ++ch) {
            const int c0 = ch * 128 + lc, c1 = (ch < 7 ? ch + 1 : ch) * 128 + lc;
            const f32x4 nwv = *(const f32x4*)(P.norm_ffn_w + c0);
            f32x4 xv[8]; uint2 av[8];
#pragma unroll
            for (int i = 0; i < 8; ++i) { xv[i] = nxv[i]; av[i] = nav[i]; }
#pragma unroll
            for (int i = 0; i < 8; ++i) { const size_t ro = (size_t)(m0 + 2 * i + ldr) * D + c1; nxv[i] = *(const f32x4*)(P.x + ro); nav[i] = *(const uint2*)((const bf16*)(P.ws + WS_A1) + ro); }
#pragma unroll
            for (int i = 0; i < 8; ++i) { const size_t ro = (size_t)(m0 + 2 * i + ldr) * D + c0;
                const f32x4 x1 = {xv[i][0] + bf2f(av[i].x & 0xffffu), xv[i][1] + bf2f(av[i].x >> 16), xv[i][2] + bf2f(av[i].y & 0xffffu), xv[i][3] + bf2f(av[i].y >> 16)};
                psq[i] += (x1[0] * x1[0] + x1[1] * x1[1]) + (x1[2] * x1[2] + x1[3] * x1[3]);
                *(LAS f32x4*)(xt + (2 * i + ldr) * 132 + lc) = x1;
                *(uint2*)((bf16*)(P.ws + WS_X1B) + ro) = make_uint2(cvtpk(x1[0], x1[1]), cvtpk(x1[2], x1[3]));
                *(unsigned*)((unsigned char*)(P.ws + WS_H) + ro) = pk4_fp8(x1[0] * nwv[0] * F8S_H, x1[1] * nwv[1] * F8S_H, x1[2] * nwv[2] * F8S_H, x1[3] * nwv[3] * F8S_H); }
#pragma unroll
            for (int j4 = 0; j4 < 4; ++j4) { const int jj = ch * 4 + j4;
                const f32x4 xa = *(const LAS f32x4*)(xt + tk * 132 + 32 * j4 + 8 * q), xb = *(const LAS f32x4*)(xt + tk * 132 + 32 * j4 + 8 * q + 4);
                const f32x4 w0a = WR2[((jj * 2 + 0) * 2 + 0) * 64 + lane], w1a = WR2[((jj * 2 + 0) * 2 + 1) * 64 + lane], w0b = WR2[((jj * 2 + 1) * 2 + 0) * 64 + lane], w1b = WR2[((jj * 2 + 1) * 2 + 1) * 64 + lane];
#pragma unroll
                for (int i = 0; i < 4; ++i) { d0 = __builtin_amdgcn_mfma_f32_16x16x4f32(w0a[i], xa[i], d0, 0, 0, 0); d1 = __builtin_amdgcn_mfma_f32_16x16x4f32(w1a[i], xa[i], d1, 0, 0, 0); }
#pragma unroll
                for (int i = 0; i < 4; ++i) { d0 = __builtin_amdgcn_mfma_f32_16x16x4f32(w0b[i], xb[i], d0, 0, 0, 0); d1 = __builtin_amdgcn_mfma_f32_16x16x4f32(w1b[i], xb[i], d1, 0, 0, 0); } }
        }
#pragma unroll
        for (int i = 0; i < 8; ++i) { float v = psq[i]; v += dpp_f<0x111, 0xF>(v); v += dpp_f<0x112, 0xF>(v); v += dpp_f<0x114, 0xF>(v); v += dpp_f<0x118, 0xF>(v); v += dpp_f<0x142, 0xA>(v);
            if ((lane & 31) == 31) xt[2 * i + ldr] = v; }
        float ssq = xt[tk];

        const float rstd = 1.0f / sqrtf(ssq * (1.f / D) + EPS);
        float cv[8]; int ci[8];
#pragma unroll
        for (int r = 0; r < 4; ++r) { cv[r] = d0[r] * rstd + P.b_router[4 * q + r]; ci[r] = 4 * q + r; cv[4 + r] = d1[r] * rstd + P.b_router[16 + 4 * q + r]; ci[4 + r] = 16 + 4 * q + r; }
        float sv[4]; int si[4];
#pragma unroll
        for (int r = 0; r < 4; ++r) { float bv = cv[0]; int bi = ci[0];
#pragma unroll
            for (int c = 1; c < 8; ++c) if (rt_better(cv[c], ci[c], bv, bi)) { bv = cv[c]; bi = ci[c]; }
            sv[r] = bv; si[r] = bi;
#pragma unroll
            for (int c = 0; c < 8; ++c) if (ci[c] == bi) cv[c] = -3.0e38f; }
#pragma unroll
        for (int off = 16; off <= 32; off <<= 1) {
            float ov[4]; int oi[4];
#pragma unroll
            for (int r = 0; r < 4; ++r) { ov[r] = __shfl_xor(sv[r], off); oi[r] = __shfl_xor(si[r], off); }
            float mv[8]; int mi[8];
#pragma unroll
            for (int r = 0; r < 4; ++r) { mv[r] = sv[r]; mi[r] = si[r]; mv[4 + r] = ov[r]; mi[4 + r] = oi[r]; }
#pragma unroll
            for (int r = 0; r < 4; ++r) { float bv = mv[0]; int bi = mi[0];
#pragma unroll
                for (int c = 1; c < 8; ++c) if (rt_better(mv[c], mi[c], bv, bi)) { bv = mv[c]; bi = mi[c]; }
                sv[r] = bv; si[r] = bi;
#pragma unroll
                for (int c = 0; c < 8; ++c) if (mi[c] == bi) mv[c] = -3.0e38f; }
        }
        float pw[4], den = 0.f;
#pragma unroll
        for (int r = 0; r < 4; ++r) { pw[r] = __expf(sv[r] - sv[0]); den += pw[r]; }
        int ee = si[0]; float ww = pw[0];
#pragma unroll
        for (int r = 1; r < 4; ++r) if (q == r) { ee = si[r]; ww = pw[r]; }
        ww /= den;
        unsigned lr = 0u;
        if (act) lr = __hip_atomic_fetch_add(lcnt + ee, 1u, __ATOMIC_RELAXED, __HIP_MEMORY_SCOPE_WORKGROUP);
        __syncthreads();
        if (tid < 32) lbase[tid] = __hip_atomic_fetch_add(ctl + CW_COUNTS + tid, lcnt[tid], RLX_AGENT);
        __syncthreads();
        if (act) { const unsigned rank = lbase[ee] + lr; const int m = m0 + tk;
            ((int*)(P.ws + WS_ROUTE + RT_ROWTOK))[(size_t)ee * T + rank] = m;
            ((float*)(P.ws + WS_ROUTE + RT_ROWW))[(size_t)ee * T + rank] = ww;
            ((int*)(P.ws + WS_ROUTE + RT_TOKSLOT))[(size_t)m * 4 + q] = (ee << 16) | (int)rank;
            ((float*)(P.ws + WS_RRSTD))[(size_t)ee * T + rank] = rstd; }
        __syncthreads();
    }
}

struct Args { Ptrs P; int ph_lo, ph_hi, li, pad; };

__device__ __forceinline__ void ph0_prep(const Ptrs& P, unsigned char* lds_generic, int vcu, int G) {
    const int tid = opaque_tid(), lane = tid & 63, wave = __builtin_amdgcn_readfirstlane(tid >> 6);
    float* scr = (float*)(lds_generic + wave * 16384);
    const int gw = vcu * NWAVES + wave, NGW = G * NWAVES;
    for (int it = gw; it < IT_IN + IT_OUT; it += NGW) p0_weight_item(P, it, scr, lane);
    bf16* Wsp = (bf16*)(P.ws + WS_WSP);
    for (int i = blockIdx.x * NTHR + tid; i < 4 * 128 * 128; i += G * NTHR) { const int t = (i >> 7) & 127, s = i & 127; Wsp[i] = (bf16)f2bf(s <= t ? P.w_spatial[i] : 0.f); }
    p0_wr2(P, blockIdx.x * NTHR + tid, G * NTHR);
    bf16* H = (bf16*)(P.ws + WS_H);
    for (int mb = gw; mb < T; mb += 4 * NGW) {
        f32x4 v[4][4];
#pragma unroll
        for (int t = 0; t < 4; ++t) { const int m = (mb + t * NGW < T) ? mb + t * NGW : mb;
#pragma unroll
            for (int j = 0; j < 4; ++j) v[t][j] = ((const f32x4*)(P.x + (size_t)m * D))[lane + 64 * j]; }
#pragma unroll
        for (int t = 0; t < 4; ++t) { const int m = mb + t * NGW;
            if (m < T) { float sq = 0.f;
#pragma unroll
                for (int j = 0; j < 4; ++j) sq += (v[t][j].x * v[t][j].x + v[t][j].y * v[t][j].y) + (v[t][j].z * v[t][j].z + v[t][j].w * v[t][j].w);
                const float rstd = 1.0f / sqrtf(wave_sum(sq) * (1.f / D) + EPS);
                unsigned long long* o8 = (unsigned long long*)(H + (size_t)m * D) + lane;
#pragma unroll
                for (int j = 0; j < 4; ++j) { const f32x4 ww = ((const f32x4*)P.norm_mix_w)[lane + 64 * j];
                    o8[64 * j] = (unsigned long long)pk2(v[t][j].x * rstd * ww.x, v[t][j].y * rstd * ww.y) | ((unsigned long long)pk2(v[t][j].z * rstd * ww.z, v[t][j].w * rstd * ww.w) << 32); } } }
    }
}
__device__ __forceinline__ void moe_tables(const Ptrs& P, LAS int* tab) {
    const unsigned* ctl = (const unsigned*)(P.ws + WS_CTL);
    if (threadIdx.x < NE) tab[66 + threadIdx.x] = (int)__hip_atomic_load(ctl + CW_COUNTS + threadIdx.x, RLX_AGENT);
    __syncthreads();
    if (threadIdx.x == 0) { int a = 0; for (int e = 0; e < NE; ++e) { tab[e] = a; tab[33 + e] = a * MT; a += (tab[66 + e] + MT - 1) / MT; } tab[NE] = a; tab[33 + NE] = a * MT; }
    __syncthreads();
}
__device__ __forceinline__ void ph7_final(const Ptrs& P, const LAS int* tab, int G, volatile LAS unsigned* MISC) {
    const int tid = opaque_tid(), lane = tid & 63, wave = tid >> 6;
    const unsigned char* Y = (const unsigned char*)(P.ws + WS_YBUF);
    constexpr int TB = 2;
    const int stride = G * NWAVES;
    uint2 xb[2][TB][4]; int yv[2][TB][4][4];
#define FIN_LOAD(buf, mb_) do { if ((mb_) < T) _Pragma("unroll") for (int t = 0; t < TB; ++t) { const int m_ = ((mb_) + t * stride < T) ? (mb_) + t * stride : (T - 1); \
            const int4 ts_ = *(const int4*)((const int*)(P.ws + WS_ROUTE + RT_TOKSLOT) + (size_t)m_ * 4); const int pk_[4] = {ts_.x, ts_.y, ts_.z, ts_.w}; \
            const bf16* X1_ = (const bf16*)(P.ws + WS_X1B) + (size_t)m_ * D; \
            _Pragma("unroll") for (int j = 0; j < 4; ++j) xb[buf][t][j] = ((const uint2*)X1_)[lane + 64 * j]; \
            _Pragma("unroll") for (int r = 0; r < 4; ++r) { const size_t slot_ = (size_t)tab[33 + (pk_[r] >> 16)] + (pk_[r] & 0xffff); \
                _Pragma("unroll") for (int j = 0; j < 4; ++j) yv[buf][t][r][j] = ((const int*)(Y + slot_ * D))[lane + 64 * j]; } } } while (0)
#define FIN_DO(buf, mb_) do { _Pragma("unroll") for (int t = 0; t < TB; ++t) { const int m = (mb_) + t * stride; \
            if (m < T) { f32x4 v[4]; \
                _Pragma("unroll") for (int j = 0; j < 4; ++j) { v[j] = (f32x4){bf2f(xb[buf][t][j].x & 0xffffu), bf2f(xb[buf][t][j].x >> 16), bf2f(xb[buf][t][j].y & 0xffffu), bf2f(xb[buf][t][j].y >> 16)}; \
                    _Pragma("unroll") for (int r = 0; r < 4; ++r) { const auto lo = __builtin_amdgcn_cvt_pk_f32_fp8(yv[buf][t][r][j], false), hi = __builtin_amdgcn_cvt_pk_f32_fp8(yv[buf][t][r][j], true); \
                        v[j].x += lo[0] * (1.0f / F8S_Y); v[j].y += lo[1] * (1.0f / F8S_Y); v[j].z += hi[0] * (1.0f / F8S_Y); v[j].w += hi[1] * (1.0f / F8S_Y); } } \
                float s = 0.f; \
                _Pragma("unroll") for (int j = 0; j < 4; ++j) s += (v[j].x * v[j].x + v[j].y * v[j].y) + (v[j].z * v[j].z + v[j].w * v[j].w); \
                const float rstd = 1.0f / sqrtf(wave_sum(s) * (1.f / D) + EPS); \
                _Pragma("unroll") for (int j = 0; j < 4; ++j) { const f32x4 ww = ((const f32x4*)P.norm_final_w)[lane + 64 * j]; \
                    ((f32x4*)(P.out + (size_t)m * D))[lane + 64 * j] = (f32x4){v[j].x * rstd * ww.x, v[j].y * rstd * ww.y, v[j].z * rstd * ww.z, v[j].w * rstd * ww.w}; } \
                if (PROBE_STAMP >= 0 && m == 0 && lane == 0) { asm volatile("s_waitcnt vmcnt(0)" ::: "memory"); P.out[0] += (float)(MISC[17] - MISC[16]) * (0.01f / 4.0f); } \
                if (PROBE_P2 >= 0 && m == 0 && lane == 0) { asm volatile("s_waitcnt vmcnt(0)" ::: "memory"); const unsigned* cw_ = (const unsigned*)(P.ws + WS_CTL); P.out[0] += (float)(__hip_atomic_load(cw_ + 201, RLX_AGENT) - __hip_atomic_load(cw_ + 200, RLX_AGENT)) * (0.01f / 4.0f); } } } } while (0)
    const int mb0 = blockIdx.x * NWAVES + wave;
    if (mb0 < T) {
        FIN_LOAD(0, mb0);
        for (int mb = mb0; mb < T; mb += 2 * TB * stride) {
            FIN_LOAD(1, mb + TB * stride);
            FIN_DO(0, mb);
            FIN_LOAD(0, mb + 2 * TB * stride);
            FIN_DO(1, mb + TB * stride);
        }
    }
#undef FIN_LOAD
#undef FIN_DO
}

constexpr int NPHASE = 8;
__global__ void __launch_bounds__(NTHR, 2) mk_fwd(Args args) {
    extern __shared__ __attribute__((aligned(16))) unsigned char lds_raw[];
    LAS unsigned char* lds = (LAS unsigned char*)lds_raw;
    const Ptrs& P = args.P;
    const int tid = threadIdx.x, G = gridDim.x;
    const int vcu = (G % 8 == 0) ? ((int)blockIdx.x % 8) * (G / 8) + (int)blockIdx.x / 8 : (int)blockIdx.x;
    volatile LAS unsigned* MISC = (volatile LAS unsigned*)(lds + MISC_OFF);
    LAS int* tab = (LAS int*)(lds + TAB_OFF);
    if (tid < 64) MISC[tid] = 0u;
    __syncthreads();
    unsigned* ctl = (unsigned*)(P.ws + WS_CTL);
    XcdBarrier bar = xcd_barrier_post(ctl + CW_BAR + args.li * XCD_BAR_WORDS, MISC + 8);
    const int lo = args.ph_lo, hi = args.ph_hi;
#define IN(k) (lo <= (k) && (k) < hi)
#define NREP(k) ((PROBE_REPEAT == (k)) ? 2 : 1)
#define PH(k, ...) if (IN(k)) { if (PROBE_STAMP == (k) && tid == 0) MISC[16] = (unsigned)__builtin_amdgcn_s_memrealtime(); \
        for (int rep = 0; rep < NREP(k); ++rep) { __VA_ARGS__; if (rep + 1 < NREP(k) || IN((k) + 1)) xcd_barrier(bar); } \
        if (PROBE_STAMP == (k) && tid == 0) MISC[17] = (unsigned)__builtin_amdgcn_s_memrealtime(); }
    PH(0, ph0_prep(P, lds_raw, vcu, G));
    PH(1, { pg8::DenseSched S; S.init(T, NPROJ, D, G, (int)blockIdx.x); pg8::EpiProj E{(bf16*)(P.ws + WS_PROJ)};
            pg8::gemm_phase(lds, lds + AUX_OFF, (const char*)(P.ws + WS_H), (const char*)(P.ws + WS_WIN), D, S, E);
            { const int nwg = (T / 256) * (NPROJ / 256), full = nwg / G, rem = nwg % G;
              if (rep == 0 && rem != 0 && (int)blockIdx.x >= rem && full > 0) { __syncthreads(); moe_weight_items(P, lds_raw, PROBE_REPEAT == 40 ? 2 : 1, 1); } } });
    PH(2, ph2_mix_fast(P, lds, lds_raw, G));
    PH(3, { pg8::DenseSched S; S.init(T, D, D, G, (int)blockIdx.x); pg8::EpiA1 E{(bf16*)(P.ws + WS_A1)};
            pg8::gemm_phase(lds, lds + AUX_OFF, (const char*)(P.ws + WS_MIX), (const char*)(P.ws + WS_WOUT), D, S, E); });
    PH(4, ph4_router_fast(P, lds, G));
    if (IN(5) || IN(6) || IN(7)) moe_tables(P, tab);
    constexpr int KM = MOE_FP8 ? D / 2 : D;
    PH(5, { pg8::MoeSched<true> S{tab, (const int*)(P.ws + WS_ROUTE + RT_ROWTOK), 8, G, (int)blockIdx.x, __builtin_amdgcn_readfirstlane(tab[NE]) * 8, KM, 2048};
            pg8::EpiAct E{(bf16*)(P.ws + WS_ACT), P.b_gate_up, (const float*)(P.ws + WS_RRSTD)};
            pg8::gemm_phase<MOE_FP8 != 0>(lds, lds + AUX_OFF, (const char*)(P.ws + WS_H), (const char*)(P.ws + WS_WGU), KM, S, E); });
    PH(6, { pg8::MoeSched<false> S{tab, nullptr, 4, G, (int)blockIdx.x, __builtin_amdgcn_readfirstlane(tab[NE]) * 4, KM, 1024};
            pg8::EpiDown E{(bf16*)(P.ws + WS_YBUF), P.b_down, (const float*)(P.ws + WS_ROUTE + RT_ROWW)};
            pg8::gemm_phase<MOE_FP8 != 0>(lds, lds + AUX_OFF, (const char*)(P.ws + WS_ACT), (const char*)(P.ws + WS_WD), KM, S, E); });
    PH(7, ph7_final(P, tab, G, MISC));
#undef IN
#undef NREP
#undef PH
}

#ifndef MK_SEGMENTS
#define MK_SEGMENTS 1
#endif
extern "C" void kernel_launch(void* const* d_in, const int* in_sizes, int n_in, void* d_out, int out_size, void* d_ws, size_t ws_size, hipStream_t stream) {
    if (n_in != 19 || out_size != T * D || ws_size < WS_END) { fprintf(stderr, "kernel_launch: unexpected shapes n_in %d out %d ws %zu (need %zu)\n", n_in, out_size, ws_size, (size_t)WS_END); return; }
    static int grid = 0;
    if (grid == 0) {
        int dev = 0, cus = 0, per_cu = 0;
        if (hipGetDevice(&dev) != hipSuccess || hipDeviceGetAttribute(&cus, hipDeviceAttributeMultiprocessorCount, dev) != hipSuccess) { fprintf(stderr, "kernel_launch: device query failed\n"); grid = -1; return; }
        if (hipFuncSetAttribute((const void*)mk_fwd, hipFuncAttributeMaxDynamicSharedMemorySize, LDS_BYTES) != hipSuccess) { fprintf(stderr, "kernel_launch: hipFuncSetAttribute failed\n"); grid = -1; return; }
        if (hipOccupancyMaxActiveBlocksPerMultiprocessor(&per_cu, (const void*)mk_fwd, NTHR, LDS_BYTES) != hipSuccess || per_cu < 1) { fprintf(stderr, "kernel_launch: occupancy query says %d\n", per_cu); per_cu = 1; }
        (void)hipGetLastError();
        grid = cus;
        fprintf(stderr, "kernel_launch: cus %d per_cu %d grid %d\n", cus, per_cu, grid);
    }
    if (grid < 0) return;
    Args a{};
    const float** pp = (const float**)&a.P;
    for (int i = 0; i < 19; ++i) pp[i] = (const float*)d_in[i];
    a.P.out = (float*)d_out; a.P.ws = (unsigned char*)d_ws;
    (void)hipMemsetAsync((char*)d_ws + WS_CTL, 0, MiB, stream);
#if MK_SEGMENTS == 1
    a.ph_lo = 0; a.ph_hi = NPHASE; a.li = 0;
    void* kargs[] = {&a};
    hipError_t e = hipLaunchCooperativeKernel((const void*)mk_fwd, dim3(grid), dim3(NTHR), kargs, LDS_BYTES, stream);
    if (e != hipSuccess) fprintf(stderr, "kernel_launch: cooperative launch failed: %s (grid %d)\n", hipGetErrorString(e), grid);
#else
    for (int ph = 0; ph < NPHASE; ++ph) { a.ph_lo = ph; a.ph_hi = ph + 1; a.li = ph; hipLaunchKernelGGL(mk_fwd, dim3(grid), dim3(NTHR), LDS_BYTES, stream, a); }
#endif
}
```

```cpp
#include <hip/hip_runtime.h>
#include <cstdio>
#include <cstdint>

constexpr int T = 32768, D = 1024, SEQ = 2048, NB = 16;
constexpr int NIN_SRC = 2576, NPROJ = 2816;
constexpr int PC_Q = 0, PC_K = 256, PC_V = 512, PC_G = 1024, PC_GK = 1536, PC_U = 1792, PC_VS = 2304;
constexpr int NE = 32, TOPK = 4, DE = 1024;
constexpr int MT = 256;
constexpr int MAXSLOTS = T * TOPK + NE * MT;
constexpr float EPS = 1e-6f;

typedef unsigned short bf16;
typedef unsigned v4u __attribute__((ext_vector_type(4)));
typedef float f32x4 __attribute__((ext_vector_type(4)));

constexpr size_t MiB = 1u << 20;
constexpr size_t WS_CTL   = 0;
constexpr size_t WS_WIN   = 1 * MiB;
constexpr size_t WS_WOUT  = 7 * MiB;
constexpr size_t WS_WSP   = 9 * MiB;
constexpr size_t WS_ROUTE = 10 * MiB;
constexpr size_t WS_WGU   = 20 * MiB;
constexpr size_t WS_WD    = 148 * MiB;
constexpr size_t WS_X1    = 212 * MiB;
constexpr size_t WS_ACT   = 340 * MiB;
constexpr size_t WS_PROJ  = 612 * MiB;
constexpr size_t WS_MIX   = 788 * MiB;
constexpr size_t WS_H     = 852 * MiB;
constexpr size_t WS_YBUF  = WS_PROJ;
constexpr size_t WS_A1    = WS_X1;
constexpr size_t WS_X1B   = WS_X1 + 64 * MiB;
constexpr size_t WS_RRSTD = WS_H + 32 * MiB;
constexpr size_t WS_VN    = WS_ACT;
constexpr size_t WS_END   = 916 * MiB;
static_assert(WS_YBUF + (size_t)MAXSLOTS * 1024 * 2 <= WS_END, "ybuf fits");
static_assert(WS_ACT + (size_t)MAXSLOTS * 1024 * 2 <= WS_PROJ, "act fits");
constexpr size_t RT_ROWTOK = 0;
constexpr size_t RT_ROWW   = 4 * MiB;
constexpr size_t RT_TOKSLOT= 8 * MiB;
constexpr int CW_COUNTS = 64;
constexpr int CW_PSTART = 128;

__device__ __forceinline__ unsigned f2bf(float f) { unsigned u = __builtin_bit_cast(unsigned, f); return (u + 0x7fffu + ((u >> 16) & 1u)) >> 16; }
__device__ __forceinline__ float bf2f(unsigned h) { return __builtin_bit_cast(float, h << 16); }
__device__ __forceinline__ unsigned pk2(float lo, float hi) { return f2bf(lo) | (f2bf(hi) << 16); }
#ifndef MOE_FP8
#define MOE_FP8 1
#endif
constexpr float F8S_H = 8.0f, F8S_W = 32.0f, F8S_ACT = 4.0f, F8S_Y = 64.0f;
__device__ __forceinline__ float f8clamp(float x) { return fminf(fmaxf(x, -448.0f), 448.0f); }
__device__ __forceinline__ unsigned pk4_fp8(float a, float b, float c, float d) {
    int w = 0; w = __builtin_amdgcn_cvt_pk_fp8_f32(f8clamp(a), f8clamp(b), w, false); w = __builtin_amdgcn_cvt_pk_fp8_f32(f8clamp(c), f8clamp(d), w, true); return (unsigned)w; }
__device__ __forceinline__ unsigned pk4_fp8_nc(float a, float b, float c, float d) { int w = 0; w = __builtin_amdgcn_cvt_pk_fp8_f32(a, b, w, false); w = __builtin_amdgcn_cvt_pk_fp8_f32(c, d, w, true); return (unsigned)w; }
__device__ __forceinline__ float gelu_tanh(float x) { const float x2 = x * x, t = x * (x2 * (-2.0f * 1.4426950408889634f * 0.7978845608028654f * 0.044715f) + (-2.0f * 1.4426950408889634f * 0.7978845608028654f));
    return x * __builtin_amdgcn_rcpf(1.0f + __builtin_amdgcn_exp2f(t)); }
__device__ __forceinline__ float silu(float x) { return x / (1.0f + __expf(-x)); }
__device__ __forceinline__ float log_sigmoid(float x) { return fminf(x, 0.0f) - log1pf(__expf(-fabsf(x))); }
template <int CTRL, int ROWMASK> __device__ __forceinline__ float dpp_f(float v) {
    return __builtin_bit_cast(float, __builtin_amdgcn_update_dpp(0, __builtin_bit_cast(int, v), CTRL, ROWMASK, 0xF, true)); }
__device__ __forceinline__ float wave_incl_scan(float v) {
    v += dpp_f<0x111, 0xF>(v); v += dpp_f<0x112, 0xF>(v); v += dpp_f<0x114, 0xF>(v); v += dpp_f<0x118, 0xF>(v);
    v += dpp_f<0x142, 0xA>(v); v += dpp_f<0x143, 0xC>(v); return v; }
__device__ __forceinline__ float wave_sum(float v) { return __builtin_bit_cast(float, __builtin_amdgcn_readlane(__builtin_bit_cast(int, wave_incl_scan(v)), 63)); }

struct Ptrs {
    const float *x, *norm_mix_w, *w_in, *w_gk_up, *b_gk, *gla_norm_w, *sg_ln_w, *sg_ln_b, *w_spatial, *b_spatial, *w_out, *norm_ffn_w,
                *w_router, *b_router, *w_gate_up, *b_gate_up, *w_down, *b_down, *norm_final_w;
    float* out; unsigned char* ws;
};

__device__ __forceinline__ void p0_tr_write(bf16* WT, int K, int d0, int k0, const float* scr, int lane) {
    const int c = lane & 7;
#pragma unroll
    for (int j = 0; j < 4; ++j) { const int n = (lane >> 3) + 8 * j; const float* s = scr + (8 * c) * 33 + n;
        v4u o; o.x = pk2(s[0 * 33], s[1 * 33]); o.y = pk2(s[2 * 33], s[3 * 33]); o.z = pk2(s[4 * 33], s[5 * 33]); o.w = pk2(s[6 * 33], s[7 * 33]);
        *(v4u*)(WT + (size_t)(d0 + n) * K + k0 + 8 * c) = o; }
}
__device__ __forceinline__ void p0_tr_write_f8(unsigned char* WT, int K, int d0, int k0, const float* scr, int lane, float sc) {
    const int c = lane & 7;
#pragma unroll
    for (int j = 0; j < 4; ++j) { const int n = (lane >> 3) + 8 * j; const float* s = scr + (8 * c) * 33 + n;
        uint2 o; o.x = pk4_fp8(s[0 * 33] * sc, s[1 * 33] * sc, s[2 * 33] * sc, s[3 * 33] * sc); o.y = pk4_fp8(s[4 * 33] * sc, s[5 * 33] * sc, s[6 * 33] * sc, s[7 * 33] * sc);
        *(uint2*)(WT + (size_t)(d0 + n) * K + k0 + 8 * c) = o; }
}
template <bool F8 = false>
__device__ __forceinline__ void p0_transpose_item(const float* W, int ldn, int n0, int k0, bf16* WT, int K, int d0, float* scr, int lane) {
    float v[32];
    const float* src = W + (size_t)(k0 + (lane >> 5)) * ldn + n0 + (lane & 31);
#pragma unroll
    for (int i = 0; i < 32; ++i) v[i] = __builtin_nontemporal_load(src + (size_t)(2 * i) * ldn);
#pragma unroll
    for (int i = 0; i < 32; ++i) scr[(2 * i + (lane >> 5)) * 33 + (lane & 31)] = v[i];
    __builtin_amdgcn_wave_barrier(); asm volatile("s_waitcnt lgkmcnt(0)" ::: "memory");
    if constexpr (F8) p0_tr_write_f8((unsigned char*)WT, K, d0, k0, scr, lane, F8S_W); else p0_tr_write(WT, K, d0, k0, scr, lane);
    asm volatile("s_waitcnt lgkmcnt(0)" ::: "memory"); __builtin_amdgcn_wave_barrier();
}
__device__ __forceinline__ void p0_gk_item(const float* w_in, const float* w_gk_up, int j0, int k0, bf16* WT, float* scr, int lane) {
    for (int i = 0; i < 32; ++i) { const int kk = 2 * i + (lane >> 5), j = j0 + (lane & 31); float s = 0.f;
#pragma unroll
        for (int r = 0; r < 16; ++r) s += w_in[(size_t)(k0 + kk) * NIN_SRC + 1536 + r] * w_gk_up[r * 256 + j];
        scr[kk * 33 + (lane & 31)] = s; }
    __builtin_amdgcn_wave_barrier(); asm volatile("s_waitcnt lgkmcnt(0)" ::: "memory");
    p0_tr_write(WT, D, PC_GK + j0, k0, scr, lane);
    asm volatile("s_waitcnt lgkmcnt(0)" ::: "memory"); __builtin_amdgcn_wave_barrier();
}
constexpr int IT_IN = (NPROJ / 32) * 16, IT_OUT = 32 * 16, IT_GU = NE * 64 * 16, IT_DN = NE * 32 * 16, IT_ALL = IT_IN + IT_OUT + IT_GU + IT_DN;
__device__ __forceinline__ void p0_weight_item(const Ptrs& P, int it, float* scr, int lane) {
    bf16* WinT = (bf16*)(P.ws + WS_WIN); bf16* WoutT = (bf16*)(P.ws + WS_WOUT); bf16* WguT = (bf16*)(P.ws + WS_WGU); bf16* WdT = (bf16*)(P.ws + WS_WD);
    if (it < IT_IN) { const int db = it / 16, kb = it % 16, d0 = db * 32;
        if (d0 >= PC_GK && d0 < PC_U) return;
        else p0_transpose_item(P.w_in, NIN_SRC, d0 < PC_GK ? d0 : d0 - 240, kb * 64, WinT, D, d0, scr, lane);
        return; }
    it -= IT_IN;
    if (it < IT_OUT) { const int db = it / 16, kb = it % 16; p0_transpose_item(P.w_out, D, db * 32, kb * 64, WoutT, D, db * 32, scr, lane); return; }
    it -= IT_OUT;
    if (it < IT_GU) { const int e = it / 1024, r = it % 1024, db = r / 16, kb = r % 16, d0 = db * 32, pn = d0 >> 8, bj = (d0 >> 7) & 1, rr = d0 & 127;
        if (MOE_FP8) p0_transpose_item<true>(P.w_gate_up + (size_t)e * D * 2048, 2048, bj * 1024 + 128 * pn + rr, kb * 64, (bf16*)((unsigned char*)WguT + (size_t)e * 2048 * D), D, d0, scr, lane);
        else p0_transpose_item(P.w_gate_up + (size_t)e * D * 2048, 2048, bj * 1024 + 128 * pn + rr, kb * 64, WguT + (size_t)e * 2048 * D, D, d0, scr, lane);
        return; }
    it -= IT_GU;
    { const int e = it / 512, r = it % 512, db = r / 16, kb = r % 16;
      if (MOE_FP8) p0_transpose_item<true>(P.w_down + (size_t)e * DE * D, D, db * 32, kb * 64, (bf16*)((unsigned char*)WdT + (size_t)e * D * DE), DE, db * 32, scr, lane);
      else p0_transpose_item(P.w_down + (size_t)e * DE * D, D, db * 32, kb * 64, WdT + (size_t)e * D * DE, DE, db * 32, scr, lane); }
}
__device__ __forceinline__ void rms_row_to_bf16(const float* xrow, const float* w, bf16* orow, int lane) {
    const f32x4* xr = (const f32x4*)xrow + lane; const f32x4* wr = (const f32x4*)w + lane;
    f32x4 v[4]; float s = 0.f;
#pragma unroll
    for (int j = 0; j < 4; ++j) { v[j] = xr[64 * j]; s += (v[j].x * v[j].x + v[j].y * v[j].y) + (v[j].z * v[j].z + v[j].w * v[j].w); }
    const float rstd = 1.0f / sqrtf(wave_sum(s) * (1.f / D) + EPS);
    unsigned long long* o8 = (unsigned long long*)orow + lane;
#pragma unroll
    for (int j = 0; j < 4; ++j) { const f32x4 ww = wr[64 * j];
        o8[64 * j] = (unsigned long long)pk2(v[j].x * rstd * ww.x, v[j].y * rstd * ww.y) | ((unsigned long long)pk2(v[j].z * rstd * ww.z, v[j].w * rstd * ww.w) << 32); }
}

#ifndef PROBE_P2
#define PROBE_P2 -1
#endif
#ifndef PROBE_STAMP
#define PROBE_STAMP -1
#endif
#ifndef PROBE_REPEAT
#define PROBE_REPEAT -1
#endif
#define LAS __attribute__((address_space(3)))
__device__ __forceinline__ int opaque_tid() { int t = threadIdx.x; asm volatile("" : "+v"(t)); return t; }
typedef short bf16x8 __attribute__((ext_vector_type(8)));
typedef unsigned u32x4 __attribute__((ext_vector_type(4)));
constexpr int NWAVES = 8, NTHR = 512;
constexpr int RING_BYTES = 131072, TAB_OFF = RING_BYTES, MISC_OFF = RING_BYTES + 1024, AUX_OFF = RING_BYTES + 2048, AUX_ROWTAB = 0, AUX_SLOTS = 8192, AUX_SLOT_BYTES = 2048, LDS_BYTES = AUX_OFF + 16384;
constexpr int CW_BAR = 4096;
#define RLX_AGENT __ATOMIC_RELAXED, __HIP_MEMORY_SCOPE_AGENT

#define XB_TMO      128
#define XB_XCNT(j)  (256  + 64 * (j))
#define XB_XSUB(j)  (1280 + 64 * (j))
#define XB_XGEN(j)  (2304 + 64 * (j))
#define XB_TOP      3328
#define XB_TOPGEN   3392
#define XCD_BAR_WORDS 3456
#define XB_SPIN_CAP (1u << 20)
__device__ __forceinline__ unsigned xb_ld(unsigned* p)              { return __hip_atomic_load(p, __ATOMIC_RELAXED, __HIP_MEMORY_SCOPE_AGENT); }
__device__ __forceinline__ unsigned xb_add(unsigned* p, unsigned v) { return __hip_atomic_fetch_add(p, v, __ATOMIC_RELAXED, __HIP_MEMORY_SCOPE_AGENT); }
__device__ __forceinline__ unsigned xb_xcc_id() { return (unsigned)__builtin_amdgcn_s_getreg((3 << 11) | 20) & 0xFu; }
#define XB_SPIN(cond, bar) do { unsigned _sp = 0; while (cond) { __builtin_amdgcn_s_sleep(1); \
    if ((++_sp & 255u) == 0u) { if (xb_ld(&(bar)[XB_TMO])) break; if (_sp > XB_SPIN_CAP) { atomicAdd(&(bar)[XB_TMO], 1u); break; } } } } while (0)
struct XcdBarrier { unsigned* bar; unsigned x; volatile LAS unsigned* st; };
__device__ __forceinline__ XcdBarrier xcd_barrier_post(unsigned* bar, volatile LAS unsigned* st) {
    XcdBarrier b; b.bar = bar; b.x = xb_xcc_id(); b.st = st;
    if (threadIdx.x == 0) (void)xb_add(&bar[XB_XCNT(b.x)], 1u);
    return b;
}
__device__ __forceinline__ void xcd_barrier_complete(unsigned* bar, unsigned x, unsigned& nloc, unsigned& nx) {
    const unsigned G = gridDim.x * gridDim.y * gridDim.z;
    unsigned sum, cnt, mine, sp = 0u;
    for (;;) {
        sum = 0u; cnt = 0u; mine = 0u;
#pragma unroll
        for (unsigned j = 0; j < 16; ++j) { const unsigned c = xb_ld(&bar[XB_XCNT(j)]); sum += c; cnt += (c > 0u) ? 1u : 0u; mine = (j == x) ? c : mine; }
        if (sum == G) break;
        __builtin_amdgcn_s_sleep(1);
        if ((++sp & 255u) == 0u) { if (xb_ld(&bar[XB_TMO])) break; if (sp > XB_SPIN_CAP) { atomicAdd(&bar[XB_TMO], 1u); break; } }
    }
    nloc = mine > 0u ? mine : 1u; nx = cnt > 0u ? cnt : 1u;
}
__device__ __forceinline__ void xcd_barrier(const XcdBarrier& b) {
    asm volatile("s_waitcnt vmcnt(0)" ::: "memory");
    __syncthreads();
    if (threadIdx.x == 0) {
        unsigned* bar = b.bar;
        __builtin_amdgcn_s_waitcnt(0);
        unsigned nloc = b.st[0], nx = b.st[1];
        if (nloc == 0u) { xcd_barrier_complete(bar, b.x, nloc, nx); b.st[0] = nloc; b.st[1] = nx; }
        const unsigned old = xb_add(&bar[XB_XSUB(b.x)], 1u);
        const unsigned gen = old / nloc;
        if (old + 1u == (gen + 1u) * nloc) {
            __builtin_amdgcn_fence(__ATOMIC_RELEASE, "agent");
            asm volatile("s_waitcnt vmcnt(0)" ::: "memory");
            const unsigned og = xb_add(&bar[XB_TOP], 1u);
            const unsigned tg = og / nx;
            if (og + 1u == (tg + 1u) * nx) xb_add(&bar[XB_TOPGEN], 1u);
            else XB_SPIN(xb_ld(&bar[XB_TOPGEN]) == tg, bar);
            __builtin_amdgcn_fence(__ATOMIC_ACQUIRE, "agent");
            xb_add(&bar[XB_XGEN(b.x)], 1u);
            asm volatile("s_waitcnt vmcnt(0)" ::: "memory");
        } else {
            XB_SPIN(xb_ld(&bar[XB_XGEN(b.x)]) == gen, bar);
            __builtin_amdgcn_fence(__ATOMIC_ACQUIRE, "agent");
            asm volatile("s_waitcnt vmcnt(0)" ::: "memory");
        }
    }
    __syncthreads();
}

namespace pg8 {
constexpr int BM = 256, BK = 64, HALF = 128, HTB = HALF * BK * 2, NXCD = 8, WGM = 8;
__device__ __forceinline__ int lds_byte(int r, int c) { const int st = (r >> 4) * 2 + (c >> 5), rr = r & 15, cc = c & 31, ob = rr * 64 + cc * 2; return st * 1024 + (ob ^ (((ob >> 9) & 1) << 5)); }
__device__ __forceinline__ void stage_rc(int b, int& R, int& C) { const int st = b / 1024, sb = b % 1024, swz = sb ^ (((sb >> 9) & 1) << 5); R = (st >> 1) * 16 + swz / 64; C = (st & 1) * 32 + (swz % 64) / 2; }
__device__ __forceinline__ int perm32(int rho) { const int n = rho >> 4, i = rho & 15; return 8 * (i >> 2) + 4 * n + (i & 3); }
typedef float f32x2_t __attribute__((ext_vector_type(2)));
typedef __bf16 bf16x2_t __attribute__((ext_vector_type(2)));
__device__ __forceinline__ unsigned cvt_pk_bf16(float lo, float hi) { const f32x2_t v = {lo, hi}; const bf16x2_t b = __builtin_convertvector(v, bf16x2_t); return __builtin_bit_cast(unsigned, b); }
__device__ __forceinline__ int xcd_remap(int wgid, int nwg) { const int q = nwg / NXCD, r = nwg % NXCD, xcd = wgid % NXCD, off = wgid / NXCD; return (xcd < r ? xcd * (q + 1) : r * (q + 1) + (xcd - r) * q) + off; }

struct Unit { int pm, pn, e, m0, count, slot0; };
typedef f32x4 Acc[2][2][4][2];

struct DenseSched {
    int nM, nN, nwg, G, c, K, skip;
    __device__ __forceinline__ void init(int M, int N, int K_, int G_, int c_, int skip_ = 1 << 20) { nM = M / BM; nN = N / BM - (skip_ < N / BM ? 1 : 0); nwg = nM * nN; G = G_; c = c_; K = K_; skip = skip_; }
    __device__ __forceinline__ bool next(int i, Unit& u) const {
        const long L = (long)i * G + c; if (L >= nwg) return false;
        const int wgid = xcd_remap((int)L, nwg);
        const int nig = WGM * nN, gid = wgid / nig, fm = gid * WGM, gsz = (nM - fm) < WGM ? (nM - fm) : WGM;
        u.pm = fm + ((wgid % nig) % gsz); u.pn = (wgid % nig) / gsz; if (u.pn >= skip) ++u.pn; u.e = 0; u.m0 = 0; u.count = 0; u.slot0 = 0; return true;
    }
    static constexpr bool GATHER = false;
    __device__ __forceinline__ unsigned a_off(const Unit& u, int r) const { return (unsigned)(u.pm * BM + r) * (unsigned)(K * 2); }
    __device__ __forceinline__ const int* row_src(const Unit&, int) const { return nullptr; }
    __device__ __forceinline__ size_t b_off(const Unit& u) const { return (size_t)u.pn * BM * K * 2; }
};
template <bool GATHER_>
struct MoeSched {
    static constexpr bool GATHER = GATHER_;
    const LAS int* tab; const int* rowtok; int NPN, G, c, ntile, K, NB_E  ;
    __device__ __forceinline__ bool next(int i, Unit& u) const {
        const long L = (long)i * G + c; if (L >= ntile) return false;
        const int wgid = xcd_remap((int)L, ntile);
        int lo = 0, hi = NE;
#pragma unroll
        for (int s = 0; s < 5; ++s) { const int mid = (lo + hi) >> 1; if (__builtin_amdgcn_readfirstlane(tab[mid]) * NPN <= wgid) lo = mid; else hi = mid; }
        const int e = lo, t0 = __builtin_amdgcn_readfirstlane(tab[e]), mte = __builtin_amdgcn_readfirstlane(tab[e + 1]) - t0, local = wgid - t0 * NPN;
        u.e = e; u.pn = local / mte; u.pm = 0; u.m0 = (local % mte) * BM; u.count = __builtin_amdgcn_readfirstlane(tab[66 + e]); u.slot0 = __builtin_amdgcn_readfirstlane(tab[33 + e]); return true;
    }
    __device__ __forceinline__ const int* row_src(const Unit& u, int r) const { int m = u.m0 + r; m = m < u.count ? m : u.count - 1; return rowtok + (size_t)u.e * T + m; }
    __device__ __forceinline__ unsigned a_off(const Unit& u, int r) const {
        if (GATHER) return (unsigned)(*row_src(u, r)) * (unsigned)(K * 2);
        return (unsigned)(u.slot0 + u.m0 + r) * (unsigned)(K * 2);
    }
    __device__ __forceinline__ size_t b_off(const Unit& u) const { return ((size_t)u.e * NB_E + (size_t)u.pn * BM) * K * 2; }
};

struct EpiProj {
    static constexpr bool PERM = true, AUX = false;
    bf16* O;
    __device__ __forceinline__ const float* aux_src(const Unit&, int) const { return nullptr; }
    __device__ __forceinline__ void operator()(const Acc& acc, const Unit& u, int wr, int wc, int fr, int fq, const LAS float*) const {
        const int row0 = u.pm * BM + wr * 64 + fr, col0 = u.pn * BM + wc * 32 + 8 * fq;
#pragma unroll
        for (int ai = 0; ai < 2; ++ai)
#pragma unroll
            for (int m = 0; m < 4; ++m) { bf16* rowp = O + (size_t)(row0 + ai * HALF + m * 16) * NPROJ + col0;
#pragma unroll
                for (int bj = 0; bj < 2; ++bj) { const f32x4 v0 = acc[ai][bj][m][0], v1 = acc[ai][bj][m][1];
                    u32x4 w; w.x = cvt_pk_bf16(v0[0], v0[1]); w.y = cvt_pk_bf16(v0[2], v0[3]); w.z = cvt_pk_bf16(v1[0], v1[1]); w.w = cvt_pk_bf16(v1[2], v1[3]);
                    *(u32x4*)(rowp + bj * HALF) = w; } }
    }
};
struct EpiA1 {
    static constexpr bool PERM = true, AUX = false;
    bf16* O;
    __device__ __forceinline__ const float* aux_src(const Unit&, int) const { return nullptr; }
    __device__ __forceinline__ void operator()(const Acc& acc, const Unit& u, int wr, int wc, int fr, int fq, const LAS float*) const {
        const int row0 = u.pm * BM + wr * 64 + fr, col0 = u.pn * BM + wc * 32 + 8 * fq;
#pragma unroll
        for (int ai = 0; ai < 2; ++ai)
#pragma unroll
            for (int m = 0; m < 4; ++m) { bf16* rowp = O + (size_t)(row0 + ai * HALF + m * 16) * D + col0;
#pragma unroll
                for (int bj = 0; bj < 2; ++bj) { const f32x4 v0 = acc[ai][bj][m][0], v1 = acc[ai][bj][m][1];
                    u32x4 w; w.x = cvt_pk_bf16(v0[0], v0[1]); w.y = cvt_pk_bf16(v0[2], v0[3]); w.z = cvt_pk_bf16(v1[0], v1[1]); w.w = cvt_pk_bf16(v1[2], v1[3]);
                    *(u32x4*)(rowp + bj * HALF) = w; } }
    }
};
struct EpiAct {
    static constexpr bool PERM = true, AUX = true;
    bf16* O; const float* bgu; const float* rrstd;
    __device__ __forceinline__ const float* aux_src(const Unit& u, int idx) const {
        if (idx < 256) return bgu + (size_t)u.e * 2048 + (idx < 128 ? u.pn * 128 + idx : 1024 + u.pn * 128 + (idx - 128));
        int m = u.m0 + (idx - 256); m = m < u.count ? m : u.count - 1; return rrstd + (size_t)u.e * T + m; }
    __device__ __forceinline__ void operator()(const Acc& acc, const Unit& u, int wr, int wc, int fr, int fq, const LAS float* aux) const {
        const int colj = u.pn * 128 + wc * 32 + 8 * fq;
        const LAS float* bg = aux + wc * 32 + 8 * fq;
        const f32x4 g0 = *(const LAS f32x4*)bg, g1 = *(const LAS f32x4*)(bg + 4), u0 = *(const LAS f32x4*)(bg + 128), u1 = *(const LAS f32x4*)(bg + 132);
#pragma unroll
        for (int ai = 0; ai < 2; ++ai)
#pragma unroll
            for (int m = 0; m < 4; ++m) { const int r = ai * HALF + wr * 64 + m * 16 + fr;
                { float y[8]; const float rs = aux[256 + r] * (MOE_FP8 ? 1.0f / (F8S_H * F8S_W) : 1.0f);
#pragma unroll
                    for (int n = 0; n < 2; ++n)
#pragma unroll
                        for (int i = 0; i < 4; ++i) {
                            float g = acc[ai][0][m][n][i] * rs + (n ? g1[i] : g0[i]), up = acc[ai][1][m][n][i] * rs + (n ? u1[i] : u0[i]);
                            g = fminf(g, 7.0f); up = fminf(fmaxf(up, -7.0f), 7.0f); y[n * 4 + i] = (up + 1.0f) * g * __builtin_amdgcn_rcpf(1.0f + __expf(-1.702f * g)); }
                    if (MOE_FP8) { uint2 w; w.x = pk4_fp8_nc(y[0] * F8S_ACT, y[1] * F8S_ACT, y[2] * F8S_ACT, y[3] * F8S_ACT); w.y = pk4_fp8_nc(y[4] * F8S_ACT, y[5] * F8S_ACT, y[6] * F8S_ACT, y[7] * F8S_ACT);
                        *(uint2*)((unsigned char*)O + (size_t)(u.slot0 + u.m0 + r) * DE + colj) = w; }
                    else { u32x4 w; w.x = cvt_pk_bf16(y[0], y[1]); w.y = cvt_pk_bf16(y[2], y[3]); w.z = cvt_pk_bf16(y[4], y[5]); w.w = cvt_pk_bf16(y[6], y[7]);
                        *(u32x4*)(O + (size_t)(u.slot0 + u.m0 + r) * DE + colj) = w; } } }
    }
};
struct EpiDown {
    static constexpr bool PERM = true, AUX = true;
    bf16* O; const float* bd; const float* roww;
    __device__ __forceinline__ const float* aux_src(const Unit& u, int idx) const {
        if (idx < 256) return bd + (size_t)u.e * D + u.pn * BM + idx;
        int m = u.m0 + (idx - 256); m = m < u.count ? m : u.count - 1; return roww + (size_t)u.e * T + m; }
    __device__ __forceinline__ void operator()(const Acc& acc, const Unit& u, int wr, int wc, int fr, int fq, const LAS float* aux) const {
        const int col0 = u.pn * BM + wc * 32 + 8 * fq;
        const LAS float* bp = aux + wc * 32 + 8 * fq;
        f32x4 bv[2][2];
#pragma unroll
        for (int bj = 0; bj < 2; ++bj)
#pragma unroll
            for (int n = 0; n < 2; ++n) bv[bj][n] = *(const LAS f32x4*)(bp + bj * HALF + 4 * n);
#pragma unroll
        for (int ai = 0; ai < 2; ++ai)
#pragma unroll
            for (int m = 0; m < 4; ++m) { const int r = ai * HALF + wr * 64 + m * 16 + fr;
                { const float w8 = aux[256 + r]; bf16* rowp = O + (size_t)(u.slot0 + u.m0 + r) * D + col0;
#pragma unroll
                    for (int bj = 0; bj < 2; ++bj) { constexpr float isc = MOE_FP8 ? 1.0f / (F8S_ACT * F8S_W) : 1.0f;
                        const f32x4 v0 = (acc[ai][bj][m][0] * isc + bv[bj][0]) * w8, v1 = (acc[ai][bj][m][1] * isc + bv[bj][1]) * w8;
                        if (MOE_FP8) { uint2 w; w.x = pk4_fp8(v0[0] * F8S_Y, v0[1] * F8S_Y, v0[2] * F8S_Y, v0[3] * F8S_Y); w.y = pk4_fp8(v1[0] * F8S_Y, v1[1] * F8S_Y, v1[2] * F8S_Y, v1[3] * F8S_Y);
                            *(uint2*)((unsigned char*)O + (size_t)(u.slot0 + u.m0 + r) * D + col0 + bj * HALF) = w; }
                        else { u32x4 w; w.x = cvt_pk_bf16(v0[0], v0[1]); w.y = cvt_pk_bf16(v0[2], v0[3]); w.z = cvt_pk_bf16(v1[0], v1[1]); w.w = cvt_pk_bf16(v1[2], v1[3]);
                            *(u32x4*)(rowp + bj * HALF) = w; } } } }
    }
};

typedef int i32x4 __attribute__((ext_vector_type(4)));
typedef int i32x8 __attribute__((ext_vector_type(8)));
template <bool F8 = false, class Epi, class Sched>
__device__ __forceinline__ void gemm_phase(LAS unsigned char* lds, LAS unsigned char* aux, const char* gA, const char* gB, int K, const Sched& S, const Epi& E) {
    const int tid = opaque_tid(), wid = __builtin_amdgcn_readfirstlane(tid >> 6), lane = tid & 63, wr = wid >> 2, wc = wid & 3, fr = lane & 15, fq = lane >> 4;
    const int nt = K / BK;
    unsigned voffB[2];
#pragma unroll
    for (int i = 0; i < 2; ++i) { int R, C; stage_rc(tid * 16 + i * 8192, R, C); const int Rb = Epi::PERM ? ((R & ~31) + perm32(R & 31)) : R; voffB[i] = (unsigned)(Rb * K + C) * 2u; }
#define PG8_AOFFS(U, o0, o1) do { int t_ = tid; asm volatile("" : "+v"(t_)); _Pragma("unroll") for (int i = 0; i < 2; ++i) { int R, C; stage_rc(t_ * 16 + i * 8192, R, C); \
        o0[i] = S.a_off(U, R) + (unsigned)C * 2u; o1[i] = S.a_off(U, HALF + R) + (unsigned)C * 2u; } } while (0)
    const size_t hstep = (size_t)HALF * K * 2;
    const unsigned ldsw = (unsigned)wid * 1024u;
    const int aoff = lds_byte(wr * 64 + fr, fq * 8), boff = lds_byte(wc * 32 + fr, fq * 8);
#define PG8_SA(b, h) (((b) * 2 + (h)) * HTB)
#define PG8_SB(b, h) ((4 + (b) * 2 + (h)) * HTB)
#define PG8_STAGEB(bufoff, gbase) do { _Pragma("unroll") for (int _i = 0; _i < 2; ++_i) { unsigned _o = voffB[_i]; asm volatile("" : "+v"(_o)); \
        __builtin_amdgcn_global_load_lds((const unsigned*)((const char*)(gbase) + _o), (LAS unsigned*)(lds + (bufoff) + ldsw + _i * 8192), 16, 0, 0); } } while (0)
#define PG8_STAGEA(bufoff, voff2, kb) do { _Pragma("unroll") for (int _i = 0; _i < 2; ++_i) { unsigned _o = (voff2)[_i]; asm volatile("" : "+v"(_o)); \
        __builtin_amdgcn_global_load_lds((const unsigned*)((gA + (size_t)(kb)) + _o), (LAS unsigned*)(lds + (bufoff) + ldsw + _i * 8192), 16, 0, 0); } } while (0)
#define PG8_LD8(p) __builtin_shufflevector(*(const LAS i32x4*)(p), *(const LAS i32x4*)((p) + 1024), 0, 1, 2, 3, 4, 5, 6, 7)
#define PG8_LDA(dst, b, h) do { _Pragma("unroll") for (int m = 0; m < 4; ++m) dst[m] = PG8_LD8(lds + PG8_SA(b, h) + aoff + m * 2048); } while (0)
#define PG8_LDB(dst, b, h) do { _Pragma("unroll") for (int n = 0; n < 2; ++n) dst[n] = PG8_LD8(lds + PG8_SB(b, h) + boff + n * 2048); } while (0)
#define PG8_LO(x) __builtin_bit_cast(bf16x8, __builtin_shufflevector(x, x, 0, 1, 2, 3))
#define PG8_HI(x) __builtin_bit_cast(bf16x8, __builtin_shufflevector(x, x, 4, 5, 6, 7))
#define PG8_MMA(ai, bj, At, Bt) do { if constexpr (F8) __builtin_amdgcn_sched_barrier(0); __builtin_amdgcn_s_setprio(1); _Pragma("unroll") for (int m = 0; m < 4; ++m) _Pragma("unroll") for (int n = 0; n < 2; ++n) { \
        if constexpr (F8) asm volatile("v_mfma_scale_f32_16x16x128_f8f6f4 %0, %1, %2, %0, %3, %3 op_sel_hi:[0,0,0]" : "+v"(acc[ai][bj][m][n]) : "v"(Bt[n]), "v"(At[m]), "v"(f8scale)); \
        else { acc[ai][bj][m][n] = __builtin_amdgcn_mfma_f32_16x16x32_bf16(PG8_LO(Bt[n]), PG8_LO(At[m]), acc[ai][bj][m][n], 0, 0, 0); \
               acc[ai][bj][m][n] = __builtin_amdgcn_mfma_f32_16x16x32_bf16(PG8_HI(Bt[n]), PG8_HI(At[m]), acc[ai][bj][m][n], 0, 0, 0); } } \
        __builtin_amdgcn_s_setprio(0); if constexpr (F8) __builtin_amdgcn_sched_barrier(0); } while (0)
#define PG8_WAIT_V(n) asm volatile("s_waitcnt vmcnt(" #n ")" ::: "memory")
#define PG8_WAIT_L(n) asm volatile("s_waitcnt lgkmcnt(" #n ")" ::: "memory")
#define PG8_BAR __builtin_amdgcn_s_barrier()
#define PG8_SCHED __builtin_amdgcn_sched_barrier(0)
    Unit cur, nxt; int ui = 0;
    if (!S.next(0, cur)) return;
    Acc acc;
#pragma unroll
    for (int a = 0; a < 2; ++a)
#pragma unroll
        for (int b = 0; b < 2; ++b)
#pragma unroll
            for (int m = 0; m < 4; ++m)
#pragma unroll
                for (int n = 0; n < 2; ++n) acc[a][b][m][n] = (f32x4){0.f, 0.f, 0.f, 0.f};
    i32x8 At[4], B0[2], B1[2];
    int f8scale = 0x7F7F7F7F; asm volatile("" : "+v"(f8scale));
    unsigned cA0[2], cA1[2];
#define PG8_DMA4(src, dstoff) __builtin_amdgcn_global_load_lds((const unsigned*)(src), (LAS unsigned*)(aux + (dstoff) + wid * 256), 4, 0, 0)
#define PG8_SIDE_DMA(U, UI) do { if constexpr (Sched::GATHER) { int t_ = tid; asm volatile("" : "+v"(t_)); _Pragma("unroll") for (int p = 0; p < 4; ++p) { int R, C; stage_rc(t_ * 16 + (p & 1) * 8192, R, C); \
            PG8_DMA4(S.row_src(U, (p >> 1) * HALF + R), AUX_ROWTAB + p * 2048); } } \
        if constexpr (Epi::AUX) PG8_DMA4(E.aux_src(U, wid * 64 + lane), AUX_SLOTS + ((UI) & 3) * AUX_SLOT_BYTES); } while (0)
    if constexpr (Epi::AUX) PG8_DMA4(E.aux_src(cur, wid * 64 + lane), AUX_SLOTS);
    PG8_AOFFS(cur, cA0, cA1);
    const char* cB = gB + S.b_off(cur);
    PG8_STAGEB(PG8_SB(0, 0), cB); PG8_STAGEB(PG8_SB(0, 1), cB + hstep); PG8_STAGEA(PG8_SA(0, 0), cA0, 0); PG8_STAGEA(PG8_SA(0, 1), cA1, 0);
    if (wr == 1) PG8_BAR;
    PG8_WAIT_V(2); PG8_BAR;
    PG8_STAGEB(PG8_SB(1, 0), cB + BK * 2); PG8_STAGEA(PG8_SA(1, 0), cA0, BK * 2); PG8_STAGEB(PG8_SB(1, 1), cB + hstep + BK * 2);
    PG8_WAIT_V(6); PG8_BAR;
    for (;;) {
        const bool has_next = S.next(ui + 1, nxt);
        const char* nB = cB;
        if (has_next) { PG8_SIDE_DMA(nxt, ui + 1); nB = gB + S.b_off(nxt); }
        unsigned a20[2], a21[2];
#pragma nounroll
        for (int t = 0; t < nt; t += 2) {
            const bool last = (t == nt - 2);
            const unsigned k1 = (unsigned)(t + 1) * (BK * 2), k2 = last ? 0u : (unsigned)(t + 2) * (BK * 2), k3 = k2 + BK * 2;
            if (last && has_next) {
                if constexpr (Sched::GATHER) { int t_ = tid; asm volatile("" : "+v"(t_));
#pragma unroll
                    for (int i = 0; i < 2; ++i) { int R, C; stage_rc(t_ * 16 + i * 8192, R, C);
                        a20[i] = *(volatile LAS unsigned*)(aux + AUX_ROWTAB + i * 2048 + t_ * 4) * (unsigned)(K * 2) + (unsigned)C * 2u;
                        a21[i] = *(volatile LAS unsigned*)(aux + AUX_ROWTAB + (2 + i) * 2048 + t_ * 4) * (unsigned)(K * 2) + (unsigned)C * 2u; } }
                else PG8_AOFFS(nxt, a20, a21);
            } else {
#pragma unroll
                for (int i = 0; i < 2; ++i) { a20[i] = cA0[i]; a21[i] = cA1[i]; }
            }
            const char* b2 = (last ? nB : cB) + k2; const char* b3 = b2 + BK * 2;
            PG8_LDB(B0, 0, 0); PG8_LDB(B1, 0, 1); PG8_SCHED; PG8_LDA(At, 0, 0); PG8_STAGEA(PG8_SA(1, 1), cA1, k1);
            PG8_WAIT_V(8); PG8_WAIT_L(0); PG8_BAR; PG8_MMA(0, 0, At, B0); PG8_MMA(0, 1, At, B1); PG8_BAR; PG8_SCHED;
            PG8_LDA(At, 0, 1); PG8_STAGEB(PG8_SB(0, 0), b2); PG8_STAGEB(PG8_SB(0, 1), b2 + hstep); PG8_STAGEA(PG8_SA(0, 0), a20, k2);
            PG8_WAIT_V(8); PG8_WAIT_L(0); PG8_BAR; PG8_MMA(1, 0, At, B0); PG8_MMA(1, 1, At, B1); PG8_BAR; PG8_SCHED;
            PG8_LDB(B0, 1, 0); PG8_LDB(B1, 1, 1); PG8_SCHED; PG8_LDA(At, 1, 0); PG8_STAGEA(PG8_SA(0, 1), a21, k2);
            PG8_WAIT_V(8); PG8_WAIT_L(0); PG8_BAR; PG8_MMA(0, 0, At, B0); PG8_MMA(0, 1, At, B1); PG8_BAR; PG8_SCHED;
            PG8_LDA(At, 1, 1); PG8_STAGEB(PG8_SB(1, 0), b3); PG8_STAGEB(PG8_SB(1, 1), b3 + hstep); PG8_STAGEA(PG8_SA(1, 0), a20, k3);
            PG8_WAIT_V(8); PG8_WAIT_L(0); PG8_BAR; PG8_MMA(1, 0, At, B0); PG8_MMA(1, 1, At, B1); PG8_BAR; PG8_SCHED;
        }
        if constexpr (F8) asm volatile("s_nop 15\n\ts_nop 15" ::: "memory");
        if (wr == 0) PG8_BAR;
        int t_e = threadIdx.x; asm volatile("" : "+v"(t_e));
        int fr_e = t_e & 15, fq_e = (t_e >> 4) & 3;
#pragma unroll
        for (int a = 0; a < 2; ++a)
#pragma unroll
            for (int b = 0; b < 2; ++b)
#pragma unroll
                for (int m = 0; m < 4; ++m)
#pragma unroll
                    for (int n = 0; n < 2; ++n) asm volatile("" : "+v"(acc[a][b][m][n]));
        E(acc, cur, wr, wc, fr_e, fq_e, (const LAS float*)(aux + AUX_SLOTS + (ui & 3) * AUX_SLOT_BYTES));
        if (PROBE_REPEAT == 30) { asm volatile("" : "+v"(t_e)); E(acc, cur, wr, wc, t_e & 15, (t_e >> 4) & 3, (const LAS float*)(aux + AUX_SLOTS + (ui & 3) * AUX_SLOT_BYTES)); }
        if (!has_next) break;
#pragma unroll
        for (int a = 0; a < 2; ++a)
#pragma unroll
            for (int b = 0; b < 2; ++b)
#pragma unroll
                for (int m = 0; m < 4; ++m)
#pragma unroll
                    for (int n = 0; n < 2; ++n) acc[a][b][m][n] = (f32x4){0.f, 0.f, 0.f, 0.f};
        cur = nxt; cB = nB; ++ui;
#pragma unroll
        for (int i = 0; i < 2; ++i) { cA0[i] = a20[i]; cA1[i] = a21[i]; }
        if (wr == 1) PG8_BAR;
    }
    PG8_WAIT_V(0);
    PG8_BAR;
#undef PG8_SA
#undef PG8_SB
#undef PG8_STAGEA
#undef PG8_AOFFS
#undef PG8_DMA4
#undef PG8_SIDE_DMA
#undef PG8_STAGEB
#undef PG8_LDA
#undef PG8_LDB
#undef PG8_MMA
#undef PG8_LD8
#undef PG8_LO
#undef PG8_HI
#undef PG8_WAIT_V
#undef PG8_WAIT_L
#undef PG8_BAR
#undef PG8_SCHED
}
}


typedef float f32x16 __attribute__((ext_vector_type(16)));
typedef short bf16x4 __attribute__((ext_vector_type(4)));
typedef unsigned u32x2 __attribute__((ext_vector_type(2)));
typedef float f32x2_t __attribute__((ext_vector_type(2)));
typedef __bf16 bf16x2_t __attribute__((ext_vector_type(2)));
__device__ __forceinline__ unsigned cvtpk(float lo, float hi) { const f32x2_t v = {lo, hi}; const bf16x2_t b = __builtin_convertvector(v, bf16x2_t); return __builtin_bit_cast(unsigned, b); }
template <int S8> __device__ __forceinline__ bf16x8 pack8(const f32x16& X) {
    u32x4 w; w.x = cvtpk(X[8 * S8 + 0], X[8 * S8 + 1]); w.y = cvtpk(X[8 * S8 + 2], X[8 * S8 + 3]); w.z = cvtpk(X[8 * S8 + 4], X[8 * S8 + 5]); w.w = cvtpk(X[8 * S8 + 6], X[8 * S8 + 7]);
    return __builtin_bit_cast(bf16x8, w);
}
__device__ __forceinline__ bf16x8 lds_b128(const LAS unsigned char* p) { return *(const LAS bf16x8*)p; }
__device__ __forceinline__ bf16x8 lds_2xb64(const LAS unsigned char* p) {
    const bf16x4 a = *(const LAS bf16x4*)p, b = *(const LAS bf16x4*)(p + 16);
    return __builtin_shufflevector(a, b, 0, 1, 2, 3, 4, 5, 6, 7);
}
__device__ __forceinline__ float fast_log_sigmoid(float x) { return fminf(x, 0.0f) - __logf(1.0f + __expf(-fabsf(x))); }

constexpr int GP = 144;
constexpr int GS_QD = 0, GS_KI = GS_QD + 64 * GP, GS_KET = GS_KI + 64 * GP, GS_VT = GS_KET + 64 * GP, GS_DEC = GS_VT + 128 * GP, GS_SIZE = GS_DEC + 256;
constexpr int GL_SSP = 2 * GS_SIZE, GL_CONST = GL_SSP + 1024, GL_OT = GL_CONST + 1024;
constexpr int OTP = 132;
constexpr int GL_END = GL_OT + 64 * OTP * 4;
static_assert(GL_END <= RING_BYTES && (GL_OT % 16) == 0 && (GS_SIZE % 16) == 0 && (GS_DEC % 16) == 0, "gla lds");

__device__ __forceinline__ void gla_item(const Ptrs& P, LAS unsigned char* lds, int bh) {
    const int tid = opaque_tid(), lane = tid & 63, w = __builtin_amdgcn_readfirstlane(tid >> 6), l31 = lane & 31, hh = lane >> 5;
    const int b = bh >> 2, h = bh & 3;
    const bool grpA = w < 4; const int wa = w & 3;
    const bf16* PROJ = (const bf16*)(P.ws + WS_PROJ); bf16* MIX = (bf16*)(P.ws + WS_MIX);
    const size_t tok0 = (size_t)b * SEQ;
    const char* ub = (const char*)(PROJ + tok0 * NPROJ);
    const unsigned laneoff = (unsigned)lane * (NPROJ * 2);
    const int cq0 = PC_Q + h * 64 + 16 * wa, ck0 = PC_K + h * 64 + 16 * wa, cg0 = PC_GK + h * 64 + 16 * wa, cv0 = PC_V + h * 128 + 32 * wa;
    const int oc = tid >> 3, ov = (tid & 7) * 16;
    const unsigned gateoff = (unsigned)oc * (NPROJ * 2) + (unsigned)ov * 2;
#define GLA_LD(colel, chunk, lo) (*(const v4u*)(ub + ((size_t)(chunk) * 64 * NPROJ + (colel)) * 2 + (lo)))
    LAS float* cst = (LAS float*)(lds + GL_CONST);
    if (tid < 64) cst[tid] = P.b_gk[h * 64 + tid]; else if (tid < 192) cst[tid] = P.gla_norm_w[tid - 64];
    f32x16 S0, S1;
#pragma unroll
    for (int r = 0; r < 16; ++r) { S0[r] = 0.f; S1[r] = 0.f; }
    v4u nq[2], nk[2], ng[2];
    if (grpA) {
#pragma unroll
        for (int s = 0; s < 2; ++s) { nq[s] = GLA_LD(cq0 + 8 * s, 0, laneoff); nk[s] = GLA_LD(ck0 + 8 * s, 0, laneoff); ng[s] = GLA_LD(cg0 + 8 * s, 0, laneoff); }
    }
    __syncthreads();
#define GLA_STAGE_A(c) do { \
        LAS unsigned char* set_ = lds + ((c) & 1) * GS_SIZE; \
        v4u cq_[2], ck_[2], cg_[2], cv_[4]; \
        _Pragma("unroll") for (int s = 0; s < 2; ++s) { cq_[s] = nq[s]; ck_[s] = nk[s]; cg_[s] = ng[s]; } \
        _Pragma("unroll") for (int s = 0; s < 4; ++s) cv_[s] = GLA_LD(cv0 + 8 * s, (c), laneoff);     \
        { const int nc_ = (c) + 1 < SEQ / 64 ? (c) + 1 : (c); \
          _Pragma("unroll") for (int s = 0; s < 2; ++s) { nq[s] = GLA_LD(cq0 + 8 * s, nc_, laneoff); nk[s] = GLA_LD(ck0 + 8 * s, nc_, laneoff); ng[s] = GLA_LD(cg0 + 8 * s, nc_, laneoff); } } \
        _Pragma("unroll") for (int s = 0; s < 2; ++s) { \
            const int kc_ = 16 * wa + 8 * s; \
            const unsigned qw_[4] = {cq_[s].x, cq_[s].y, cq_[s].z, cq_[s].w}, kw_[4] = {ck_[s].x, ck_[s].y, ck_[s].z, ck_[s].w}, gw_[4] = {cg_[s].x, cg_[s].y, cg_[s].z, cg_[s].w}; \
            const f32x4 bg0_ = *(const LAS f32x4*)(cst + kc_), bg1_ = *(const LAS f32x4*)(cst + kc_ + 4); \
            float bb_[8];                                   \
            _Pragma("unroll") for (int j = 0; j < 8; ++j) { const float x_ = bf2f((gw_[j >> 1] >> (16 * (j & 1))) & 0xffffu) + (j < 4 ? bg0_[j & 3] : bg1_[j & 3]); \
                const float l2_ = __builtin_amdgcn_logf(1.0f + __builtin_amdgcn_exp2f(fabsf(x_) * -1.4426950408889634f));     \
                bb_[j] = wave_incl_scan(fminf(x_, 0.0f) * (1.4426950408889634f / 16.0f) - l2_ * (1.0f / 16.0f)); } \
            float qd_[8], ki_[8], ke_[8]; \
            _Pragma("unroll") for (int j = 0; j < 8; ++j) { \
                const float e_ = __builtin_amdgcn_exp2f(bb_[j]), ie_ = __builtin_amdgcn_exp2f(-bb_[j]); \
                const float dec_ = __builtin_bit_cast(float, __builtin_amdgcn_readlane(__builtin_bit_cast(int, e_), 63));     \
                const float qv_ = bf2f((qw_[j >> 1] >> (16 * (j & 1))) & 0xffffu), kv_ = bf2f((kw_[j >> 1] >> (16 * (j & 1))) & 0xffffu); \
                qd_[j] = qv_ * (e_ * 0.125f); ki_[j] = kv_ * ie_; ke_[j] = ki_[j] * dec_; \
                if (lane == 63) *(LAS float*)(set_ + GS_DEC + (kc_ + j) * 4) = e_; } \
            u32x4 t_; t_.x = cvtpk(qd_[0], qd_[1]); t_.y = cvtpk(qd_[2], qd_[3]); t_.z = cvtpk(qd_[4], qd_[5]); t_.w = cvtpk(qd_[6], qd_[7]); \
            *(LAS u32x4*)(set_ + GS_QD + lane * GP + kc_ * 2) = t_; \
            t_.x = cvtpk(ki_[0], ki_[1]); t_.y = cvtpk(ki_[2], ki_[3]); t_.z = cvtpk(ki_[4], ki_[5]); t_.w = cvtpk(ki_[6], ki_[7]); \
            *(LAS u32x4*)(set_ + GS_KI + lane * GP + kc_ * 2) = t_; \
            _Pragma("unroll") for (int j = 0; j < 4; ++j) { const unsigned pk_ = cvtpk(ke_[2 * j], ke_[2 * j + 1]); \
                *(LAS unsigned short*)(set_ + GS_KET + (kc_ + 2 * j) * GP + lane * 2) = (unsigned short)(pk_ & 0xffffu); *(LAS unsigned short*)(set_ + GS_KET + (kc_ + 2 * j + 1) * GP + lane * 2) = (unsigned short)(pk_ >> 16); } } \
        _Pragma("unroll") for (int s = 0; s < 4; ++s) { const unsigned vw_[4] = {cv_[s].x, cv_[s].y, cv_[s].z, cv_[s].w}; \
            _Pragma("unroll") for (int j = 0; j < 8; ++j) *(LAS unsigned short*)(set_ + GS_VT + (32 * wa + 8 * s + j) * GP + lane * 2) = (unsigned short)((vw_[j >> 1] >> (16 * (j & 1))) & 0xffffu); } \
    } while (0)
    if (grpA) GLA_STAGE_A(0);
    __syncthreads();
    for (int n = 0; n < SEQ / 64; ++n) {
        const v4u gate0 = GLA_LD(PC_G + h * 128, n, gateoff), gate1 = GLA_LD(PC_G + h * 128 + 8, n, gateoff);
        if (grpA) {
            if (n + 1 < SEQ / 64) GLA_STAGE_A(n + 1);
        } else {
            const LAS unsigned char* set = lds + (n & 1) * GS_SIZE;
            const int vc = wa;
            f32x16 O0, O1;
#pragma unroll
            for (int r = 0; r < 16; ++r) { O0[r] = 0.f; O1[r] = 0.f; }
            {
                const bf16x8 s00 = pack8<0>(S0), s01 = pack8<1>(S0), s10 = pack8<0>(S1), s11 = pack8<1>(S1);
                const LAS unsigned char* q0 = set + GS_QD + l31 * GP + 8 * hh; const LAS unsigned char* q1 = q0 + 32 * GP;
                const bf16x8 a0 = lds_2xb64(q0), a1 = lds_2xb64(q0 + 32), a2 = lds_2xb64(q0 + 64), a3 = lds_2xb64(q0 + 96);
                const bf16x8 b0 = lds_2xb64(q1), b1 = lds_2xb64(q1 + 32), b2 = lds_2xb64(q1 + 64), b3 = lds_2xb64(q1 + 96);
                O0 = __builtin_amdgcn_mfma_f32_32x32x16_bf16(s00, a0, O0, 0, 0, 0); O1 = __builtin_amdgcn_mfma_f32_32x32x16_bf16(s00, b0, O1, 0, 0, 0);
                O0 = __builtin_amdgcn_mfma_f32_32x32x16_bf16(s01, a1, O0, 0, 0, 0); O1 = __builtin_amdgcn_mfma_f32_32x32x16_bf16(s01, b1, O1, 0, 0, 0);
                O0 = __builtin_amdgcn_mfma_f32_32x32x16_bf16(s10, a2, O0, 0, 0, 0); O1 = __builtin_amdgcn_mfma_f32_32x32x16_bf16(s10, b2, O1, 0, 0, 0);
                O0 = __builtin_amdgcn_mfma_f32_32x32x16_bf16(s11, a3, O0, 0, 0, 0); O1 = __builtin_amdgcn_mfma_f32_32x32x16_bf16(s11, b3, O1, 0, 0, 0);
            }
            {
                const LAS unsigned char* kA0 = set + GS_KI + l31 * GP + 16 * hh; const LAS unsigned char* kA1 = kA0 + 32 * GP;
                const LAS unsigned char* qB0 = set + GS_QD + l31 * GP + 16 * hh; const LAS unsigned char* qB1 = qB0 + 32 * GP;
                const LAS unsigned char* vrow = set + GS_VT + (vc * 32 + l31) * GP + 8 * hh;
                bf16x8 fa[4], fb[4];
                f32x16 X;
#pragma unroll
                for (int kk = 0; kk < 4; ++kk) { fa[kk] = lds_b128(kA0 + 32 * kk); fb[kk] = lds_b128(qB0 + 32 * kk); }
                const bf16x8 v0 = lds_2xb64(vrow), v1 = lds_2xb64(vrow + 32);
#pragma unroll
                for (int r = 0; r < 16; ++r) X[r] = 0.f;
#pragma unroll
                for (int kk = 0; kk < 4; ++kk) X = __builtin_amdgcn_mfma_f32_32x32x16_bf16(fa[kk], fb[kk], X, 0, 0, 0);
#pragma unroll
                for (int kk = 0; kk < 4; ++kk) fb[kk] = lds_b128(qB1 + 32 * kk);
#pragma unroll
                for (int r = 0; r < 16; ++r) { const int srow = (r & 3) + 8 * (r >> 2) + 4 * hh; X[r] = (srow <= l31) ? X[r] : 0.f; }
                O0 = __builtin_amdgcn_mfma_f32_32x32x16_bf16(v0, pack8<0>(X), O0, 0, 0, 0); O0 = __builtin_amdgcn_mfma_f32_32x32x16_bf16(v1, pack8<1>(X), O0, 0, 0, 0);
#pragma unroll
                for (int r = 0; r < 16; ++r) X[r] = 0.f;
#pragma unroll
                for (int kk = 0; kk < 4; ++kk) X = __builtin_amdgcn_mfma_f32_32x32x16_bf16(fa[kk], fb[kk], X, 0, 0, 0);
#pragma unroll
                for (int kk = 0; kk < 4; ++kk) fa[kk] = lds_b128(kA1 + 32 * kk);
                O1 = __builtin_amdgcn_mfma_f32_32x32x16_bf16(v0, pack8<0>(X), O1, 0, 0, 0); O1 = __builtin_amdgcn_mfma_f32_32x32x16_bf16(v1, pack8<1>(X), O1, 0, 0, 0);
                const bf16x8 v2 = lds_2xb64(vrow + 64), v3 = lds_2xb64(vrow + 96);
#pragma unroll
                for (int r = 0; r < 16; ++r) X[r] = 0.f;
#pragma unroll
                for (int kk = 0; kk < 4; ++kk) X = __builtin_amdgcn_mfma_f32_32x32x16_bf16(fa[kk], fb[kk], X, 0, 0, 0);
#pragma unroll
                for (int r = 0; r < 16; ++r) { const int srow = (r & 3) + 8 * (r >> 2) + 4 * hh; X[r] = (srow <= l31) ? X[r] : 0.f; }
                O1 = __builtin_amdgcn_mfma_f32_32x32x16_bf16(v2, pack8<0>(X), O1, 0, 0, 0); O1 = __builtin_amdgcn_mfma_f32_32x32x16_bf16(v3, pack8<1>(X), O1, 0, 0, 0);
            }
            {
                const LAS float* dec = (const LAS float*)(set + GS_DEC);
                const LAS unsigned char* ka0 = set + GS_KET + l31 * GP + 16 * hh; const LAS unsigned char* ka1 = ka0 + 32 * GP;
                const LAS unsigned char* vb = set + GS_VT + (vc * 32 + l31) * GP + 16 * hh;
                bf16x8 e0[4], e1[4], vv[4];
#pragma unroll
                for (int ss = 0; ss < 4; ++ss) { e0[ss] = lds_b128(ka0 + 32 * ss); e1[ss] = lds_b128(ka1 + 32 * ss); vv[ss] = lds_b128(vb + 32 * ss); }
#pragma unroll
                for (int g4 = 0; g4 < 4; ++g4) { const f32x4 d0 = *(const LAS f32x4*)(dec + 8 * g4 + 4 * hh), d1 = *(const LAS f32x4*)(dec + 32 + 8 * g4 + 4 * hh);
#pragma unroll
                    for (int i = 0; i < 4; ++i) { S0[4 * g4 + i] *= d0[i]; S1[4 * g4 + i] *= d1[i]; } }
#pragma unroll
                for (int ss = 0; ss < 4; ++ss) { S0 = __builtin_amdgcn_mfma_f32_32x32x16_bf16(e0[ss], vv[ss], S0, 0, 0, 0); S1 = __builtin_amdgcn_mfma_f32_32x32x16_bf16(e1[ss], vv[ss], S1, 0, 0, 0); }
            }
            {
                float q0 = 0.f, q1 = 0.f;
#pragma unroll
                for (int r = 0; r < 16; ++r) { q0 += O0[r] * O0[r]; q1 += O1[r] * O1[r]; }
                q0 += __shfl_xor(q0, 32); q1 += __shfl_xor(q1, 32);
                if (hh == 0) { *(LAS float*)(lds + GL_SSP + (vc * 64 + l31) * 4) = q0; *(LAS float*)(lds + GL_SSP + (vc * 64 + 32 + l31) * 4) = q1; }
                LAS float* ot0 = (LAS float*)(lds + GL_OT) + l31 * OTP + vc * 32 + 4 * hh; LAS float* ot1 = ot0 + 32 * OTP;
#pragma unroll
                for (int g4 = 0; g4 < 4; ++g4) { *(LAS f32x4*)(ot0 + 8 * g4) = (f32x4){O0[4 * g4], O0[4 * g4 + 1], O0[4 * g4 + 2], O0[4 * g4 + 3]};
                    *(LAS f32x4*)(ot1 + 8 * g4) = (f32x4){O1[4 * g4], O1[4 * g4 + 1], O1[4 * g4 + 2], O1[4 * g4 + 3]}; }
            }
        }
        __syncthreads();
        {
            const LAS float* ssp = (const LAS float*)(lds + GL_SSP) + oc;
            const float tot = (ssp[0] + ssp[64]) + (ssp[128] + ssp[192]);
            const float rstd = 1.0f / sqrtf(tot * (1.0f / 128.0f) + EPS);
            const LAS float* ot = (const LAS float*)(lds + GL_OT) + oc * OTP + ov;
            const LAS float* nwp = cst + 64 + ov;
            const unsigned gw[8] = {gate0.x, gate0.y, gate0.z, gate0.w, gate1.x, gate1.y, gate1.z, gate1.w};
            float y[16];
#pragma unroll
            for (int q4 = 0; q4 < 4; ++q4) { const f32x4 o4 = *(const LAS f32x4*)(ot + 4 * q4), n4 = *(const LAS f32x4*)(nwp + 4 * q4);
#pragma unroll
                for (int i = 0; i < 4; ++i) { const int j = 4 * q4 + i; const float gv = bf2f((gw[j >> 1] >> (16 * (j & 1))) & 0xffffu); y[j] = o4[i] * rstd * n4[i] * gv * __builtin_amdgcn_rcpf(1.0f + __expf(-gv)); } }
            bf16* orow = MIX + (tok0 + (size_t)n * 64 + oc) * D + h * 128 + ov;
            u32x4 t; t.x = cvtpk(y[0], y[1]); t.y = cvtpk(y[2], y[3]); t.z = cvtpk(y[4], y[5]); t.w = cvtpk(y[6], y[7]); *(u32x4*)orow = t;
            t.x = cvtpk(y[8], y[9]); t.y = cvtpk(y[10], y[11]); t.z = cvtpk(y[12], y[13]); t.w = cvtpk(y[14], y[15]); *(u32x4*)(orow + 8) = t;
        }
        __syncthreads();
    }
#undef GLA_STAGE_A
#undef GLA_LD
}

constexpr int SP = 272;
constexpr int SG_W = 0, SG_VN = SG_W + 128 * SP, SG_OT = SG_VN + 128 * SP, SG_ST = SG_OT + 128 * SP, SG_END = SG_ST + 1024;
static_assert(SG_END <= RING_BYTES, "sgu lds");
__device__ __forceinline__ void sgu_item(const Ptrs& P, LAS unsigned char* lds, int bn) {
    const int tid = opaque_tid(), lane = tid & 63, w = __builtin_amdgcn_readfirstlane(tid >> 6), l31 = lane & 31, hh = lane >> 5;
    const bf16* PROJ = (const bf16*)(P.ws + WS_PROJ); bf16* MIX = (bf16*)(P.ws + WS_MIX); const bf16* Wsp = (const bf16*)(P.ws + WS_WSP);
    const size_t tok0 = (size_t)bn * 128;
    LAS float* st = (LAS float*)(lds + SG_ST);
    {
        v4u raws[16];
#pragma unroll
        for (int rr = 0; rr < 16; ++rr) raws[rr] = *(const v4u*)(PROJ + (tok0 + 16 * w + rr) * NPROJ + PC_VS + lane * 8);
#pragma unroll
        for (int rr = 0; rr < 16; ++rr) { const int row = 16 * w + rr; const unsigned rw[4] = {raws[rr].x, raws[rr].y, raws[rr].z, raws[rr].w};
            float s = 0.f, q = 0.f;
#pragma unroll
            for (int j = 0; j < 8; ++j) { const float g = gelu_tanh(bf2f((rw[j >> 1] >> (16 * (j & 1))) & 0xffffu)); s += g; q += g * g; }
            s = wave_sum(s); q = wave_sum(q);
            const float mu = s * (1.0f / 512.0f), var = fmaxf(q * (1.0f / 512.0f) - mu * mu, 0.f);
            if (lane == 0) { st[row] = mu; st[128 + row] = 1.0f / sqrtf(var + EPS); } }
    }
    const int s_ = tid & 127, c0_ = (tid >> 7) * 32;
    const int t_ = tid >> 2, cg_ = (tid & 3) * 32;
    v4u vsr[4];
#pragma unroll
    for (int q4 = 0; q4 < 4; ++q4) vsr[q4] = *(const v4u*)(PROJ + (tok0 + s_) * NPROJ + PC_VS + c0_ + q4 * 8);
    __syncthreads();
    for (int g = 0; g < 4; ++g) {
#pragma unroll
        for (int ps = 0; ps < 4; ++ps) { const int idx = ps * NTHR + tid, row = idx >> 4, c16 = idx & 15;
            *(LAS v4u*)(lds + SG_W + row * SP + c16 * 16) = *(const v4u*)(Wsp + ((size_t)g * 128 + row) * 128 + c16 * 8); }
        { const float mu = st[s_], rs = st[128 + s_];
#pragma unroll
          for (int q4 = 0; q4 < 4; ++q4) { const int cb = c0_ + q4 * 8;
              const unsigned rw[4] = {vsr[q4].x, vsr[q4].y, vsr[q4].z, vsr[q4].w};
              const f32x4 lw0 = *(const f32x4*)(P.sg_ln_w + g * 128 + cb), lw1 = *(const f32x4*)(P.sg_ln_w + g * 128 + cb + 4), lb0 = *(const f32x4*)(P.sg_ln_b + g * 128 + cb), lb1 = *(const f32x4*)(P.sg_ln_b + g * 128 + cb + 4);
#pragma unroll
              for (int j = 0; j < 8; ++j) { const float gv = gelu_tanh(bf2f((rw[j >> 1] >> (16 * (j & 1))) & 0xffffu));
                  const float vn = (gv - mu) * rs * (j < 4 ? lw0[j & 3] : lw1[j & 3]) + (j < 4 ? lb0[j & 3] : lb1[j & 3]);
                  *(LAS unsigned short*)(lds + SG_VN + (cb + j) * SP + s_ * 2) = (unsigned short)f2bf(vn); } } }
        v4u ur[4];
#pragma unroll
        for (int q4 = 0; q4 < 4; ++q4) ur[q4] = *(const v4u*)(PROJ + (tok0 + t_) * NPROJ + PC_U + g * 128 + cg_ + q4 * 8);
        { const int gn = g < 3 ? g + 1 : g;
#pragma unroll
          for (int q4 = 0; q4 < 4; ++q4) vsr[q4] = *(const v4u*)(PROJ + (tok0 + s_) * NPROJ + PC_VS + gn * 128 + c0_ + q4 * 8); }
        __syncthreads();
        { const int ct = w >> 1;
          const LAS unsigned char* arow = lds + SG_VN + (ct * 32 + l31) * SP + 16 * hh;
#pragma unroll
          for (int ti = 0; ti < 2; ++ti) { const int tt = (w & 1) * 2 + ti;
              const LAS unsigned char* brow = lds + SG_W + (tt * 32 + l31) * SP + 16 * hh;
              f32x16 acc;
#pragma unroll
              for (int r = 0; r < 16; ++r) acc[r] = 0.f;
              for (int ks = 0; ks < 2 * (tt + 1); ++ks) acc = __builtin_amdgcn_mfma_f32_32x32x16_bf16(lds_b128(arow + 32 * ks), lds_b128(brow + 32 * ks), acc, 0, 0, 0);
              const float bs = P.b_spatial[g * 128 + tt * 32 + l31];
              LAS unsigned char* orow = lds + SG_OT + (tt * 32 + l31) * SP + (ct * 32 + 4 * hh) * 2;
#pragma unroll
              for (int g4 = 0; g4 < 4; ++g4) { u32x2 pk; pk.x = cvtpk(acc[4 * g4] + bs, acc[4 * g4 + 1] + bs); pk.y = cvtpk(acc[4 * g4 + 2] + bs, acc[4 * g4 + 3] + bs); *(LAS u32x2*)(orow + 16 * g4) = pk; } } }
        __syncthreads();
        {
#pragma unroll
          for (int q4 = 0; q4 < 4; ++q4) { const v4u mx = *(const LAS v4u*)(lds + SG_OT + t_ * SP + (cg_ + q4 * 8) * 2);
              const unsigned mw[4] = {mx.x, mx.y, mx.z, mx.w}, uw[4] = {ur[q4].x, ur[q4].y, ur[q4].z, ur[q4].w}; unsigned ow[4];
#pragma unroll
              for (int j = 0; j < 4; ++j) { const float a0 = gelu_tanh(bf2f(uw[j] & 0xffffu)) * bf2f(mw[j] & 0xffffu), a1 = gelu_tanh(bf2f(uw[j] >> 16)) * bf2f(mw[j] >> 16); ow[j] = cvtpk(a0, a1); }
              *(v4u*)(MIX + (tok0 + t_) * D + 512 + g * 128 + cg_ + q4 * 8) = (v4u){ow[0], ow[1], ow[2], ow[3]}; } }
    }
    __syncthreads();
}
constexpr int CW_CONVQ = 192;
constexpr int CONV_UNIT = 4;
struct WItem { const float* src; int ldn; unsigned char* wt; int d0, k0; };
__device__ __forceinline__ WItem moe_witem(const Ptrs& P, int it, int lane) {
    WItem w; const int sub = lane >> 5, col = lane & 31;
    if (it < IT_GU) { const int e = it / 1024, r = it % 1024, db = r / 16, kb = r % 16, d0 = db * 32, pn = d0 >> 8, bj = (d0 >> 7) & 1, rr = d0 & 127;
        w.ldn = 2048; w.src = P.w_gate_up + (size_t)e * D * 2048 + (size_t)(kb * 64 + sub) * 2048 + bj * 1024 + 128 * pn + rr + col; w.wt = (unsigned char*)(P.ws + WS_WGU) + (size_t)e * 2048 * D; w.d0 = d0; w.k0 = kb * 64; }
    else { it -= IT_GU; const int e = it / 512, r = it % 512, db = r / 16, kb = r % 16;
        w.ldn = D; w.src = P.w_down + (size_t)e * DE * D + (size_t)(kb * 64 + sub) * D + db * 32 + col; w.wt = (unsigned char*)(P.ws + WS_WD) + (size_t)e * D * DE; w.d0 = db * 32; w.k0 = kb * 64; }
    return w;
}
__device__ __forceinline__ void moe_weight_items(const Ptrs& P, unsigned char* lds_generic, int units_per_grab, int max_grabs) {
    const int tid_ = opaque_tid(), lane = tid_ & 63, wave = __builtin_amdgcn_readfirstlane(tid_ >> 6);
    float* scr = (float*)(lds_generic + wave * 16384);
    unsigned* q = (unsigned*)(P.ws + WS_CTL) + CW_CONVQ;
    constexpr unsigned NUNITS = (IT_GU + IT_DN) / CONV_UNIT;
    int grab = units_per_grab;
    for (int ng = 0; ng < max_grabs; ++ng) {
        unsigned c0 = 0; if (lane == 0) c0 = __hip_atomic_fetch_add(q, (unsigned)grab, RLX_AGENT);
        c0 = __builtin_amdgcn_readfirstlane(c0);
        if (c0 >= NUNITS) break;
        const unsigned c1 = (c0 + (unsigned)grab < NUNITS) ? c0 + (unsigned)grab : NUNITS;
        if (c1 >= NUNITS * 3 / 4) grab = 1;
        const int it0 = (int)(c0 * CONV_UNIT), it1 = (int)(c1 * CONV_UNIT);
        float v[32]; WItem cur = moe_witem(P, it0, lane);
#pragma unroll
        for (int i = 0; i < 32; ++i) v[i] = __builtin_nontemporal_load(cur.src + (size_t)(2 * i) * cur.ldn);
#pragma nounroll
        for (int it = it0; it < it1; ++it) {
            float vn[32]; WItem nxt = cur;
            if (it + 1 < it1) { nxt = moe_witem(P, it + 1, lane);
#pragma unroll
                for (int i = 0; i < 32; ++i) vn[i] = __builtin_nontemporal_load(nxt.src + (size_t)(2 * i) * nxt.ldn); }
#pragma unroll
            for (int i = 0; i < 32; ++i) scr[(2 * i + (lane >> 5)) * 33 + (lane & 31)] = v[i];
            __builtin_amdgcn_wave_barrier(); asm volatile("s_waitcnt lgkmcnt(0)" ::: "memory");
            p0_tr_write_f8(cur.wt, D, cur.d0, cur.k0, scr, lane, F8S_W);
            asm volatile("s_waitcnt lgkmcnt(0)" ::: "memory"); __builtin_amdgcn_wave_barrier();
            cur = nxt;
#pragma unroll
            for (int i = 0; i < 32; ++i) v[i] = vn[i];
        }
    }
}
#define P2_MARK(id, wg) do { if (PROBE_P2 == (id) && (int)blockIdx.x == (wg) && threadIdx.x == 0) __hip_atomic_store((unsigned*)(P.ws + WS_CTL) + 201, (unsigned)__builtin_amdgcn_s_memrealtime(), RLX_AGENT); } while (0)
__device__ __forceinline__ void ph2_mix_fast(const Ptrs& P, LAS unsigned char* lds, unsigned char* lds_generic, int G) {
    const int bid = blockIdx.x;
    if (PROBE_P2 >= 0 && bid == 0 && threadIdx.x == 0) __hip_atomic_store((unsigned*)(P.ws + WS_CTL) + 200, (unsigned)__builtin_amdgcn_s_memrealtime(), RLX_AGENT);
    if (G >= 128) {
        if (bid < 64) { for (int rep = 0; rep < ((PROBE_REPEAT == 21) ? 2 : 1); ++rep) gla_item(P, lds, bid); }
        else { for (int rep = 0; rep < ((PROBE_REPEAT == 20) ? 2 : 1); ++rep) for (int it = bid - 64; it < NB * 16; it += G - 64) sgu_item(P, lds, it); }
    } else {
        for (int it = bid; it < 64; it += G) gla_item(P, lds, it);
        for (int it = bid; it < NB * 16; it += G) sgu_item(P, lds, it);
    }
    __syncthreads();
    P2_MARK(0, 0); P2_MARK(1, 64); P2_MARK(5, 255);
    moe_weight_items(P, lds_generic, 4, 1 << 30);
    __syncthreads();
    P2_MARK(2, 64); P2_MARK(3, 255); P2_MARK(4, 0);
}

constexpr size_t WS_WR2 = WS_WSP + 256 * 1024;
__device__ __forceinline__ void p0_wr2(const Ptrs& P, int gtid, int gthreads) {
    f32x4* WR2 = (f32x4*)(P.ws + WS_WR2);
    for (int idx = gtid; idx < 32 * 2 * 2 * 64; idx += gthreads) { const int jj = idx >> 8, i4 = (idx >> 7) & 1, tl = (idx >> 6) & 1, q = (idx >> 4) & 3, e = tl * 16 + (idx & 15); f32x4 o;
#pragma unroll
        for (int i = 0; i < 4; ++i) { const int k = 32 * jj + 8 * q + 4 * i4 + i; o[i] = P.w_router[(size_t)k * NE + e] * P.norm_ffn_w[k]; }
        WR2[idx] = o; }
}
__device__ __forceinline__ bool rt_better(float va, int ia, float vb, int ib) { return va > vb || (va == vb && ia < ib); }
__device__ __forceinline__ void ph4_router_fast(const Ptrs& P, LAS unsigned char* lds, int G) {
    const int tid = opaque_tid(), lane = tid & 63, wave = __builtin_amdgcn_readfirstlane(tid >> 6), tk = lane & 15, q = lane >> 4;
    unsigned* ctl = (unsigned*)(P.ws + WS_CTL);
    LAS unsigned* lcnt = (LAS unsigned*)lds; LAS unsigned* lbase = lcnt + 32;
    const f32x4* WR2 = (const f32x4*)(P.ws + WS_WR2);
    const int NGRP = T / 16, rounds = (NGRP + G * NWAVES - 1) / (G * NWAVES);
    for (int rd = 0; rd < rounds; ++rd) {
        if (tid < 32) lcnt[tid] = 0u;
        __syncthreads();
        const int grp = (rd * G + (int)blockIdx.x) * NWAVES + wave; const bool act = grp < NGRP;
        const int m0 = (act ? grp : 0) * 16;
        LAS float* xt = (LAS float*)(lds + 1024 + wave * (16 * 132 * 4));
        const int ldr = lane >> 5, lc = (lane & 31) * 4;
        f32x4 d0 = {0.f, 0.f, 0.f, 0.f}, d1 = {0.f, 0.f, 0.f, 0.f}; float psq[8];
#pragma unroll
        for (int i = 0; i < 8; ++i) psq[i] = 0.f;
        f32x4 nxv[8]; uint2 nav[8];
#pragma unroll
        for (int i = 0; i < 8; ++i) { const size_t ro = (size_t)(m0 + 2 * i + ldr) * D + lc; nxv[i] = *(const f32x4*)(P.x + ro); nav[i] = *(const uint2*)((const bf16*)(P.ws + WS_A1) + ro); }
#pragma nounroll
        for (int ch = 0; ch < 8; ++ch) {
            const int c0 = ch * 128 + lc, c1 = (ch < 7 ? ch + 1 : ch) * 128 + lc;
            const f32x4 nwv = *(const f32x4*)(P.norm_ffn_w + c0);
            f32x4 xv[8]; uint2 av[8];
#pragma unroll
            for (int i = 0; i < 8; ++i) { xv[i] = nxv[i]; av[i] = nav[i]; }
#pragma unroll
            for (int i = 0; i < 8; ++i) { const size_t ro = (size_t)(m0 + 2 * i + ldr) * D + c1; nxv[i] = *(const f32x4*)(P.x + ro); nav[i] = *(const uint2*)((const bf16*)(P.ws + WS_A1) + ro); }
#pragma unroll
            for (int i = 0; i < 8; ++i) { const size_t ro = (size_t)(m0 + 2 * i + ldr) * D + c0;
                const f32x4 x1 = {xv[i][0] + bf2f(av[i].x & 0xffffu), xv[i][1] + bf2f(av[i].x >> 16), xv[i][2] + bf2f(av[i].y & 0xffffu), xv[i][3] + bf2f(av[i].y >> 16)};
                psq[i] += (x1[0] * x1[0] + x1[1] * x1[1]) + (x1[2] * x1[2] + x1[3] * x1[3]);
                *(LAS f32x4*)(xt + (2 * i + ldr) * 132 + lc) = x1;
                *(uint2*)((bf16*)(P.ws + WS_X1B) + ro) = make_uint2(cvtpk(x1[0], x1[1]), cvtpk(x1[2], x1[3]));
                *(unsigned*)((unsigned char*)(P.ws + WS_H) + ro) = pk4_fp8(x1[0] * nwv[0] * F8S_H, x1[1] * nwv[1] * F8S_H, x1[2] * nwv[2] * F8S_H, x1[3] * nwv[3] * F8S_H); }
#pragma unroll
            for (int j4 = 0; j4 < 4; ++j4) { const int jj = ch * 4 + j4;
                const f32x4 xa = *(const LAS f32x4*)(xt + tk * 132 + 32 * j4 + 8 * q), xb = *(const LAS f32x4*)(xt + tk * 132 + 32 * j4 + 8 * q + 4);
                const f32x4 w0a = WR2[((jj * 2 + 0) * 2 + 0) * 64 + lane], w1a = WR2[((jj * 2 + 0) * 2 + 1) * 64 + lane], w0b = WR2[((jj * 2 + 1) * 2 + 0) * 64 + lane], w1b = WR2[((jj * 2 + 1) * 2 + 1) * 64 + lane];
#pragma unroll
                for (int i = 0; i < 4; ++i) { d0 = __builtin_amdgcn_mfma_f32_16x16x4f32(w0a[i], xa[i], d0, 0, 0, 0); d1 = __builtin_amdgcn_mfma_f32_16x16x4f32(w1a[i], xa[i], d1, 0, 0, 0); }
#pragma unroll
                for (int i = 0; i < 4; ++i) { d0 = __builtin_amdgcn_mfma_f32_16x16x4f32(w0b[i], xb[i], d0, 0, 0, 0); d1 = __builtin_amdgcn_mfma_f32_16x16x4f32(w1b[i], xb[i], d1, 0, 0, 0); } }
        }
#pragma unroll
        for (int i = 0; i < 8; ++i) { float v = psq[i]; v += dpp_f<0x111, 0xF>(v); v += dpp_f<0x112, 0xF>(v); v += dpp_f<0x114, 0xF>(v); v += dpp_f<0x118, 0xF>(v); v += dpp_f<0x142, 0xA>(v);
            if ((lane & 31) == 31) xt[2 * i + ldr] = v; }
        float ssq = xt[tk];

        const float rstd = 1.0f / sqrtf(ssq * (1.f / D) + EPS);
        float cv[8]; int ci[8];
#pragma unroll
        for (int r = 0; r < 4; ++r) { cv[r] = d0[r] * rstd + P.b_router[4 * q + r]; ci[r] = 4 * q + r; cv[4 + r] = d1[r] * rstd + P.b_router[16 + 4 * q + r]; ci[4 + r] = 16 + 4 * q + r; }
        float sv[4]; int si[4];
#pragma unroll
        for (int r = 0; r < 4; ++r) { float bv = cv[0]; int bi = ci[0];
#pragma unroll
            for (int c = 1; c < 8; ++c) if (rt_better(cv[c], ci[c], bv, bi)) { bv = cv[c]; bi = ci[c]; }
            sv[r] = bv; si[r] = bi;
#pragma unroll
            for (int c = 0; c < 8; ++c) if (ci[c] == bi) cv[c] = -3.0e38f; }
#pragma unroll
        for (int off = 16; off <= 32; off <<= 1) {
            float ov[4]; int oi[4];
#pragma unroll
            for (int r = 0; r < 4; ++r) { ov[r] = __shfl_xor(sv[r], off); oi[r] = __shfl_xor(si[r], off); }
            float mv[8]; int mi[8];
#pragma unroll
            for (int r = 0; r < 4; ++r) { mv[r] = sv[r]; mi[r] = si[r]; mv[4 + r] = ov[r]; mi[4 + r] = oi[r]; }
#pragma unroll
            for (int r = 0; r < 4; ++r) { float bv = mv[0]; int bi = mi[0];
#pragma unroll
                for (int c = 1; c < 8; ++c) if (rt_better(mv[c], mi[c], bv, bi)) { bv = mv[c]; bi = mi[c]; }
                sv[r] = bv; si[r] = bi;
#pragma unroll
                for (int c = 0; c < 8; ++c) if (mi[c] == bi) mv[c] = -3.0e38f; }
        }
        float pw[4], den = 0.f;
#pragma unroll
        for (int r = 0; r < 4; ++r) { pw[r] = __expf(sv[r] - sv[0]); den += pw[r]; }
        int ee = si[0]; float ww = pw[0];
#pragma unroll
        for (int r = 1; r < 4; ++r) if (q == r) { ee = si[r]; ww = pw[r]; }
        ww /= den;
        unsigned lr = 0u;
        if (act) lr = __hip_atomic_fetch_add(lcnt + ee, 1u, __ATOMIC_RELAXED, __HIP_MEMORY_SCOPE_WORKGROUP);
        __syncthreads();
        if (tid < 32) lbase[tid] = __hip_atomic_fetch_add(ctl + CW_COUNTS + tid, lcnt[tid], RLX_AGENT);
        __syncthreads();
        if (act) { const unsigned rank = lbase[ee] + lr; const int m = m0 + tk;
            ((int*)(P.ws + WS_ROUTE + RT_ROWTOK))[(size_t)ee * T + rank] = m;
            ((float*)(P.ws + WS_ROUTE + RT_ROWW))[(size_t)ee * T + rank] = ww;
            ((int*)(P.ws + WS_ROUTE + RT_TOKSLOT))[(size_t)m * 4 + q] = (ee << 16) | (int)rank;
            ((float*)(P.ws + WS_RRSTD))[(size_t)ee * T + rank] = rstd; }
        __syncthreads();
    }
}

struct Args { Ptrs P; int ph_lo, ph_hi, li, pad; };

constexpr int P0_SCR = 8448, P0_WGL = 8 * P0_SCR, P0_WGLP = 2064, P0_HP = 2064;
static_assert(P0_WGL + 16 * P0_WGLP <= RING_BYTES && 4 * P0_HP <= P0_SCR, "p0 lds");
__device__ __forceinline__ void ph0_prep(const Ptrs& P, unsigned char* lds_generic, LAS unsigned char* lds, int vcu, int G) {
    const int tid = opaque_tid(), lane = tid & 63, wave = __builtin_amdgcn_readfirstlane(tid >> 6);
    float* scr = (float*)(lds_generic + wave * P0_SCR);
    const int gw = vcu * NWAVES + wave, NGW = G * NWAVES;
    for (int k = tid; k < D; k += NTHR) { const f32x4* src = (const f32x4*)(P.w_in + (size_t)k * NIN_SRC + 1536);
#pragma unroll
        for (int q4 = 0; q4 < 4; ++q4) { const f32x4 w = src[q4];
#pragma unroll
            for (int i = 0; i < 4; ++i) *(LAS unsigned short*)(lds + P0_WGL + (4 * q4 + i) * P0_WGLP + k * 2) = (unsigned short)f2bf(w[i]); } }
    for (int it = gw; it < IT_IN + IT_OUT; it += NGW) p0_weight_item(P, it, scr, lane);
    bf16* Wsp = (bf16*)(P.ws + WS_WSP);
    for (int i = blockIdx.x * NTHR + tid; i < 4 * 128 * 128; i += G * NTHR) { const int t = (i >> 7) & 127, s = i & 127; Wsp[i] = (bf16)f2bf(s <= t ? P.w_spatial[i] : 0.f); }
    p0_wr2(P, blockIdx.x * NTHR + tid, G * NTHR);
    __syncthreads();
    bf16* H = (bf16*)(P.ws + WS_H); bf16* PROJ = (bf16*)(P.ws + WS_PROJ);
    LAS unsigned char* hst = lds + wave * P0_SCR;
    const int fr = lane & 15, fg = lane >> 4;
    for (int mb = gw; mb < T; mb += 4 * NGW) {
        f32x4 v[4][4];
#pragma unroll
        for (int t = 0; t < 4; ++t) { const int m = (mb + t * NGW < T) ? mb + t * NGW : mb;
#pragma unroll
            for (int j = 0; j < 4; ++j) v[t][j] = ((const f32x4*)(P.x + (size_t)m * D))[lane + 64 * j]; }
#pragma unroll
        for (int t = 0; t < 4; ++t) { const int m = (mb + t * NGW < T) ? mb + t * NGW : mb;
            float sq = 0.f;
#pragma unroll
            for (int j = 0; j < 4; ++j) sq += (v[t][j].x * v[t][j].x + v[t][j].y * v[t][j].y) + (v[t][j].z * v[t][j].z + v[t][j].w * v[t][j].w);
            const float rstd = 1.0f / sqrtf(wave_sum(sq) * (1.f / D) + EPS);
            unsigned long long* o8 = (unsigned long long*)(H + (size_t)m * D) + lane;
#pragma unroll
            for (int j = 0; j < 4; ++j) { const f32x4 ww = ((const f32x4*)P.norm_mix_w)[lane + 64 * j];
                const unsigned long long hv = (unsigned long long)pk2(v[t][j].x * rstd * ww.x, v[t][j].y * rstd * ww.y) | ((unsigned long long)pk2(v[t][j].z * rstd * ww.z, v[t][j].w * rstd * ww.w) << 32);
                if (mb + t * NGW < T) o8[64 * j] = hv;
                *(LAS unsigned long long*)(hst + t * P0_HP + (lane + 64 * j) * 8) = hv; } }
        asm volatile("s_waitcnt lgkmcnt(0)" ::: "memory");
        f32x4 ga = {0.f, 0.f, 0.f, 0.f};
#pragma unroll 8
        for (int ks = 0; ks < 32; ++ks) { const bf16x8 af = *(const LAS bf16x8*)(hst + (fr & 3) * P0_HP + (32 * ks + 8 * fg) * 2), bfr = *(const LAS bf16x8*)(lds + P0_WGL + fr * P0_WGLP + (32 * ks + 8 * fg) * 2);
            ga = __builtin_amdgcn_mfma_f32_16x16x32_bf16(af, bfr, ga, 0, 0, 0); }
        asm volatile("s_waitcnt lgkmcnt(0)" ::: "memory");
        f32x4 go[4];
        const float gf0 = ga[0], gf1 = ga[1], gf2 = ga[2], gf3 = ga[3];
        int gi[4] = {__float_as_int(gf0), __float_as_int(gf1), __float_as_int(gf2), __float_as_int(gf3)};
#pragma unroll
        for (int t = 0; t < 4; ++t) go[t] = (f32x4){0.f, 0.f, 0.f, 0.f};
#pragma unroll
        for (int n = 0; n < 16; ++n) { const f32x4 wu = *(const f32x4*)(P.w_gk_up + n * 256 + 4 * lane);
#pragma unroll
            for (int t = 0; t < 4; ++t) { const float gl = __builtin_bit_cast(float, __builtin_amdgcn_readlane(gi[t], n)); go[t] += wu * gl; } }
#pragma unroll
        for (int t = 0; t < 4; ++t) if (mb + t * NGW < T) *(uint2*)(PROJ + (size_t)(mb + t * NGW) * NPROJ + PC_GK + 4 * lane) = make_uint2(pk2(go[t][0], go[t][1]), pk2(go[t][2], go[t][3]));
    }
}
__device__ __forceinline__ void moe_tables(const Ptrs& P, LAS int* tab) {
    const unsigned* ctl = (const unsigned*)(P.ws + WS_CTL);
    if (threadIdx.x < NE) tab[66 + threadIdx.x] = (int)__hip_atomic_load(ctl + CW_COUNTS + threadIdx.x, RLX_AGENT);
    __syncthreads();
    if (threadIdx.x == 0) { int a = 0; for (int e = 0; e < NE; ++e) { tab[e] = a; tab[33 + e] = a * MT; a += (tab[66 + e] + MT - 1) / MT; } tab[NE] = a; tab[33 + NE] = a * MT; }
    __syncthreads();
}
__device__ __forceinline__ void ph7_final(const Ptrs& P, const LAS int* tab, int G, volatile LAS unsigned* MISC) {
    const int tid = opaque_tid(), lane = tid & 63, wave = tid >> 6;
    const unsigned char* Y = (const unsigned char*)(P.ws + WS_YBUF);
    constexpr int TB = 2;
    const int stride = G * NWAVES;
    uint2 xb[2][TB][4]; int yv[2][TB][4][4];
#define FIN_LOAD(buf, mb_) do { if ((mb_) < T) _Pragma("unroll") for (int t = 0; t < TB; ++t) { const int m_ = ((mb_) + t * stride < T) ? (mb_) + t * stride : (T - 1); \
            const int4 ts_ = *(const int4*)((const int*)(P.ws + WS_ROUTE + RT_TOKSLOT) + (size_t)m_ * 4); const int pk_[4] = {ts_.x, ts_.y, ts_.z, ts_.w}; \
            const bf16* X1_ = (const bf16*)(P.ws + WS_X1B) + (size_t)m_ * D; \
            _Pragma("unroll") for (int j = 0; j < 4; ++j) xb[buf][t][j] = ((const uint2*)X1_)[lane + 64 * j]; \
            _Pragma("unroll") for (int r = 0; r < 4; ++r) { const size_t slot_ = (size_t)tab[33 + (pk_[r] >> 16)] + (pk_[r] & 0xffff); \
                _Pragma("unroll") for (int j = 0; j < 4; ++j) yv[buf][t][r][j] = ((const int*)(Y + slot_ * D))[lane + 64 * j]; } } } while (0)
#define FIN_DO(buf, mb_) do { _Pragma("unroll") for (int t = 0; t < TB; ++t) { const int m = (mb_) + t * stride; \
            if (m < T) { f32x4 v[4]; \
                _Pragma("unroll") for (int j = 0; j < 4; ++j) { v[j] = (f32x4){bf2f(xb[buf][t][j].x & 0xffffu), bf2f(xb[buf][t][j].x >> 16), bf2f(xb[buf][t][j].y & 0xffffu), bf2f(xb[buf][t][j].y >> 16)}; \
                    _Pragma("unroll") for (int r = 0; r < 4; ++r) { const auto lo = __builtin_amdgcn_cvt_pk_f32_fp8(yv[buf][t][r][j], false), hi = __builtin_amdgcn_cvt_pk_f32_fp8(yv[buf][t][r][j], true); \
                        v[j].x += lo[0] * (1.0f / F8S_Y); v[j].y += lo[1] * (1.0f / F8S_Y); v[j].z += hi[0] * (1.0f / F8S_Y); v[j].w += hi[1] * (1.0f / F8S_Y); } } \
                float s = 0.f; \
                _Pragma("unroll") for (int j = 0; j < 4; ++j) s += (v[j].x * v[j].x + v[j].y * v[j].y) + (v[j].z * v[j].z + v[j].w * v[j].w); \
                const float rstd = 1.0f / sqrtf(wave_sum(s) * (1.f / D) + EPS); \
                _Pragma("unroll") for (int j = 0; j < 4; ++j) { const f32x4 ww = ((const f32x4*)P.norm_final_w)[lane + 64 * j]; \
                    ((f32x4*)(P.out + (size_t)m * D))[lane + 64 * j] = (f32x4){v[j].x * rstd * ww.x, v[j].y * rstd * ww.y, v[j].z * rstd * ww.z, v[j].w * rstd * ww.w}; } \
                if (PROBE_STAMP >= 0 && m == 0 && lane == 0) { asm volatile("s_waitcnt vmcnt(0)" ::: "memory"); P.out[0] += (float)(MISC[17] - MISC[16]) * (0.01f / 4.0f); } \
                if (PROBE_P2 >= 0 && m == 0 && lane == 0) { asm volatile("s_waitcnt vmcnt(0)" ::: "memory"); const unsigned* cw_ = (const unsigned*)(P.ws + WS_CTL); P.out[0] += (float)(__hip_atomic_load(cw_ + 201, RLX_AGENT) - __hip_atomic_load(cw_ + 200, RLX_AGENT)) * (0.01f / 4.0f); } } } } while (0)
    const int mb0 = blockIdx.x * NWAVES + wave;
    if (mb0 < T) {
        FIN_LOAD(0, mb0);
        for (int mb = mb0; mb < T; mb += 2 * TB * stride) {
            FIN_LOAD(1, mb + TB * stride);
            FIN_DO(0, mb);
            FIN_LOAD(0, mb + 2 * TB * stride);
            FIN_DO(1, mb + TB * stride);
        }
    }
#undef FIN_LOAD
#undef FIN_DO
}

constexpr int NPHASE = 8;
__global__ void __launch_bounds__(NTHR, 2) mk_fwd(Args args) {
    extern __shared__ __attribute__((aligned(16))) unsigned char lds_raw[];
    LAS unsigned char* lds = (LAS unsigned char*)lds_raw;
    const Ptrs& P = args.P;
    const int tid = threadIdx.x, G = gridDim.x;
    const int vcu = (G % 8 == 0) ? ((int)blockIdx.x % 8) * (G / 8) + (int)blockIdx.x / 8 : (int)blockIdx.x;
    volatile LAS unsigned* MISC = (volatile LAS unsigned*)(lds + MISC_OFF);
    LAS int* tab = (LAS int*)(lds + TAB_OFF);
    if (tid < 64) MISC[tid] = 0u;
    __syncthreads();
    unsigned* ctl = (unsigned*)(P.ws + WS_CTL);
    XcdBarrier bar = xcd_barrier_post(ctl + CW_BAR + args.li * XCD_BAR_WORDS, MISC + 8);
    const int lo = args.ph_lo, hi = args.ph_hi;
#define IN(k) (lo <= (k) && (k) < hi)
#define NREP(k) ((PROBE_REPEAT == (k)) ? 2 : 1)
#define PH(k, ...) if (IN(k)) { if (PROBE_STAMP == (k) && tid == 0) MISC[16] = (unsigned)__builtin_amdgcn_s_memrealtime(); \
        for (int rep = 0; rep < NREP(k); ++rep) { __VA_ARGS__; if (rep + 1 < NREP(k) || IN((k) + 1)) xcd_barrier(bar); } \
        if (PROBE_STAMP == (k) && tid == 0) MISC[17] = (unsigned)__builtin_amdgcn_s_memrealtime(); }
    PH(0, ph0_prep(P, lds_raw, lds, vcu, G));
    PH(1, { pg8::DenseSched S; S.init(T, NPROJ, D, G, (int)blockIdx.x, PC_GK / 256); pg8::EpiProj E{(bf16*)(P.ws + WS_PROJ)};
            pg8::gemm_phase(lds, lds + AUX_OFF, (const char*)(P.ws + WS_H), (const char*)(P.ws + WS_WIN), D, S, E);
            { const int nwg = (T / 256) * (NPROJ / 256 - 1), full = nwg / G, rem = nwg % G;
              if (rep == 0 && rem != 0 && (int)blockIdx.x >= rem && full > 0) { __syncthreads(); moe_weight_items(P, lds_raw, PROBE_REPEAT == 40 ? 2 : 1, 1); } } });
    PH(2, ph2_mix_fast(P, lds, lds_raw, G));
    PH(3, { pg8::DenseSched S; S.init(T, D, D, G, (int)blockIdx.x); pg8::EpiA1 E{(bf16*)(P.ws + WS_A1)};
            pg8::gemm_phase(lds, lds + AUX_OFF, (const char*)(P.ws + WS_MIX), (const char*)(P.ws + WS_WOUT), D, S, E); });
    PH(4, ph4_router_fast(P, lds, G));
    if (IN(5) || IN(6) || IN(7)) moe_tables(P, tab);
    constexpr int KM = MOE_FP8 ? D / 2 : D;
    PH(5, { pg8::MoeSched<true> S{tab, (const int*)(P.ws + WS_ROUTE + RT_ROWTOK), 8, G, (int)blockIdx.x, __builtin_amdgcn_readfirstlane(tab[NE]) * 8, KM, 2048};
            pg8::EpiAct E{(bf16*)(P.ws + WS_ACT), P.b_gate_up, (const float*)(P.ws + WS_RRSTD)};
            pg8::gemm_phase<MOE_FP8 != 0>(lds, lds + AUX_OFF, (const char*)(P.ws + WS_H), (const char*)(P.ws + WS_WGU), KM, S, E); });
    PH(6, { pg8::MoeSched<false> S{tab, nullptr, 4, G, (int)blockIdx.x, __builtin_amdgcn_readfirstlane(tab[NE]) * 4, KM, 1024};
            pg8::EpiDown E{(bf16*)(P.ws + WS_YBUF), P.b_down, (const float*)(P.ws + WS_ROUTE + RT_ROWW)};
            pg8::gemm_phase<MOE_FP8 != 0>(lds, lds + AUX_OFF, (const char*)(P.ws + WS_ACT), (const char*)(P.ws + WS_WD), KM, S, E); });
    PH(7, ph7_final(P, tab, G, MISC));
#undef IN
#undef NREP
#undef PH
}

#ifndef MK_SEGMENTS
#define MK_SEGMENTS 1
#endif
extern "C" void kernel_launch(void* const* d_in, const int* in_sizes, int n_in, void* d_out, int out_size, void* d_ws, size_t ws_size, hipStream_t stream) {
    if (n_in != 19 || out_size != T * D || ws_size < WS_END) { fprintf(stderr, "kernel_launch: unexpected shapes n_in %d out %d ws %zu (need %zu)\n", n_in, out_size, ws_size, (size_t)WS_END); return; }
    static int grid = 0;
    if (grid == 0) {
        int dev = 0, cus = 0, per_cu = 0;
        if (hipGetDevice(&dev) != hipSuccess || hipDeviceGetAttribute(&cus, hipDeviceAttributeMultiprocessorCount, dev) != hipSuccess) { fprintf(stderr, "kernel_launch: device query failed\n"); grid = -1; return; }
        if (hipFuncSetAttribute((const void*)mk_fwd, hipFuncAttributeMaxDynamicSharedMemorySize, LDS_BYTES) != hipSuccess) { fprintf(stderr, "kernel_launch: hipFuncSetAttribute failed\n"); grid = -1; return; }
        if (hipOccupancyMaxActiveBlocksPerMultiprocessor(&per_cu, (const void*)mk_fwd, NTHR, LDS_BYTES) != hipSuccess || per_cu < 1) { fprintf(stderr, "kernel_launch: occupancy query says %d\n", per_cu); per_cu = 1; }
        (void)hipGetLastError();
        grid = cus;
        fprintf(stderr, "kernel_launch: cus %d per_cu %d grid %d\n", cus, per_cu, grid);
    }
    if (grid < 0) return;
    Args a{};
    const float** pp = (const float**)&a.P;
    for (int i = 0; i < 19; ++i) pp[i] = (const float*)d_in[i];
    a.P.out = (float*)d_out; a.P.ws = (unsigned char*)d_ws;
    (void)hipMemsetAsync((char*)d_ws + WS_CTL, 0, MiB, stream);
#if MK_SEGMENTS == 1
    a.ph_lo = 0; a.ph_hi = NPHASE; a.li = 0;
    void* kargs[] = {&a};
    hipError_t e = hipLaunchCooperativeKernel((const void*)mk_fwd, dim3(grid), dim3(NTHR), kargs, LDS_BYTES, stream);
    if (e != hipSuccess) fprintf(stderr, "kernel_launch: cooperative launch failed: %s (grid %d)\n", hipGetErrorString(e), grid);
#else
    for (int ph = 0; ph < NPHASE; ++ph) { a.ph_lo = ph; a.ph_hi = ph + 1; a.li = ph; hipLaunchKernelGGL(mk_fwd, dim3(grid), dim3(NTHR), LDS_BYTES, stream, a); }
#endif
}
```

```cpp
#include <hip/hip_runtime.h>
#include <cstdio>
#include <cstdint>

constexpr int T = 32768, D = 1024, SEQ = 2048, NB = 16;
constexpr int NIN_SRC = 2576, NPROJ = 2816;
constexpr int PC_Q = 0, PC_K = 256, PC_V = 512, PC_G = 1024, PC_GK = 1536, PC_U = 1792, PC_VS = 2304;
constexpr int NE = 32, TOPK = 4, DE = 1024;
constexpr int MT = 256;
constexpr int MAXSLOTS = T * TOPK + NE * MT;
constexpr float EPS = 1e-6f;

typedef unsigned short bf16;
typedef unsigned v4u __attribute__((ext_vector_type(4)));
typedef float f32x4 __attribute__((ext_vector_type(4)));

constexpr size_t MiB = 1u << 20;
constexpr size_t WS_CTL   = 0;
constexpr size_t WS_WIN   = 1 * MiB;
constexpr size_t WS_WOUT  = 7 * MiB;
constexpr size_t WS_WSP   = 9 * MiB;
constexpr size_t WS_ROUTE = 10 * MiB;
constexpr size_t WS_WGU   = 20 * MiB;
constexpr size_t WS_WD    = 148 * MiB;
constexpr size_t WS_X1    = 212 * MiB;
constexpr size_t WS_ACT   = 340 * MiB;
constexpr size_t WS_PROJ  = 612 * MiB;
constexpr size_t WS_MIX   = 788 * MiB;
constexpr size_t WS_H     = 852 * MiB;
constexpr size_t WS_YBUF  = WS_PROJ;
constexpr size_t WS_A1    = WS_X1;
constexpr size_t WS_X1B   = WS_X1 + 64 * MiB;
constexpr size_t WS_RRSTD = WS_H + 32 * MiB;
constexpr size_t WS_VN    = WS_ACT;
constexpr size_t WS_END   = 916 * MiB;
static_assert(WS_YBUF + (size_t)MAXSLOTS * 1024 * 2 <= WS_END, "ybuf fits");
static_assert(WS_ACT + (size_t)MAXSLOTS * 1024 * 2 <= WS_PROJ, "act fits");
constexpr size_t RT_ROWTOK = 0;
constexpr size_t RT_ROWW   = 4 * MiB;
constexpr size_t RT_TOKSLOT= 8 * MiB;
constexpr int CW_COUNTS = 64;
constexpr int CW_PSTART = 128;

__device__ __forceinline__ unsigned f2bf(float f) { unsigned u = __builtin_bit_cast(unsigned, f); return (u + 0x7fffu + ((u >> 16) & 1u)) >> 16; }
__device__ __forceinline__ float bf2f(unsigned h) { return __builtin_bit_cast(float, h << 16); }
__device__ __forceinline__ unsigned pk2(float lo, float hi) { return f2bf(lo) | (f2bf(hi) << 16); }
#ifndef MOE_FP8
#define MOE_FP8 1
#endif
constexpr float F8S_H = 8.0f, F8S_W = 32.0f, F8S_ACT = 4.0f, F8S_Y = 64.0f;
__device__ __forceinline__ float f8clamp(float x) { return fminf(fmaxf(x, -448.0f), 448.0f); }
__device__ __forceinline__ unsigned pk4_fp8(float a, float b, float c, float d) {
    int w = 0; w = __builtin_amdgcn_cvt_pk_fp8_f32(f8clamp(a), f8clamp(b), w, false); w = __builtin_amdgcn_cvt_pk_fp8_f32(f8clamp(c), f8clamp(d), w, true); return (unsigned)w; }
__device__ __forceinline__ unsigned pk4_fp8_nc(float a, float b, float c, float d) { int w = 0; w = __builtin_amdgcn_cvt_pk_fp8_f32(a, b, w, false); w = __builtin_amdgcn_cvt_pk_fp8_f32(c, d, w, true); return (unsigned)w; }
__device__ __forceinline__ float gelu_tanh(float x) { const float x2 = x * x, t = x * (x2 * (-2.0f * 1.4426950408889634f * 0.7978845608028654f * 0.044715f) + (-2.0f * 1.4426950408889634f * 0.7978845608028654f));
    return x * __builtin_amdgcn_rcpf(1.0f + __builtin_amdgcn_exp2f(t)); }
__device__ __forceinline__ float silu(float x) { return x / (1.0f + __expf(-x)); }
__device__ __forceinline__ float log_sigmoid(float x) { return fminf(x, 0.0f) - log1pf(__expf(-fabsf(x))); }
template <int CTRL, int ROWMASK> __device__ __forceinline__ float dpp_f(float v) {
    return __builtin_bit_cast(float, __builtin_amdgcn_update_dpp(0, __builtin_bit_cast(int, v), CTRL, ROWMASK, 0xF, true)); }
__device__ __forceinline__ float wave_incl_scan(float v) {
    v += dpp_f<0x111, 0xF>(v); v += dpp_f<0x112, 0xF>(v); v += dpp_f<0x114, 0xF>(v); v += dpp_f<0x118, 0xF>(v);
    v += dpp_f<0x142, 0xA>(v); v += dpp_f<0x143, 0xC>(v); return v; }
__device__ __forceinline__ float wave_sum(float v) { return __builtin_bit_cast(float, __builtin_amdgcn_readlane(__builtin_bit_cast(int, wave_incl_scan(v)), 63)); }

struct Ptrs {
    const float *x, *norm_mix_w, *w_in, *w_gk_up, *b_gk, *gla_norm_w, *sg_ln_w, *sg_ln_b, *w_spatial, *b_spatial, *w_out, *norm_ffn_w,
                *w_router, *b_router, *w_gate_up, *b_gate_up, *w_down, *b_down, *norm_final_w;
    float* out; unsigned char* ws;
};

__device__ __forceinline__ void p0_tr_write(bf16* WT, int K, int d0, int k0, const float* scr, int lane) {
    const int c = lane & 7;
#pragma unroll
    for (int j = 0; j < 4; ++j) { const int n = (lane >> 3) + 8 * j; const float* s = scr + (8 * c) * 33 + n;
        v4u o; o.x = pk2(s[0 * 33], s[1 * 33]); o.y = pk2(s[2 * 33], s[3 * 33]); o.z = pk2(s[4 * 33], s[5 * 33]); o.w = pk2(s[6 * 33], s[7 * 33]);
        *(v4u*)(WT + (size_t)(d0 + n) * K + k0 + 8 * c) = o; }
}
__device__ __forceinline__ void p0_tr_write_f8(unsigned char* WT, int K, int d0, int k0, const float* scr, int lane, float sc) {
    const int c = lane & 7;
#pragma unroll
    for (int j = 0; j < 4; ++j) { const int n = (lane >> 3) + 8 * j; const float* s = scr + (8 * c) * 33 + n;
        uint2 o; o.x = pk4_fp8(s[0 * 33] * sc, s[1 * 33] * sc, s[2 * 33] * sc, s[3 * 33] * sc); o.y = pk4_fp8(s[4 * 33] * sc, s[5 * 33] * sc, s[6 * 33] * sc, s[7 * 33] * sc);
        *(uint2*)(WT + (size_t)(d0 + n) * K + k0 + 8 * c) = o; }
}
template <bool F8 = false>
__device__ __forceinline__ void p0_transpose_item(const float* W, int ldn, int n0, int k0, bf16* WT, int K, int d0, float* scr, int lane) {
    float v[32];
    const float* src = W + (size_t)(k0 + (lane >> 5)) * ldn + n0 + (lane & 31);
#pragma unroll
    for (int i = 0; i < 32; ++i) v[i] = __builtin_nontemporal_load(src + (size_t)(2 * i) * ldn);
#pragma unroll
    for (int i = 0; i < 32; ++i) scr[(2 * i + (lane >> 5)) * 33 + (lane & 31)] = v[i];
    __builtin_amdgcn_wave_barrier(); asm volatile("s_waitcnt lgkmcnt(0)" ::: "memory");
    if constexpr (F8) p0_tr_write_f8((unsigned char*)WT, K, d0, k0, scr, lane, F8S_W); else p0_tr_write(WT, K, d0, k0, scr, lane);
    asm volatile("s_waitcnt lgkmcnt(0)" ::: "memory"); __builtin_amdgcn_wave_barrier();
}
__device__ __forceinline__ void p0_gk_item(const float* w_in, const float* w_gk_up, int j0, int k0, bf16* WT, float* scr, int lane) {
    for (int i = 0; i < 32; ++i) { const int kk = 2 * i + (lane >> 5), j = j0 + (lane & 31); float s = 0.f;
#pragma unroll
        for (int r = 0; r < 16; ++r) s += w_in[(size_t)(k0 + kk) * NIN_SRC + 1536 + r] * w_gk_up[r * 256 + j];
        scr[kk * 33 + (lane & 31)] = s; }
    __builtin_amdgcn_wave_barrier(); asm volatile("s_waitcnt lgkmcnt(0)" ::: "memory");
    p0_tr_write(WT, D, PC_GK + j0, k0, scr, lane);
    asm volatile("s_waitcnt lgkmcnt(0)" ::: "memory"); __builtin_amdgcn_wave_barrier();
}
constexpr int IT_IN = (NPROJ / 32) * 16, IT_OUT = 32 * 16, IT_GU = NE * 64 * 16, IT_DN = NE * 32 * 16, IT_ALL = IT_IN + IT_OUT + IT_GU + IT_DN;
__device__ __forceinline__ void p0_weight_item(const Ptrs& P, int it, float* scr, int lane) {
    bf16* WinT = (bf16*)(P.ws + WS_WIN); bf16* WoutT = (bf16*)(P.ws + WS_WOUT); bf16* WguT = (bf16*)(P.ws + WS_WGU); bf16* WdT = (bf16*)(P.ws + WS_WD);
    if (it < IT_IN) { const int db = it / 16, kb = it % 16, d0 = db * 32;
        if (d0 >= PC_GK && d0 < PC_U) return;
        else p0_transpose_item(P.w_in, NIN_SRC, d0 < PC_GK ? d0 : d0 - 240, kb * 64, WinT, D, d0, scr, lane);
        return; }
    it -= IT_IN;
    if (it < IT_OUT) { const int db = it / 16, kb = it % 16; p0_transpose_item(P.w_out, D, db * 32, kb * 64, WoutT, D, db * 32, scr, lane); return; }
    it -= IT_OUT;
    if (it < IT_GU) { const int e = it / 1024, r = it % 1024, db = r / 16, kb = r % 16, d0 = db * 32, pn = d0 >> 8, bj = (d0 >> 7) & 1, rr = d0 & 127;
        if (MOE_FP8) p0_transpose_item<true>(P.w_gate_up + (size_t)e * D * 2048, 2048, bj * 1024 + 128 * pn + rr, kb * 64, (bf16*)((unsigned char*)WguT + (size_t)e * 2048 * D), D, d0, scr, lane);
        else p0_transpose_item(P.w_gate_up + (size_t)e * D * 2048, 2048, bj * 1024 + 128 * pn + rr, kb * 64, WguT + (size_t)e * 2048 * D, D, d0, scr, lane);
        return; }
    it -= IT_GU;
    { const int e = it / 512, r = it % 512, db = r / 16, kb = r % 16;
      if (MOE_FP8) p0_transpose_item<true>(P.w_down + (size_t)e * DE * D, D, db * 32, kb * 64, (bf16*)((unsigned char*)WdT + (size_t)e * D * DE), DE, db * 32, scr, lane);
      else p0_transpose_item(P.w_down + (size_t)e * DE * D, D, db * 32, kb * 64, WdT + (size_t)e * D * DE, DE, db * 32, scr, lane); }
}
__device__ __forceinline__ void rms_row_to_bf16(const float* xrow, const float* w, bf16* orow, int lane) {
    const f32x4* xr = (const f32x4*)xrow + lane; const f32x4* wr = (const f32x4*)w + lane;
    f32x4 v[4]; float s = 0.f;
#pragma unroll
    for (int j = 0; j < 4; ++j) { v[j] = xr[64 * j]; s += (v[j].x * v[j].x + v[j].y * v[j].y) + (v[j].z * v[j].z + v[j].w * v[j].w); }
    const float rstd = 1.0f / sqrtf(wave_sum(s) * (1.f / D) + EPS);
    unsigned long long* o8 = (unsigned long long*)orow + lane;
#pragma unroll
    for (int j = 0; j < 4; ++j) { const f32x4 ww = wr[64 * j];
        o8[64 * j] = (unsigned long long)pk2(v[j].x * rstd * ww.x, v[j].y * rstd * ww.y) | ((unsigned long long)pk2(v[j].z * rstd * ww.z, v[j].w * rstd * ww.w) << 32); }
}

#ifndef PROBE_P2
#define PROBE_P2 -1
#endif
#ifndef PROBE_K2
#define PROBE_K2 -1
#endif
#ifndef PROBE_BIAS
#define PROBE_BIAS 0
#endif
#ifndef PROBE_STAMP
#define PROBE_STAMP -1
#endif
#ifndef PROBE_REPEAT
#define PROBE_REPEAT -1
#endif
#define LAS __attribute__((address_space(3)))
__device__ __forceinline__ int opaque_tid() { int t = threadIdx.x; asm volatile("" : "+v"(t)); return t; }
typedef short bf16x8 __attribute__((ext_vector_type(8)));
typedef unsigned u32x4 __attribute__((ext_vector_type(4)));
constexpr int NWAVES = 8, NTHR = 512;
constexpr int RING_BYTES = 131072, TAB_OFF = RING_BYTES, MISC_OFF = RING_BYTES + 1024, AUX_OFF = RING_BYTES + 2048, AUX_ROWTAB = 0, AUX_SLOTS = 8192, AUX_SLOT_BYTES = 2048, LDS_BYTES = AUX_OFF + 16384;
constexpr int CW_BAR = 4096;
#define RLX_AGENT __ATOMIC_RELAXED, __HIP_MEMORY_SCOPE_AGENT

#define XB_TMO      128
#define XB_XCNT(j)  (256  + 64 * (j))
#define XB_XSUB(j)  (1280 + 64 * (j))
#define XB_XGEN(j)  (2304 + 64 * (j))
#define XB_TOP      3328
#define XB_TOPGEN   3392
#define XCD_BAR_WORDS 3456
#define XB_SPIN_CAP (1u << 20)
__device__ __forceinline__ unsigned xb_ld(unsigned* p)              { return __hip_atomic_load(p, __ATOMIC_RELAXED, __HIP_MEMORY_SCOPE_AGENT); }
__device__ __forceinline__ unsigned xb_add(unsigned* p, unsigned v) { return __hip_atomic_fetch_add(p, v, __ATOMIC_RELAXED, __HIP_MEMORY_SCOPE_AGENT); }
__device__ __forceinline__ unsigned xb_xcc_id() { return (unsigned)__builtin_amdgcn_s_getreg((3 << 11) | 20) & 0xFu; }
#define XB_SPIN(cond, bar) do { unsigned _sp = 0; while (cond) { __builtin_amdgcn_s_sleep(1); \
    if ((++_sp & 255u) == 0u) { if (xb_ld(&(bar)[XB_TMO])) break; if (_sp > XB_SPIN_CAP) { atomicAdd(&(bar)[XB_TMO], 1u); break; } } } } while (0)
struct XcdBarrier { unsigned* bar; unsigned x; volatile LAS unsigned* st; };
__device__ __forceinline__ XcdBarrier xcd_barrier_post(unsigned* bar, volatile LAS unsigned* st) {
    XcdBarrier b; b.bar = bar; b.x = xb_xcc_id(); b.st = st;
    if (threadIdx.x == 0) (void)xb_add(&bar[XB_XCNT(b.x)], 1u);
    return b;
}
__device__ __forceinline__ void xcd_barrier_complete(unsigned* bar, unsigned x, unsigned& nloc, unsigned& nx) {
    const unsigned G = gridDim.x * gridDim.y * gridDim.z;
    unsigned sum, cnt, mine, sp = 0u;
    for (;;) {
        sum = 0u; cnt = 0u; mine = 0u;
#pragma unroll
        for (unsigned j = 0; j < 16; ++j) { const unsigned c = xb_ld(&bar[XB_XCNT(j)]); sum += c; cnt += (c > 0u) ? 1u : 0u; mine = (j == x) ? c : mine; }
        if (sum == G) break;
        __builtin_amdgcn_s_sleep(1);
        if ((++sp & 255u) == 0u) { if (xb_ld(&bar[XB_TMO])) break; if (sp > XB_SPIN_CAP) { atomicAdd(&bar[XB_TMO], 1u); break; } }
    }
    nloc = mine > 0u ? mine : 1u; nx = cnt > 0u ? cnt : 1u;
}
__device__ __forceinline__ void xcd_barrier(const XcdBarrier& b) {
    asm volatile("s_waitcnt vmcnt(0)" ::: "memory");
    __syncthreads();
    if (threadIdx.x == 0) {
        unsigned* bar = b.bar;
        __builtin_amdgcn_s_waitcnt(0);
        unsigned nloc = b.st[0], nx = b.st[1];
        if (nloc == 0u) { xcd_barrier_complete(bar, b.x, nloc, nx); b.st[0] = nloc; b.st[1] = nx; }
        const unsigned old = xb_add(&bar[XB_XSUB(b.x)], 1u);
        const unsigned gen = old / nloc;
        if (old + 1u == (gen + 1u) * nloc) {
            __builtin_amdgcn_fence(__ATOMIC_RELEASE, "agent");
            asm volatile("s_waitcnt vmcnt(0)" ::: "memory");
            const unsigned og = xb_add(&bar[XB_TOP], 1u);
            const unsigned tg = og / nx;
            if (og + 1u == (tg + 1u) * nx) xb_add(&bar[XB_TOPGEN], 1u);
            else XB_SPIN(xb_ld(&bar[XB_TOPGEN]) == tg, bar);
            __builtin_amdgcn_fence(__ATOMIC_ACQUIRE, "agent");
            xb_add(&bar[XB_XGEN(b.x)], 1u);
            asm volatile("s_waitcnt vmcnt(0)" ::: "memory");
        } else {
            XB_SPIN(xb_ld(&bar[XB_XGEN(b.x)]) == gen, bar);
            __builtin_amdgcn_fence(__ATOMIC_ACQUIRE, "agent");
            asm volatile("s_waitcnt vmcnt(0)" ::: "memory");
        }
    }
    __syncthreads();
}

namespace pg8 {
constexpr int BM = 256, BK = 64, HALF = 128, HTB = HALF * BK * 2, NXCD = 8, WGM = 8;
__device__ __forceinline__ int lds_byte(int r, int c) { const int st = (r >> 4) * 2 + (c >> 5), rr = r & 15, cc = c & 31, ob = rr * 64 + cc * 2; return st * 1024 + (ob ^ (((ob >> 9) & 1) << 5)); }
__device__ __forceinline__ void stage_rc(int b, int& R, int& C) { const int st = b / 1024, sb = b % 1024, swz = sb ^ (((sb >> 9) & 1) << 5); R = (st >> 1) * 16 + swz / 64; C = (st & 1) * 32 + (swz % 64) / 2; }
__device__ __forceinline__ int perm32(int rho) { const int n = rho >> 4, i = rho & 15; return 8 * (i >> 2) + 4 * n + (i & 3); }
typedef float f32x2_t __attribute__((ext_vector_type(2)));
typedef __bf16 bf16x2_t __attribute__((ext_vector_type(2)));
__device__ __forceinline__ unsigned cvt_pk_bf16(float lo, float hi) { const f32x2_t v = {lo, hi}; const bf16x2_t b = __builtin_convertvector(v, bf16x2_t); return __builtin_bit_cast(unsigned, b); }
__device__ __forceinline__ int xcd_remap(int wgid, int nwg) { const int q = nwg / NXCD, r = nwg % NXCD, xcd = wgid % NXCD, off = wgid / NXCD; return (xcd < r ? xcd * (q + 1) : r * (q + 1) + (xcd - r) * q) + off; }

struct Unit { int pm, pn, e, m0, count, slot0; };
typedef f32x4 Acc[2][2][4][2];

struct DenseSched {
    int nM, nN, nwg, G, c, K, skip;
    __device__ __forceinline__ void init(int M, int N, int K_, int G_, int c_, int skip_ = 1 << 20) { nM = M / BM; nN = N / BM - (skip_ < N / BM ? 1 : 0); nwg = nM * nN; G = G_; c = c_; K = K_; skip = skip_; }
    __device__ __forceinline__ bool next(int i, Unit& u) const {
        const long L = (long)i * G + c; if (L >= nwg) return false;
        const int wgid = xcd_remap((int)L, nwg);
        const int nig = WGM * nN, gid = wgid / nig, fm = gid * WGM, gsz = (nM - fm) < WGM ? (nM - fm) : WGM;
        u.pm = fm + ((wgid % nig) % gsz); u.pn = (wgid % nig) / gsz; if (u.pn >= skip) ++u.pn; u.e = 0; u.m0 = 0; u.count = 0; u.slot0 = 0; return true;
    }
    static constexpr bool GATHER = false;
    __device__ __forceinline__ unsigned a_off(const Unit& u, int r) const { return (unsigned)(u.pm * BM + r) * (unsigned)(K * 2); }
    __device__ __forceinline__ const int* row_src(const Unit&, int) const { return nullptr; }
    __device__ __forceinline__ size_t b_off(const Unit& u) const { return (size_t)u.pn * BM * K * 2; }
};
template <bool GATHER_>
struct MoeSched {
    static constexpr bool GATHER = GATHER_;
    const LAS int* tab; const int* rowtok; int NPN, G, c, ntile, K, NB_E  ;
    __device__ __forceinline__ bool next(int i, Unit& u) const {
        const long L = (long)i * G + c; if (L >= ntile) return false;
        const int wgid = xcd_remap((int)L, ntile);
        int lo = 0, hi = NE;
#pragma unroll
        for (int s = 0; s < 5; ++s) { const int mid = (lo + hi) >> 1; if (__builtin_amdgcn_readfirstlane(tab[mid]) * NPN <= wgid) lo = mid; else hi = mid; }
        const int e = lo, t0 = __builtin_amdgcn_readfirstlane(tab[e]), mte = __builtin_amdgcn_readfirstlane(tab[e + 1]) - t0, local = wgid - t0 * NPN;
        u.e = e; u.pn = local / mte; u.pm = 0; u.m0 = (local % mte) * BM; u.count = __builtin_amdgcn_readfirstlane(tab[66 + e]); u.slot0 = __builtin_amdgcn_readfirstlane(tab[33 + e]); return true;
    }
    __device__ __forceinline__ const int* row_src(const Unit& u, int r) const { int m = u.m0 + r; m = m < u.count ? m : u.count - 1; return rowtok + (size_t)u.e * T + m; }
    __device__ __forceinline__ unsigned a_off(const Unit& u, int r) const {
        if (GATHER) return (unsigned)(*row_src(u, r)) * (unsigned)(K * 2);
        return (unsigned)(u.slot0 + u.m0 + r) * (unsigned)(K * 2);
    }
    __device__ __forceinline__ size_t b_off(const Unit& u) const { return ((size_t)u.e * NB_E + (size_t)u.pn * BM) * K * 2; }
};

struct EpiProj {
    static constexpr bool PERM = true, AUX = false;
    bf16* O;
    __device__ __forceinline__ const float* aux_src(const Unit&, int) const { return nullptr; }
    __device__ __forceinline__ void operator()(const Acc& acc, const Unit& u, int wr, int wc, int fr, int fq, const LAS float*) const {
        const int row0 = u.pm * BM + wr * 64 + fr, col0 = u.pn * BM + wc * 32 + 8 * fq;
#pragma unroll
        for (int ai = 0; ai < 2; ++ai)
#pragma unroll
            for (int m = 0; m < 4; ++m) { bf16* rowp = O + (size_t)(row0 + ai * HALF + m * 16) * NPROJ + col0;
#pragma unroll
                for (int bj = 0; bj < 2; ++bj) { const f32x4 v0 = acc[ai][bj][m][0], v1 = acc[ai][bj][m][1];
                    u32x4 w; w.x = cvt_pk_bf16(v0[0], v0[1]); w.y = cvt_pk_bf16(v0[2], v0[3]); w.z = cvt_pk_bf16(v1[0], v1[1]); w.w = cvt_pk_bf16(v1[2], v1[3]);
                    *(u32x4*)(rowp + bj * HALF) = w; } }
    }
};
struct EpiA1 {
    static constexpr bool PERM = true, AUX = false;
    bf16* O;
    __device__ __forceinline__ const float* aux_src(const Unit&, int) const { return nullptr; }
    __device__ __forceinline__ void operator()(const Acc& acc, const Unit& u, int wr, int wc, int fr, int fq, const LAS float*) const {
        const int row0 = u.pm * BM + wr * 64 + fr, col0 = u.pn * BM + wc * 32 + 8 * fq;
#pragma unroll
        for (int ai = 0; ai < 2; ++ai)
#pragma unroll
            for (int m = 0; m < 4; ++m) { bf16* rowp = O + (size_t)(row0 + ai * HALF + m * 16) * D + col0;
#pragma unroll
                for (int bj = 0; bj < 2; ++bj) { const f32x4 v0 = acc[ai][bj][m][0], v1 = acc[ai][bj][m][1];
                    u32x4 w; w.x = cvt_pk_bf16(v0[0], v0[1]); w.y = cvt_pk_bf16(v0[2], v0[3]); w.z = cvt_pk_bf16(v1[0], v1[1]); w.w = cvt_pk_bf16(v1[2], v1[3]);
                    *(u32x4*)(rowp + bj * HALF) = w; } }
    }
};
struct EpiAct {
    static constexpr bool PERM = true, AUX = true;
    bf16* O; const float* bgu; const float* rrstd;
    __device__ __forceinline__ const float* aux_src(const Unit& u, int idx) const {
        if (idx < 256) return bgu + (size_t)u.e * 2048 + (idx < 128 ? u.pn * 128 + idx : 1024 + u.pn * 128 + (idx - 128));
        int m = u.m0 + (idx - 256); m = m < u.count ? m : u.count - 1; return rrstd + (size_t)u.e * T + m; }
    __device__ __forceinline__ void operator()(const Acc& acc, const Unit& u, int wr, int wc, int fr, int fq, const LAS float* aux) const {
        const int colj = u.pn * 128 + wc * 32 + 8 * fq;
        const LAS float* bg = aux + wc * 32 + 8 * fq;
        const f32x4 g0 = *(const LAS f32x4*)bg, g1 = *(const LAS f32x4*)(bg + 4), u0 = *(const LAS f32x4*)(bg + 128), u1 = *(const LAS f32x4*)(bg + 132);
        if constexpr (MOE_FP8 != 0) {
            const f32x4 gb[2] = {g0, g1}, ub[2] = {u0 * (float)F8S_ACT, u1 * (float)F8S_ACT};
#pragma unroll
            for (int ai = 0; ai < 2; ++ai)
#pragma unroll
                for (int m = 0; m < 4; ++m) { const int r = ai * HALF + wr * 64 + m * 16 + fr;
                    const float rs = aux[256 + r] * (1.0f / (F8S_H * F8S_W)), rs4 = rs * (float)F8S_ACT;
                    unsigned wd[2];
#pragma unroll
                    for (int n = 0; n < 2; ++n) {
                        f32x4 g = acc[ai][0][m][n] * rs + gb[n], up = acc[ai][1][m][n] * rs4 + ub[n];
#pragma unroll
                        for (int i = 0; i < 4; ++i) { g[i] = fminf(g[i], 7.0f); up[i] = __builtin_amdgcn_fmed3f(up[i], -7.0f * F8S_ACT, 7.0f * F8S_ACT); }
                        f32x4 e = g * (-1.702f * 1.4426950408889634f);
#pragma unroll
                        for (int i = 0; i < 4; ++i) e[i] = __builtin_amdgcn_exp2f(e[i]);
                        e = e + 1.0f;
#pragma unroll
                        for (int i = 0; i < 4; ++i) e[i] = __builtin_amdgcn_rcpf(e[i]);
                        const f32x4 y = (up + (float)F8S_ACT) * g * e;
                        wd[n] = pk4_fp8_nc(y[0], y[1], y[2], y[3]); }
                    uint2 w; w.x = wd[0]; w.y = wd[1];
                    *(uint2*)((unsigned char*)O + (size_t)(u.slot0 + u.m0 + r) * DE + colj) = w; }
        } else {
#pragma unroll
        for (int ai = 0; ai < 2; ++ai)
#pragma unroll
            for (int m = 0; m < 4; ++m) { const int r = ai * HALF + wr * 64 + m * 16 + fr;
                { float y[8]; const float rs = aux[256 + r];
#pragma unroll
                    for (int n = 0; n < 2; ++n)
#pragma unroll
                        for (int i = 0; i < 4; ++i) {
                            float g = acc[ai][0][m][n][i] * rs + (n ? g1[i] : g0[i]), up = acc[ai][1][m][n][i] * rs + (n ? u1[i] : u0[i]);
                            g = fminf(g, 7.0f); up = fminf(fmaxf(up, -7.0f), 7.0f); y[n * 4 + i] = (up + 1.0f) * g * __builtin_amdgcn_rcpf(1.0f + __expf(-1.702f * g)); }
                    u32x4 w; w.x = cvt_pk_bf16(y[0], y[1]); w.y = cvt_pk_bf16(y[2], y[3]); w.z = cvt_pk_bf16(y[4], y[5]); w.w = cvt_pk_bf16(y[6], y[7]);
                    *(u32x4*)(O + (size_t)(u.slot0 + u.m0 + r) * DE + colj) = w; } }
        }
    }
};
struct EpiDown {
    static constexpr bool PERM = true, AUX = true;
    bf16* O; const float* bd; const float* roww;
    __device__ __forceinline__ const float* aux_src(const Unit& u, int idx) const {
        if (idx < 256) return bd + (size_t)u.e * D + u.pn * BM + idx;
        int m = u.m0 + (idx - 256); m = m < u.count ? m : u.count - 1; return roww + (size_t)u.e * T + m; }
    __device__ __forceinline__ void operator()(const Acc& acc, const Unit& u, int wr, int wc, int fr, int fq, const LAS float* aux) const {
        const int col0 = u.pn * BM + wc * 32 + 8 * fq;
        const LAS float* bp = aux + wc * 32 + 8 * fq;
        f32x4 bv[2][2];
#pragma unroll
        for (int bj = 0; bj < 2; ++bj)
#pragma unroll
            for (int n = 0; n < 2; ++n) bv[bj][n] = *(const LAS f32x4*)(bp + bj * HALF + 4 * n);
#pragma unroll
        for (int ai = 0; ai < 2; ++ai)
#pragma unroll
            for (int m = 0; m < 4; ++m) { const int r = ai * HALF + wr * 64 + m * 16 + fr;
                { const float w8 = aux[256 + r]; bf16* rowp = O + (size_t)(u.slot0 + u.m0 + r) * D + col0;
#pragma unroll
                    for (int bj = 0; bj < 2; ++bj) { constexpr float isc = MOE_FP8 ? 1.0f / (F8S_ACT * F8S_W) : 1.0f;
                        if (MOE_FP8) { const float wy = w8 * (float)F8S_Y, wa = wy * isc;
                            const f32x4 v0 = acc[ai][bj][m][0] * wa + bv[bj][0] * wy, v1 = acc[ai][bj][m][1] * wa + bv[bj][1] * wy;
                            uint2 w; w.x = pk4_fp8(v0[0], v0[1], v0[2], v0[3]); w.y = pk4_fp8(v1[0], v1[1], v1[2], v1[3]);
                            *(uint2*)((unsigned char*)O + (size_t)(u.slot0 + u.m0 + r) * D + col0 + bj * HALF) = w; continue; }
                        const f32x4 v0 = (acc[ai][bj][m][0] * isc + bv[bj][0]) * w8, v1 = (acc[ai][bj][m][1] * isc + bv[bj][1]) * w8;
                        if (MOE_FP8) { }
                        else { u32x4 w; w.x = cvt_pk_bf16(v0[0], v0[1]); w.y = cvt_pk_bf16(v0[2], v0[3]); w.z = cvt_pk_bf16(v1[0], v1[1]); w.w = cvt_pk_bf16(v1[2], v1[3]);
                            *(u32x4*)(rowp + bj * HALF) = w; } } } }
    }
};

typedef int i32x4 __attribute__((ext_vector_type(4)));
typedef int i32x8 __attribute__((ext_vector_type(8)));
template <bool F8 = false, class Epi, class Sched>
__device__ __forceinline__ void gemm_phase(LAS unsigned char* lds, LAS unsigned char* aux, const char* gA, const char* gB, int K, const Sched& S, const Epi& E, const int krep = 1) {
    const int tid = opaque_tid(), wid = __builtin_amdgcn_readfirstlane(tid >> 6), lane = tid & 63, wr = wid >> 2, wc = wid & 3, fr = lane & 15, fq = lane >> 4;
    const int nt = K / BK;
    unsigned voffB[2];
#pragma unroll
    for (int i = 0; i < 2; ++i) { int R, C; stage_rc(tid * 16 + i * 8192, R, C); const int Rb = Epi::PERM ? ((R & ~31) + perm32(R & 31)) : R; voffB[i] = (unsigned)(Rb * K + C) * 2u; }
#define PG8_AOFFS(U, o0, o1) do { int t_ = tid; asm volatile("" : "+v"(t_)); _Pragma("unroll") for (int i = 0; i < 2; ++i) { int R, C; stage_rc(t_ * 16 + i * 8192, R, C); \
        o0[i] = S.a_off(U, R) + (unsigned)C * 2u; o1[i] = S.a_off(U, HALF + R) + (unsigned)C * 2u; } } while (0)
    const size_t hstep = (size_t)HALF * K * 2;
    const unsigned ldsw = (unsigned)wid * 1024u;
    const int aoff = lds_byte(wr * 64 + fr, fq * 8), boff = lds_byte(wc * 32 + fr, fq * 8);
#define PG8_SA(b, h) (((b) * 2 + (h)) * HTB)
#define PG8_SB(b, h) ((4 + (b) * 2 + (h)) * HTB)
#define PG8_STAGEB(bufoff, gbase) do { _Pragma("unroll") for (int _i = 0; _i < 2; ++_i) { unsigned _o = voffB[_i]; asm volatile("" : "+v"(_o)); \
        __builtin_amdgcn_global_load_lds((const unsigned*)((const char*)(gbase) + _o), (LAS unsigned*)(lds + (bufoff) + ldsw + _i * 8192), 16, 0, 0); } } while (0)
#define PG8_STAGEA(bufoff, voff2, kb) do { _Pragma("unroll") for (int _i = 0; _i < 2; ++_i) { unsigned _o = (voff2)[_i]; asm volatile("" : "+v"(_o)); \
        __builtin_amdgcn_global_load_lds((const unsigned*)((gA + (size_t)(kb)) + _o), (LAS unsigned*)(lds + (bufoff) + ldsw + _i * 8192), 16, 0, 0); } } while (0)
#define PG8_LD8(p) __builtin_shufflevector(*(const LAS i32x4*)(p), *(const LAS i32x4*)((p) + 1024), 0, 1, 2, 3, 4, 5, 6, 7)
#define PG8_LDA(dst, b, h) do { _Pragma("unroll") for (int m = 0; m < 4; ++m) dst[m] = PG8_LD8(lds + PG8_SA(b, h) + aoff + m * 2048); } while (0)
#define PG8_LDB(dst, b, h) do { _Pragma("unroll") for (int n = 0; n < 2; ++n) dst[n] = PG8_LD8(lds + PG8_SB(b, h) + boff + n * 2048); } while (0)
#define PG8_LO(x) __builtin_bit_cast(bf16x8, __builtin_shufflevector(x, x, 0, 1, 2, 3))
#define PG8_HI(x) __builtin_bit_cast(bf16x8, __builtin_shufflevector(x, x, 4, 5, 6, 7))
#define PG8_MMA(ai, bj, At, Bt) do { if constexpr (F8) __builtin_amdgcn_sched_barrier(0); __builtin_amdgcn_s_setprio(1); _Pragma("unroll") for (int m = 0; m < 4; ++m) _Pragma("unroll") for (int n = 0; n < 2; ++n) { \
        if constexpr (F8) asm volatile("v_mfma_scale_f32_16x16x128_f8f6f4 %0, %1, %2, %0, %3, %3 op_sel_hi:[0,0,0]" : "+v"(acc[ai][bj][m][n]) : "v"(Bt[n]), "v"(At[m]), "v"(f8scale)); \
        else { acc[ai][bj][m][n] = __builtin_amdgcn_mfma_f32_16x16x32_bf16(PG8_LO(Bt[n]), PG8_LO(At[m]), acc[ai][bj][m][n], 0, 0, 0); \
               acc[ai][bj][m][n] = __builtin_amdgcn_mfma_f32_16x16x32_bf16(PG8_HI(Bt[n]), PG8_HI(At[m]), acc[ai][bj][m][n], 0, 0, 0); } } \
        __builtin_amdgcn_s_setprio(0); if constexpr (F8) __builtin_amdgcn_sched_barrier(0); } while (0)
#define PG8_WAIT_V(n) asm volatile("s_waitcnt vmcnt(" #n ")" ::: "memory")
#define PG8_WAIT_L(n) asm volatile("s_waitcnt lgkmcnt(" #n ")" ::: "memory")
#define PG8_BAR __builtin_amdgcn_s_barrier()
#define PG8_SCHED __builtin_amdgcn_sched_barrier(0)
    Unit cur, nxt; int ui = 0;
    if (!S.next(0, cur)) return;
    Acc acc;
#pragma unroll
    for (int a = 0; a < 2; ++a)
#pragma unroll
        for (int b = 0; b < 2; ++b)
#pragma unroll
            for (int m = 0; m < 4; ++m)
#pragma unroll
                for (int n = 0; n < 2; ++n) acc[a][b][m][n] = (f32x4){0.f, 0.f, 0.f, 0.f};
    i32x8 At[4], B0[2], B1[2];
    int f8scale = 0x7F7F7F7F; asm volatile("" : "+v"(f8scale));
    unsigned cA0[2], cA1[2];
#define PG8_DMA4(src, dstoff) __builtin_amdgcn_global_load_lds((const unsigned*)(src), (LAS unsigned*)(aux + (dstoff) + wid * 256), 4, 0, 0)
#define PG8_SIDE_DMA(U, UI) do { if constexpr (Sched::GATHER) { int t_ = tid; asm volatile("" : "+v"(t_)); _Pragma("unroll") for (int p = 0; p < 4; ++p) { int R, C; stage_rc(t_ * 16 + (p & 1) * 8192, R, C); \
            PG8_DMA4(S.row_src(U, (p >> 1) * HALF + R), AUX_ROWTAB + p * 2048); } } \
        if constexpr (Epi::AUX) PG8_DMA4(E.aux_src(U, wid * 64 + lane), AUX_SLOTS + ((UI) & 3) * AUX_SLOT_BYTES); } while (0)
    if constexpr (Epi::AUX) PG8_DMA4(E.aux_src(cur, wid * 64 + lane), AUX_SLOTS);
    PG8_AOFFS(cur, cA0, cA1);
    const char* cB = gB + S.b_off(cur);
    PG8_STAGEB(PG8_SB(0, 0), cB); PG8_STAGEB(PG8_SB(0, 1), cB + hstep); PG8_STAGEA(PG8_SA(0, 0), cA0, 0); PG8_STAGEA(PG8_SA(0, 1), cA1, 0);
    if (wr == 1) PG8_BAR;
    PG8_WAIT_V(2); PG8_BAR;
    PG8_STAGEB(PG8_SB(1, 0), cB + BK * 2); PG8_STAGEA(PG8_SA(1, 0), cA0, BK * 2); PG8_STAGEB(PG8_SB(1, 1), cB + hstep + BK * 2);
    PG8_WAIT_V(6); PG8_BAR;
    for (;;) {
        const bool has_next = S.next(ui + 1, nxt);
        const char* nB = cB;
        if (has_next) { PG8_SIDE_DMA(nxt, ui + 1); nB = gB + S.b_off(nxt); }
        unsigned a20[2], a21[2];
        for (int krep_i = 0; krep_i < krep; ++krep_i)
#pragma nounroll
        for (int t = 0; t < nt; t += 2) {
            const bool last = (t == nt - 2), lastx = last && (krep_i == krep - 1);
            const unsigned k1 = (unsigned)(t + 1) * (BK * 2), k2 = last ? 0u : (unsigned)(t + 2) * (BK * 2), k3 = k2 + BK * 2;
            if (lastx && has_next) {
                if constexpr (Sched::GATHER) { int t_ = tid; asm volatile("" : "+v"(t_));
#pragma unroll
                    for (int i = 0; i < 2; ++i) { int R, C; stage_rc(t_ * 16 + i * 8192, R, C);
                        a20[i] = *(volatile LAS unsigned*)(aux + AUX_ROWTAB + i * 2048 + t_ * 4) * (unsigned)(K * 2) + (unsigned)C * 2u;
                        a21[i] = *(volatile LAS unsigned*)(aux + AUX_ROWTAB + (2 + i) * 2048 + t_ * 4) * (unsigned)(K * 2) + (unsigned)C * 2u; } }
                else PG8_AOFFS(nxt, a20, a21);
            } else {
#pragma unroll
                for (int i = 0; i < 2; ++i) { a20[i] = cA0[i]; a21[i] = cA1[i]; }
            }
            const char* b2 = (lastx ? nB : cB) + k2; const char* b3 = b2 + BK * 2;
            PG8_LDB(B0, 0, 0); PG8_LDB(B1, 0, 1); PG8_SCHED; PG8_LDA(At, 0, 0); PG8_STAGEA(PG8_SA(1, 1), cA1, k1);
            PG8_WAIT_V(8); PG8_WAIT_L(0); PG8_BAR; PG8_MMA(0, 0, At, B0); PG8_MMA(0, 1, At, B1); PG8_BAR; PG8_SCHED;
            PG8_LDA(At, 0, 1); PG8_STAGEB(PG8_SB(0, 0), b2); PG8_STAGEB(PG8_SB(0, 1), b2 + hstep); PG8_STAGEA(PG8_SA(0, 0), a20, k2);
            PG8_WAIT_V(8); PG8_WAIT_L(0); PG8_BAR; PG8_MMA(1, 0, At, B0); PG8_MMA(1, 1, At, B1); PG8_BAR; PG8_SCHED;
            PG8_LDB(B0, 1, 0); PG8_LDB(B1, 1, 1); PG8_SCHED; PG8_LDA(At, 1, 0); PG8_STAGEA(PG8_SA(0, 1), a21, k2);
            PG8_WAIT_V(8); PG8_WAIT_L(0); PG8_BAR; PG8_MMA(0, 0, At, B0); PG8_MMA(0, 1, At, B1); PG8_BAR; PG8_SCHED;
            PG8_LDA(At, 1, 1); PG8_STAGEB(PG8_SB(1, 0), b3); PG8_STAGEB(PG8_SB(1, 1), b3 + hstep); PG8_STAGEA(PG8_SA(1, 0), a20, k3);
            PG8_WAIT_V(8); PG8_WAIT_L(0); PG8_BAR; PG8_MMA(1, 0, At, B0); PG8_MMA(1, 1, At, B1); PG8_BAR; PG8_SCHED;
        }
        if constexpr (F8) asm volatile("s_nop 15\n\ts_nop 15" ::: "memory");
        if (wr == 0) PG8_BAR;
        int t_e = threadIdx.x; asm volatile("" : "+v"(t_e));
        int fr_e = t_e & 15, fq_e = (t_e >> 4) & 3;
#pragma unroll
        for (int a = 0; a < 2; ++a)
#pragma unroll
            for (int b = 0; b < 2; ++b)
#pragma unroll
                for (int m = 0; m < 4; ++m)
#pragma unroll
                    for (int n = 0; n < 2; ++n) asm volatile("" : "+v"(acc[a][b][m][n]));
        E(acc, cur, wr, wc, fr_e, fq_e, (const LAS float*)(aux + AUX_SLOTS + (ui & 3) * AUX_SLOT_BYTES));
        if (PROBE_REPEAT == 30) { asm volatile("" : "+v"(t_e)); E(acc, cur, wr, wc, t_e & 15, (t_e >> 4) & 3, (const LAS float*)(aux + AUX_SLOTS + (ui & 3) * AUX_SLOT_BYTES)); }
        if (!has_next) break;
#pragma unroll
        for (int a = 0; a < 2; ++a)
#pragma unroll
            for (int b = 0; b < 2; ++b)
#pragma unroll
                for (int m = 0; m < 4; ++m)
#pragma unroll
                    for (int n = 0; n < 2; ++n) acc[a][b][m][n] = (f32x4){0.f, 0.f, 0.f, 0.f};
        cur = nxt; cB = nB; ++ui;
#pragma unroll
        for (int i = 0; i < 2; ++i) { cA0[i] = a20[i]; cA1[i] = a21[i]; }
        if (wr == 1) PG8_BAR;
    }
    PG8_WAIT_V(0);
    PG8_BAR;
#undef PG8_SA
#undef PG8_SB
#undef PG8_STAGEA
#undef PG8_AOFFS
#undef PG8_DMA4
#undef PG8_SIDE_DMA
#undef PG8_STAGEB
#undef PG8_LDA
#undef PG8_LDB
#undef PG8_MMA
#undef PG8_LD8
#undef PG8_LO
#undef PG8_HI
#undef PG8_WAIT_V
#undef PG8_WAIT_L
#undef PG8_BAR
#undef PG8_SCHED
}
}


typedef float f32x16 __attribute__((ext_vector_type(16)));
typedef short bf16x4 __attribute__((ext_vector_type(4)));
typedef unsigned u32x2 __attribute__((ext_vector_type(2)));
typedef float f32x2_t __attribute__((ext_vector_type(2)));
typedef __bf16 bf16x2_t __attribute__((ext_vector_type(2)));
__device__ __forceinline__ unsigned cvtpk(float lo, float hi) { const f32x2_t v = {lo, hi}; const bf16x2_t b = __builtin_convertvector(v, bf16x2_t); return __builtin_bit_cast(unsigned, b); }
template <int S8> __device__ __forceinline__ bf16x8 pack8(const f32x16& X) {
    u32x4 w; w.x = cvtpk(X[8 * S8 + 0], X[8 * S8 + 1]); w.y = cvtpk(X[8 * S8 + 2], X[8 * S8 + 3]); w.z = cvtpk(X[8 * S8 + 4], X[8 * S8 + 5]); w.w = cvtpk(X[8 * S8 + 6], X[8 * S8 + 7]);
    return __builtin_bit_cast(bf16x8, w);
}
__device__ __forceinline__ bf16x8 lds_b128(const LAS unsigned char* p) { return *(const LAS bf16x8*)p; }
__device__ __forceinline__ bf16x8 lds_2xb64(const LAS unsigned char* p) {
    const bf16x4 a = *(const LAS bf16x4*)p, b = *(const LAS bf16x4*)(p + 16);
    return __builtin_shufflevector(a, b, 0, 1, 2, 3, 4, 5, 6, 7);
}
__device__ __forceinline__ float fast_log_sigmoid(float x) { return fminf(x, 0.0f) - __logf(1.0f + __expf(-fabsf(x))); }

constexpr int GP = 144;
constexpr int GS_QD = 0, GS_KI = GS_QD + 64 * GP, GS_KET = GS_KI + 64 * GP, GS_VT = GS_KET + 64 * GP, GS_DEC = GS_VT + 128 * GP, GS_SIZE = GS_DEC + 256;
constexpr int GL_SSP = 2 * GS_SIZE, GL_CONST = GL_SSP + 1024, GL_OT = GL_CONST + 1024;
constexpr int OTP = 132;
constexpr int GL_END = GL_OT + 64 * OTP * 4;
static_assert(GL_END <= RING_BYTES && (GL_OT % 16) == 0 && (GS_SIZE % 16) == 0 && (GS_DEC % 16) == 0, "gla lds");

__device__ __forceinline__ void gla_item(const Ptrs& P, LAS unsigned char* lds, int bh) {
    const int tid = opaque_tid(), lane = tid & 63, w = __builtin_amdgcn_readfirstlane(tid >> 6), l31 = lane & 31, hh = lane >> 5;
    const int b = bh >> 2, h = bh & 3;
    const bool grpA = w < 4; const int wa = w & 3;
    const bf16* PROJ = (const bf16*)(P.ws + WS_PROJ); bf16* MIX = (bf16*)(P.ws + WS_MIX);
    const size_t tok0 = (size_t)b * SEQ;
    const char* ub = (const char*)(PROJ + tok0 * NPROJ);
    const unsigned laneoff = (unsigned)lane * (NPROJ * 2);
    const int cq0 = PC_Q + h * 64 + 16 * wa, ck0 = PC_K + h * 64 + 16 * wa, cg0 = PC_GK + h * 64 + 16 * wa, cv0 = PC_V + h * 128 + 32 * wa;
    const int oc = tid >> 3, ov = (tid & 7) * 16;
    const unsigned gateoff = (unsigned)oc * (NPROJ * 2) + (unsigned)ov * 2;
#define GLA_LD(colel, chunk, lo) (*(const v4u*)(ub + ((size_t)(chunk) * 64 * NPROJ + (colel)) * 2 + (lo)))
    LAS float* cst = (LAS float*)(lds + GL_CONST);
    if (tid < 64) cst[tid] = P.b_gk[h * 64 + tid]; else if (tid < 192) cst[tid] = P.gla_norm_w[tid - 64];
    f32x16 S0, S1;
#pragma unroll
    for (int r = 0; r < 16; ++r) { S0[r] = 0.f; S1[r] = 0.f; }
    v4u nq[2], nk[2], ng[2];
    if (grpA) {
#pragma unroll
        for (int s = 0; s < 2; ++s) { nq[s] = GLA_LD(cq0 + 8 * s, 0, laneoff); nk[s] = GLA_LD(ck0 + 8 * s, 0, laneoff); ng[s] = GLA_LD(cg0 + 8 * s, 0, laneoff); }
    }
    __syncthreads();
#define GLA_STAGE_A(c) do { \
        LAS unsigned char* set_ = lds + ((c) & 1) * GS_SIZE; \
        v4u cq_[2], ck_[2], cg_[2], cv_[4]; \
        _Pragma("unroll") for (int s = 0; s < 2; ++s) { cq_[s] = nq[s]; ck_[s] = nk[s]; cg_[s] = ng[s]; } \
        _Pragma("unroll") for (int s = 0; s < 4; ++s) cv_[s] = GLA_LD(cv0 + 8 * s, (c), laneoff);     \
        { const int nc_ = (c) + 1 < SEQ / 64 ? (c) + 1 : (c); \
          _Pragma("unroll") for (int s = 0; s < 2; ++s) { nq[s] = GLA_LD(cq0 + 8 * s, nc_, laneoff); nk[s] = GLA_LD(ck0 + 8 * s, nc_, laneoff); ng[s] = GLA_LD(cg0 + 8 * s, nc_, laneoff); } } \
        _Pragma("unroll") for (int s = 0; s < 2; ++s) { \
            const int kc_ = 16 * wa + 8 * s; \
            const unsigned qw_[4] = {cq_[s].x, cq_[s].y, cq_[s].z, cq_[s].w}, kw_[4] = {ck_[s].x, ck_[s].y, ck_[s].z, ck_[s].w}, gw_[4] = {cg_[s].x, cg_[s].y, cg_[s].z, cg_[s].w}; \
            const f32x4 bg0_ = *(const LAS f32x4*)(cst + kc_), bg1_ = *(const LAS f32x4*)(cst + kc_ + 4); \
            float bb_[8];                                   \
            _Pragma("unroll") for (int j = 0; j < 8; ++j) { const float x_ = bf2f((gw_[j >> 1] >> (16 * (j & 1))) & 0xffffu) + (j < 4 ? bg0_[j & 3] : bg1_[j & 3]); \
                const float l2_ = __builtin_amdgcn_logf(1.0f + __builtin_amdgcn_exp2f(fabsf(x_) * -1.4426950408889634f));     \
                bb_[j] = wave_incl_scan(fminf(x_, 0.0f) * (1.4426950408889634f / 16.0f) - l2_ * (1.0f / 16.0f)); } \
            float qd_[8], ki_[8], ke_[8]; \
            _Pragma("unroll") for (int j = 0; j < 8; ++j) { \
                const float e_ = __builtin_amdgcn_exp2f(bb_[j]), ie_ = __builtin_amdgcn_exp2f(-bb_[j]); \
                const float dec_ = __builtin_bit_cast(float, __builtin_amdgcn_readlane(__builtin_bit_cast(int, e_), 63));     \
                const float qv_ = bf2f((qw_[j >> 1] >> (16 * (j & 1))) & 0xffffu), kv_ = bf2f((kw_[j >> 1] >> (16 * (j & 1))) & 0xffffu); \
                qd_[j] = qv_ * (e_ * 0.125f); ki_[j] = kv_ * ie_; ke_[j] = ki_[j] * dec_; \
                if (lane == 63) *(LAS float*)(set_ + GS_DEC + (kc_ + j) * 4) = e_; } \
            u32x4 t_; t_.x = cvtpk(qd_[0], qd_[1]); t_.y = cvtpk(qd_[2], qd_[3]); t_.z = cvtpk(qd_[4], qd_[5]); t_.w = cvtpk(qd_[6], qd_[7]); \
            *(LAS u32x4*)(set_ + GS_QD + lane * GP + kc_ * 2) = t_; \
            t_.x = cvtpk(ki_[0], ki_[1]); t_.y = cvtpk(ki_[2], ki_[3]); t_.z = cvtpk(ki_[4], ki_[5]); t_.w = cvtpk(ki_[6], ki_[7]); \
            *(LAS u32x4*)(set_ + GS_KI + lane * GP + kc_ * 2) = t_; \
            _Pragma("unroll") for (int j = 0; j < 4; ++j) { const unsigned pk_ = cvtpk(ke_[2 * j], ke_[2 * j + 1]); \
                *(LAS unsigned short*)(set_ + GS_KET + (kc_ + 2 * j) * GP + lane * 2) = (unsigned short)(pk_ & 0xffffu); *(LAS unsigned short*)(set_ + GS_KET + (kc_ + 2 * j + 1) * GP + lane * 2) = (unsigned short)(pk_ >> 16); } } \
        _Pragma("unroll") for (int s = 0; s < 4; ++s) { const unsigned vw_[4] = {cv_[s].x, cv_[s].y, cv_[s].z, cv_[s].w}; \
            _Pragma("unroll") for (int j = 0; j < 8; ++j) *(LAS unsigned short*)(set_ + GS_VT + (32 * wa + 8 * s + j) * GP + lane * 2) = (unsigned short)((vw_[j >> 1] >> (16 * (j & 1))) & 0xffffu); } \
    } while (0)
    if (grpA) GLA_STAGE_A(0);
    __syncthreads();
    for (int n = 0; n < SEQ / 64; ++n) {
        const v4u gate0 = GLA_LD(PC_G + h * 128, n, gateoff), gate1 = GLA_LD(PC_G + h * 128 + 8, n, gateoff);
        if (grpA) {
            if (n + 1 < SEQ / 64) GLA_STAGE_A(n + 1);
        } else {
            const LAS unsigned char* set = lds + (n & 1) * GS_SIZE;
            const int vc = wa;
            f32x16 O0, O1;
#pragma unroll
            for (int r = 0; r < 16; ++r) { O0[r] = 0.f; O1[r] = 0.f; }
            {
                const bf16x8 s00 = pack8<0>(S0), s01 = pack8<1>(S0), s10 = pack8<0>(S1), s11 = pack8<1>(S1);
                const LAS unsigned char* q0 = set + GS_QD + l31 * GP + 8 * hh; const LAS unsigned char* q1 = q0 + 32 * GP;
                const bf16x8 a0 = lds_2xb64(q0), a1 = lds_2xb64(q0 + 32), a2 = lds_2xb64(q0 + 64), a3 = lds_2xb64(q0 + 96);
                const bf16x8 b0 = lds_2xb64(q1), b1 = lds_2xb64(q1 + 32), b2 = lds_2xb64(q1 + 64), b3 = lds_2xb64(q1 + 96);
                O0 = __builtin_amdgcn_mfma_f32_32x32x16_bf16(s00, a0, O0, 0, 0, 0); O1 = __builtin_amdgcn_mfma_f32_32x32x16_bf16(s00, b0, O1, 0, 0, 0);
                O0 = __builtin_amdgcn_mfma_f32_32x32x16_bf16(s01, a1, O0, 0, 0, 0); O1 = __builtin_amdgcn_mfma_f32_32x32x16_bf16(s01, b1, O1, 0, 0, 0);
                O0 = __builtin_amdgcn_mfma_f32_32x32x16_bf16(s10, a2, O0, 0, 0, 0); O1 = __builtin_amdgcn_mfma_f32_32x32x16_bf16(s10, b2, O1, 0, 0, 0);
                O0 = __builtin_amdgcn_mfma_f32_32x32x16_bf16(s11, a3, O0, 0, 0, 0); O1 = __builtin_amdgcn_mfma_f32_32x32x16_bf16(s11, b3, O1, 0, 0, 0);
            }
            {
                const LAS unsigned char* kA0 = set + GS_KI + l31 * GP + 16 * hh; const LAS unsigned char* kA1 = kA0 + 32 * GP;
                const LAS unsigned char* qB0 = set + GS_QD + l31 * GP + 16 * hh; const LAS unsigned char* qB1 = qB0 + 32 * GP;
                const LAS unsigned char* vrow = set + GS_VT + (vc * 32 + l31) * GP + 8 * hh;
                bf16x8 fa[4], fb[4];
                f32x16 X;
#pragma unroll
                for (int kk = 0; kk < 4; ++kk) { fa[kk] = lds_b128(kA0 + 32 * kk); fb[kk] = lds_b128(qB0 + 32 * kk); }
                const bf16x8 v0 = lds_2xb64(vrow), v1 = lds_2xb64(vrow + 32);
#pragma unroll
                for (int r = 0; r < 16; ++r) X[r] = 0.f;
#pragma unroll
                for (int kk = 0; kk < 4; ++kk) X = __builtin_amdgcn_mfma_f32_32x32x16_bf16(fa[kk], fb[kk], X, 0, 0, 0);
#pragma unroll
                for (int kk = 0; kk < 4; ++kk) fb[kk] = lds_b128(qB1 + 32 * kk);
#pragma unroll
                for (int r = 0; r < 16; ++r) { const int srow = (r & 3) + 8 * (r >> 2) + 4 * hh; X[r] = (srow <= l31) ? X[r] : 0.f; }
                O0 = __builtin_amdgcn_mfma_f32_32x32x16_bf16(v0, pack8<0>(X), O0, 0, 0, 0); O0 = __builtin_amdgcn_mfma_f32_32x32x16_bf16(v1, pack8<1>(X), O0, 0, 0, 0);
#pragma unroll
                for (int r = 0; r < 16; ++r) X[r] = 0.f;
#pragma unroll
                for (int kk = 0; kk < 4; ++kk) X = __builtin_amdgcn_mfma_f32_32x32x16_bf16(fa[kk], fb[kk], X, 0, 0, 0);
#pragma unroll
                for (int kk = 0; kk < 4; ++kk) fa[kk] = lds_b128(kA1 + 32 * kk);
                O1 = __builtin_amdgcn_mfma_f32_32x32x16_bf16(v0, pack8<0>(X), O1, 0, 0, 0); O1 = __builtin_amdgcn_mfma_f32_32x32x16_bf16(v1, pack8<1>(X), O1, 0, 0, 0);
                const bf16x8 v2 = lds_2xb64(vrow + 64), v3 = lds_2xb64(vrow + 96);
#pragma unroll
                for (int r = 0; r < 16; ++r) X[r] = 0.f;
#pragma unroll
                for (int kk = 0; kk < 4; ++kk) X = __builtin_amdgcn_mfma_f32_32x32x16_bf16(fa[kk], fb[kk], X, 0, 0, 0);
#pragma unroll
                for (int r = 0; r < 16; ++r) { const int srow = (r & 3) + 8 * (r >> 2) + 4 * hh; X[r] = (srow <= l31) ? X[r] : 0.f; }
                O1 = __builtin_amdgcn_mfma_f32_32x32x16_bf16(v2, pack8<0>(X), O1, 0, 0, 0); O1 = __builtin_amdgcn_mfma_f32_32x32x16_bf16(v3, pack8<1>(X), O1, 0, 0, 0);
            }
            {
                const LAS float* dec = (const LAS float*)(set + GS_DEC);
                const LAS unsigned char* ka0 = set + GS_KET + l31 * GP + 16 * hh; const LAS unsigned char* ka1 = ka0 + 32 * GP;
                const LAS unsigned char* vb = set + GS_VT + (vc * 32 + l31) * GP + 16 * hh;
                bf16x8 e0[4], e1[4], vv[4];
#pragma unroll
                for (int ss = 0; ss < 4; ++ss) { e0[ss] = lds_b128(ka0 + 32 * ss); e1[ss] = lds_b128(ka1 + 32 * ss); vv[ss] = lds_b128(vb + 32 * ss); }
#pragma unroll
                for (int g4 = 0; g4 < 4; ++g4) { const f32x4 d0 = *(const LAS f32x4*)(dec + 8 * g4 + 4 * hh), d1 = *(const LAS f32x4*)(dec + 32 + 8 * g4 + 4 * hh);
#pragma unroll
                    for (int i = 0; i < 4; ++i) { S0[4 * g4 + i] *= d0[i]; S1[4 * g4 + i] *= d1[i]; } }
#pragma unroll
                for (int ss = 0; ss < 4; ++ss) { S0 = __builtin_amdgcn_mfma_f32_32x32x16_bf16(e0[ss], vv[ss], S0, 0, 0, 0); S1 = __builtin_amdgcn_mfma_f32_32x32x16_bf16(e1[ss], vv[ss], S1, 0, 0, 0); }
            }
            {
                float q0 = 0.f, q1 = 0.f;
#pragma unroll
                for (int r = 0; r < 16; ++r) { q0 += O0[r] * O0[r]; q1 += O1[r] * O1[r]; }
                q0 += __shfl_xor(q0, 32); q1 += __shfl_xor(q1, 32);
                if (hh == 0) { *(LAS float*)(lds + GL_SSP + (vc * 64 + l31) * 4) = q0; *(LAS float*)(lds + GL_SSP + (vc * 64 + 32 + l31) * 4) = q1; }
                LAS float* ot0 = (LAS float*)(lds + GL_OT) + l31 * OTP + vc * 32 + 4 * hh; LAS float* ot1 = ot0 + 32 * OTP;
#pragma unroll
                for (int g4 = 0; g4 < 4; ++g4) { *(LAS f32x4*)(ot0 + 8 * g4) = (f32x4){O0[4 * g4], O0[4 * g4 + 1], O0[4 * g4 + 2], O0[4 * g4 + 3]};
                    *(LAS f32x4*)(ot1 + 8 * g4) = (f32x4){O1[4 * g4], O1[4 * g4 + 1], O1[4 * g4 + 2], O1[4 * g4 + 3]}; }
            }
        }
        __syncthreads();
        {
            const LAS float* ssp = (const LAS float*)(lds + GL_SSP) + oc;
            const float tot = (ssp[0] + ssp[64]) + (ssp[128] + ssp[192]);
            const float rstd = 1.0f / sqrtf(tot * (1.0f / 128.0f) + EPS);
            const LAS float* ot = (const LAS float*)(lds + GL_OT) + oc * OTP + ov;
            const LAS float* nwp = cst + 64 + ov;
            const unsigned gw[8] = {gate0.x, gate0.y, gate0.z, gate0.w, gate1.x, gate1.y, gate1.z, gate1.w};
            float y[16];
#pragma unroll
            for (int q4 = 0; q4 < 4; ++q4) { const f32x4 o4 = *(const LAS f32x4*)(ot + 4 * q4), n4 = *(const LAS f32x4*)(nwp + 4 * q4);
#pragma unroll
                for (int i = 0; i < 4; ++i) { const int j = 4 * q4 + i; const float gv = bf2f((gw[j >> 1] >> (16 * (j & 1))) & 0xffffu); y[j] = o4[i] * rstd * n4[i] * gv * __builtin_amdgcn_rcpf(1.0f + __expf(-gv)); } }
            bf16* orow = MIX + (tok0 + (size_t)n * 64 + oc) * D + h * 128 + ov;
            u32x4 t; t.x = cvtpk(y[0], y[1]); t.y = cvtpk(y[2], y[3]); t.z = cvtpk(y[4], y[5]); t.w = cvtpk(y[6], y[7]); *(u32x4*)orow = t;
            t.x = cvtpk(y[8], y[9]); t.y = cvtpk(y[10], y[11]); t.z = cvtpk(y[12], y[13]); t.w = cvtpk(y[14], y[15]); *(u32x4*)(orow + 8) = t;
        }
        __syncthreads();
    }
#undef GLA_STAGE_A
#undef GLA_LD
}

constexpr int SP = 272;
constexpr int SG_W = 0, SG_VN = SG_W + 128 * SP, SG_OT = SG_VN + 128 * SP, SG_ST = SG_OT + 128 * SP, SG_END = SG_ST + 1024;
static_assert(SG_END <= RING_BYTES, "sgu lds");
__device__ __forceinline__ void sgu_item(const Ptrs& P, LAS unsigned char* lds, int bn) {
    const int tid = opaque_tid(), lane = tid & 63, w = __builtin_amdgcn_readfirstlane(tid >> 6), l31 = lane & 31, hh = lane >> 5;
    const bf16* PROJ = (const bf16*)(P.ws + WS_PROJ); bf16* MIX = (bf16*)(P.ws + WS_MIX); const bf16* Wsp = (const bf16*)(P.ws + WS_WSP);
    const size_t tok0 = (size_t)bn * 128;
    LAS float* st = (LAS float*)(lds + SG_ST);
    {
        v4u raws[16];
#pragma unroll
        for (int rr = 0; rr < 16; ++rr) raws[rr] = *(const v4u*)(PROJ + (tok0 + 16 * w + rr) * NPROJ + PC_VS + lane * 8);
#pragma unroll
        for (int rr = 0; rr < 16; ++rr) { const int row = 16 * w + rr; const unsigned rw[4] = {raws[rr].x, raws[rr].y, raws[rr].z, raws[rr].w};
            float s = 0.f, q = 0.f;
#pragma unroll
            for (int j = 0; j < 8; ++j) { const float g = gelu_tanh(bf2f((rw[j >> 1] >> (16 * (j & 1))) & 0xffffu)); s += g; q += g * g; }
            s = wave_sum(s); q = wave_sum(q);
            const float mu = s * (1.0f / 512.0f), var = fmaxf(q * (1.0f / 512.0f) - mu * mu, 0.f);
            if (lane == 0) { st[row] = mu; st[128 + row] = 1.0f / sqrtf(var + EPS); } }
    }
    const int s_ = tid & 127, c0_ = (tid >> 7) * 32;
    const int t_ = tid >> 2, cg_ = (tid & 3) * 32;
    v4u vsr[4];
#pragma unroll
    for (int q4 = 0; q4 < 4; ++q4) vsr[q4] = *(const v4u*)(PROJ + (tok0 + s_) * NPROJ + PC_VS + c0_ + q4 * 8);
    __syncthreads();
    for (int g = 0; g < 4; ++g) {
#pragma unroll
        for (int ps = 0; ps < 4; ++ps) { const int idx = ps * NTHR + tid, row = idx >> 4, c16 = idx & 15;
            *(LAS v4u*)(lds + SG_W + row * SP + c16 * 16) = *(const v4u*)(Wsp + ((size_t)g * 128 + row) * 128 + c16 * 8); }
        { const float mu = st[s_], rs = st[128 + s_];
#pragma unroll
          for (int q4 = 0; q4 < 4; ++q4) { const int cb = c0_ + q4 * 8;
              const unsigned rw[4] = {vsr[q4].x, vsr[q4].y, vsr[q4].z, vsr[q4].w};
              const f32x4 lw0 = *(const f32x4*)(P.sg_ln_w + g * 128 + cb), lw1 = *(const f32x4*)(P.sg_ln_w + g * 128 + cb + 4), lb0 = *(const f32x4*)(P.sg_ln_b + g * 128 + cb), lb1 = *(const f32x4*)(P.sg_ln_b + g * 128 + cb + 4);
#pragma unroll
              for (int j = 0; j < 8; ++j) { const float gv = gelu_tanh(bf2f((rw[j >> 1] >> (16 * (j & 1))) & 0xffffu));
                  const float vn = (gv - mu) * rs * (j < 4 ? lw0[j & 3] : lw1[j & 3]) + (j < 4 ? lb0[j & 3] : lb1[j & 3]);
                  *(LAS unsigned short*)(lds + SG_VN + (cb + j) * SP + s_ * 2) = (unsigned short)f2bf(vn); } } }
        v4u ur[4];
#pragma unroll
        for (int q4 = 0; q4 < 4; ++q4) ur[q4] = *(const v4u*)(PROJ + (tok0 + t_) * NPROJ + PC_U + g * 128 + cg_ + q4 * 8);
        { const int gn = g < 3 ? g + 1 : g;
#pragma unroll
          for (int q4 = 0; q4 < 4; ++q4) vsr[q4] = *(const v4u*)(PROJ + (tok0 + s_) * NPROJ + PC_VS + gn * 128 + c0_ + q4 * 8); }
        __syncthreads();
        { const int ct = w >> 1;
          const LAS unsigned char* arow = lds + SG_VN + (ct * 32 + l31) * SP + 16 * hh;
#pragma unroll
          for (int ti = 0; ti < 2; ++ti) { const int tt = (w & 1) * 2 + ti;
              const LAS unsigned char* brow = lds + SG_W + (tt * 32 + l31) * SP + 16 * hh;
              f32x16 acc;
#pragma unroll
              for (int r = 0; r < 16; ++r) acc[r] = 0.f;
              for (int ks = 0; ks < 2 * (tt + 1); ++ks) acc = __builtin_amdgcn_mfma_f32_32x32x16_bf16(lds_b128(arow + 32 * ks), lds_b128(brow + 32 * ks), acc, 0, 0, 0);
              const float bs = P.b_spatial[g * 128 + tt * 32 + l31];
              LAS unsigned char* orow = lds + SG_OT + (tt * 32 + l31) * SP + (ct * 32 + 4 * hh) * 2;
#pragma unroll
              for (int g4 = 0; g4 < 4; ++g4) { u32x2 pk; pk.x = cvtpk(acc[4 * g4] + bs, acc[4 * g4 + 1] + bs); pk.y = cvtpk(acc[4 * g4 + 2] + bs, acc[4 * g4 + 3] + bs); *(LAS u32x2*)(orow + 16 * g4) = pk; } } }
        __syncthreads();
        {
#pragma unroll
          for (int q4 = 0; q4 < 4; ++q4) { const v4u mx = *(const LAS v4u*)(lds + SG_OT + t_ * SP + (cg_ + q4 * 8) * 2);
              const unsigned mw[4] = {mx.x, mx.y, mx.z, mx.w}, uw[4] = {ur[q4].x, ur[q4].y, ur[q4].z, ur[q4].w}; unsigned ow[4];
#pragma unroll
              for (int j = 0; j < 4; ++j) { const float a0 = gelu_tanh(bf2f(uw[j] & 0xffffu)) * bf2f(mw[j] & 0xffffu), a1 = gelu_tanh(bf2f(uw[j] >> 16)) * bf2f(mw[j] >> 16); ow[j] = cvtpk(a0, a1); }
              *(v4u*)(MIX + (tok0 + t_) * D + 512 + g * 128 + cg_ + q4 * 8) = (v4u){ow[0], ow[1], ow[2], ow[3]}; } }
    }
    __syncthreads();
}
constexpr int CW_CONVQ = 192;
constexpr int CONV_UNIT = 4;
struct WItem { const float* src; int ldn; unsigned char* wt; int d0, k0; };
__device__ __forceinline__ WItem moe_witem(const Ptrs& P, int it, int lane) {
    WItem w; const int sub = lane >> 5, col = lane & 31;
    if (it < IT_GU) { const int e = it / 1024, r = it % 1024, db = r / 16, kb = r % 16, d0 = db * 32, pn = d0 >> 8, bj = (d0 >> 7) & 1, rr = d0 & 127;
        w.ldn = 2048; w.src = P.w_gate_up + (size_t)e * D * 2048 + (size_t)(kb * 64 + sub) * 2048 + bj * 1024 + 128 * pn + rr + col; w.wt = (unsigned char*)(P.ws + WS_WGU) + (size_t)e * 2048 * D; w.d0 = d0; w.k0 = kb * 64; }
    else { it -= IT_GU; const int e = it / 512, r = it % 512, db = r / 16, kb = r % 16;
        w.ldn = D; w.src = P.w_down + (size_t)e * DE * D + (size_t)(kb * 64 + sub) * D + db * 32 + col; w.wt = (unsigned char*)(P.ws + WS_WD) + (size_t)e * D * DE; w.d0 = db * 32; w.k0 = kb * 64; }
    return w;
}
__device__ __forceinline__ void moe_weight_items(const Ptrs& P, unsigned char* lds_generic, int units_per_grab, int max_grabs) {
    const int tid_ = opaque_tid(), lane = tid_ & 63, wave = __builtin_amdgcn_readfirstlane(tid_ >> 6);
    float* scr = (float*)(lds_generic + wave * 16384);
    unsigned* q = (unsigned*)(P.ws + WS_CTL) + CW_CONVQ;
    constexpr unsigned NUNITS = (IT_GU + IT_DN) / CONV_UNIT;
    int grab = units_per_grab;
    for (int ng = 0; ng < max_grabs; ++ng) {
        unsigned c0 = 0; if (lane == 0) c0 = __hip_atomic_fetch_add(q, (unsigned)grab, RLX_AGENT);
        c0 = __builtin_amdgcn_readfirstlane(c0);
        if (c0 >= NUNITS) break;
        const unsigned c1 = (c0 + (unsigned)grab < NUNITS) ? c0 + (unsigned)grab : NUNITS;
        if (c1 >= NUNITS * 3 / 4) grab = 1;
        const int it0 = (int)(c0 * CONV_UNIT), it1 = (int)(c1 * CONV_UNIT);
        float v[32]; WItem cur = moe_witem(P, it0, lane);
#pragma unroll
        for (int i = 0; i < 32; ++i) v[i] = __builtin_nontemporal_load(cur.src + (size_t)(2 * i) * cur.ldn);
#pragma nounroll
        for (int it = it0; it < it1; ++it) {
            float vn[32]; WItem nxt = cur;
            if (it + 1 < it1) { nxt = moe_witem(P, it + 1, lane);
#pragma unroll
                for (int i = 0; i < 32; ++i) vn[i] = __builtin_nontemporal_load(nxt.src + (size_t)(2 * i) * nxt.ldn); }
#pragma unroll
            for (int i = 0; i < 32; ++i) scr[(2 * i + (lane >> 5)) * 33 + (lane & 31)] = v[i];
            __builtin_amdgcn_wave_barrier(); asm volatile("s_waitcnt lgkmcnt(0)" ::: "memory");
            p0_tr_write_f8(cur.wt, D, cur.d0, cur.k0, scr, lane, F8S_W);
            asm volatile("s_waitcnt lgkmcnt(0)" ::: "memory"); __builtin_amdgcn_wave_barrier();
            cur = nxt;
#pragma unroll
            for (int i = 0; i < 32; ++i) v[i] = vn[i];
        }
    }
}
#define P2_MARK(id, wg) do { if (PROBE_P2 == (id) && (int)blockIdx.x == (wg) && threadIdx.x == 0) __hip_atomic_store((unsigned*)(P.ws + WS_CTL) + 201, (unsigned)__builtin_amdgcn_s_memrealtime(), RLX_AGENT); } while (0)
__device__ __forceinline__ void ph2_mix_fast(const Ptrs& P, LAS unsigned char* lds, unsigned char* lds_generic, int G) {
    const int bid = blockIdx.x;
    if (PROBE_P2 >= 0 && bid == 0 && threadIdx.x == 0) __hip_atomic_store((unsigned*)(P.ws + WS_CTL) + 200, (unsigned)__builtin_amdgcn_s_memrealtime(), RLX_AGENT);
    if (G >= 128) {
        if (bid < 64) { for (int rep = 0; rep < ((PROBE_REPEAT == 21) ? 2 : 1); ++rep) gla_item(P, lds, bid); }
        else { for (int rep = 0; rep < ((PROBE_REPEAT == 20) ? 2 : 1); ++rep) for (int it = bid - 64; it < NB * 16; it += G - 64) sgu_item(P, lds, it); }
    } else {
        for (int it = bid; it < 64; it += G) gla_item(P, lds, it);
        for (int it = bid; it < NB * 16; it += G) sgu_item(P, lds, it);
    }
    __syncthreads();
    P2_MARK(0, 0); P2_MARK(1, 64); P2_MARK(5, 255);
    moe_weight_items(P, lds_generic, 4, 1 << 30);
    __syncthreads();
    P2_MARK(2, 64); P2_MARK(3, 255); P2_MARK(4, 0);
}

constexpr size_t WS_WR2 = WS_WSP + 256 * 1024;
__device__ __forceinline__ void p0_wr2(const Ptrs& P, int gtid, int gthreads) {
    f32x4* WR2 = (f32x4*)(P.ws + WS_WR2);
    for (int idx = gtid; idx < 32 * 2 * 2 * 64; idx += gthreads) { const int jj = idx >> 8, i4 = (idx >> 7) & 1, tl = (idx >> 6) & 1, q = (idx >> 4) & 3, e = tl * 16 + (idx & 15); f32x4 o;
#pragma unroll
        for (int i = 0; i < 4; ++i) { const int k = 32 * jj + 8 * q + 4 * i4 + i; o[i] = P.w_router[(size_t)k * NE + e] * P.norm_ffn_w[k]; }
        WR2[idx] = o; }
}
__device__ __forceinline__ bool rt_better(float va, int ia, float vb, int ib) { return va > vb || (va == vb && ia < ib); }
__device__ __forceinline__ void ph4_router_fast(const Ptrs& P, LAS unsigned char* lds, int G) {
    const int tid = opaque_tid(), lane = tid & 63, wave = __builtin_amdgcn_readfirstlane(tid >> 6), tk = lane & 15, q = lane >> 4;
    unsigned* ctl = (unsigned*)(P.ws + WS_CTL);
    LAS unsigned* lcnt = (LAS unsigned*)lds; LAS unsigned* lbase = lcnt + 32;
    const f32x4* WR2 = (const f32x4*)(P.ws + WS_WR2);
    const int NGRP = T / 16, rounds = (NGRP + G * NWAVES - 1) / (G * NWAVES);
    for (int rd = 0; rd < rounds; ++rd) {
        if (tid < 32) lcnt[tid] = 0u;
        __syncthreads();
        const int grp = (rd * G + (int)blockIdx.x) * NWAVES + wave; const bool act = grp < NGRP;
        const int m0 = (act ? grp : 0) * 16;
        LAS float* xt = (LAS float*)(lds + 1024 + wave * (16 * 132 * 4));
        const int ldr = lane >> 5, lc = (lane & 31) * 4;
        f32x4 d0 = {0.f, 0.f, 0.f, 0.f}, d1 = {0.f, 0.f, 0.f, 0.f}; float psq[8];
#pragma unroll
        for (int i = 0; i < 8; ++i) psq[i] = 0.f;
        f32x4 nxv[8]; uint2 nav[8];
#pragma unroll
        for (int i = 0; i < 8; ++i) { const size_t ro = (size_t)(m0 + 2 * i + ldr) * D + lc; nxv[i] = *(const f32x4*)(P.x + ro); nav[i] = *(const uint2*)((const bf16*)(P.ws + WS_A1) + ro); }
#pragma nounroll
        for (int ch = 0; ch < 8; ++ch) {
            const int c0 = ch * 128 + lc, c1 = (ch < 7 ? ch + 1 : ch) * 128 + lc;
            const f32x4 nwv = *(const f32x4*)(P.norm_ffn_w + c0);
            f32x4 xv[8]; uint2 av[8];
#pragma unroll
            for (int i = 0; i < 8; ++i) { xv[i] = nxv[i]; av[i] = nav[i]; }
#pragma unroll
            for (int i = 0; i < 8; ++i) { const size_t ro = (size_t)(m0 + 2 * i + ldr) * D + c1; nxv[i] = *(const f32x4*)(P.x + ro); nav[i] = *(const uint2*)((const bf16*)(P.ws + WS_A1) + ro); }
#pragma unroll
            for (int i = 0; i < 8; ++i) { const size_t ro = (size_t)(m0 + 2 * i + ldr) * D + c0;
                const f32x4 x1 = {xv[i][0] + bf2f(av[i].x & 0xffffu), xv[i][1] + bf2f(av[i].x >> 16), xv[i][2] + bf2f(av[i].y & 0xffffu), xv[i][3] + bf2f(av[i].y >> 16)};
                psq[i] += (x1[0] * x1[0] + x1[1] * x1[1]) + (x1[2] * x1[2] + x1[3] * x1[3]);
                *(LAS f32x4*)(xt + (2 * i + ldr) * 132 + lc) = x1;
                *(uint2*)((bf16*)(P.ws + WS_X1B) + ro) = make_uint2(cvtpk(x1[0], x1[1]), cvtpk(x1[2], x1[3]));
                *(unsigned*)((unsigned char*)(P.ws + WS_H) + ro) = pk4_fp8(x1[0] * nwv[0] * F8S_H, x1[1] * nwv[1] * F8S_H, x1[2] * nwv[2] * F8S_H, x1[3] * nwv[3] * F8S_H); }
#pragma unroll
            for (int j4 = 0; j4 < 4; ++j4) { const int jj = ch * 4 + j4;
                const f32x4 xa = *(const LAS f32x4*)(xt + tk * 132 + 32 * j4 + 8 * q), xb = *(const LAS f32x4*)(xt + tk * 132 + 32 * j4 + 8 * q + 4);
                const f32x4 w0a = WR2[((jj * 2 + 0) * 2 + 0) * 64 + lane], w1a = WR2[((jj * 2 + 0) * 2 + 1) * 64 + lane], w0b = WR2[((jj * 2 + 1) * 2 + 0) * 64 + lane], w1b = WR2[((jj * 2 + 1) * 2 + 1) * 64 + lane];
#pragma unroll
                for (int i = 0; i < 4; ++i) { d0 = __builtin_amdgcn_mfma_f32_16x16x4f32(w0a[i], xa[i], d0, 0, 0, 0); d1 = __builtin_amdgcn_mfma_f32_16x16x4f32(w1a[i], xa[i], d1, 0, 0, 0); }
#pragma unroll
                for (int i = 0; i < 4; ++i) { d0 = __builtin_amdgcn_mfma_f32_16x16x4f32(w0b[i], xb[i], d0, 0, 0, 0); d1 = __builtin_amdgcn_mfma_f32_16x16x4f32(w1b[i], xb[i], d1, 0, 0, 0); } }
        }
#pragma unroll
        for (int i = 0; i < 8; ++i) { float v = psq[i]; v += dpp_f<0x111, 0xF>(v); v += dpp_f<0x112, 0xF>(v); v += dpp_f<0x114, 0xF>(v); v += dpp_f<0x118, 0xF>(v); v += dpp_f<0x142, 0xA>(v);
            if ((lane & 31) == 31) xt[2 * i + ldr] = v; }
        float ssq = xt[tk];

        const float rstd = 1.0f / sqrtf(ssq * (1.f / D) + EPS);
        float cv[8]; int ci[8];
#pragma unroll
        for (int r = 0; r < 4; ++r) { cv[r] = d0[r] * rstd + P.b_router[4 * q + r]; ci[r] = 4 * q + r; cv[4 + r] = d1[r] * rstd + P.b_router[16 + 4 * q + r]; ci[4 + r] = 16 + 4 * q + r; }
        float sv[4]; int si[4];
#pragma unroll
        for (int r = 0; r < 4; ++r) { float bv = cv[0]; int bi = ci[0];
#pragma unroll
            for (int c = 1; c < 8; ++c) if (rt_better(cv[c], ci[c], bv, bi)) { bv = cv[c]; bi = ci[c]; }
            sv[r] = bv; si[r] = bi;
#pragma unroll
            for (int c = 0; c < 8; ++c) if (ci[c] == bi) cv[c] = -3.0e38f; }
#pragma unroll
        for (int off = 16; off <= 32; off <<= 1) {
            float ov[4]; int oi[4];
#pragma unroll
            for (int r = 0; r < 4; ++r) { ov[r] = __shfl_xor(sv[r], off); oi[r] = __shfl_xor(si[r], off); }
            float mv[8]; int mi[8];
#pragma unroll
            for (int r = 0; r < 4; ++r) { mv[r] = sv[r]; mi[r] = si[r]; mv[4 + r] = ov[r]; mi[4 + r] = oi[r]; }
#pragma unroll
            for (int r = 0; r < 4; ++r) { float bv = mv[0]; int bi = mi[0];
#pragma unroll
                for (int c = 1; c < 8; ++c) if (rt_better(mv[c], mi[c], bv, bi)) { bv = mv[c]; bi = mi[c]; }
                sv[r] = bv; si[r] = bi;
#pragma unroll
                for (int c = 0; c < 8; ++c) if (mi[c] == bi) mv[c] = -3.0e38f; }
        }
        float pw[4], den = 0.f;
#pragma unroll
        for (int r = 0; r < 4; ++r) { pw[r] = __expf(sv[r] - sv[0]); den += pw[r]; }
        int ee = si[0]; float ww = pw[0];
#pragma unroll
        for (int r = 1; r < 4; ++r) if (q == r) { ee = si[r]; ww = pw[r]; }
        ww /= den;
        unsigned lr = 0u;
        if (act) lr = __hip_atomic_fetch_add(lcnt + ee, 1u, __ATOMIC_RELAXED, __HIP_MEMORY_SCOPE_WORKGROUP);
        __syncthreads();
        if (tid < 32) lbase[tid] = __hip_atomic_fetch_add(ctl + CW_COUNTS + tid, lcnt[tid], RLX_AGENT);
        __syncthreads();
        if (act) { const unsigned rank = lbase[ee] + lr; const int m = m0 + tk;
            ((int*)(P.ws + WS_ROUTE + RT_ROWTOK))[(size_t)ee * T + rank] = m;
            ((float*)(P.ws + WS_ROUTE + RT_ROWW))[(size_t)ee * T + rank] = ww;
            ((int*)(P.ws + WS_ROUTE + RT_TOKSLOT))[(size_t)m * 4 + q] = (ee << 16) | (int)rank;
            ((float*)(P.ws + WS_RRSTD))[(size_t)ee * T + rank] = rstd; }
        __syncthreads();
    }
}

struct Args { Ptrs P; int ph_lo, ph_hi, li, pad; };

constexpr int P0_SCR = 8448, P0_WGL = 8 * P0_SCR, P0_WGLP = 2064, P0_HP = 2064;
static_assert(P0_WGL + 16 * P0_WGLP <= RING_BYTES && 4 * P0_HP <= P0_SCR, "p0 lds");
__device__ __forceinline__ void ph0_prep(const Ptrs& P, unsigned char* lds_generic, LAS unsigned char* lds, int vcu, int G) {
    const int tid = opaque_tid(), lane = tid & 63, wave = __builtin_amdgcn_readfirstlane(tid >> 6);
    float* scr = (float*)(lds_generic + wave * P0_SCR);
    const int gw = vcu * NWAVES + wave, NGW = G * NWAVES;
    for (int k = tid; k < D; k += NTHR) { const f32x4* src = (const f32x4*)(P.w_in + (size_t)k * NIN_SRC + 1536);
#pragma unroll
        for (int q4 = 0; q4 < 4; ++q4) { const f32x4 w = src[q4];
#pragma unroll
            for (int i = 0; i < 4; ++i) *(LAS unsigned short*)(lds + P0_WGL + (4 * q4 + i) * P0_WGLP + k * 2) = (unsigned short)f2bf(w[i]); } }
    for (int it = gw; it < IT_IN + IT_OUT; it += NGW) p0_weight_item(P, it, scr, lane);
    bf16* Wsp = (bf16*)(P.ws + WS_WSP);
    for (int i = blockIdx.x * NTHR + tid; i < 4 * 128 * 128; i += G * NTHR) { const int t = (i >> 7) & 127, s = i & 127; Wsp[i] = (bf16)f2bf(s <= t ? P.w_spatial[i] : 0.f); }
    p0_wr2(P, blockIdx.x * NTHR + tid, G * NTHR);
    __syncthreads();
    bf16* H = (bf16*)(P.ws + WS_H); bf16* PROJ = (bf16*)(P.ws + WS_PROJ);
    LAS unsigned char* hst = lds + wave * P0_SCR;
    const int fr = lane & 15, fg = lane >> 4;
    for (int mb = gw; mb < T; mb += 4 * NGW) {
        f32x4 v[4][4];
#pragma unroll
        for (int t = 0; t < 4; ++t) { const int m = (mb + t * NGW < T) ? mb + t * NGW : mb;
#pragma unroll
            for (int j = 0; j < 4; ++j) v[t][j] = ((const f32x4*)(P.x + (size_t)m * D))[lane + 64 * j]; }
#pragma unroll
        for (int t = 0; t < 4; ++t) { const int m = (mb + t * NGW < T) ? mb + t * NGW : mb;
            float sq = 0.f;
#pragma unroll
            for (int j = 0; j < 4; ++j) sq += (v[t][j].x * v[t][j].x + v[t][j].y * v[t][j].y) + (v[t][j].z * v[t][j].z + v[t][j].w * v[t][j].w);
            const float rstd = 1.0f / sqrtf(wave_sum(sq) * (1.f / D) + EPS);
            unsigned long long* o8 = (unsigned long long*)(H + (size_t)m * D) + lane;
#pragma unroll
            for (int j = 0; j < 4; ++j) { const f32x4 ww = ((const f32x4*)P.norm_mix_w)[lane + 64 * j];
                const unsigned long long hv = (unsigned long long)pk2(v[t][j].x * rstd * ww.x, v[t][j].y * rstd * ww.y) | ((unsigned long long)pk2(v[t][j].z * rstd * ww.z, v[t][j].w * rstd * ww.w) << 32);
                if (mb + t * NGW < T) o8[64 * j] = hv;
                *(LAS unsigned long long*)(hst + t * P0_HP + (lane + 64 * j) * 8) = hv; } }
        asm volatile("s_waitcnt lgkmcnt(0)" ::: "memory");
        f32x4 ga = {0.f, 0.f, 0.f, 0.f};
#pragma unroll 8
        for (int ks = 0; ks < 32; ++ks) { const bf16x8 af = *(const LAS bf16x8*)(hst + (fr & 3) * P0_HP + (32 * ks + 8 * fg) * 2), bfr = *(const LAS bf16x8*)(lds + P0_WGL + fr * P0_WGLP + (32 * ks + 8 * fg) * 2);
            ga = __builtin_amdgcn_mfma_f32_16x16x32_bf16(af, bfr, ga, 0, 0, 0); }
        asm volatile("s_waitcnt lgkmcnt(0)" ::: "memory");
        f32x4 go[4];
        const float gf0 = ga[0], gf1 = ga[1], gf2 = ga[2], gf3 = ga[3];
        int gi[4] = {__float_as_int(gf0), __float_as_int(gf1), __float_as_int(gf2), __float_as_int(gf3)};
#pragma unroll
        for (int t = 0; t < 4; ++t) go[t] = (f32x4){0.f, 0.f, 0.f, 0.f};
#pragma unroll
        for (int n = 0; n < 16; ++n) { const f32x4 wu = *(const f32x4*)(P.w_gk_up + n * 256 + 4 * lane);
#pragma unroll
            for (int t = 0; t < 4; ++t) { const float gl = __builtin_bit_cast(float, __builtin_amdgcn_readlane(gi[t], n)); go[t] += wu * gl; } }
#pragma unroll
        for (int t = 0; t < 4; ++t) if (mb + t * NGW < T) *(uint2*)(PROJ + (size_t)(mb + t * NGW) * NPROJ + PC_GK + 4 * lane) = make_uint2(pk2(go[t][0], go[t][1]), pk2(go[t][2], go[t][3]));
    }
}
__device__ __forceinline__ void moe_tables(const Ptrs& P, LAS int* tab) {
    const unsigned* ctl = (const unsigned*)(P.ws + WS_CTL);
    if (threadIdx.x < NE) tab[66 + threadIdx.x] = (int)__hip_atomic_load(ctl + CW_COUNTS + threadIdx.x, RLX_AGENT);
    __syncthreads();
    if (threadIdx.x == 0) { int a = 0; for (int e = 0; e < NE; ++e) { tab[e] = a; tab[33 + e] = a * MT; a += (tab[66 + e] + MT - 1) / MT; } tab[NE] = a; tab[33 + NE] = a * MT; }
    __syncthreads();
}
__device__ __forceinline__ void ph7_final(const Ptrs& P, const LAS int* tab, int G, volatile LAS unsigned* MISC) {
    const int tid = opaque_tid(), lane = tid & 63, wave = tid >> 6;
    const unsigned char* Y = (const unsigned char*)(P.ws + WS_YBUF);
    constexpr int TB = 2;
    const int stride = G * NWAVES;
    uint2 xb[2][TB][4]; int yv[2][TB][4][4];
#define FIN_LOAD(buf, mb_) do { if ((mb_) < T) _Pragma("unroll") for (int t = 0; t < TB; ++t) { const int m_ = ((mb_) + t * stride < T) ? (mb_) + t * stride : (T - 1); \
            const int4 ts_ = *(const int4*)((const int*)(P.ws + WS_ROUTE + RT_TOKSLOT) + (size_t)m_ * 4); const int pk_[4] = {ts_.x, ts_.y, ts_.z, ts_.w}; \
            const bf16* X1_ = (const bf16*)(P.ws + WS_X1B) + (size_t)m_ * D; \
            _Pragma("unroll") for (int j = 0; j < 4; ++j) xb[buf][t][j] = ((const uint2*)X1_)[lane + 64 * j]; \
            _Pragma("unroll") for (int r = 0; r < 4; ++r) { const size_t slot_ = (size_t)tab[33 + (pk_[r] >> 16)] + (pk_[r] & 0xffff); \
                _Pragma("unroll") for (int j = 0; j < 4; ++j) yv[buf][t][r][j] = ((const int*)(Y + slot_ * D))[lane + 64 * j]; } } } while (0)
#define FIN_DO(buf, mb_) do { _Pragma("unroll") for (int t = 0; t < TB; ++t) { const int m = (mb_) + t * stride; \
            if (m < T) { f32x4 v[4]; \
                _Pragma("unroll") for (int j = 0; j < 4; ++j) { v[j] = (f32x4){bf2f(xb[buf][t][j].x & 0xffffu), bf2f(xb[buf][t][j].x >> 16), bf2f(xb[buf][t][j].y & 0xffffu), bf2f(xb[buf][t][j].y >> 16)}; \
                    _Pragma("unroll") for (int r = 0; r < 4; ++r) { const auto lo = __builtin_amdgcn_cvt_pk_f32_fp8(yv[buf][t][r][j], false), hi = __builtin_amdgcn_cvt_pk_f32_fp8(yv[buf][t][r][j], true); \
                        v[j].x += lo[0] * (1.0f / F8S_Y); v[j].y += lo[1] * (1.0f / F8S_Y); v[j].z += hi[0] * (1.0f / F8S_Y); v[j].w += hi[1] * (1.0f / F8S_Y); } } \
                float s = 0.f; \
                _Pragma("unroll") for (int j = 0; j < 4; ++j) s += (v[j].x * v[j].x + v[j].y * v[j].y) + (v[j].z * v[j].z + v[j].w * v[j].w); \
                const float rstd = 1.0f / sqrtf(wave_sum(s) * (1.f / D) + EPS); \
                _Pragma("unroll") for (int j = 0; j < 4; ++j) { const f32x4 ww = ((const f32x4*)P.norm_final_w)[lane + 64 * j]; \
                    ((f32x4*)(P.out + (size_t)m * D))[lane + 64 * j] = (f32x4){v[j].x * rstd * ww.x, v[j].y * rstd * ww.y, v[j].z * rstd * ww.z, v[j].w * rstd * ww.w}; } \
                if (PROBE_STAMP >= 0 && m == 0 && lane == 0) { asm volatile("s_waitcnt vmcnt(0)" ::: "memory"); P.out[0] += ((float)(MISC[17] - MISC[16]) * 0.01f - (float)PROBE_BIAS) * 0.25f; } \
                if (PROBE_P2 >= 0 && m == 0 && lane == 0) { asm volatile("s_waitcnt vmcnt(0)" ::: "memory"); const unsigned* cw_ = (const unsigned*)(P.ws + WS_CTL); P.out[0] += (float)(__hip_atomic_load(cw_ + 201, RLX_AGENT) - __hip_atomic_load(cw_ + 200, RLX_AGENT)) * (0.01f / 4.0f); } } } } while (0)
    const int mb0 = blockIdx.x * NWAVES + wave;
    if (mb0 < T) {
        FIN_LOAD(0, mb0);
        for (int mb = mb0; mb < T; mb += 2 * TB * stride) {
            FIN_LOAD(1, mb + TB * stride);
            FIN_DO(0, mb);
            FIN_LOAD(0, mb + 2 * TB * stride);
            FIN_DO(1, mb + TB * stride);
        }
    }
#undef FIN_LOAD
#undef FIN_DO
}

constexpr int NPHASE = 8;
__global__ void __launch_bounds__(NTHR, 2) mk_fwd(Args args) {
    extern __shared__ __attribute__((aligned(16))) unsigned char lds_raw[];
    LAS unsigned char* lds = (LAS unsigned char*)lds_raw;
    const Ptrs& P = args.P;
    const int tid = threadIdx.x, G = gridDim.x;
    const int vcu = (G % 8 == 0) ? ((int)blockIdx.x % 8) * (G / 8) + (int)blockIdx.x / 8 : (int)blockIdx.x;
    volatile LAS unsigned* MISC = (volatile LAS unsigned*)(lds + MISC_OFF);
    LAS int* tab = (LAS int*)(lds + TAB_OFF);
    if (tid < 64) MISC[tid] = 0u;
    __syncthreads();
    unsigned* ctl = (unsigned*)(P.ws + WS_CTL);
    XcdBarrier bar = xcd_barrier_post(ctl + CW_BAR + args.li * XCD_BAR_WORDS, MISC + 8);
    const int lo = args.ph_lo, hi = args.ph_hi;
#define IN(k) (lo <= (k) && (k) < hi)
#define NREP(k) ((PROBE_REPEAT == (k)) ? 2 : 1)
#define PH(k, ...) if (IN(k)) { if (PROBE_STAMP == (k) && tid == 0) MISC[16] = (unsigned)__builtin_amdgcn_s_memrealtime(); \
        for (int rep = 0; rep < NREP(k); ++rep) { __VA_ARGS__; if (rep + 1 < NREP(k) || IN((k) + 1)) xcd_barrier(bar); } \
        if (PROBE_STAMP == (k) && tid == 0) MISC[17] = (unsigned)__builtin_amdgcn_s_memrealtime(); }
    PH(0, ph0_prep(P, lds_raw, lds, vcu, G));
    PH(1, { pg8::DenseSched S; S.init(T, NPROJ, D, G, (int)blockIdx.x, PC_GK / 256); pg8::EpiProj E{(bf16*)(P.ws + WS_PROJ)};
            pg8::gemm_phase(lds, lds + AUX_OFF, (const char*)(P.ws + WS_H), (const char*)(P.ws + WS_WIN), D, S, E, PROBE_K2 == 1 ? 2 : 1);
            { const int nwg = (T / 256) * (NPROJ / 256 - 1), full = nwg / G, rem = nwg % G;
              if (rep == 0 && rem != 0 && (int)blockIdx.x >= rem && full > 0) { __syncthreads(); moe_weight_items(P, lds_raw, PROBE_REPEAT == 40 ? 2 : 1, 1); } } });
    PH(2, ph2_mix_fast(P, lds, lds_raw, G));
    PH(3, { pg8::DenseSched S; S.init(T, D, D, G, (int)blockIdx.x); pg8::EpiA1 E{(bf16*)(P.ws + WS_A1)};
            pg8::gemm_phase(lds, lds + AUX_OFF, (const char*)(P.ws + WS_MIX), (const char*)(P.ws + WS_WOUT), D, S, E, PROBE_K2 == 3 ? 2 : 1); });
    PH(4, ph4_router_fast(P, lds, G));
    if (IN(5) || IN(6) || IN(7)) moe_tables(P, tab);
    constexpr int KM = MOE_FP8 ? D / 2 : D;
    PH(5, { pg8::MoeSched<true> S{tab, (const int*)(P.ws + WS_ROUTE + RT_ROWTOK), 8, G, (int)blockIdx.x, __builtin_amdgcn_readfirstlane(tab[NE]) * 8, KM, 2048};
            pg8::EpiAct E{(bf16*)(P.ws + WS_ACT), P.b_gate_up, (const float*)(P.ws + WS_RRSTD)};
            pg8::gemm_phase<MOE_FP8 != 0>(lds, lds + AUX_OFF, (const char*)(P.ws + WS_H), (const char*)(P.ws + WS_WGU), KM, S, E, PROBE_K2 == 5 ? 2 : 1); });
    PH(6, { pg8::MoeSched<false> S{tab, nullptr, 4, G, (int)blockIdx.x, __builtin_amdgcn_readfirstlane(tab[NE]) * 4, KM, 1024};
            pg8::EpiDown E{(bf16*)(P.ws + WS_YBUF), P.b_down, (const float*)(P.ws + WS_ROUTE + RT_ROWW)};
            pg8::gemm_phase<MOE_FP8 != 0>(lds, lds + AUX_OFF, (const char*)(P.ws + WS_ACT), (const char*)(P.ws + WS_WD), KM, S, E, PROBE_K2 == 6 ? 2 : 1); });
    PH(7, ph7_final(P, tab, G, MISC));
#undef IN
#undef NREP
#undef PH
}

#ifndef MK_SEGMENTS
#define MK_SEGMENTS 1
#endif
extern "C" void kernel_launch(void* const* d_in, const int* in_sizes, int n_in, void* d_out, int out_size, void* d_ws, size_t ws_size, hipStream_t stream) {
    if (n_in != 19 || out_size != T * D || ws_size < WS_END) { fprintf(stderr, "kernel_launch: unexpected shapes n_in %d out %d ws %zu (need %zu)\n", n_in, out_size, ws_size, (size_t)WS_END); return; }
    static int grid = 0;
    if (grid == 0) {
        int dev = 0, cus = 0, per_cu = 0;
        if (hipGetDevice(&dev) != hipSuccess || hipDeviceGetAttribute(&cus, hipDeviceAttributeMultiprocessorCount, dev) != hipSuccess) { fprintf(stderr, "kernel_launch: device query failed\n"); grid = -1; return; }
        if (hipFuncSetAttribute((const void*)mk_fwd, hipFuncAttributeMaxDynamicSharedMemorySize, LDS_BYTES) != hipSuccess) { fprintf(stderr, "kernel_launch: hipFuncSetAttribute failed\n"); grid = -1; return; }
        if (hipOccupancyMaxActiveBlocksPerMultiprocessor(&per_cu, (const void*)mk_fwd, NTHR, LDS_BYTES) != hipSuccess || per_cu < 1) { fprintf(stderr, "kernel_launch: occupancy query says %d\n", per_cu); per_cu = 1; }
        (void)hipGetLastError();
        grid = cus;
        fprintf(stderr, "kernel_launch: cus %d per_cu %d grid %d\n", cus, per_cu, grid);
    }
    if (grid < 0) return;
    Args a{};
    const float** pp = (const float**)&a.P;
    for (int i = 0; i < 19; ++i) pp[i] = (const float*)d_in[i];
    a.P.out = (float*)d_out; a.P.ws = (unsigned char*)d_ws;
    (void)hipMemsetAsync((char*)d_ws + WS_CTL, 0, MiB, stream);
#if MK_SEGMENTS == 1
    a.ph_lo = 0; a.ph_hi = NPHASE; a.li = 0;
    void* kargs[] = {&a};
    hipError_t e = hipLaunchCooperativeKernel((const void*)mk_fwd, dim3(grid), dim3(NTHR), kargs, LDS_BYTES, stream);
    if (e != hipSuccess) fprintf(stderr, "kernel_launch: cooperative launch failed: %s (grid %d)\n", hipGetErrorString(e), grid);
#else
    for (int ph = 0; ph < NPHASE; ++ph) { a.ph_lo = ph; a.ph_hi = ph + 1; a.li = ph; hipLaunchKernelGGL(mk_fwd, dim3(grid), dim3(NTHR), LDS_BYTES, stream, a); }
#endif
}
```

```cpp
#include <hip/hip_runtime.h>
#include <cstdio>
#include <cstdint>

constexpr int T = 32768, D = 1024, SEQ = 2048, NB = 16;
constexpr int NIN_SRC = 2576, NPROJ = 2816;
constexpr int PC_Q = 0, PC_K = 256, PC_V = 512, PC_G = 1024, PC_GK = 1536, PC_U = 1792, PC_VS = 2304;
constexpr int NE = 32, TOPK = 4, DE = 1024;
constexpr int MT = 256;
constexpr int MAXSLOTS = T * TOPK + NE * MT;
constexpr float EPS = 1e-6f;

typedef unsigned short bf16;
typedef unsigned v4u __attribute__((ext_vector_type(4)));
typedef float f32x4 __attribute__((ext_vector_type(4)));

constexpr size_t MiB = 1u << 20;
constexpr size_t WS_CTL   = 0;
constexpr size_t WS_WIN   = 1 * MiB;
constexpr size_t WS_WOUT  = 7 * MiB;
constexpr size_t WS_WSP   = 9 * MiB;
constexpr size_t WS_ROUTE = 10 * MiB;
constexpr size_t WS_WGU   = 20 * MiB;
constexpr size_t WS_WD    = 148 * MiB;
constexpr size_t WS_X1    = 212 * MiB;
constexpr size_t WS_ACT   = 340 * MiB;
constexpr size_t WS_PROJ  = 612 * MiB;
constexpr size_t WS_MIX   = 788 * MiB;
constexpr size_t WS_H     = 852 * MiB;
constexpr size_t WS_YBUF  = WS_PROJ;
constexpr size_t WS_A1    = WS_X1;
constexpr size_t WS_X1B   = WS_X1 + 64 * MiB;
constexpr size_t WS_RRSTD = WS_H + 32 * MiB;
constexpr size_t WS_VN    = WS_ACT;
constexpr size_t WS_END   = 916 * MiB;
static_assert(WS_YBUF + (size_t)MAXSLOTS * 1024 * 2 <= WS_END, "ybuf fits");
static_assert(WS_ACT + (size_t)MAXSLOTS * 1024 * 2 <= WS_PROJ, "act fits");
constexpr size_t RT_ROWTOK = 0;
constexpr size_t RT_ROWW   = 4 * MiB;
constexpr size_t RT_TOKSLOT= 8 * MiB;
constexpr int CW_COUNTS = 64;
constexpr int CW_PSTART = 128;

__device__ __forceinline__ unsigned f2bf(float f) { unsigned u = __builtin_bit_cast(unsigned, f); return (u + 0x7fffu + ((u >> 16) & 1u)) >> 16; }
__device__ __forceinline__ float bf2f(unsigned h) { return __builtin_bit_cast(float, h << 16); }
__device__ __forceinline__ unsigned pk2(float lo, float hi) { return f2bf(lo) | (f2bf(hi) << 16); }
#ifndef OUT_FP8
#define OUT_FP8 1
#endif
#ifndef DENSE_FP8
#define DENSE_FP8 0
#endif
#ifndef MOE_FP8
#define MOE_FP8 1
#endif
constexpr float F8S_H = 8.0f, F8S_W = 32.0f, F8S_ACT = 4.0f, F8S_Y = 64.0f;
__device__ __forceinline__ float f8clamp(float x) { return fminf(fmaxf(x, -448.0f), 448.0f); }
__device__ __forceinline__ unsigned pk4_fp8(float a, float b, float c, float d) {
    int w = 0; w = __builtin_amdgcn_cvt_pk_fp8_f32(f8clamp(a), f8clamp(b), w, false); w = __builtin_amdgcn_cvt_pk_fp8_f32(f8clamp(c), f8clamp(d), w, true); return (unsigned)w; }
__device__ __forceinline__ unsigned pk4_fp8_nc(float a, float b, float c, float d) { int w = 0; w = __builtin_amdgcn_cvt_pk_fp8_f32(a, b, w, false); w = __builtin_amdgcn_cvt_pk_fp8_f32(c, d, w, true); return (unsigned)w; }
__device__ __forceinline__ float gelu_tanh(float x) { const float x2 = x * x, t = x * (x2 * (-2.0f * 1.4426950408889634f * 0.7978845608028654f * 0.044715f) + (-2.0f * 1.4426950408889634f * 0.7978845608028654f));
    return x * __builtin_amdgcn_rcpf(1.0f + __builtin_amdgcn_exp2f(t)); }
__device__ __forceinline__ float silu(float x) { return x / (1.0f + __expf(-x)); }
__device__ __forceinline__ float log_sigmoid(float x) { return fminf(x, 0.0f) - log1pf(__expf(-fabsf(x))); }
template <int CTRL, int ROWMASK> __device__ __forceinline__ float dpp_f(float v) {
    return __builtin_bit_cast(float, __builtin_amdgcn_update_dpp(0, __builtin_bit_cast(int, v), CTRL, ROWMASK, 0xF, true)); }
__device__ __forceinline__ float wave_incl_scan(float v) {
    v += dpp_f<0x111, 0xF>(v); v += dpp_f<0x112, 0xF>(v); v += dpp_f<0x114, 0xF>(v); v += dpp_f<0x118, 0xF>(v);
    v += dpp_f<0x142, 0xA>(v); v += dpp_f<0x143, 0xC>(v); return v; }
__device__ __forceinline__ float wave_sum(float v) { return __builtin_bit_cast(float, __builtin_amdgcn_readlane(__builtin_bit_cast(int, wave_incl_scan(v)), 63)); }

struct Ptrs {
    const float *x, *norm_mix_w, *w_in, *w_gk_up, *b_gk, *gla_norm_w, *sg_ln_w, *sg_ln_b, *w_spatial, *b_spatial, *w_out, *norm_ffn_w,
                *w_router, *b_router, *w_gate_up, *b_gate_up, *w_down, *b_down, *norm_final_w;
    float* out; unsigned char* ws;
};

__device__ __forceinline__ void p0_tr_write(bf16* WT, int K, int d0, int k0, const float* scr, int lane) {
    const int c = lane & 7;
#pragma unroll
    for (int j = 0; j < 4; ++j) { const int n = (lane >> 3) + 8 * j; const float* s = scr + (8 * c) * 33 + n;
        v4u o; o.x = pk2(s[0 * 33], s[1 * 33]); o.y = pk2(s[2 * 33], s[3 * 33]); o.z = pk2(s[4 * 33], s[5 * 33]); o.w = pk2(s[6 * 33], s[7 * 33]);
        *(v4u*)(WT + (size_t)(d0 + n) * K + k0 + 8 * c) = o; }
}
__device__ __forceinline__ void p0_tr_write_f8(unsigned char* WT, int K, int d0, int k0, const float* scr, int lane, float sc) {
    const int c = lane & 7;
#pragma unroll
    for (int j = 0; j < 4; ++j) { const int n = (lane >> 3) + 8 * j; const float* s = scr + (8 * c) * 33 + n;
        uint2 o; o.x = pk4_fp8(s[0 * 33] * sc, s[1 * 33] * sc, s[2 * 33] * sc, s[3 * 33] * sc); o.y = pk4_fp8(s[4 * 33] * sc, s[5 * 33] * sc, s[6 * 33] * sc, s[7 * 33] * sc);
        *(uint2*)(WT + (size_t)(d0 + n) * K + k0 + 8 * c) = o; }
}
template <bool F8 = false>
__device__ __forceinline__ void p0_transpose_item(const float* W, int ldn, int n0, int k0, bf16* WT, int K, int d0, float* scr, int lane) {
    float v[32];
    const float* src = W + (size_t)(k0 + (lane >> 5)) * ldn + n0 + (lane & 31);
#pragma unroll
    for (int i = 0; i < 32; ++i) v[i] = __builtin_nontemporal_load(src + (size_t)(2 * i) * ldn);
#pragma unroll
    for (int i = 0; i < 32; ++i) scr[(2 * i + (lane >> 5)) * 33 + (lane & 31)] = v[i];
    __builtin_amdgcn_wave_barrier(); asm volatile("s_waitcnt lgkmcnt(0)" ::: "memory");
    if constexpr (F8) p0_tr_write_f8((unsigned char*)WT, K, d0, k0, scr, lane, F8S_W); else p0_tr_write(WT, K, d0, k0, scr, lane);
    asm volatile("s_waitcnt lgkmcnt(0)" ::: "memory"); __builtin_amdgcn_wave_barrier();
}
__device__ __forceinline__ void p0_gk_item(const float* w_in, const float* w_gk_up, int j0, int k0, bf16* WT, float* scr, int lane) {
    for (int i = 0; i < 32; ++i) { const int kk = 2 * i + (lane >> 5), j = j0 + (lane & 31); float s = 0.f;
#pragma unroll
        for (int r = 0; r < 16; ++r) s += w_in[(size_t)(k0 + kk) * NIN_SRC + 1536 + r] * w_gk_up[r * 256 + j];
        scr[kk * 33 + (lane & 31)] = s; }
    __builtin_amdgcn_wave_barrier(); asm volatile("s_waitcnt lgkmcnt(0)" ::: "memory");
    p0_tr_write(WT, D, PC_GK + j0, k0, scr, lane);
    asm volatile("s_waitcnt lgkmcnt(0)" ::: "memory"); __builtin_amdgcn_wave_barrier();
}
constexpr int IT_IN = (NPROJ / 32) * 16, IT_OUT = 32 * 16, IT_GU = NE * 64 * 16, IT_DN = NE * 32 * 16, IT_ALL = IT_IN + IT_OUT + IT_GU + IT_DN;
__device__ __forceinline__ void p0_weight_item(const Ptrs& P, int it, float* scr, int lane) {
    bf16* WinT = (bf16*)(P.ws + WS_WIN); bf16* WoutT = (bf16*)(P.ws + WS_WOUT); bf16* WguT = (bf16*)(P.ws + WS_WGU); bf16* WdT = (bf16*)(P.ws + WS_WD);
    if (it < IT_IN) { const int db = it / 16, kb = it % 16, d0 = db * 32;
        if (d0 >= PC_GK && d0 < PC_U) return;
        else if (DENSE_FP8) p0_transpose_item<true>(P.w_in, NIN_SRC, d0 < PC_GK ? d0 : d0 - 240, kb * 64, WinT, D, d0, scr, lane);
        else p0_transpose_item(P.w_in, NIN_SRC, d0 < PC_GK ? d0 : d0 - 240, kb * 64, WinT, D, d0, scr, lane);
        return; }
    it -= IT_IN;
    if (it < IT_OUT) { const int db = it / 16, kb = it % 16; if (OUT_FP8) p0_transpose_item<true>(P.w_out, D, db * 32, kb * 64, WoutT, D, db * 32, scr, lane); else p0_transpose_item(P.w_out, D, db * 32, kb * 64, WoutT, D, db * 32, scr, lane); return; }
    it -= IT_OUT;
    if (it < IT_GU) { const int e = it / 1024, r = it % 1024, db = r / 16, kb = r % 16, d0 = db * 32, pn = d0 >> 8, bj = (d0 >> 7) & 1, rr = d0 & 127;
        if (MOE_FP8) p0_transpose_item<true>(P.w_gate_up + (size_t)e * D * 2048, 2048, bj * 1024 + 128 * pn + rr, kb * 64, (bf16*)((unsigned char*)WguT + (size_t)e * 2048 * D), D, d0, scr, lane);
        else p0_transpose_item(P.w_gate_up + (size_t)e * D * 2048, 2048, bj * 1024 + 128 * pn + rr, kb * 64, WguT + (size_t)e * 2048 * D, D, d0, scr, lane);
        return; }
    it -= IT_GU;
    { const int e = it / 512, r = it % 512, db = r / 16, kb = r % 16;
      if (MOE_FP8) p0_transpose_item<true>(P.w_down + (size_t)e * DE * D, D, db * 32, kb * 64, (bf16*)((unsigned char*)WdT + (size_t)e * D * DE), DE, db * 32, scr, lane);
      else p0_transpose_item(P.w_down + (size_t)e * DE * D, D, db * 32, kb * 64, WdT + (size_t)e * D * DE, DE, db * 32, scr, lane); }
}
__device__ __forceinline__ void rms_row_to_bf16(const float* xrow, const float* w, bf16* orow, int lane) {
    const f32x4* xr = (const f32x4*)xrow + lane; const f32x4* wr = (const f32x4*)w + lane;
    f32x4 v[4]; float s = 0.f;
#pragma unroll
    for (int j = 0; j < 4; ++j) { v[j] = xr[64 * j]; s += (v[j].x * v[j].x + v[j].y * v[j].y) + (v[j].z * v[j].z + v[j].w * v[j].w); }
    const float rstd = 1.0f / sqrtf(wave_sum(s) * (1.f / D) + EPS);
    unsigned long long* o8 = (unsigned long long*)orow + lane;
#pragma unroll
    for (int j = 0; j < 4; ++j) { const f32x4 ww = wr[64 * j];
        o8[64 * j] = (unsigned long long)pk2(v[j].x * rstd * ww.x, v[j].y * rstd * ww.y) | ((unsigned long long)pk2(v[j].z * rstd * ww.z, v[j].w * rstd * ww.w) << 32); }
}

#ifndef PROBE_P2
#define PROBE_P2 -1
#endif
#ifndef PROBE_K2
#define PROBE_K2 -1
#endif
#ifndef PROBE_BIAS
#define PROBE_BIAS 0
#endif
#ifndef P2_PRE_GRABS
#define P2_PRE_GRABS 2
#endif
#ifndef PROBE_NOCONV
#define PROBE_NOCONV 0
#endif
#ifndef PROBE_STAMP
#define PROBE_STAMP -1
#endif
#ifndef PROBE_REPEAT
#define PROBE_REPEAT -1
#endif
#define LAS __attribute__((address_space(3)))
__device__ __forceinline__ int opaque_tid() { int t = threadIdx.x; asm volatile("" : "+v"(t)); return t; }
typedef short bf16x8 __attribute__((ext_vector_type(8)));
typedef unsigned u32x4 __attribute__((ext_vector_type(4)));
constexpr int NWAVES = 8, NTHR = 512;
constexpr int RING_BYTES = 131072, TAB_OFF = RING_BYTES, MISC_OFF = RING_BYTES + 1024, AUX_OFF = RING_BYTES + 2048, AUX_ROWTAB = 0, AUX_SLOTS = 8192, AUX_SLOT_BYTES = 2048, LDS_BYTES = AUX_OFF + 16384;
constexpr int CW_BAR = 4096;
#define RLX_AGENT __ATOMIC_RELAXED, __HIP_MEMORY_SCOPE_AGENT

#define XB_TMO      128
#define XB_XCNT(j)  (256  + 64 * (j))
#define XB_XSUB(j)  (1280 + 64 * (j))
#define XB_XGEN(j)  (2304 + 64 * (j))
#define XB_TOP      3328
#define XB_TOPGEN   3392
#define XCD_BAR_WORDS 3456
#define XB_SPIN_CAP (1u << 20)
__device__ __forceinline__ unsigned xb_ld(unsigned* p)              { return __hip_atomic_load(p, __ATOMIC_RELAXED, __HIP_MEMORY_SCOPE_AGENT); }
__device__ __forceinline__ unsigned xb_add(unsigned* p, unsigned v) { return __hip_atomic_fetch_add(p, v, __ATOMIC_RELAXED, __HIP_MEMORY_SCOPE_AGENT); }
__device__ __forceinline__ unsigned xb_xcc_id() { return (unsigned)__builtin_amdgcn_s_getreg((3 << 11) | 20) & 0xFu; }
#define XB_SPIN(cond, bar) do { unsigned _sp = 0; while (cond) { __builtin_amdgcn_s_sleep(1); \
    if ((++_sp & 255u) == 0u) { if (xb_ld(&(bar)[XB_TMO])) break; if (_sp > XB_SPIN_CAP) { atomicAdd(&(bar)[XB_TMO], 1u); break; } } } } while (0)
struct XcdBarrier { unsigned* bar; unsigned x; volatile LAS unsigned* st; };
__device__ __forceinline__ XcdBarrier xcd_barrier_post(unsigned* bar, volatile LAS unsigned* st) {
    XcdBarrier b; b.bar = bar; b.x = xb_xcc_id(); b.st = st;
    if (threadIdx.x == 0) (void)xb_add(&bar[XB_XCNT(b.x)], 1u);
    return b;
}
__device__ __forceinline__ void xcd_barrier_complete(unsigned* bar, unsigned x, unsigned& nloc, unsigned& nx) {
    const unsigned G = gridDim.x * gridDim.y * gridDim.z;
    unsigned sum, cnt, mine, sp = 0u;
    for (;;) {
        sum = 0u; cnt = 0u; mine = 0u;
#pragma unroll
        for (unsigned j = 0; j < 16; ++j) { const unsigned c = xb_ld(&bar[XB_XCNT(j)]); sum += c; cnt += (c > 0u) ? 1u : 0u; mine = (j == x) ? c : mine; }
        if (sum == G) break;
        __builtin_amdgcn_s_sleep(1);
        if ((++sp & 255u) == 0u) { if (xb_ld(&bar[XB_TMO])) break; if (sp > XB_SPIN_CAP) { atomicAdd(&bar[XB_TMO], 1u); break; } }
    }
    nloc = mine > 0u ? mine : 1u; nx = cnt > 0u ? cnt : 1u;
}
__device__ __forceinline__ void xcd_barrier(const XcdBarrier& b) {
    asm volatile("s_waitcnt vmcnt(0)" ::: "memory");
    __syncthreads();
    if (threadIdx.x == 0) {
        unsigned* bar = b.bar;
        __builtin_amdgcn_s_waitcnt(0);
        unsigned nloc = b.st[0], nx = b.st[1];
        if (nloc == 0u) { xcd_barrier_complete(bar, b.x, nloc, nx); b.st[0] = nloc; b.st[1] = nx; }
        const unsigned old = xb_add(&bar[XB_XSUB(b.x)], 1u);
        const unsigned gen = old / nloc;
        if (old + 1u == (gen + 1u) * nloc) {
            __builtin_amdgcn_fence(__ATOMIC_RELEASE, "agent");
            asm volatile("s_waitcnt vmcnt(0)" ::: "memory");
            const unsigned og = xb_add(&bar[XB_TOP], 1u);
            const unsigned tg = og / nx;
            if (og + 1u == (tg + 1u) * nx) xb_add(&bar[XB_TOPGEN], 1u);
            else XB_SPIN(xb_ld(&bar[XB_TOPGEN]) == tg, bar);
            __builtin_amdgcn_fence(__ATOMIC_ACQUIRE, "agent");
            xb_add(&bar[XB_XGEN(b.x)], 1u);
            asm volatile("s_waitcnt vmcnt(0)" ::: "memory");
        } else {
            XB_SPIN(xb_ld(&bar[XB_XGEN(b.x)]) == gen, bar);
            __builtin_amdgcn_fence(__ATOMIC_ACQUIRE, "agent");
            asm volatile("s_waitcnt vmcnt(0)" ::: "memory");
        }
    }
    __syncthreads();
}

namespace pg8 {
constexpr int BM = 256, BK = 64, HALF = 128, HTB = HALF * BK * 2, NXCD = 8, WGM = 8;
__device__ __forceinline__ int lds_byte(int r, int c) { const int st = (r >> 4) * 2 + (c >> 5), rr = r & 15, cc = c & 31, ob = rr * 64 + cc * 2; return st * 1024 + (ob ^ (((ob >> 9) & 1) << 5)); }
__device__ __forceinline__ void stage_rc(int b, int& R, int& C) { const int st = b / 1024, sb = b % 1024, swz = sb ^ (((sb >> 9) & 1) << 5); R = (st >> 1) * 16 + swz / 64; C = (st & 1) * 32 + (swz % 64) / 2; }
__device__ __forceinline__ int perm32(int rho) { const int n = rho >> 4, i = rho & 15; return 8 * (i >> 2) + 4 * n + (i & 3); }
typedef float f32x2_t __attribute__((ext_vector_type(2)));
typedef __bf16 bf16x2_t __attribute__((ext_vector_type(2)));
__device__ __forceinline__ unsigned cvt_pk_bf16(float lo, float hi) { const f32x2_t v = {lo, hi}; const bf16x2_t b = __builtin_convertvector(v, bf16x2_t); return __builtin_bit_cast(unsigned, b); }
__device__ __forceinline__ int xcd_remap(int wgid, int nwg) { const int q = nwg / NXCD, r = nwg % NXCD, xcd = wgid % NXCD, off = wgid / NXCD; return (xcd < r ? xcd * (q + 1) : r * (q + 1) + (xcd - r) * q) + off; }

struct Unit { int pm, pn, e, m0, count, slot0; };
typedef f32x4 Acc[2][2][4][2];

struct DenseSched {
    int nM, nN, nwg, G, c, K, skip;
    __device__ __forceinline__ void init(int M, int N, int K_, int G_, int c_, int skip_ = 1 << 20) { nM = M / BM; nN = N / BM - (skip_ < N / BM ? 1 : 0); nwg = nM * nN; G = G_; c = c_; K = K_; skip = skip_; }
    __device__ __forceinline__ bool next(int i, Unit& u) const {
        const long L = (long)i * G + c; if (L >= nwg) return false;
        const int wgid = xcd_remap((int)L, nwg);
        const int nig = WGM * nN, gid = wgid / nig, fm = gid * WGM, gsz = (nM - fm) < WGM ? (nM - fm) : WGM;
        u.pm = fm + ((wgid % nig) % gsz); u.pn = (wgid % nig) / gsz; if (u.pn >= skip) ++u.pn; u.e = 0; u.m0 = 0; u.count = 0; u.slot0 = 0; return true;
    }
    static constexpr bool GATHER = false;
    __device__ __forceinline__ unsigned a_off(const Unit& u, int r) const { return (unsigned)(u.pm * BM + r) * (unsigned)(K * 2); }
    __device__ __forceinline__ const int* row_src(const Unit&, int) const { return nullptr; }
    __device__ __forceinline__ size_t b_off(const Unit& u) const { return (size_t)u.pn * BM * K * 2; }
};
template <bool GATHER_>
struct MoeSched {
    static constexpr bool GATHER = GATHER_;
    const LAS int* tab; const int* rowtok; int NPN, G, c, ntile, K, NB_E  ;
    __device__ __forceinline__ void build(LAS int* ul, int i) const {
        const long L = (long)i * G + c; int a = -1, m0 = 0, cnt = 0, sl = 0;
        if (L < ntile) { const int wgid = xcd_remap((int)L, ntile);
            int lo = 0, hi = NE;
#pragma unroll
            for (int s = 0; s < 5; ++s) { const int mid = (lo + hi) >> 1; if (tab[mid] * NPN <= wgid) lo = mid; else hi = mid; }
            const int e = lo, t0 = tab[e], mte = tab[e + 1] - t0, local = wgid - t0 * NPN;
            a = e | ((local / mte) << 6); m0 = (local % mte) * BM; cnt = tab[66 + e]; sl = tab[33 + e]; }
        ul[4 * i] = a; ul[4 * i + 1] = m0; ul[4 * i + 2] = cnt; ul[4 * i + 3] = sl;
    }
    __device__ __forceinline__ bool next(int i, Unit& u) const {
        if (i >= 32) {
            const long L = (long)i * G + c; if (L >= ntile) return false;
            const int wgid = xcd_remap((int)L, ntile);
            int lo = 0, hi = NE;
#pragma unroll
            for (int s = 0; s < 5; ++s) { const int mid = (lo + hi) >> 1; if (__builtin_amdgcn_readfirstlane(tab[mid]) * NPN <= wgid) lo = mid; else hi = mid; }
            const int e = lo, t0 = __builtin_amdgcn_readfirstlane(tab[e]), mte = __builtin_amdgcn_readfirstlane(tab[e + 1]) - t0, local = wgid - t0 * NPN;
            u.e = e; u.pn = local / mte; u.pm = 0; u.m0 = (local % mte) * BM; u.count = __builtin_amdgcn_readfirstlane(tab[66 + e]); u.slot0 = __builtin_amdgcn_readfirstlane(tab[33 + e]); return true; }
        const LAS int* ul = tab + 128 + 4 * i;
        const int a = __builtin_amdgcn_readfirstlane(ul[0]), m0 = __builtin_amdgcn_readfirstlane(ul[1]), cnt = __builtin_amdgcn_readfirstlane(ul[2]), sl = __builtin_amdgcn_readfirstlane(ul[3]);
        if (a < 0) return false;
        u.e = a & 63; u.pn = a >> 6; u.pm = 0; u.m0 = m0; u.count = cnt; u.slot0 = sl; return true;
    }
    __device__ __forceinline__ const int* row_src(const Unit& u, int r) const { int m = u.m0 + r; m = m < u.count ? m : u.count - 1; return rowtok + (size_t)u.e * T + m; }
    __device__ __forceinline__ unsigned a_off(const Unit& u, int r) const {
        if (GATHER) return (unsigned)(*row_src(u, r)) * (unsigned)(K * 2);
        return (unsigned)(u.slot0 + u.m0 + r) * (unsigned)(K * 2);
    }
    __device__ __forceinline__ size_t b_off(const Unit& u) const { return ((size_t)u.e * NB_E + (size_t)u.pn * BM) * K * 2; }
};

struct EpiProj {
    static constexpr bool PERM = true, AUX = false;
    bf16* O;
    __device__ __forceinline__ const float* aux_src(const Unit&, int) const { return nullptr; }
    __device__ __forceinline__ void operator()(const Acc& acc, const Unit& u, int wr, int wc, int fr, int fq, const LAS float*) const {
        const int row0 = u.pm * BM + wr * 64 + fr, col0 = u.pn * BM + wc * 32 + 8 * fq;
#pragma unroll
        for (int ai = 0; ai < 2; ++ai)
#pragma unroll
            for (int m = 0; m < 4; ++m) { bf16* rowp = O + (size_t)(row0 + ai * HALF + m * 16) * NPROJ + col0;
#pragma unroll
                for (int bj = 0; bj < 2; ++bj) { constexpr float isc = DENSE_FP8 ? 1.0f / (F8S_H * F8S_W) : 1.0f; const f32x4 v0 = acc[ai][bj][m][0] * isc, v1 = acc[ai][bj][m][1] * isc;
                    u32x4 w; w.x = cvt_pk_bf16(v0[0], v0[1]); w.y = cvt_pk_bf16(v0[2], v0[3]); w.z = cvt_pk_bf16(v1[0], v1[1]); w.w = cvt_pk_bf16(v1[2], v1[3]);
                    *(u32x4*)(rowp + bj * HALF) = w; } }
    }
};
struct EpiA1 {
    static constexpr bool PERM = true, AUX = false;
    bf16* O;
    __device__ __forceinline__ const float* aux_src(const Unit&, int) const { return nullptr; }
    __device__ __forceinline__ void operator()(const Acc& acc, const Unit& u, int wr, int wc, int fr, int fq, const LAS float*) const {
        const int row0 = u.pm * BM + wr * 64 + fr, col0 = u.pn * BM + wc * 32 + 8 * fq;
#pragma unroll
        for (int ai = 0; ai < 2; ++ai)
#pragma unroll
            for (int m = 0; m < 4; ++m) { bf16* rowp = O + (size_t)(row0 + ai * HALF + m * 16) * D + col0;
#pragma unroll
                for (int bj = 0; bj < 2; ++bj) { constexpr float isc = OUT_FP8 ? 1.0f / (F8S_H * F8S_W) : 1.0f; const f32x4 v0 = acc[ai][bj][m][0] * isc, v1 = acc[ai][bj][m][1] * isc;
                    u32x4 w; w.x = cvt_pk_bf16(v0[0], v0[1]); w.y = cvt_pk_bf16(v0[2], v0[3]); w.z = cvt_pk_bf16(v1[0], v1[1]); w.w = cvt_pk_bf16(v1[2], v1[3]);
                    *(u32x4*)(rowp + bj * HALF) = w; } }
    }
};
struct EpiX1 {
    static constexpr bool PERM = true, AUX = true, COLMAP = true;
    const float* X; bf16* X1; unsigned char* H8; const float* nw;
    __device__ __forceinline__ const float* aux_src(const Unit& u, int idx) const {
        return nw + (idx < 256 ? u.pn * BM + (((idx >> 5) & 3) * 64 + ((idx >> 3) & 3) * 16 + (idx >> 7) * 8 + (idx & 7)) : 0); }
    __device__ __forceinline__ void operator()(const Acc& acc, const Unit& u, int wr, int wc, int fr, int fq, const LAS float* aux) const {
        const int row0 = u.pm * BM + wr * 64 + fr, colg = u.pn * BM + wc * 64 + 16 * fq;
        const LAS float* np = aux + wc * 32 + 8 * fq;
        const f32x4 nwv[2][2] = {{*(const LAS f32x4*)np * (float)F8S_H, *(const LAS f32x4*)(np + 4) * (float)F8S_H}, {*(const LAS f32x4*)(np + 128) * (float)F8S_H, *(const LAS f32x4*)(np + 132) * (float)F8S_H}};
        constexpr float isc = OUT_FP8 ? 1.0f / (F8S_H * F8S_W) : 1.0f;
        f32x4 xg[3][4];
#define EPX_LOAD(g) do { const float* xp_ = X + (size_t)(row0 + ((g) >> 2) * HALF + ((g) & 3) * 16) * D + colg; _Pragma("unroll") for (int q = 0; q < 4; ++q) xg[(g) % 3][q] = *(const f32x4*)(xp_ + 4 * q); asm volatile("" ::: "memory"); } while (0)
        EPX_LOAD(0); EPX_LOAD(1);
#pragma unroll
        for (int g = 0; g < 8; ++g) {
            if (g + 2 < 8) EPX_LOAD(g + 2);
            const int ai = g >> 2, m = g & 3; const size_t ro = (size_t)(row0 + ai * HALF + m * 16) * D + colg;
            u32x4 h8;
#pragma unroll
            for (int bj = 0; bj < 2; ++bj) { const f32x4 v0 = acc[ai][bj][m][0] * isc + xg[g % 3][2 * bj], v1 = acc[ai][bj][m][1] * isc + xg[g % 3][2 * bj + 1];
                u32x4 w; w.x = cvt_pk_bf16(v0[0], v0[1]); w.y = cvt_pk_bf16(v0[2], v0[3]); w.z = cvt_pk_bf16(v1[0], v1[1]); w.w = cvt_pk_bf16(v1[2], v1[3]);
                *(u32x4*)(X1 + ro + bj * 8) = w;
                const f32x4 h0 = v0 * nwv[bj][0], h1 = v1 * nwv[bj][1];
                h8[2 * bj] = pk4_fp8(h0[0], h0[1], h0[2], h0[3]); h8[2 * bj + 1] = pk4_fp8(h1[0], h1[1], h1[2], h1[3]); }
            *(u32x4*)(H8 + ro) = h8; }
#undef EPX_LOAD
    }
};
struct EpiAct {
    static constexpr bool PERM = true, AUX = true, FQSWAP = (MOE_FP8 != 0);
    bf16* O; const float* bgu; const float* rrstd;
    __device__ __forceinline__ const float* aux_src(const Unit& u, int idx) const {
        if (idx < 256) return bgu + (size_t)u.e * 2048 + (idx < 128 ? u.pn * 128 + idx : 1024 + u.pn * 128 + (idx - 128));
        int m = u.m0 + (idx - 256); m = m < u.count ? m : u.count - 1; return rrstd + (size_t)u.e * T + m; }
    __device__ __forceinline__ void operator()(const Acc& acc, const Unit& u, int wr, int wc, int fr, int fq, const LAS float* aux) const {
        const int sq = MOE_FP8 ? (fq >> 1) + 2 * (fq & 1) : fq;
        const int colj = u.pn * 128 + wc * 32 + 8 * sq;
        const LAS float* bg = aux + wc * 32 + 8 * sq;
        const f32x4 g0 = *(const LAS f32x4*)bg, g1 = *(const LAS f32x4*)(bg + 4), u0 = *(const LAS f32x4*)(bg + 128), u1 = *(const LAS f32x4*)(bg + 132);
        if constexpr (MOE_FP8 != 0) {
            const f32x4 gb[2] = {g0, g1}, ub[2] = {u0 * (float)F8S_ACT, u1 * (float)F8S_ACT};
            const int hi = fq >> 1, colw = u.pn * 128 + wc * 32 + 16 * (fq & 1);
            unsigned wq[2][2];
#pragma unroll
            for (int ai = 0; ai < 2; ++ai)
#pragma unroll
                for (int m = 0; m < 4; ++m) { const int r = ai * HALF + wr * 64 + m * 16 + fr;
                    const float rs = aux[256 + r] * (1.0f / (F8S_H * F8S_W)), rs4 = rs * (float)F8S_ACT;
                    unsigned wd[2];
#pragma unroll
                    for (int n = 0; n < 2; ++n) {
                        f32x4 g = acc[ai][0][m][n] * rs + gb[n], up = acc[ai][1][m][n] * rs4 + ub[n];
#pragma unroll
                        for (int i = 0; i < 4; ++i) { g[i] = fminf(g[i], 7.0f); up[i] = __builtin_amdgcn_fmed3f(up[i], -7.0f * F8S_ACT, 7.0f * F8S_ACT); }
                        f32x4 e = g * (-1.702f * 1.4426950408889634f);
#pragma unroll
                        for (int i = 0; i < 4; ++i) e[i] = __builtin_amdgcn_exp2f(e[i]);
                        e = e + 1.0f;
#pragma unroll
                        for (int i = 0; i < 4; ++i) e[i] = __builtin_amdgcn_rcpf(e[i]);
                        const f32x4 y = (up + (float)F8S_ACT) * g * e;
                        wd[n] = pk4_fp8_nc(y[0], y[1], y[2], y[3]); }
                    wq[m & 1][0] = wd[0]; wq[m & 1][1] = wd[1];
                    if (m & 1) {
                        const auto s0 = __builtin_amdgcn_permlane32_swap(wq[0][0], wq[1][0], false, false), s1 = __builtin_amdgcn_permlane32_swap(wq[0][1], wq[1][1], false, false);
                        const int rr = ai * HALF + wr * 64 + (m - 1 + hi) * 16 + fr;
                        u32x4 w; w.x = s0[0]; w.y = s1[0]; w.z = s0[1]; w.w = s1[1];
                        *(u32x4*)((unsigned char*)O + (size_t)(u.slot0 + u.m0 + rr) * DE + colw) = w; } }
        } else {
#pragma unroll
        for (int ai = 0; ai < 2; ++ai)
#pragma unroll
            for (int m = 0; m < 4; ++m) { const int r = ai * HALF + wr * 64 + m * 16 + fr;
                { float y[8]; const float rs = aux[256 + r];
#pragma unroll
                    for (int n = 0; n < 2; ++n)
#pragma unroll
                        for (int i = 0; i < 4; ++i) {
                            float g = acc[ai][0][m][n][i] * rs + (n ? g1[i] : g0[i]), up = acc[ai][1][m][n][i] * rs + (n ? u1[i] : u0[i]);
                            g = fminf(g, 7.0f); up = fminf(fmaxf(up, -7.0f), 7.0f); y[n * 4 + i] = (up + 1.0f) * g * __builtin_amdgcn_rcpf(1.0f + __expf(-1.702f * g)); }
                    u32x4 w; w.x = cvt_pk_bf16(y[0], y[1]); w.y = cvt_pk_bf16(y[2], y[3]); w.z = cvt_pk_bf16(y[4], y[5]); w.w = cvt_pk_bf16(y[6], y[7]);
                    *(u32x4*)(O + (size_t)(u.slot0 + u.m0 + r) * DE + colj) = w; } }
        }
    }
};
struct EpiDown {
    static constexpr bool PERM = true, AUX = true, COLMAP = (MOE_FP8 != 0);
    bf16* O; const float* bd; const float* roww;
    __device__ __forceinline__ const float* aux_src(const Unit& u, int idx) const {
        if (idx < 256) return bd + (size_t)u.e * D + u.pn * BM + (MOE_FP8 ? (((idx >> 5) & 3) * 64 + ((idx >> 3) & 3) * 16 + (idx >> 7) * 8 + (idx & 7)) : idx);
        int m = u.m0 + (idx - 256); m = m < u.count ? m : u.count - 1; return roww + (size_t)u.e * T + m; }
    __device__ __forceinline__ void operator()(const Acc& acc, const Unit& u, int wr, int wc, int fr, int fq, const LAS float* aux) const {
        const int col0 = u.pn * BM + wc * 32 + 8 * fq;
        const LAS float* bp = aux + wc * 32 + 8 * fq;
        f32x4 bv[2][2];
#pragma unroll
        for (int bj = 0; bj < 2; ++bj)
#pragma unroll
            for (int n = 0; n < 2; ++n) bv[bj][n] = *(const LAS f32x4*)(bp + bj * HALF + 4 * n);
        if constexpr (MOE_FP8 != 0) {
            const int colg = u.pn * BM + wc * 64 + fq * 16;
#pragma unroll
            for (int ai = 0; ai < 2; ++ai)
#pragma unroll
                for (int m = 0; m < 4; ++m) { const int r = ai * HALF + wr * 64 + m * 16 + fr;
                    const float w8 = aux[256 + r], wy = w8 * (float)F8S_Y, wa = wy * (1.0f / (F8S_ACT * F8S_W));
                    u32x4 w;
#pragma unroll
                    for (int bj = 0; bj < 2; ++bj) { const f32x4 v0 = acc[ai][bj][m][0] * wa + bv[bj][0] * wy, v1 = acc[ai][bj][m][1] * wa + bv[bj][1] * wy;
                        w[2 * bj] = pk4_fp8(v0[0], v0[1], v0[2], v0[3]); w[2 * bj + 1] = pk4_fp8(v1[0], v1[1], v1[2], v1[3]); }
                    *(u32x4*)((unsigned char*)O + (size_t)(u.slot0 + u.m0 + r) * D + colg) = w; }
        } else {
#pragma unroll
        for (int ai = 0; ai < 2; ++ai)
#pragma unroll
            for (int m = 0; m < 4; ++m) { const int r = ai * HALF + wr * 64 + m * 16 + fr;
                { const float w8 = aux[256 + r]; bf16* rowp = O + (size_t)(u.slot0 + u.m0 + r) * D + col0;
#pragma unroll
                    for (int bj = 0; bj < 2; ++bj) { constexpr float isc = MOE_FP8 ? 1.0f / (F8S_ACT * F8S_W) : 1.0f;
                        if (MOE_FP8) { const float wy = w8 * (float)F8S_Y, wa = wy * isc;
                            const f32x4 v0 = acc[ai][bj][m][0] * wa + bv[bj][0] * wy, v1 = acc[ai][bj][m][1] * wa + bv[bj][1] * wy;
                            uint2 w; w.x = pk4_fp8(v0[0], v0[1], v0[2], v0[3]); w.y = pk4_fp8(v1[0], v1[1], v1[2], v1[3]);
                            *(uint2*)((unsigned char*)O + (size_t)(u.slot0 + u.m0 + r) * D + col0 + bj * HALF) = w; continue; }
                        const f32x4 v0 = (acc[ai][bj][m][0] * isc + bv[bj][0]) * w8, v1 = (acc[ai][bj][m][1] * isc + bv[bj][1]) * w8;
                        if (MOE_FP8) { }
                        else { u32x4 w; w.x = cvt_pk_bf16(v0[0], v0[1]); w.y = cvt_pk_bf16(v0[2], v0[3]); w.z = cvt_pk_bf16(v1[0], v1[1]); w.w = cvt_pk_bf16(v1[2], v1[3]);
                            *(u32x4*)(rowp + bj * HALF) = w; } } } }
        }
    }
};

typedef int i32x4 __attribute__((ext_vector_type(4)));
typedef int i32x8 __attribute__((ext_vector_type(8)));
template <class E, class = void> struct epi_fqswap { static constexpr bool value = false; };
template <class E> struct epi_fqswap<E, decltype((void)E::FQSWAP)> { static constexpr bool value = E::FQSWAP; };
template <class E, class = void> struct epi_colmap { static constexpr bool value = false; };
template <class E> struct epi_colmap<E, decltype((void)E::COLMAP)> { static constexpr bool value = E::COLMAP; };
template <bool F8 = false, class Epi, class Sched>
__device__ __forceinline__ void gemm_phase(LAS unsigned char* lds, LAS unsigned char* aux, const char* gA, const char* gB, int K, const Sched& S, const Epi& E, const int krep = 1) {
    const int tid = opaque_tid(), wid = __builtin_amdgcn_readfirstlane(tid >> 6), lane = tid & 63, wr = wid >> 2, wc = wid & 3, fr = lane & 15, fq = lane >> 4;
    const int nt = K / BK;
    unsigned voffB[2];
#pragma unroll
    for (int i = 0; i < 2; ++i) { int R, C; stage_rc(tid * 16 + i * 8192, R, C); int Rb = Epi::PERM ? ((R & ~31) + perm32(R & 31)) : R;
        if constexpr (epi_fqswap<Epi>::value) Rb = (Rb & ~31) + (((Rb >> 4) & 1) + ((Rb >> 3) & 1) * 2) * 8 + (Rb & 7);
        if constexpr (epi_colmap<Epi>::value) Rb = ((Rb >> 5) & 3) * 64 + ((Rb >> 3) & 3) * 16 + (Rb & 7);
        voffB[i] = (unsigned)(Rb * K + C) * 2u; }
#define PG8_AOFFS(U, o0, o1) do { int t_ = tid; asm volatile("" : "+v"(t_)); _Pragma("unroll") for (int i = 0; i < 2; ++i) { int R, C; stage_rc(t_ * 16 + i * 8192, R, C); \
        o0[i] = S.a_off(U, R) + (unsigned)C * 2u; o1[i] = S.a_off(U, HALF + R) + (unsigned)C * 2u; } } while (0)
    const size_t hstep = (size_t)(epi_colmap<Epi>::value ? 8 : HALF) * K * 2;
    const unsigned ldsw = (unsigned)wid * 1024u;
    const int aoff = lds_byte(wr * 64 + fr, fq * 8), boff = lds_byte(wc * 32 + fr, fq * 8);
#define PG8_SA(b, h) (((b) * 2 + (h)) * HTB)
#define PG8_SB(b, h) ((4 + (b) * 2 + (h)) * HTB)
#define PG8_STAGEB(bufoff, gbase) do { _Pragma("unroll") for (int _i = 0; _i < 2; ++_i) { unsigned _o = voffB[_i]; asm volatile("" : "+v"(_o)); \
        __builtin_amdgcn_global_load_lds((const unsigned*)((const char*)(gbase) + _o), (LAS unsigned*)(lds + (bufoff) + ldsw + _i * 8192), 16, 0, 0); } } while (0)
#define PG8_STAGEA(bufoff, voff2, kb) do { _Pragma("unroll") for (int _i = 0; _i < 2; ++_i) { unsigned _o = (voff2)[_i]; asm volatile("" : "+v"(_o)); \
        __builtin_amdgcn_global_load_lds((const unsigned*)((gA + (size_t)(kb)) + _o), (LAS unsigned*)(lds + (bufoff) + ldsw + _i * 8192), 16, 0, 0); } } while (0)
#define PG8_LD8(p) __builtin_shufflevector(*(const LAS i32x4*)(p), *(const LAS i32x4*)((p) + 1024), 0, 1, 2, 3, 4, 5, 6, 7)
#define PG8_LDA(dst, b, h) do { _Pragma("unroll") for (int m = 0; m < 4; ++m) dst[m] = PG8_LD8(lds + PG8_SA(b, h) + aoff + m * 2048); } while (0)
#define PG8_LDB(dst, b, h) do { _Pragma("unroll") for (int n = 0; n < 2; ++n) dst[n] = PG8_LD8(lds + PG8_SB(b, h) + boff + n * 2048); } while (0)
#define PG8_LO(x) __builtin_bit_cast(bf16x8, __builtin_shufflevector(x, x, 0, 1, 2, 3))
#define PG8_HI(x) __builtin_bit_cast(bf16x8, __builtin_shufflevector(x, x, 4, 5, 6, 7))
#define PG8_MMA(ai, bj, At, Bt) do { if constexpr (F8) __builtin_amdgcn_sched_barrier(0); __builtin_amdgcn_s_setprio(1); _Pragma("unroll") for (int m = 0; m < 4; ++m) _Pragma("unroll") for (int n = 0; n < 2; ++n) { \
        if constexpr (F8) asm volatile("v_mfma_scale_f32_16x16x128_f8f6f4 %0, %1, %2, %0, %3, %3 op_sel_hi:[0,0,0]" : "+v"(acc[ai][bj][m][n]) : "v"(Bt[n]), "v"(At[m]), "v"(f8scale)); \
        else { acc[ai][bj][m][n] = __builtin_amdgcn_mfma_f32_16x16x32_bf16(PG8_LO(Bt[n]), PG8_LO(At[m]), acc[ai][bj][m][n], 0, 0, 0); \
               acc[ai][bj][m][n] = __builtin_amdgcn_mfma_f32_16x16x32_bf16(PG8_HI(Bt[n]), PG8_HI(At[m]), acc[ai][bj][m][n], 0, 0, 0); } } \
        __builtin_amdgcn_s_setprio(0); if constexpr (F8) __builtin_amdgcn_sched_barrier(0); } while (0)
#define PG8_WAIT_V(n) asm volatile("s_waitcnt vmcnt(" #n ")" ::: "memory")
#define PG8_WAIT_L(n) asm volatile("s_waitcnt lgkmcnt(" #n ")" ::: "memory")
#define PG8_BAR __builtin_amdgcn_s_barrier()
#define PG8_SCHED __builtin_amdgcn_sched_barrier(0)
    Unit cur, nxt; int ui = 0;
    if (!S.next(0, cur)) return;
    Acc acc;
#pragma unroll
    for (int a = 0; a < 2; ++a)
#pragma unroll
        for (int b = 0; b < 2; ++b)
#pragma unroll
            for (int m = 0; m < 4; ++m)
#pragma unroll
                for (int n = 0; n < 2; ++n) acc[a][b][m][n] = (f32x4){0.f, 0.f, 0.f, 0.f};
    i32x8 At[4], B0[2], B1[2];
    int f8scale = 0x7F7F7F7F; asm volatile("" : "+v"(f8scale));
    unsigned cA0[2], cA1[2];
#define PG8_DMA4(src, dstoff) __builtin_amdgcn_global_load_lds((const unsigned*)(src), (LAS unsigned*)(aux + (dstoff) + wid * 256), 4, 0, 0)
#define PG8_SIDE_DMA(U, UI) do { if constexpr (Sched::GATHER) { int t_ = tid; asm volatile("" : "+v"(t_)); _Pragma("unroll") for (int p = 0; p < 4; ++p) { int R, C; stage_rc(t_ * 16 + (p & 1) * 8192, R, C); \
            PG8_DMA4(S.row_src(U, (p >> 1) * HALF + R), AUX_ROWTAB + p * 2048); } } \
        if constexpr (Epi::AUX) PG8_DMA4(E.aux_src(U, wid * 64 + lane), AUX_SLOTS + ((UI) & 3) * AUX_SLOT_BYTES); } while (0)
    if constexpr (Epi::AUX) PG8_DMA4(E.aux_src(cur, wid * 64 + lane), AUX_SLOTS);
    PG8_AOFFS(cur, cA0, cA1);
    const char* cB = gB + S.b_off(cur);
    PG8_STAGEB(PG8_SB(0, 0), cB); PG8_STAGEB(PG8_SB(0, 1), cB + hstep); PG8_STAGEA(PG8_SA(0, 0), cA0, 0); PG8_STAGEA(PG8_SA(0, 1), cA1, 0);
    if (wr == 1) PG8_BAR;
    PG8_WAIT_V(2); PG8_BAR;
    PG8_STAGEB(PG8_SB(1, 0), cB + BK * 2); PG8_STAGEA(PG8_SA(1, 0), cA0, BK * 2); PG8_STAGEB(PG8_SB(1, 1), cB + hstep + BK * 2);
    PG8_WAIT_V(6); PG8_BAR;
    for (;;) {
        const bool has_next = S.next(ui + 1, nxt);
        const char* nB = cB;
        if (has_next) { PG8_SIDE_DMA(nxt, ui + 1); nB = gB + S.b_off(nxt); }
        unsigned a20[2], a21[2];
        for (int krep_i = 0; krep_i < krep; ++krep_i)
#pragma nounroll
        for (int t = 0; t < nt; t += 2) {
            const bool last = (t == nt - 2), lastx = last && (krep_i == krep - 1);
            const unsigned k1 = (unsigned)(t + 1) * (BK * 2), k2 = last ? 0u : (unsigned)(t + 2) * (BK * 2), k3 = k2 + BK * 2;
            if (lastx && has_next) {
                if constexpr (Sched::GATHER) { int t_ = tid; asm volatile("" : "+v"(t_));
#pragma unroll
                    for (int i = 0; i < 2; ++i) { int R, C; stage_rc(t_ * 16 + i * 8192, R, C);
                        a20[i] = *(volatile LAS unsigned*)(aux + AUX_ROWTAB + i * 2048 + t_ * 4) * (unsigned)(K * 2) + (unsigned)C * 2u;
                        a21[i] = *(volatile LAS unsigned*)(aux + AUX_ROWTAB + (2 + i) * 2048 + t_ * 4) * (unsigned)(K * 2) + (unsigned)C * 2u; } }
                else PG8_AOFFS(nxt, a20, a21);
            } else {
#pragma unroll
                for (int i = 0; i < 2; ++i) { a20[i] = cA0[i]; a21[i] = cA1[i]; }
            }
            const char* b2 = (lastx ? nB : cB) + k2; const char* b3 = b2 + BK * 2;
            PG8_LDB(B0, 0, 0); PG8_LDB(B1, 0, 1); PG8_SCHED; PG8_LDA(At, 0, 0); PG8_STAGEA(PG8_SA(1, 1), cA1, k1);
            PG8_WAIT_V(8); PG8_WAIT_L(0); PG8_BAR; PG8_MMA(0, 0, At, B0); PG8_MMA(0, 1, At, B1); PG8_BAR; PG8_SCHED;
            PG8_LDA(At, 0, 1); PG8_STAGEB(PG8_SB(0, 0), b2); PG8_STAGEB(PG8_SB(0, 1), b2 + hstep); PG8_STAGEA(PG8_SA(0, 0), a20, k2);
            PG8_WAIT_V(8); PG8_WAIT_L(0); PG8_BAR; PG8_MMA(1, 0, At, B0); PG8_MMA(1, 1, At, B1); PG8_BAR; PG8_SCHED;
            PG8_LDB(B0, 1, 0); PG8_LDB(B1, 1, 1); PG8_SCHED; PG8_LDA(At, 1, 0); PG8_STAGEA(PG8_SA(0, 1), a21, k2);
            PG8_WAIT_V(8); PG8_WAIT_L(0); PG8_BAR; PG8_MMA(0, 0, At, B0); PG8_MMA(0, 1, At, B1); PG8_BAR; PG8_SCHED;
            PG8_LDA(At, 1, 1); PG8_STAGEB(PG8_SB(1, 0), b3); PG8_STAGEB(PG8_SB(1, 1), b3 + hstep); PG8_STAGEA(PG8_SA(1, 0), a20, k3);
            PG8_WAIT_V(8); PG8_WAIT_L(0); PG8_BAR; PG8_MMA(1, 0, At, B0); PG8_MMA(1, 1, At, B1); PG8_BAR; PG8_SCHED;
        }
        if constexpr (F8) asm volatile("s_nop 15\n\ts_nop 15" ::: "memory");
        if (wr == 0) PG8_BAR;
        int t_e = threadIdx.x; asm volatile("" : "+v"(t_e));
        int fr_e = t_e & 15, fq_e = (t_e >> 4) & 3;
#pragma unroll
        for (int a = 0; a < 2; ++a)
#pragma unroll
            for (int b = 0; b < 2; ++b)
#pragma unroll
                for (int m = 0; m < 4; ++m)
#pragma unroll
                    for (int n = 0; n < 2; ++n) asm volatile("" : "+v"(acc[a][b][m][n]));
        E(acc, cur, wr, wc, fr_e, fq_e, (const LAS float*)(aux + AUX_SLOTS + (ui & 3) * AUX_SLOT_BYTES));
        if (PROBE_REPEAT == 30) { asm volatile("" : "+v"(t_e)); E(acc, cur, wr, wc, t_e & 15, (t_e >> 4) & 3, (const LAS float*)(aux + AUX_SLOTS + (ui & 3) * AUX_SLOT_BYTES)); }
        if (!has_next) break;
#pragma unroll
        for (int a = 0; a < 2; ++a)
#pragma unroll
            for (int b = 0; b < 2; ++b)
#pragma unroll
                for (int m = 0; m < 4; ++m)
#pragma unroll
                    for (int n = 0; n < 2; ++n) acc[a][b][m][n] = (f32x4){0.f, 0.f, 0.f, 0.f};
        cur = nxt; cB = nB; ++ui;
#pragma unroll
        for (int i = 0; i < 2; ++i) { cA0[i] = a20[i]; cA1[i] = a21[i]; }
        if (wr == 1) PG8_BAR;
    }
    PG8_WAIT_V(0);
    PG8_BAR;
#undef PG8_SA
#undef PG8_SB
#undef PG8_STAGEA
#undef PG8_AOFFS
#undef PG8_DMA4
#undef PG8_SIDE_DMA
#undef PG8_STAGEB
#undef PG8_LDA
#undef PG8_LDB
#undef PG8_MMA
#undef PG8_LD8
#undef PG8_LO
#undef PG8_HI
#undef PG8_WAIT_V
#undef PG8_WAIT_L
#undef PG8_BAR
#undef PG8_SCHED
}
}


typedef float f32x16 __attribute__((ext_vector_type(16)));
typedef short bf16x4 __attribute__((ext_vector_type(4)));
typedef unsigned u32x2 __attribute__((ext_vector_type(2)));
typedef float f32x2_t __attribute__((ext_vector_type(2)));
typedef __bf16 bf16x2_t __attribute__((ext_vector_type(2)));
__device__ __forceinline__ unsigned cvtpk(float lo, float hi) { const f32x2_t v = {lo, hi}; const bf16x2_t b = __builtin_convertvector(v, bf16x2_t); return __builtin_bit_cast(unsigned, b); }
template <int S8> __device__ __forceinline__ bf16x8 pack8(const f32x16& X) {
    u32x4 w; w.x = cvtpk(X[8 * S8 + 0], X[8 * S8 + 1]); w.y = cvtpk(X[8 * S8 + 2], X[8 * S8 + 3]); w.z = cvtpk(X[8 * S8 + 4], X[8 * S8 + 5]); w.w = cvtpk(X[8 * S8 + 6], X[8 * S8 + 7]);
    return __builtin_bit_cast(bf16x8, w);
}
__device__ __forceinline__ bf16x8 lds_b128(const LAS unsigned char* p) { return *(const LAS bf16x8*)p; }
__device__ __forceinline__ bf16x8 lds_2xb64(const LAS unsigned char* p) {
    const bf16x4 a = *(const LAS bf16x4*)p, b = *(const LAS bf16x4*)(p + 16);
    return __builtin_shufflevector(a, b, 0, 1, 2, 3, 4, 5, 6, 7);
}
__device__ __forceinline__ float fast_log_sigmoid(float x) { return fminf(x, 0.0f) - __logf(1.0f + __expf(-fabsf(x))); }

constexpr int GP = 144;
constexpr int GS_QD = 0, GS_KI = GS_QD + 64 * GP, GS_KET = GS_KI + 64 * GP, GS_VT = GS_KET + 64 * GP, GS_DEC = GS_VT + 128 * GP, GS_SIZE = GS_DEC + 256;
constexpr int GL_SSP = 2 * GS_SIZE, GL_CONST = GL_SSP + 1024, GL_OT = GL_CONST + 1024;
constexpr int OTP = 132;
constexpr int GL_END = GL_OT + 64 * OTP * 4;
static_assert(GL_END <= RING_BYTES && (GL_OT % 16) == 0 && (GS_SIZE % 16) == 0 && (GS_DEC % 16) == 0, "gla lds");

template <int V> struct IntC { static constexpr int value = V; };
#define LDS_BARRIER() do { asm volatile("s_waitcnt lgkmcnt(0)" ::: "memory"); __builtin_amdgcn_s_barrier(); asm volatile("" ::: "memory"); } while (0)
__device__ __forceinline__ void gla_item(const Ptrs& P, LAS unsigned char* lds, int bh) {
    const int tid = opaque_tid(), lane = tid & 63, w = __builtin_amdgcn_readfirstlane(tid >> 6), l31 = lane & 31, hh = lane >> 5;
    const int b = bh >> 2, h = bh & 3;
    const bool grpA = w < 4; const int wa = w & 3;
    const bf16* PROJ = (const bf16*)(P.ws + WS_PROJ); bf16* MIX = (bf16*)(P.ws + WS_MIX);
    const size_t tok0 = (size_t)b * SEQ;
    const char* ub = (const char*)(PROJ + tok0 * NPROJ);
    const unsigned laneoff = (unsigned)lane * (NPROJ * 2);
    const int cq0 = PC_Q + h * 64 + 16 * wa, ck0 = PC_K + h * 64 + 16 * wa, cg0 = PC_GK + h * 64 + 16 * wa, cv0 = PC_V + h * 128 + 32 * wa;
    const int oc = tid >> 3, ov = (tid & 7) * 16;
    const unsigned gateoff = (unsigned)oc * (NPROJ * 2) + (unsigned)ov * 2;
#define GLA_LD(colel, chunk, lo) (*(const v4u*)(ub + ((size_t)(chunk) * 64 * NPROJ + (colel)) * 2 + (lo)))
    LAS float* cst = (LAS float*)(lds + GL_CONST);
    if (tid < 64) cst[tid] = P.b_gk[h * 64 + tid]; else if (tid < 192) cst[tid] = P.gla_norm_w[tid - 64];
    f32x16 S0, S1;
#pragma unroll
    for (int r = 0; r < 16; ++r) { S0[r] = 0.f; S1[r] = 0.f; }
    v4u pq[2][2], pk[2][2], pg[2][2], pv[4];
    if (grpA) {
#pragma unroll
        for (int s = 0; s < 2; ++s) { pq[0][s] = GLA_LD(cq0 + 8 * s, 0, laneoff); pk[0][s] = GLA_LD(ck0 + 8 * s, 0, laneoff); pg[0][s] = GLA_LD(cg0 + 8 * s, 0, laneoff); }
#pragma unroll
        for (int s = 0; s < 4; ++s) pv[s] = GLA_LD(cv0 + 8 * s, 0, laneoff);
    }
    __syncthreads();
#define GLA_STAGE_A(c, X, SLO, SHI, WITH_PRE, WITH_VT) do { \
        LAS unsigned char* set_ = lds + ((c) & 1) * GS_SIZE; \
        const v4u* cq_ = pq[X]; const v4u* ck_ = pk[X]; const v4u* cg_ = pg[X]; const v4u* cv_ = pv; \
        if (WITH_PRE) { const int nc_ = (c) + 1 < SEQ / 64 ? (c) + 1 : (c); \
          _Pragma("unroll") for (int s = 0; s < 2; ++s) { pq[1 - (X)][s] = GLA_LD(cq0 + 8 * s, nc_, laneoff); pk[1 - (X)][s] = GLA_LD(ck0 + 8 * s, nc_, laneoff); pg[1 - (X)][s] = GLA_LD(cg0 + 8 * s, nc_, laneoff); } } \
        _Pragma("unroll") for (int s = (SLO); s < (SHI); ++s) { \
            const int kc_ = 16 * wa + 8 * s; \
            const unsigned qw_[4] = {cq_[s].x, cq_[s].y, cq_[s].z, cq_[s].w}, kw_[4] = {ck_[s].x, ck_[s].y, ck_[s].z, ck_[s].w}, gw_[4] = {cg_[s].x, cg_[s].y, cg_[s].z, cg_[s].w}; \
            const f32x4 bg0_ = *(const LAS f32x4*)(cst + kc_), bg1_ = *(const LAS f32x4*)(cst + kc_ + 4); \
            float bb_[8];                                   \
            _Pragma("unroll") for (int j = 0; j < 8; ++j) { const float x_ = bf2f((gw_[j >> 1] >> (16 * (j & 1))) & 0xffffu) + (j < 4 ? bg0_[j & 3] : bg1_[j & 3]); \
                const float l2_ = __builtin_amdgcn_logf(1.0f + __builtin_amdgcn_exp2f(fabsf(x_) * -1.4426950408889634f));     \
                bb_[j] = wave_incl_scan(fminf(x_, 0.0f) * (1.4426950408889634f / 16.0f) - l2_ * (1.0f / 16.0f)); } \
            float qd_[8], ki_[8], ke_[8]; \
            _Pragma("unroll") for (int j = 0; j < 8; ++j) { \
                const float e_ = __builtin_amdgcn_exp2f(bb_[j]), ie_ = __builtin_amdgcn_exp2f(-bb_[j]); \
                const float dec_ = __builtin_bit_cast(float, __builtin_amdgcn_readlane(__builtin_bit_cast(int, e_), 63));     \
                const float qv_ = bf2f((qw_[j >> 1] >> (16 * (j & 1))) & 0xffffu), kv_ = bf2f((kw_[j >> 1] >> (16 * (j & 1))) & 0xffffu); \
                qd_[j] = qv_ * (e_ * 0.125f); ki_[j] = kv_ * ie_; ke_[j] = ki_[j] * dec_; \
                if (lane == 63) *(LAS float*)(set_ + GS_DEC + (kc_ + j) * 4) = e_; } \
            u32x4 t_; t_.x = cvtpk(qd_[0], qd_[1]); t_.y = cvtpk(qd_[2], qd_[3]); t_.z = cvtpk(qd_[4], qd_[5]); t_.w = cvtpk(qd_[6], qd_[7]); \
            *(LAS u32x4*)(set_ + GS_QD + lane * GP + kc_ * 2) = t_; \
            t_.x = cvtpk(ki_[0], ki_[1]); t_.y = cvtpk(ki_[2], ki_[3]); t_.z = cvtpk(ki_[4], ki_[5]); t_.w = cvtpk(ki_[6], ki_[7]); \
            *(LAS u32x4*)(set_ + GS_KI + lane * GP + kc_ * 2) = t_; \
            _Pragma("unroll") for (int j = 0; j < 4; ++j) { const unsigned pk_ = cvtpk(ke_[2 * j], ke_[2 * j + 1]); \
                *(LAS unsigned short*)(set_ + GS_KET + (kc_ + 2 * j) * GP + lane * 2) = (unsigned short)(pk_ & 0xffffu); *(LAS unsigned short*)(set_ + GS_KET + (kc_ + 2 * j + 1) * GP + lane * 2) = (unsigned short)(pk_ >> 16); } } \
        if (WITH_VT) _Pragma("unroll") for (int s = 0; s < 4; ++s) { const unsigned vw_[4] = {cv_[s].x, cv_[s].y, cv_[s].z, cv_[s].w}; \
            _Pragma("unroll") for (int j = 0; j < 8; ++j) *(LAS unsigned short*)(set_ + GS_VT + (32 * wa + 8 * s + j) * GP + lane * 2) = (unsigned short)((vw_[j >> 1] >> (16 * (j & 1))) & 0xffffu); } \
        if (WITH_VT) { const int nc_ = (c) + 1 < SEQ / 64 ? (c) + 1 : (c);     \
          _Pragma("unroll") for (int s = 0; s < 4; ++s) pv[s] = GLA_LD(cv0 + 8 * s, nc_, laneoff); } \
    } while (0)
    unsigned zcar = 0u;
#define GLA_ZCAR(X) do { zcar = pq[X][0].x | pq[X][1].x | pk[X][0].x | pk[X][1].x | pg[X][0].x | pg[X][1].x; asm volatile("v_and_b32 %0, 0, %0" : "+v"(zcar) :: "memory"); } while (0)
    const unsigned gateoffa = (unsigned)(tid >> 2) * (NPROJ * 2) + (unsigned)((tid & 3) * 32) * 2;
    v4u gq[4];
#define GLA_GATE_LD(nn) do { const int gn_ = (nn) < SEQ / 64 ? (nn) : SEQ / 64 - 1; _Pragma("unroll") for (int s_ = 0; s_ < 4; ++s_) gq[s_] = GLA_LD(PC_G + h * 128 + 8 * s_, gn_, gateoffa); } while (0)
#define GLA_GATE_PARK() do { _Pragma("unroll") for (int s_ = 0; s_ < 4; ++s_) *(LAS v4u*)(lds + AUX_OFF + tid * 64 + s_ * 16) = gq[s_]; } while (0)
    if (grpA) { GLA_GATE_LD(0); GLA_ZCAR(0); GLA_STAGE_A(0, 0, 0, 2, 1, 1); GLA_ZCAR(1); GLA_STAGE_A(1, 1, 0, 2, 1, 1); GLA_GATE_PARK(); GLA_GATE_LD(1); }
    LDS_BARRIER();
    static_assert((SEQ / 64) % 2 == 0, "chunk pairs");
    if (grpA) {
        auto a_chunk = [&](const int n, auto xt_) __attribute__((always_inline)) {
            constexpr int X = decltype(xt_)::value;
            LDS_BARRIER();
            if (n + 2 < SEQ / 64) { GLA_ZCAR(X); GLA_STAGE_A(n + 2, X, 0, 1, 1, 0); }
            LDS_BARRIER();
            if (n + 2 < SEQ / 64) GLA_STAGE_A(n + 2, X, 1, 2, 0, 1);
            GLA_GATE_PARK();
            GLA_GATE_LD(n + 2);
        };
#pragma nounroll
        for (int n = 0; n < SEQ / 64; n += 2) { a_chunk(n, IntC<0>{}); a_chunk(n + 1, IntC<1>{}); }
    } else {
        const int tm = tid - 256, ocm = tm >> 2, ovm = (tm & 3) * 32;
        auto m_chunk = [&](const int n) __attribute__((always_inline)) {
            const LAS unsigned char* set = lds + (n & 1) * GS_SIZE;
            const int vc = wa;
            f32x16 O0, O1;
#pragma unroll
            for (int r = 0; r < 16; ++r) { O0[r] = 0.f; O1[r] = 0.f; }
            {
                const bf16x8 s00 = pack8<0>(S0), s01 = pack8<1>(S0), s10 = pack8<0>(S1), s11 = pack8<1>(S1);
                const LAS unsigned char* q0 = set + GS_QD + l31 * GP + 8 * hh; const LAS unsigned char* q1 = q0 + 32 * GP;
                const bf16x8 a0 = lds_2xb64(q0), a1 = lds_2xb64(q0 + 32), a2 = lds_2xb64(q0 + 64), a3 = lds_2xb64(q0 + 96);
                const bf16x8 b0 = lds_2xb64(q1), b1 = lds_2xb64(q1 + 32), b2 = lds_2xb64(q1 + 64), b3 = lds_2xb64(q1 + 96);
                O0 = __builtin_amdgcn_mfma_f32_32x32x16_bf16(s00, a0, O0, 0, 0, 0); O1 = __builtin_amdgcn_mfma_f32_32x32x16_bf16(s00, b0, O1, 0, 0, 0);
                O0 = __builtin_amdgcn_mfma_f32_32x32x16_bf16(s01, a1, O0, 0, 0, 0); O1 = __builtin_amdgcn_mfma_f32_32x32x16_bf16(s01, b1, O1, 0, 0, 0);
                O0 = __builtin_amdgcn_mfma_f32_32x32x16_bf16(s10, a2, O0, 0, 0, 0); O1 = __builtin_amdgcn_mfma_f32_32x32x16_bf16(s10, b2, O1, 0, 0, 0);
                O0 = __builtin_amdgcn_mfma_f32_32x32x16_bf16(s11, a3, O0, 0, 0, 0); O1 = __builtin_amdgcn_mfma_f32_32x32x16_bf16(s11, b3, O1, 0, 0, 0);
            }
            {
                const LAS unsigned char* kA0 = set + GS_KI + l31 * GP + 16 * hh; const LAS unsigned char* kA1 = kA0 + 32 * GP;
                const LAS unsigned char* qB0 = set + GS_QD + l31 * GP + 16 * hh; const LAS unsigned char* qB1 = qB0 + 32 * GP;
                const LAS unsigned char* vrow = set + GS_VT + (vc * 32 + l31) * GP + 8 * hh;
                bf16x8 fa[4], fb[4];
                f32x16 X;
#pragma unroll
                for (int kk = 0; kk < 4; ++kk) { fa[kk] = lds_b128(kA0 + 32 * kk); fb[kk] = lds_b128(qB0 + 32 * kk); }
                const bf16x8 v0 = lds_2xb64(vrow), v1 = lds_2xb64(vrow + 32);
#pragma unroll
                for (int r = 0; r < 16; ++r) X[r] = 0.f;
#pragma unroll
                for (int kk = 0; kk < 4; ++kk) X = __builtin_amdgcn_mfma_f32_32x32x16_bf16(fa[kk], fb[kk], X, 0, 0, 0);
#pragma unroll
                for (int kk = 0; kk < 4; ++kk) fb[kk] = lds_b128(qB1 + 32 * kk);
#pragma unroll
                for (int r = 0; r < 16; ++r) { const int srow = (r & 3) + 8 * (r >> 2) + 4 * hh; X[r] = (srow <= l31) ? X[r] : 0.f; }
                O0 = __builtin_amdgcn_mfma_f32_32x32x16_bf16(v0, pack8<0>(X), O0, 0, 0, 0); O0 = __builtin_amdgcn_mfma_f32_32x32x16_bf16(v1, pack8<1>(X), O0, 0, 0, 0);
#pragma unroll
                for (int r = 0; r < 16; ++r) X[r] = 0.f;
#pragma unroll
                for (int kk = 0; kk < 4; ++kk) X = __builtin_amdgcn_mfma_f32_32x32x16_bf16(fa[kk], fb[kk], X, 0, 0, 0);
#pragma unroll
                for (int kk = 0; kk < 4; ++kk) fa[kk] = lds_b128(kA1 + 32 * kk);
                O1 = __builtin_amdgcn_mfma_f32_32x32x16_bf16(v0, pack8<0>(X), O1, 0, 0, 0); O1 = __builtin_amdgcn_mfma_f32_32x32x16_bf16(v1, pack8<1>(X), O1, 0, 0, 0);
                const bf16x8 v2 = lds_2xb64(vrow + 64), v3 = lds_2xb64(vrow + 96);
#pragma unroll
                for (int r = 0; r < 16; ++r) X[r] = 0.f;
#pragma unroll
                for (int kk = 0; kk < 4; ++kk) X = __builtin_amdgcn_mfma_f32_32x32x16_bf16(fa[kk], fb[kk], X, 0, 0, 0);
#pragma unroll
                for (int r = 0; r < 16; ++r) { const int srow = (r & 3) + 8 * (r >> 2) + 4 * hh; X[r] = (srow <= l31) ? X[r] : 0.f; }
                O1 = __builtin_amdgcn_mfma_f32_32x32x16_bf16(v2, pack8<0>(X), O1, 0, 0, 0); O1 = __builtin_amdgcn_mfma_f32_32x32x16_bf16(v3, pack8<1>(X), O1, 0, 0, 0);
            }
            {
                const LAS float* dec = (const LAS float*)(set + GS_DEC);
                const LAS unsigned char* ka0 = set + GS_KET + l31 * GP + 16 * hh; const LAS unsigned char* ka1 = ka0 + 32 * GP;
                const LAS unsigned char* vb = set + GS_VT + (vc * 32 + l31) * GP + 16 * hh;
                bf16x8 e0[4], e1[4], vv[4];
#pragma unroll
                for (int ss = 0; ss < 4; ++ss) { e0[ss] = lds_b128(ka0 + 32 * ss); e1[ss] = lds_b128(ka1 + 32 * ss); vv[ss] = lds_b128(vb + 32 * ss); }
#pragma unroll
                for (int g4 = 0; g4 < 4; ++g4) { const f32x4 d0 = *(const LAS f32x4*)(dec + 8 * g4 + 4 * hh), d1 = *(const LAS f32x4*)(dec + 32 + 8 * g4 + 4 * hh);
#pragma unroll
                    for (int i = 0; i < 4; ++i) { S0[4 * g4 + i] *= d0[i]; S1[4 * g4 + i] *= d1[i]; } }
#pragma unroll
                for (int ss = 0; ss < 4; ++ss) { S0 = __builtin_amdgcn_mfma_f32_32x32x16_bf16(e0[ss], vv[ss], S0, 0, 0, 0); S1 = __builtin_amdgcn_mfma_f32_32x32x16_bf16(e1[ss], vv[ss], S1, 0, 0, 0); }
            }
            {
                float q0 = 0.f, q1 = 0.f;
#pragma unroll
                for (int r = 0; r < 16; ++r) { q0 += O0[r] * O0[r]; q1 += O1[r] * O1[r]; }
                q0 += __shfl_xor(q0, 32); q1 += __shfl_xor(q1, 32);
                if (hh == 0) { *(LAS float*)(lds + GL_SSP + (vc * 64 + l31) * 4) = q0; *(LAS float*)(lds + GL_SSP + (vc * 64 + 32 + l31) * 4) = q1; }
                LAS float* ot0 = (LAS float*)(lds + GL_OT) + l31 * OTP + vc * 32 + 4 * hh; LAS float* ot1 = ot0 + 32 * OTP;
#pragma unroll
                for (int g4 = 0; g4 < 4; ++g4) { *(LAS f32x4*)(ot0 + 8 * g4) = (f32x4){O0[4 * g4], O0[4 * g4 + 1], O0[4 * g4 + 2], O0[4 * g4 + 3]};
                    *(LAS f32x4*)(ot1 + 8 * g4) = (f32x4){O1[4 * g4], O1[4 * g4 + 1], O1[4 * g4 + 2], O1[4 * g4 + 3]}; }
            }
            LDS_BARRIER();
            {
                const LAS float* ssp = (const LAS float*)(lds + GL_SSP) + ocm;
                const float tot = (ssp[0] + ssp[64]) + (ssp[128] + ssp[192]);
                const float rstd = 1.0f / sqrtf(tot * (1.0f / 128.0f) + EPS);
                const LAS float* ot = (const LAS float*)(lds + GL_OT) + ocm * OTP + ovm;
                const LAS float* nwp = cst + 64 + ovm;
#pragma unroll
                for (int hq = 0; hq < 2; ++hq) {
                    const v4u ga = *(const LAS v4u*)(lds + AUX_OFF + tm * 64 + hq * 32), gb = *(const LAS v4u*)(lds + AUX_OFF + tm * 64 + hq * 32 + 16);
                    const unsigned gw[8] = {ga.x, ga.y, ga.z, ga.w, gb.x, gb.y, gb.z, gb.w};
                    float y[16];
#pragma unroll
                    for (int q4 = 0; q4 < 4; ++q4) { const f32x4 o4 = *(const LAS f32x4*)(ot + 16 * hq + 4 * q4), n4 = *(const LAS f32x4*)(nwp + 16 * hq + 4 * q4);
#pragma unroll
                        for (int i = 0; i < 4; ++i) { const int j = 4 * q4 + i; const float gv = bf2f((gw[j >> 1] >> (16 * (j & 1))) & 0xffffu); y[j] = o4[i] * rstd * n4[i] * gv * __builtin_amdgcn_rcpf(1.0f + __expf(-gv)); } }
                    if (OUT_FP8) { unsigned char* orow = (unsigned char*)MIX + (tok0 + (size_t)n * 64 + ocm) * D + h * 128 + ovm + 16 * hq; u32x4 t8;
                        t8.x = pk4_fp8(y[0] * F8S_H, y[1] * F8S_H, y[2] * F8S_H, y[3] * F8S_H); t8.y = pk4_fp8(y[4] * F8S_H, y[5] * F8S_H, y[6] * F8S_H, y[7] * F8S_H);
                        t8.z = pk4_fp8(y[8] * F8S_H, y[9] * F8S_H, y[10] * F8S_H, y[11] * F8S_H); t8.w = pk4_fp8(y[12] * F8S_H, y[13] * F8S_H, y[14] * F8S_H, y[15] * F8S_H);
                        *(u32x4*)orow = t8; }
                    else { bf16* orow = MIX + (tok0 + (size_t)n * 64 + ocm) * D + h * 128 + ovm + 16 * hq; u32x4 t;
                        t.x = cvtpk(y[0], y[1]); t.y = cvtpk(y[2], y[3]); t.z = cvtpk(y[4], y[5]); t.w = cvtpk(y[6], y[7]); *(u32x4*)orow = t;
                        t.x = cvtpk(y[8], y[9]); t.y = cvtpk(y[10], y[11]); t.z = cvtpk(y[12], y[13]); t.w = cvtpk(y[14], y[15]); *(u32x4*)(orow + 8) = t; } }
            }
            LDS_BARRIER();
        };
#pragma nounroll
        for (int n = 0; n < SEQ / 64; ++n) m_chunk(n);
    }
#undef GLA_GATE_LD
#undef GLA_GATE_PARK
#undef GLA_STAGE_A
#undef GLA_ZCAR
#undef GLA_LD
}

constexpr int SP = 272;
constexpr int SG_W = 0, SG_VN = SG_W + 128 * SP, SG_OT = SG_VN + 128 * SP, SG_ST = SG_OT + 128 * SP, SG_LN = SG_ST + 1024, SG_END = SG_LN + 4096;
static_assert(SG_END <= RING_BYTES, "sgu lds");
__device__ __forceinline__ void sgu_item(const Ptrs& P, LAS unsigned char* lds, int bn) {
    const int tid = opaque_tid(), lane = tid & 63, w = __builtin_amdgcn_readfirstlane(tid >> 6), l31 = lane & 31, hh = lane >> 5;
    const bf16* PROJ = (const bf16*)(P.ws + WS_PROJ); bf16* MIX = (bf16*)(P.ws + WS_MIX); const bf16* Wsp = (const bf16*)(P.ws + WS_WSP);
    const size_t tok0 = (size_t)bn * 128;
    LAS float* st = (LAS float*)(lds + SG_ST);
    {
        v4u raws[16];
#pragma unroll
        for (int rr = 0; rr < 16; ++rr) raws[rr] = *(const v4u*)(PROJ + (tok0 + 16 * w + rr) * NPROJ + PC_VS + lane * 8);
#pragma unroll
        for (int rr = 0; rr < 16; ++rr) { const int row = 16 * w + rr; const unsigned rw[4] = {raws[rr].x, raws[rr].y, raws[rr].z, raws[rr].w};
            float s = 0.f, q = 0.f;
#pragma unroll
            for (int j = 0; j < 8; ++j) { const float g = gelu_tanh(bf2f((rw[j >> 1] >> (16 * (j & 1))) & 0xffffu)); s += g; q += g * g; }
            s = wave_sum(s); q = wave_sum(q);
            const float mu = s * (1.0f / 512.0f), var = fmaxf(q * (1.0f / 512.0f) - mu * mu, 0.f);
            if (lane == 0) { st[row] = mu; st[128 + row] = 1.0f / sqrtf(var + EPS); } }
    }
    const int s_ = tid & 127, c0_ = (tid >> 7) * 32;
    const int t_ = tid >> 2, cg_ = (tid & 3) * 32;
    if (tid < 256) *(LAS f32x4*)(lds + SG_LN + tid * 16) = (tid < 128) ? ((const f32x4*)P.sg_ln_w)[tid] : ((const f32x4*)P.sg_ln_b)[tid - 128];
    v4u vsr[4];
#pragma unroll
    for (int q4 = 0; q4 < 4; ++q4) vsr[q4] = *(const v4u*)(PROJ + (tok0 + s_) * NPROJ + PC_VS + c0_ + q4 * 8);
    __syncthreads();
    for (int g = 0; g < 4; ++g) {
#pragma unroll
        for (int ps = 0; ps < 4; ++ps) { const int idx = ps * NTHR + tid, row = idx >> 4, c16 = idx & 15;
            *(LAS v4u*)(lds + SG_W + row * SP + c16 * 16) = *(const v4u*)(Wsp + ((size_t)g * 128 + row) * 128 + c16 * 8); }
        { const float mu = st[s_], rs = st[128 + s_];
#pragma unroll
          for (int q4 = 0; q4 < 4; ++q4) { const int cb = c0_ + q4 * 8;
              const unsigned rw[4] = {vsr[q4].x, vsr[q4].y, vsr[q4].z, vsr[q4].w};
              const LAS float* lnw = (const LAS float*)(lds + SG_LN) + g * 128 + cb;
              const f32x4 lw0 = *(const LAS f32x4*)lnw, lw1 = *(const LAS f32x4*)(lnw + 4), lb0 = *(const LAS f32x4*)(lnw + 512), lb1 = *(const LAS f32x4*)(lnw + 516);
#pragma unroll
              for (int j = 0; j < 8; ++j) { const float gv = gelu_tanh(bf2f((rw[j >> 1] >> (16 * (j & 1))) & 0xffffu));
                  const float vn = (gv - mu) * rs * (j < 4 ? lw0[j & 3] : lw1[j & 3]) + (j < 4 ? lb0[j & 3] : lb1[j & 3]);
                  *(LAS unsigned short*)(lds + SG_VN + (cb + j) * SP + s_ * 2) = (unsigned short)f2bf(vn); } } }
        v4u ur[4];
#pragma unroll
        for (int q4 = 0; q4 < 4; ++q4) ur[q4] = *(const v4u*)(PROJ + (tok0 + t_) * NPROJ + PC_U + g * 128 + cg_ + q4 * 8);
        { const int gn = g < 3 ? g + 1 : g;
#pragma unroll
          for (int q4 = 0; q4 < 4; ++q4) vsr[q4] = *(const v4u*)(PROJ + (tok0 + s_) * NPROJ + PC_VS + gn * 128 + c0_ + q4 * 8); }
        LDS_BARRIER();
        { const int ct = w >> 1;
          const LAS unsigned char* arow = lds + SG_VN + (ct * 32 + l31) * SP + 16 * hh;
#pragma unroll
          for (int ti = 0; ti < 2; ++ti) { const int tt = (w & 1) * 2 + ti;
              const LAS unsigned char* brow = lds + SG_W + (tt * 32 + l31) * SP + 16 * hh;
              f32x16 acc;
#pragma unroll
              for (int r = 0; r < 16; ++r) acc[r] = 0.f;
              for (int ks = 0; ks < 2 * (tt + 1); ++ks) acc = __builtin_amdgcn_mfma_f32_32x32x16_bf16(lds_b128(arow + 32 * ks), lds_b128(brow + 32 * ks), acc, 0, 0, 0);
              const float bs = P.b_spatial[g * 128 + tt * 32 + l31];
              LAS unsigned char* orow = lds + SG_OT + (tt * 32 + l31) * SP + (ct * 32 + 4 * hh) * 2;
#pragma unroll
              for (int g4 = 0; g4 < 4; ++g4) { u32x2 pk; pk.x = cvtpk(acc[4 * g4] + bs, acc[4 * g4 + 1] + bs); pk.y = cvtpk(acc[4 * g4 + 2] + bs, acc[4 * g4 + 3] + bs); *(LAS u32x2*)(orow + 16 * g4) = pk; } } }
        LDS_BARRIER();
        {
          unsigned o8[8];
#pragma unroll
          for (int q4 = 0; q4 < 4; ++q4) { const v4u mx = *(const LAS v4u*)(lds + SG_OT + t_ * SP + (cg_ + q4 * 8) * 2);
              const unsigned mw[4] = {mx.x, mx.y, mx.z, mx.w}, uw[4] = {ur[q4].x, ur[q4].y, ur[q4].z, ur[q4].w}; unsigned ow[4]; float af[8];
#pragma unroll
              for (int j = 0; j < 4; ++j) { const float a0 = gelu_tanh(bf2f(uw[j] & 0xffffu)) * bf2f(mw[j] & 0xffffu), a1 = gelu_tanh(bf2f(uw[j] >> 16)) * bf2f(mw[j] >> 16); ow[j] = cvtpk(a0, a1); af[2 * j] = a0; af[2 * j + 1] = a1; }
              if (OUT_FP8) { o8[2 * q4] = pk4_fp8(af[0] * F8S_H, af[1] * F8S_H, af[2] * F8S_H, af[3] * F8S_H); o8[2 * q4 + 1] = pk4_fp8(af[4] * F8S_H, af[5] * F8S_H, af[6] * F8S_H, af[7] * F8S_H); }
              else *(v4u*)(MIX + (tok0 + t_) * D + 512 + g * 128 + cg_ + q4 * 8) = (v4u){ow[0], ow[1], ow[2], ow[3]}; }
          if (OUT_FP8) { unsigned char* mrow = (unsigned char*)MIX + (tok0 + t_) * D + 512 + g * 128 + cg_;
              *(v4u*)mrow = (v4u){o8[0], o8[1], o8[2], o8[3]}; *(v4u*)(mrow + 16) = (v4u){o8[4], o8[5], o8[6], o8[7]}; } }
    }
    __syncthreads();
}
constexpr int CW_CONVQ = 192;
constexpr int CONV_UNIT = 1;
struct WItem { const float* src; int ldn; unsigned char* wt; int d0, k0; };
__device__ __forceinline__ WItem moe_witem(const Ptrs& P, int it, int lane) {
    WItem w; const int sub = lane >> 5, col = lane & 31;
    if (it < IT_GU) { const int e = it / 1024, r = it % 1024, db = r / 16, kb = r % 16, d0 = db * 32, pn = d0 >> 8, bj = (d0 >> 7) & 1, rr = d0 & 127;
        w.ldn = 2048; w.src = P.w_gate_up + (size_t)e * D * 2048 + (size_t)(kb * 64 + sub) * 2048 + bj * 1024 + 128 * pn + rr + col; w.wt = (unsigned char*)(P.ws + WS_WGU) + (size_t)e * 2048 * D; w.d0 = d0; w.k0 = kb * 64; }
    else { it -= IT_GU; const int e = it / 512, r = it % 512, db = r / 16, kb = r % 16;
        w.ldn = D; w.src = P.w_down + (size_t)e * DE * D + (size_t)(kb * 64 + sub) * D + db * 32 + col; w.wt = (unsigned char*)(P.ws + WS_WD) + (size_t)e * D * DE; w.d0 = db * 32; w.k0 = kb * 64; }
    return w;
}
__device__ __forceinline__ void moe_weight_items(const Ptrs& P, unsigned char* lds_generic, int units_per_grab, int max_grabs) {
    const int tid_ = opaque_tid(), lane = tid_ & 63, wave = __builtin_amdgcn_readfirstlane(tid_ >> 6);
    float* scr = (float*)(lds_generic + wave * 16384);
    unsigned* q = (unsigned*)(P.ws + WS_CTL) + CW_CONVQ;
    constexpr unsigned NUNITS = (IT_GU + IT_DN) / CONV_UNIT;
    int grab = units_per_grab;
    for (int ng = 0; ng < max_grabs; ++ng) {
        unsigned c0 = 0; if (lane == 0) c0 = __hip_atomic_fetch_add(q, (unsigned)grab, RLX_AGENT);
        c0 = __builtin_amdgcn_readfirstlane(c0);
        if (c0 >= NUNITS) break;
        const unsigned c1 = (c0 + (unsigned)grab < NUNITS) ? c0 + (unsigned)grab : NUNITS;
        if (c1 >= NUNITS * 15 / 16) grab = 1; else if (c1 >= NUNITS * 3 / 4) grab = (grab < 4 ? grab : 4);
        const int it0 = (int)(c0 * CONV_UNIT), it1 = (int)(c1 * CONV_UNIT);
        float v[32]; WItem cur = moe_witem(P, it0, lane);
#pragma unroll
        for (int i = 0; i < 32; ++i) v[i] = __builtin_nontemporal_load(cur.src + (size_t)(2 * i) * cur.ldn);
#pragma nounroll
        for (int it = it0; it < it1; ++it) {
            float vn[32]; WItem nxt = cur;
            if (it + 1 < it1) { nxt = moe_witem(P, it + 1, lane);
#pragma unroll
                for (int i = 0; i < 32; ++i) vn[i] = __builtin_nontemporal_load(nxt.src + (size_t)(2 * i) * nxt.ldn); }
#pragma unroll
            for (int i = 0; i < 32; ++i) scr[(2 * i + (lane >> 5)) * 33 + (lane & 31)] = v[i];
            __builtin_amdgcn_wave_barrier(); asm volatile("s_waitcnt lgkmcnt(0)" ::: "memory");
            p0_tr_write_f8(cur.wt, D, cur.d0, cur.k0, scr, lane, F8S_W);
            asm volatile("s_waitcnt lgkmcnt(0)" ::: "memory"); __builtin_amdgcn_wave_barrier();
            cur = nxt;
#pragma unroll
            for (int i = 0; i < 32; ++i) v[i] = vn[i];
        }
    }
}
#define P2_MARK(id, wg) do { if (PROBE_P2 == (id) && (int)blockIdx.x == (wg) && threadIdx.x == 0) __hip_atomic_store((unsigned*)(P.ws + WS_CTL) + 201, (unsigned)__builtin_amdgcn_s_memrealtime(), RLX_AGENT); } while (0)
__device__ __forceinline__ void p0_wr2(const Ptrs& P, int gtid, int gthreads);
__device__ __forceinline__ void ph2_mix_fast(const Ptrs& P, LAS unsigned char* lds, unsigned char* lds_generic, int G) {
    const int bid = blockIdx.x;
    if (PROBE_P2 >= 0 && bid == 0 && threadIdx.x == 0) __hip_atomic_store((unsigned*)(P.ws + WS_CTL) + 200, (unsigned)__builtin_amdgcn_s_memrealtime(), RLX_AGENT);
    if (G >= 128) {
        if (bid < 64) { for (int rep = 0; rep < ((PROBE_REPEAT == 21) ? 2 : 1); ++rep) gla_item(P, lds, bid); }
        else {
            p0_wr2(P, (bid - 64) * NTHR + (int)threadIdx.x, (G - 64) * NTHR);
            if (P2_PRE_GRABS > 0 && bid - 64 + (G - 64) >= NB * 16) { moe_weight_items(P, lds_generic, 16, P2_PRE_GRABS); __syncthreads(); }
            for (int rep = 0; rep < ((PROBE_REPEAT == 20) ? 2 : 1); ++rep) for (int it = bid - 64; it < NB * 16; it += G - 64) sgu_item(P, lds, it); }
    } else {
        for (int it = bid; it < 64; it += G) gla_item(P, lds, it);
        for (int it = bid; it < NB * 16; it += G) sgu_item(P, lds, it);
    }
    __syncthreads();
    P2_MARK(0, 0); P2_MARK(1, 64); P2_MARK(5, 255);
    if (((PROBE_P2 == 11 && blockIdx.x < 64) || (PROBE_P2 == 12 && blockIdx.x >= 64)) && threadIdx.x == 0) atomicMax((unsigned*)(P.ws + WS_CTL) + 201, (unsigned)__builtin_amdgcn_s_memrealtime());
    if (((PROBE_P2 == 11 && blockIdx.x < 64) || (PROBE_P2 == 12 && blockIdx.x >= 64)) && threadIdx.x == 0) atomicMax((unsigned*)(P.ws + WS_CTL) + 201, (unsigned)__builtin_amdgcn_s_memrealtime());
    if (!PROBE_NOCONV) moe_weight_items(P, lds_generic, 16, 1 << 30);
    __syncthreads();
    P2_MARK(2, 64); P2_MARK(3, 255); P2_MARK(4, 0);
    if (((PROBE_P2 == 8 && blockIdx.x < 64) || (PROBE_P2 == 9 && blockIdx.x >= 64 && blockIdx.x < 128) || (PROBE_P2 == 10 && blockIdx.x >= 128) || PROBE_P2 == 7) && threadIdx.x == 0) atomicMax((unsigned*)(P.ws + WS_CTL) + 201, (unsigned)__builtin_amdgcn_s_memrealtime());
}

constexpr size_t WS_WR2 = WS_WSP + 256 * 1024;
__device__ __forceinline__ void p0_wr2(const Ptrs& P, int gtid, int gthreads) {
    v4u* WR2 = (v4u*)(P.ws + WS_WR2);
    for (int idx = gtid; idx < 32 * 2 * 2 * 64; idx += gthreads) { const int kb = idx >> 8, tl = (idx >> 7) & 1, hl = (idx >> 6) & 1, l = idx & 63, e = tl * 16 + (l & 15), k0 = 32 * kb + 8 * (l >> 4); unsigned hb[8];
#pragma unroll
        for (int j = 0; j < 8; ++j) { const float w = P.w_router[(size_t)(k0 + j) * NE + e] * P.norm_ffn_w[k0 + j]; const unsigned hi = f2bf(w); hb[j] = hl ? f2bf(w - bf2f(hi)) : hi; }
        WR2[idx] = (v4u){hb[0] | (hb[1] << 16), hb[2] | (hb[3] << 16), hb[4] | (hb[5] << 16), hb[6] | (hb[7] << 16)}; }
}
__device__ __forceinline__ bool rt_better(float va, int ia, float vb, int ib) { return va > vb || (va == vb && ia < ib); }
constexpr int R4_WRING = 1024 + 8 * (16 * 132 * 4) + 1024;
static_assert((R4_WRING % 1024) == 0 && R4_WRING + 3 * 16384 <= RING_BYTES && AUX_OFF + 16384 <= LDS_BYTES, "router lds");
__device__ __forceinline__ void ph4_router_fast(const Ptrs& P, LAS unsigned char* lds, int G) {
    const int tid = opaque_tid(), lane = tid & 63, wave = __builtin_amdgcn_readfirstlane(tid >> 6), tk = lane & 15, q = lane >> 4;
    unsigned* ctl = (unsigned*)(P.ws + WS_CTL);
    LAS unsigned* lcnt = (LAS unsigned*)lds; LAS unsigned* lbase = lcnt + 32;
    const f32x4* WR2 = (const f32x4*)(P.ws + WS_WR2);
    const int NGRP = T / 16, rounds = (NGRP + G * NWAVES - 1) / (G * NWAVES);
    for (int rd = 0; rd < rounds; ++rd) {
        if (tid < 32) lcnt[tid] = 0u;
        __syncthreads();
        const int grp = (rd * G + (int)blockIdx.x) * NWAVES + wave; const bool act = grp < NGRP;
        const int m0 = (act ? grp : 0) * 16;
        LAS float* xt = (LAS float*)(lds + 1024 + wave * (16 * 132 * 4)); LAS unsigned char* xtb = (LAS unsigned char*)xt;
        const int rg = lane >> 4, lc8 = (lane & 15) * 8;
        f32x4 d0 = {0.f, 0.f, 0.f, 0.f}, d1 = {0.f, 0.f, 0.f, 0.f}; float psq[4] = {0.f, 0.f, 0.f, 0.f};
#define R4_SLOT(sidx) ((sidx) < 3 ? R4_WRING + (sidx) * 16384 : AUX_OFF)
        const char* xb1 = (const char*)(P.ws + WS_X1B);
        const unsigned rowb = (unsigned)((m0 + rg) * D + lc8) * 2u;
#define R4_DMA_W(chx) do { const int cw_ = (chx) < 8 ? (chx) : 7; _Pragma("unroll") for (int i_ = 0; i_ < 2; ++i_) __builtin_amdgcn_global_load_lds((const unsigned*)((const char*)WR2 + (size_t)cw_ * 16384 + wave * 2048 + i_ * 1024 + lane * 16), \
            (LAS unsigned*)(lds + R4_SLOT((chx) & 3) + wave * 2048 + i_ * 1024), 16, 0, 0); asm volatile("" ::: "memory"); } while (0)
#define R4_LOAD_X(XS, chx) do { const int cx_ = (chx) < 8 ? (chx) : 7; _Pragma("unroll") for (int i = 0; i < 4; ++i) { unsigned o_ = rowb + (unsigned)i * (4u * D * 2u) + (unsigned)cx_ * 256u; asm volatile("" : "+v"(o_)); \
            XS[i] = *(const v4u*)(xb1 + o_); } asm volatile("" ::: "memory"); } while (0)
        v4u xs0[4], xs1[4], xs2[4], xs3[4];
        R4_LOAD_X(xs0, 0); R4_DMA_W(0); R4_LOAD_X(xs1, 1); R4_DMA_W(1); R4_LOAD_X(xs2, 2); R4_DMA_W(2); R4_LOAD_X(xs3, 3);
#define R4_CHUNK(ch, XC) do { \
            asm volatile("s_waitcnt vmcnt(16)" : "+v"(XC[0]), "+v"(XC[1]), "+v"(XC[2]), "+v"(XC[3]) :: "memory");     \
            LDS_BARRIER();                                            \
            R4_DMA_W((ch) + 3); \
            _Pragma("unroll") for (int i = 0; i < 4; ++i) { const unsigned rw_[4] = {XC[i].x, XC[i].y, XC[i].z, XC[i].w}; \
                const f32x4 xa_ = {bf2f(rw_[0] & 0xffffu), bf2f(rw_[0] >> 16), bf2f(rw_[1] & 0xffffu), bf2f(rw_[1] >> 16)}, xb_ = {bf2f(rw_[2] & 0xffffu), bf2f(rw_[2] >> 16), bf2f(rw_[3] & 0xffffu), bf2f(rw_[3] >> 16)}; \
                psq[i] += ((xa_[0] * xa_[0] + xa_[1] * xa_[1]) + (xa_[2] * xa_[2] + xa_[3] * xa_[3])) + ((xb_[0] * xb_[0] + xb_[1] * xb_[1]) + (xb_[2] * xb_[2] + xb_[3] * xb_[3])); \
                *(LAS v4u*)(xtb + (4 * i + rg) * 272 + lc8 * 2) = XC[i]; } \
            R4_LOAD_X(XC, (ch) + 4); \
            const LAS v4u* wsl = (const LAS v4u*)(lds + R4_SLOT((ch) & 3)); \
            _Pragma("unroll 2") for (int kb = 0; kb < 4; ++kb) { \
                const bf16x8 xf = *(const LAS bf16x8*)(xtb + tk * 272 + (32 * kb + 8 * q) * 2); \
                const bf16x8 w0h = __builtin_bit_cast(bf16x8, wsl[((kb * 2 + 0) * 2 + 0) * 64 + lane]), w0l = __builtin_bit_cast(bf16x8, wsl[((kb * 2 + 0) * 2 + 1) * 64 + lane]); \
                const bf16x8 w1h = __builtin_bit_cast(bf16x8, wsl[((kb * 2 + 1) * 2 + 0) * 64 + lane]), w1l = __builtin_bit_cast(bf16x8, wsl[((kb * 2 + 1) * 2 + 1) * 64 + lane]); \
                d0 = __builtin_amdgcn_mfma_f32_16x16x32_bf16(w0h, xf, d0, 0, 0, 0); d1 = __builtin_amdgcn_mfma_f32_16x16x32_bf16(w1h, xf, d1, 0, 0, 0); \
                d0 = __builtin_amdgcn_mfma_f32_16x16x32_bf16(w0l, xf, d0, 0, 0, 0); d1 = __builtin_amdgcn_mfma_f32_16x16x32_bf16(w1l, xf, d1, 0, 0, 0); } \
        } while (0)
#pragma nounroll
        for (int c4 = 0; c4 < 8; c4 += 4) { R4_CHUNK(c4, xs0); R4_CHUNK(c4 + 1, xs1); R4_CHUNK(c4 + 2, xs2); R4_CHUNK(c4 + 3, xs3); }
#undef R4_CHUNK
#undef R4_LOAD_X
        asm volatile("s_waitcnt vmcnt(0)" ::: "memory");
#undef R4_DMA_W
#undef R4_SLOT
#pragma unroll
        for (int i = 0; i < 4; ++i) { float v = psq[i]; v += dpp_f<0x111, 0xF>(v); v += dpp_f<0x112, 0xF>(v); v += dpp_f<0x114, 0xF>(v); v += dpp_f<0x118, 0xF>(v);
            if ((lane & 15) == 15) xt[4 * i + rg] = v; }
        float ssq = xt[tk];

        const float rstd = 1.0f / sqrtf(ssq * (1.f / D) + EPS);
        float cv[8]; int ci[8];
#pragma unroll
        for (int r = 0; r < 4; ++r) { cv[r] = d0[r] * rstd + P.b_router[4 * q + r]; ci[r] = 4 * q + r; cv[4 + r] = d1[r] * rstd + P.b_router[16 + 4 * q + r]; ci[4 + r] = 16 + 4 * q + r; }
        float sv[4]; int si[4];
#pragma unroll
        for (int r = 0; r < 4; ++r) { float bv = cv[0]; int bi = ci[0];
#pragma unroll
            for (int c = 1; c < 8; ++c) if (rt_better(cv[c], ci[c], bv, bi)) { bv = cv[c]; bi = ci[c]; }
            sv[r] = bv; si[r] = bi;
#pragma unroll
            for (int c = 0; c < 8; ++c) if (ci[c] == bi) cv[c] = -3.0e38f; }
#pragma unroll
        for (int off = 16; off <= 32; off <<= 1) {
            float ov[4]; int oi[4];
#pragma unroll
            for (int r = 0; r < 4; ++r) { ov[r] = __shfl_xor(sv[r], off); oi[r] = __shfl_xor(si[r], off); }
            float mv[8]; int mi[8];
#pragma unroll
            for (int r = 0; r < 4; ++r) { mv[r] = sv[r]; mi[r] = si[r]; mv[4 + r] = ov[r]; mi[4 + r] = oi[r]; }
#pragma unroll
            for (int r = 0; r < 4; ++r) { float bv = mv[0]; int bi = mi[0];
#pragma unroll
                for (int c = 1; c < 8; ++c) if (rt_better(mv[c], mi[c], bv, bi)) { bv = mv[c]; bi = mi[c]; }
                sv[r] = bv; si[r] = bi;
#pragma unroll
                for (int c = 0; c < 8; ++c) if (mi[c] == bi) mv[c] = -3.0e38f; }
        }
        float pw[4], den = 0.f;
#pragma unroll
        for (int r = 0; r < 4; ++r) { pw[r] = __expf(sv[r] - sv[0]); den += pw[r]; }
        int ee = si[0]; float ww = pw[0];
#pragma unroll
        for (int r = 1; r < 4; ++r) if (q == r) { ee = si[r]; ww = pw[r]; }
        ww /= den;
        unsigned lr = 0u;
        if (act) lr = __hip_atomic_fetch_add(lcnt + ee, 1u, __ATOMIC_RELAXED, __HIP_MEMORY_SCOPE_WORKGROUP);
        __syncthreads();
        if (tid < 32) lbase[tid] = __hip_atomic_fetch_add(ctl + CW_COUNTS + tid, lcnt[tid], RLX_AGENT);
        __syncthreads();
        if (act) { const unsigned rank = lbase[ee] + lr; const int m = m0 + tk;
            ((int*)(P.ws + WS_ROUTE + RT_ROWTOK))[(size_t)ee * T + rank] = m;
            ((float*)(P.ws + WS_ROUTE + RT_ROWW))[(size_t)ee * T + rank] = ww;
            ((int*)(P.ws + WS_ROUTE + RT_TOKSLOT))[(size_t)m * 4 + q] = (ee << 16) | (int)rank;
            ((float*)(P.ws + WS_RRSTD))[(size_t)ee * T + rank] = rstd; }
        __syncthreads();
    }
}

struct Args { Ptrs P; int ph_lo, ph_hi, li, pad; };

constexpr int P0_SCR = 8448, P0_WGL = 8 * P0_SCR, P0_WGLP = 2064, P0_HP = 2064;
static_assert(P0_WGL + 16 * P0_WGLP <= RING_BYTES && 4 * P0_HP <= P0_SCR, "p0 lds");
__device__ __forceinline__ void ph0_prep(const Ptrs& P, unsigned char* lds_generic, LAS unsigned char* lds, int vcu, int G) {
    const int tid = opaque_tid(), lane = tid & 63, wave = __builtin_amdgcn_readfirstlane(tid >> 6);
    float* scr = (float*)(lds_generic + wave * P0_SCR);
    const int gw = vcu * NWAVES + wave, NGW = G * NWAVES;
    for (int k = tid; k < D; k += NTHR) { const f32x4* src = (const f32x4*)(P.w_in + (size_t)k * NIN_SRC + 1536);
#pragma unroll
        for (int q4 = 0; q4 < 4; ++q4) { const f32x4 w = src[q4];
#pragma unroll
            for (int i = 0; i < 4; ++i) *(LAS unsigned short*)(lds + P0_WGL + (4 * q4 + i) * P0_WGLP + k * 2) = (unsigned short)f2bf(w[i]); } }
    for (int it = gw; it < IT_IN + IT_OUT; it += NGW) p0_weight_item(P, it, scr, lane);
    bf16* Wsp = (bf16*)(P.ws + WS_WSP);
    for (int i = blockIdx.x * NTHR + tid; i < 4 * 128 * 128; i += G * NTHR) { const int t = (i >> 7) & 127, s = i & 127; Wsp[i] = (bf16)f2bf(s <= t ? P.w_spatial[i] : 0.f); }
    if (G < 128) p0_wr2(P, blockIdx.x * NTHR + tid, G * NTHR);
    __syncthreads();
    bf16* H = (bf16*)(P.ws + WS_H); bf16* PROJ = (bf16*)(P.ws + WS_PROJ);
    LAS unsigned char* hst = lds + wave * P0_SCR;
    const int fr = lane & 15, fg = lane >> 4;
    f32x4 wmix[4];
#pragma unroll
    for (int j = 0; j < 4; ++j) wmix[j] = ((const f32x4*)P.norm_mix_w)[lane + 64 * j];
    for (int mb = gw; mb < T; mb += 4 * NGW) {
        f32x4 v[4][4];
#pragma unroll
        for (int t = 0; t < 4; ++t) { const int m = (mb + t * NGW < T) ? mb + t * NGW : mb;
#pragma unroll
            for (int j = 0; j < 4; ++j) v[t][j] = ((const f32x4*)(P.x + (size_t)m * D))[lane + 64 * j]; }
#pragma unroll
        for (int t = 0; t < 4; ++t) { const int m = (mb + t * NGW < T) ? mb + t * NGW : mb;
            float sq = 0.f;
#pragma unroll
            for (int j = 0; j < 4; ++j) sq += (v[t][j].x * v[t][j].x + v[t][j].y * v[t][j].y) + (v[t][j].z * v[t][j].z + v[t][j].w * v[t][j].w);
            const float rstd = 1.0f / sqrtf(wave_sum(sq) * (1.f / D) + EPS);
            unsigned long long* o8 = (unsigned long long*)(H + (size_t)m * D) + lane;
#pragma unroll
            for (int j = 0; j < 4; ++j) { const f32x4 ww = wmix[j];
                const unsigned long long hv = (unsigned long long)pk2(v[t][j].x * rstd * ww.x, v[t][j].y * rstd * ww.y) | ((unsigned long long)pk2(v[t][j].z * rstd * ww.z, v[t][j].w * rstd * ww.w) << 32);
                if (mb + t * NGW < T) { if (DENSE_FP8) ((unsigned*)((unsigned char*)H + (size_t)m * D))[lane + 64 * j] = pk4_fp8(v[t][j].x * rstd * ww.x * F8S_H, v[t][j].y * rstd * ww.y * F8S_H, v[t][j].z * rstd * ww.z * F8S_H, v[t][j].w * rstd * ww.w * F8S_H);
                                        else o8[64 * j] = hv; }
                *(LAS unsigned long long*)(hst + t * P0_HP + (lane + 64 * j) * 8) = hv; } }
        asm volatile("s_waitcnt lgkmcnt(0)" ::: "memory");
        f32x4 ga = {0.f, 0.f, 0.f, 0.f};
#pragma unroll 8
        for (int ks = 0; ks < 32; ++ks) { const bf16x8 af = *(const LAS bf16x8*)(hst + (fr & 3) * P0_HP + (32 * ks + 8 * fg) * 2), bfr = *(const LAS bf16x8*)(lds + P0_WGL + fr * P0_WGLP + (32 * ks + 8 * fg) * 2);
            ga = __builtin_amdgcn_mfma_f32_16x16x32_bf16(af, bfr, ga, 0, 0, 0); }
        asm volatile("s_waitcnt lgkmcnt(0)" ::: "memory");
        f32x4 go[4];
        const float gf0 = ga[0], gf1 = ga[1], gf2 = ga[2], gf3 = ga[3];
        int gi[4] = {__float_as_int(gf0), __float_as_int(gf1), __float_as_int(gf2), __float_as_int(gf3)};
#pragma unroll
        for (int t = 0; t < 4; ++t) go[t] = (f32x4){0.f, 0.f, 0.f, 0.f};
#pragma unroll
        for (int n = 0; n < 16; ++n) { const f32x4 wu = *(const f32x4*)(P.w_gk_up + n * 256 + 4 * lane);
#pragma unroll
            for (int t = 0; t < 4; ++t) { const float gl = __builtin_bit_cast(float, __builtin_amdgcn_readlane(gi[t], n)); go[t] += wu * gl; } }
#pragma unroll
        for (int t = 0; t < 4; ++t) if (mb + t * NGW < T) *(uint2*)(PROJ + (size_t)(mb + t * NGW) * NPROJ + PC_GK + 4 * lane) = make_uint2(pk2(go[t][0], go[t][1]), pk2(go[t][2], go[t][3]));
    }
}
__device__ __forceinline__ void moe_tables(const Ptrs& P, LAS int* tab) {
    const unsigned* ctl = (const unsigned*)(P.ws + WS_CTL);
    if (threadIdx.x < NE) tab[66 + threadIdx.x] = (int)__hip_atomic_load(ctl + CW_COUNTS + threadIdx.x, RLX_AGENT);
    __syncthreads();
    if (threadIdx.x == 0) { int a = 0; for (int e = 0; e < NE; ++e) { tab[e] = a; tab[33 + e] = a * MT; a += (tab[66 + e] + MT - 1) / MT; } tab[NE] = a; tab[33 + NE] = a * MT; }
    __syncthreads();
}
__device__ __forceinline__ void ph7_final(const Ptrs& P, const LAS int* tab, int G, volatile LAS unsigned* MISC) {
    const int tid = opaque_tid(), lane = tid & 63, wave = tid >> 6;
    const unsigned char* Y = (const unsigned char*)(P.ws + WS_YBUF);
    constexpr int TB = 2;
    const int stride = G * NWAVES;
    uint2 xb[2][TB][4]; int yv[2][TB][4][4];
#define FIN_LOAD(buf, mb_) do { if ((mb_) < T) _Pragma("unroll") for (int t = 0; t < TB; ++t) { const int m_ = ((mb_) + t * stride < T) ? (mb_) + t * stride : (T - 1); \
            const int4 ts_ = *(const int4*)((const int*)(P.ws + WS_ROUTE + RT_TOKSLOT) + (size_t)m_ * 4); const int pk_[4] = {ts_.x, ts_.y, ts_.z, ts_.w}; \
            const bf16* X1_ = (const bf16*)(P.ws + WS_X1B) + (size_t)m_ * D; \
            _Pragma("unroll") for (int j = 0; j < 4; ++j) xb[buf][t][j] = ((const uint2*)X1_)[lane + 64 * j]; \
            _Pragma("unroll") for (int r = 0; r < 4; ++r) { const size_t slot_ = (size_t)tab[33 + (pk_[r] >> 16)] + (pk_[r] & 0xffff); \
                _Pragma("unroll") for (int j = 0; j < 4; ++j) yv[buf][t][r][j] = ((const int*)(Y + slot_ * D))[lane + 64 * j]; } } } while (0)
#define FIN_DO(buf, mb_) do { _Pragma("unroll") for (int t = 0; t < TB; ++t) { const int m = (mb_) + t * stride; \
            if (m < T) { f32x4 v[4]; \
                _Pragma("unroll") for (int j = 0; j < 4; ++j) { v[j] = (f32x4){bf2f(xb[buf][t][j].x & 0xffffu), bf2f(xb[buf][t][j].x >> 16), bf2f(xb[buf][t][j].y & 0xffffu), bf2f(xb[buf][t][j].y >> 16)}; \
                    _Pragma("unroll") for (int r = 0; r < 4; ++r) { const auto lo = __builtin_amdgcn_cvt_pk_f32_fp8(yv[buf][t][r][j], false), hi = __builtin_amdgcn_cvt_pk_f32_fp8(yv[buf][t][r][j], true); \
                        v[j].x += lo[0] * (1.0f / F8S_Y); v[j].y += lo[1] * (1.0f / F8S_Y); v[j].z += hi[0] * (1.0f / F8S_Y); v[j].w += hi[1] * (1.0f / F8S_Y); } } \
                float s = 0.f; \
                _Pragma("unroll") for (int j = 0; j < 4; ++j) s += (v[j].x * v[j].x + v[j].y * v[j].y) + (v[j].z * v[j].z + v[j].w * v[j].w); \
                const float rstd = 1.0f / sqrtf(wave_sum(s) * (1.f / D) + EPS); \
                _Pragma("unroll") for (int j = 0; j < 4; ++j) { const f32x4 ww = ((const f32x4*)P.norm_final_w)[lane + 64 * j]; \
                    ((f32x4*)(P.out + (size_t)m * D))[lane + 64 * j] = (f32x4){v[j].x * rstd * ww.x, v[j].y * rstd * ww.y, v[j].z * rstd * ww.z, v[j].w * rstd * ww.w}; } \
                if (PROBE_STAMP >= 0 && PROBE_STAMP < 7 && m == 0 && lane == 0) { asm volatile("s_waitcnt vmcnt(0)" ::: "memory"); P.out[0] += ((float)(MISC[17] - MISC[16]) * 0.01f - (float)PROBE_BIAS) * 0.25f; } \
                if (PROBE_P2 >= 0 && m == 0 && lane == 0) { asm volatile("s_waitcnt vmcnt(0)" ::: "memory"); const unsigned* cw_ = (const unsigned*)(P.ws + WS_CTL); P.out[0] += (float)(__hip_atomic_load(cw_ + 201, RLX_AGENT) - __hip_atomic_load(cw_ + 200, RLX_AGENT)) * (0.01f / 4.0f) * (PROBE_NOCONV ? 1.0f : 1.0f); } } } } while (0)
    const int mb0 = blockIdx.x * NWAVES + wave;
    if (mb0 < T) {
        FIN_LOAD(0, mb0);
        for (int mb = mb0; mb < T; mb += 2 * TB * stride) {
            FIN_LOAD(1, mb + TB * stride);
            FIN_DO(0, mb);
            FIN_LOAD(0, mb + 2 * TB * stride);
            FIN_DO(1, mb + TB * stride);
        }
    }
#undef FIN_LOAD
#undef FIN_DO
}

constexpr int NPHASE = 8;
__global__ void __launch_bounds__(NTHR, 2) mk_fwd(Args args) {
    extern __shared__ __attribute__((aligned(16))) unsigned char lds_raw[];
    LAS unsigned char* lds = (LAS unsigned char*)lds_raw;
    const Ptrs& P = args.P;
    const int tid = threadIdx.x, G = gridDim.x;
    const int vcu = (G % 8 == 0) ? ((int)blockIdx.x % 8) * (G / 8) + (int)blockIdx.x / 8 : (int)blockIdx.x;
    volatile LAS unsigned* MISC = (volatile LAS unsigned*)(lds + MISC_OFF);
    LAS int* tab = (LAS int*)(lds + TAB_OFF);
    if (tid < 64) MISC[tid] = 0u;
    __syncthreads();
    unsigned* ctl = (unsigned*)(P.ws + WS_CTL);
    XcdBarrier bar = xcd_barrier_post(ctl + CW_BAR + args.li * XCD_BAR_WORDS, MISC + 8);
    const int lo = args.ph_lo, hi = args.ph_hi;
#define IN(k) (lo <= (k) && (k) < hi)
#define NREP(k) ((PROBE_REPEAT == (k)) ? 2 : 1)
#define PH(k, ...) if (IN(k)) { if (PROBE_STAMP == (k) && tid == 0) MISC[16] = (unsigned)__builtin_amdgcn_s_memrealtime(); \
        for (int rep = 0; rep < NREP(k); ++rep) { __VA_ARGS__; if (rep + 1 < NREP(k) || IN((k) + 1)) xcd_barrier(bar); } \
        if (PROBE_STAMP == (k) && tid == 0) MISC[17] = (unsigned)__builtin_amdgcn_s_memrealtime(); }
    PH(0, ph0_prep(P, lds_raw, lds, vcu, G));
    PH(1, { constexpr int KD = DENSE_FP8 ? D / 2 : D;
            pg8::DenseSched S; S.init(T, NPROJ, KD, G, (int)blockIdx.x, PC_GK / 256); pg8::EpiProj E{(bf16*)(P.ws + WS_PROJ)};
            pg8::gemm_phase<DENSE_FP8 != 0>(lds, lds + AUX_OFF, (const char*)(P.ws + WS_H), (const char*)(P.ws + WS_WIN), KD, S, E, PROBE_K2 == 1 ? 2 : 1);
            { const int nwg = (T / 256) * (NPROJ / 256 - 1), full = nwg / G, rem = nwg % G;
              if (rep == 0 && rem != 0 && (int)blockIdx.x >= rem && full > 0) { __syncthreads(); moe_weight_items(P, lds_raw, PROBE_REPEAT == 40 ? 8 : 4, 1); } } });
    PH(2, ph2_mix_fast(P, lds, lds_raw, G));
    PH(3, { constexpr int KO = OUT_FP8 ? D / 2 : D;
            pg8::DenseSched S; S.init(T, D, KO, G, (int)blockIdx.x); pg8::EpiX1 E{P.x, (bf16*)(P.ws + WS_X1B), (unsigned char*)(P.ws + WS_H), P.norm_ffn_w};
            pg8::gemm_phase<OUT_FP8 != 0>(lds, lds + AUX_OFF, (const char*)(P.ws + WS_MIX), (const char*)(P.ws + WS_WOUT), KO, S, E, PROBE_K2 == 3 ? 2 : 1); });
    PH(4, ph4_router_fast(P, lds, G));
    if (IN(5) || IN(6) || IN(7)) moe_tables(P, tab);
    constexpr int KM = MOE_FP8 ? D / 2 : D;
    PH(5, { pg8::MoeSched<true> S{tab, (const int*)(P.ws + WS_ROUTE + RT_ROWTOK), 8, G, (int)blockIdx.x, __builtin_amdgcn_readfirstlane(tab[NE]) * 8, KM, 2048};
            if (tid < 32) S.build(tab + 128, tid); __syncthreads();
            pg8::EpiAct E{(bf16*)(P.ws + WS_ACT), P.b_gate_up, (const float*)(P.ws + WS_RRSTD)};
            pg8::gemm_phase<MOE_FP8 != 0>(lds, lds + AUX_OFF, (const char*)(P.ws + WS_H), (const char*)(P.ws + WS_WGU), KM, S, E, PROBE_K2 == 5 ? 2 : 1); });
    PH(6, { pg8::MoeSched<false> S{tab, nullptr, 4, G, (int)blockIdx.x, __builtin_amdgcn_readfirstlane(tab[NE]) * 4, KM, 1024};
            if (tid < 32) S.build(tab + 128, tid); __syncthreads();
            pg8::EpiDown E{(bf16*)(P.ws + WS_YBUF), P.b_down, (const float*)(P.ws + WS_ROUTE + RT_ROWW)};
            pg8::gemm_phase<MOE_FP8 != 0>(lds, lds + AUX_OFF, (const char*)(P.ws + WS_ACT), (const char*)(P.ws + WS_WD), KM, S, E, PROBE_K2 == 6 ? 2 : 1); });
    PH(7, ph7_final(P, tab, G, MISC));
    if (PROBE_STAMP == 7 && IN(7)) {
        xcd_barrier(bar);
        if (blockIdx.x == 0 && tid == 0) { const unsigned t1 = (unsigned)__builtin_amdgcn_s_memrealtime(); P.out[0] += ((float)(t1 - MISC[16]) * 0.01f - (float)PROBE_BIAS) * 0.25f; }
    }
#undef IN
#undef NREP
#undef PH
}

#ifndef MK_SEGMENTS
#define MK_SEGMENTS 1
#endif
extern "C" void kernel_launch(void* const* d_in, const int* in_sizes, int n_in, void* d_out, int out_size, void* d_ws, size_t ws_size, hipStream_t stream) {
    if (n_in != 19 || out_size != T * D || ws_size < WS_END) { fprintf(stderr, "kernel_launch: unexpected shapes n_in %d out %d ws %zu (need %zu)\n", n_in, out_size, ws_size, (size_t)WS_END); return; }
    static int grid = 0;
    if (grid == 0) {
        int dev = 0, cus = 0, per_cu = 0;
        if (hipGetDevice(&dev) != hipSuccess || hipDeviceGetAttribute(&cus, hipDeviceAttributeMultiprocessorCount, dev) != hipSuccess) { fprintf(stderr, "kernel_launch: device query failed\n"); grid = -1; return; }
        if (hipFuncSetAttribute((const void*)mk_fwd, hipFuncAttributeMaxDynamicSharedMemorySize, LDS_BYTES) != hipSuccess) { fprintf(stderr, "kernel_launch: hipFuncSetAttribute failed\n"); grid = -1; return; }
        if (hipOccupancyMaxActiveBlocksPerMultiprocessor(&per_cu, (const void*)mk_fwd, NTHR, LDS_BYTES) != hipSuccess || per_cu < 1) { fprintf(stderr, "kernel_launch: occupancy query says %d\n", per_cu); per_cu = 1; }
        (void)hipGetLastError();
        grid = cus;
        fprintf(stderr, "kernel_launch: cus %d per_cu %d grid %d\n", cus, per_cu, grid);
    }
    if (grid < 0) return;
    Args a{};
    const float** pp = (const float**)&a.P;
    for (int i = 0; i < 19; ++i) pp[i] = (const float*)d_in[i];
    a.P.out = (float*)d_out; a.P.ws = (unsigned char*)d_ws;
    (void)hipMemsetAsync((char*)d_ws + WS_CTL, 0, MiB, stream);
#if MK_SEGMENTS == 1
    a.ph_lo = 0; a.ph_hi = NPHASE; a.li = 0;
    void* kargs[] = {&a};
    hipError_t e = hipLaunchCooperativeKernel((const void*)mk_fwd, dim3(grid), dim3(NTHR), kargs, LDS_BYTES, stream);
    if (e != hipSuccess) fprintf(stderr, "kernel_launch: cooperative launch failed: %s (grid %d)\n", hipGetErrorString(e), grid);
#else
    for (int ph = 0; ph < NPHASE; ++ph) { a.ph_lo = ph; a.ph_hi = ph + 1; a.li = ph; hipLaunchKernelGGL(mk_fwd, dim3(grid), dim3(NTHR), LDS_BYTES, stream, a); }
#endif
}
```
